# Optimizing an MI355X kernel written in HIP

```python
import jax
import jax.numpy as jnp
from jax import lax
import numpy as np

D_MODEL = 1024
BATCH = 2
SEQ = 16384
DEPTH = 2

GRID_W = 64
CTX_LEN = 256
HEAD_DIM = 64
ATT_WIDTH = D_MODEL // 2
ATT_HEADS = ATT_WIDTH // HEAD_DIM
LRU_WIDTH = D_MODEL // 2
LRU_BLOCKS = 8
LRU_BLOCK = LRU_WIDTH // LRU_BLOCKS
LRU_CONV = 4
LRU_PAD = (2, 1)
LRU_C = 8.0
IN_WIDTH_EVEN = 3 * ATT_WIDTH + 2 * LRU_WIDTH
WIN_ROWS_MAX = 8
WIN_COLS = 16
Q_ROWS = 2
SC_WIDTH = D_MODEL
SC_CONV = 3
SC_PAD = (1, 1)
FFN_HIDDEN = ((8 * D_MODEL + 3 * 256 - 1) // (3 * 256)) * 256
N_EVEN = (DEPTH + 1) // 2
N_ODD = DEPTH // 2
EPS = 1e-6

kernel_name = "hybrid_na_rglru_shortconv_dit"


def rmsnorm(x, g):
    xf = x.astype(jnp.float32)
    y = xf * lax.rsqrt(jnp.mean(xf * xf, axis=-1, keepdims=True) + EPS)
    return (y * g.astype(jnp.float32)).astype(x.dtype)


def adaln(cond, w, b):
    m = jax.nn.silu(cond) @ w + b
    return jnp.split(m[..., None, :], 6, axis=-1)


def modulate(x, shift, scale):
    return x * (1 + scale) + shift


def dwconv(x, w, pad):
    ch = x.shape[-1]
    return lax.conv_general_dilated(x, w[:, None, :].astype(x.dtype), window_strides=(1,),
                                    padding=[pad], dimension_numbers=("NWC", "WIO", "NWC"),
                                    feature_group_count=ch)


def swiglu(h, w_gu, w_down):
    gt, up = jnp.split(h @ w_gu, 2, axis=-1)
    return (jax.nn.silu(gt) * up) @ w_down


def linear_scan(a, b, h0, reverse):
    if reverse:
        b = b.at[:, -1].add(a[:, -1] * h0)
    else:
        b = b.at[:, 0].add(a[:, 0] * h0)

    def combine(l, r):
        return l[0] * r[0], r[0] * l[1] + r[1]

    _, h = lax.associative_scan(combine, (a, b), reverse=reverse, axis=1)
    return h


def rglru_coeffs(xc, w_r, b_r, w_i, b_i, lam):
    bsz, s, _ = xc.shape
    xb = xc.reshape(bsz, s, LRU_BLOCKS, LRU_BLOCK)
    f32 = jnp.float32
    r = jax.nn.sigmoid(jnp.einsum("bsgi,gij->bsgj", xb, w_r.astype(f32)).reshape(bsz, s, LRU_WIDTH) + b_r.astype(f32))
    i = jax.nn.sigmoid(jnp.einsum("bsgi,gij->bsgj", xb, w_i.astype(f32)).reshape(bsz, s, LRU_WIDTH) + b_i.astype(f32))
    log_a = -LRU_C * r * jax.nn.softplus(-lam.astype(f32))
    return jnp.exp(log_a), jnp.sqrt(-jnp.expm1(2.0 * log_a)) * (i * xc)


def bidir_rglru(xl, xc, w_r, b_r, w_i, b_i, lam, ctx_out):
    xl32 = xl.astype(jnp.float32)
    xc32 = xc.astype(jnp.float32)
    lat, con = [], []
    for d, rev in enumerate((False, True)):
        a_c, u_c = rglru_coeffs(xc32, w_r[d], b_r[d], w_i[d], b_i[d], lam[d])
        h_c = linear_scan(a_c, u_c, jnp.zeros_like(xc32[:, 0]), rev)
        h0 = h_c[:, 0] if rev else h_c[:, -1]
        a_l, u_l = rglru_coeffs(xl32, w_r[d], b_r[d], w_i[d], b_i[d], lam[d])
        lat.append(linear_scan(a_l, u_l, h0, rev))
        con.append(h_c)
    yl = (lat[0] + lat[1]).astype(xl.dtype)
    yc = (con[0] + con[1]).astype(xc.dtype) if ctx_out else None
    return yl, yc


def neighbourhood_attention(q, k, v, k_ctx, v_ctx, rpb):
    bsz, s, nh, dh = q.shape
    rows = s // GRID_W
    wr = min(WIN_ROWS_MAX, rows)
    qg = (q * (dh ** -0.5)).reshape(bsz, rows, GRID_W, nh, dh)
    kg = k.reshape(bsz, rows, GRID_W, nh, dh)
    vg = v.reshape(bsz, rows, GRID_W, nh, dh)
    row_start = jnp.clip(jnp.arange(rows) - wr // 2, 0, rows - wr)
    row_idx = row_start[:, None] + jnp.arange(wr)
    col_start = jnp.clip(jnp.arange(GRID_W) - WIN_COLS // 2, 0, GRID_W - WIN_COLS)
    col_idx = col_start[:, None] + jnp.arange(WIN_COLS)
    dc = col_idx - jnp.arange(GRID_W)[:, None] + (WIN_COLS - 1)
    n_keys_win = wr * WIN_COLS

    def block(i):
        r0 = i * Q_ROWS
        qb = lax.dynamic_slice_in_dim(qg, r0, Q_ROWS, axis=1)
        ridx = lax.dynamic_slice_in_dim(row_idx, r0, Q_ROWS, axis=0)
        kw = jnp.take(jnp.take(kg, ridx, axis=1), col_idx, axis=3)
        vw = jnp.take(jnp.take(vg, ridx, axis=1), col_idx, axis=3)
        dr = ridx - (r0 + jnp.arange(Q_ROWS))[:, None] + (WIN_ROWS_MAX - 1)
        bias = rpb[:, dr[:, None, :, None], dc[None, :, None, :]]
        s_win = jnp.einsum("bqjhd,bqrjchd->bhqjrc", qb, kw) + bias[None]
        s_ctx = jnp.einsum("bqjhd,bnhd->bhqjn", qb, k_ctx)
        logits = jnp.concatenate([s_win.reshape(s_win.shape[:4] + (n_keys_win,)), s_ctx], axis=-1)
        p = jax.nn.softmax(logits.astype(jnp.float32), axis=-1).astype(v.dtype)
        p_win = p[..., :n_keys_win].reshape(s_win.shape)
        p_ctx = p[..., n_keys_win:]
        return (jnp.einsum("bhqjrc,bqrjchd->bqjhd", p_win, vw)
                + jnp.einsum("bhqjn,bnhd->bqjhd", p_ctx, v_ctx))

    out = lax.map(block, jnp.arange(rows // Q_ROWS))
    return jnp.moveaxis(out, 0, 1).reshape(bsz, s, nh * dh)


def context_attention(q, k, v):
    s = jnp.einsum("bnhd,bmhd->bhnm", q, k) * (q.shape[-1] ** -0.5)
    p = jax.nn.softmax(s.astype(jnp.float32), axis=-1).astype(v.dtype)
    out = jnp.einsum("bhnm,bmhd->bnhd", p, v)
    return out.reshape(out.shape[0], out.shape[1], -1)


def hybrid_mixer(hl, hc, w_in, w_out, conv_w, conv_b, lru_wr, lru_br, lru_wi, lru_bi, lru_lam, rpb, ctx_out):
    splits = [ATT_WIDTH, 2 * ATT_WIDTH, 3 * ATT_WIDTH, 3 * ATT_WIDTH + LRU_WIDTH]

    def heads(t):
        return t.reshape(t.shape[0], t.shape[1], ATT_HEADS, HEAD_DIM)

    q, k, v, xr, gr = jnp.split(hl @ w_in, splits, axis=-1)
    w_q, w_k, w_v, w_x, w_g = jnp.split(w_in, splits, axis=1)
    kc, vc = heads(hc @ w_k), heads(hc @ w_v)
    att = neighbourhood_attention(heads(q), heads(k), heads(v), kc, vc, rpb)
    xr = dwconv(xr, conv_w, LRU_PAD) + conv_b
    xc = dwconv(hc @ w_x, conv_w, LRU_PAD) + conv_b
    rec, rec_c = bidir_rglru(xr, xc, lru_wr, lru_br, lru_wi, lru_bi, lru_lam, ctx_out)
    y = jnp.concatenate([att, rec * jax.nn.gelu(gr)], axis=-1) @ w_out
    if not ctx_out:
        return y, None
    att_c = context_attention(heads(hc @ w_q), kc, vc)
    yc = jnp.concatenate([att_c, rec_c * jax.nn.gelu(hc @ w_g)], axis=-1) @ w_out
    return y, yc


def short_conv_mixer(h, w_in, w_conv, w_out):
    bg, cg, xv = jnp.split(h @ w_in, 3, axis=-1)
    return (bg * dwconv(cg * xv, w_conv, SC_PAD)) @ w_out


def setup_inputs(seed: int = 0) -> dict:
    key = jax.random.key(seed)
    ks = iter(jax.random.split(key, 32))
    D = D_MODEL
    f32 = jnp.float32

    def nrm(shape, s):
        return s * jax.random.normal(next(ks), shape, f32)

    u = jax.random.uniform(next(ks), (N_EVEN, 2, LRU_WIDTH), f32, minval=0.9, maxval=0.999)
    p = u ** (1.0 / LRU_C)
    lam = jnp.log(p) - jnp.log1p(-p)
    return {
        "x": nrm((BATCH, SEQ, D), 1.0),
        "c": nrm((BATCH, D), 1.0),
        "ctx": nrm((BATCH, CTX_LEN, D), 1.0),
        "c_ctx": nrm((D,), 1.0),
        "mod_w": nrm((DEPTH, D, 6 * D), D ** -0.5),
        "mod_b": nrm((DEPTH, 6 * D), 0.02),
        "norm1_g": 1.0 + nrm((DEPTH, D), 0.05),
        "norm2_g": 1.0 + nrm((DEPTH, D), 0.05),
        "ffn_w_gu": nrm((DEPTH, D, 2 * FFN_HIDDEN), D ** -0.5),
        "ffn_w_down": nrm((DEPTH, FFN_HIDDEN, D), FFN_HIDDEN ** -0.5),
        "e_w_in": nrm((N_EVEN, D, IN_WIDTH_EVEN), D ** -0.5),
        "e_w_out": nrm((N_EVEN, ATT_WIDTH + LRU_WIDTH, D), (ATT_WIDTH + LRU_WIDTH) ** -0.5),
        "e_conv_w": nrm((N_EVEN, LRU_CONV, LRU_WIDTH), LRU_CONV ** -0.5),
        "e_conv_b": nrm((N_EVEN, LRU_WIDTH), 0.02),
        "e_lru_wr": nrm((N_EVEN, 2, LRU_BLOCKS, LRU_BLOCK, LRU_BLOCK), LRU_BLOCK ** -0.5),
        "e_lru_br": nrm((N_EVEN, 2, LRU_WIDTH), 0.02),
        "e_lru_wi": nrm((N_EVEN, 2, LRU_BLOCKS, LRU_BLOCK, LRU_BLOCK), LRU_BLOCK ** -0.5),
        "e_lru_bi": nrm((N_EVEN, 2, LRU_WIDTH), 0.02),
        "e_lru_lam": lam,
        "e_rpb": nrm((N_EVEN, ATT_HEADS, 2 * WIN_ROWS_MAX - 1, 2 * WIN_COLS - 1), 0.1),
        "o_w_in": nrm((N_ODD, D, 3 * SC_WIDTH), D ** -0.5),
        "o_conv_w": nrm((N_ODD, SC_CONV, SC_WIDTH), SC_CONV ** -0.5),
        "o_w_out": nrm((N_ODD, SC_WIDTH, D), SC_WIDTH ** -0.5),
        "final_g": 1.0 + nrm((D,), 0.05),
    }


def reference(x, c, ctx, c_ctx, mod_w, mod_b, norm1_g, norm2_g, ffn_w_gu, ffn_w_down,
              e_w_in, e_w_out, e_conv_w, e_conv_b, e_lru_wr, e_lru_br, e_lru_wi, e_lru_bi,
              e_lru_lam, e_rpb, o_w_in, o_conv_w, o_w_out, final_g):
    h, hc = x, ctx
    for l in range(DEPTH):
        even = l % 2 == 0
        ctx_out = any(j % 2 == 0 for j in range(l + 1, DEPTH))
        sh1, sc1, g1, sh2, sc2, g2 = adaln(c, mod_w[l], mod_b[l])
        n_lat = modulate(rmsnorm(h, norm1_g[l]), sh1, sc1)
        if even or ctx_out:
            csh1, csc1, cg1, csh2, csc2, cg2 = adaln(c_ctx, mod_w[l], mod_b[l])
            n_ctx = modulate(rmsnorm(hc, norm1_g[l]), csh1, csc1)
        if even:
            e = l // 2
            y, yc = hybrid_mixer(n_lat, n_ctx, e_w_in[e], e_w_out[e], e_conv_w[e], e_conv_b[e],
                                 e_lru_wr[e], e_lru_br[e], e_lru_wi[e], e_lru_bi[e], e_lru_lam[e],
                                 e_rpb[e], ctx_out)
        else:
            o = l // 2
            y = short_conv_mixer(n_lat, o_w_in[o], o_conv_w[o], o_w_out[o])
            yc = short_conv_mixer(n_ctx, o_w_in[o], o_conv_w[o], o_w_out[o]) if ctx_out else None
        h = h + g1 * y
        h = h + g2 * swiglu(modulate(rmsnorm(h, norm2_g[l]), sh2, sc2), ffn_w_gu[l], ffn_w_down[l])
        if ctx_out:
            hc = hc + cg1 * yc
            hc = hc + cg2 * swiglu(modulate(rmsnorm(hc, norm2_g[l]), csh2, csc2), ffn_w_gu[l], ffn_w_down[l])
    return rmsnorm(h, final_g)
```

```cpp
#include <hip/hip_runtime.h>
#include <cstdio>
#include <cstdint>
#include <type_traits>

#ifndef PROBE_REP_MASK
#define PROBE_REP_MASK 0
#endif
#ifndef MK_PER_PHASE
#define MK_PER_PHASE 0
#endif

#define GAS __attribute__((address_space(1)))
#define LAS __attribute__((address_space(3)))
typedef unsigned short bf16_t;
typedef short bf16x8 __attribute__((ext_vector_type(8)));
typedef short s16x4 __attribute__((ext_vector_type(4)));
typedef float f32x4 __attribute__((ext_vector_type(4)));
typedef float f32x2 __attribute__((ext_vector_type(2)));
typedef float f32x16 __attribute__((ext_vector_type(16)));
typedef unsigned u32x4 __attribute__((ext_vector_type(4)));
typedef unsigned u32x2 __attribute__((ext_vector_type(2)));

constexpr int D = 1024, NB = 2, SEQ = 16384, ML = NB * SEQ, NCTX = 256, MC = NB * NCTX, MT = ML + MC;
constexpr int NIN0 = 2560, FF = 2816, NGU = 2 * FF, NIN1 = 3072;
constexpr int NCHUNK = 128, CHUNK = SEQ / NCHUNK  , NCI = NCHUNK + 2;
constexpr float EPS = 1e-6f;
constexpr float LOG2E = 1.4426950408889634f;
constexpr float QSCALE = 0.125f * LOG2E;
enum { I_X = 0, I_C, I_CTX, I_CCTX, I_MODW, I_MODB, I_N1G, I_N2G, I_WGU, I_WDN, I_EWIN, I_EWOUT, I_ECW, I_ECB, I_LWR, I_LBR, I_LWI, I_LBI, I_LAM, I_RPB, I_OWIN, I_OCW, I_OWOUT, I_FG, N_IN };

constexpr size_t MiB = 1u << 20;
constexpr size_t WS_CTL = 0, CTL_ZERO_BYTES = 1 * MiB + 160 * 1024;
constexpr size_t WS_SSQ = 256 * 1024;
constexpr size_t WS_B_IN0 = 768 * 1024;
constexpr size_t WS_B_GU0 = WS_B_IN0 + 3 * 2560 * 4;
constexpr size_t WS_B_IN1 = WS_B_GU0 + 2 * 5632 * 4;
constexpr size_t WS_B_GU1 = WS_B_IN1 + 2 * 3072 * 4;
static_assert(WS_B_GU1 + 2 * 5632 * 4 <= 1024 * 1024, "zeroed region");
constexpr size_t WS_MODS = 1 * MiB;
constexpr size_t WS_SS0 = WS_MODS + 160 * 1024;
constexpr size_t WS_BP_IN0 = WS_SS0 + 136 * 1024;
constexpr size_t WS_BP_GU0 = WS_BP_IN0 + 128 * 1024;
constexpr size_t WS_BP_IN1 = WS_BP_GU0 + 192 * 1024;
constexpr size_t WS_BP_GU1 = WS_BP_IN1 + 128 * 1024;
static_assert(WS_BP_GU1 + 192 * 1024 <= 4 * MiB, "small map");
constexpr size_t WS_TOT = 4 * MiB;
constexpr size_t WS_TOTG = 6 * MiB;
constexpr size_t WS_TOTC = 6 * MiB + 256 * 1024;
constexpr size_t WS_LRUW = 6 * MiB + 512 * 1024;
constexpr size_t WS_WIN0 = 8 * MiB;
constexpr size_t WS_WOUT0 = 23 * MiB;
constexpr size_t WS_WGU0 = 25 * MiB;
constexpr size_t WS_WDN0 = 47 * MiB;
constexpr size_t WS_WIN1 = 53 * MiB;
constexpr size_t WS_WOUT1 = 65 * MiB;
constexpr size_t WS_WGU1 = 67 * MiB;
constexpr size_t WS_WDN1 = 89 * MiB;
constexpr size_t WS_A1 = 96 * MiB;
constexpr size_t WS_A2 = 161 * MiB;
constexpr size_t WS_A3 = 225 * MiB;
constexpr size_t WS_BIG = 289 * MiB;
constexpr size_t WS_XCONV = 465 * MiB;
constexpr size_t WS_END = 498 * MiB;

constexpr int CW_BAR = 4096;
constexpr int CW_MODS = 3968;
constexpr int CW_PCNT = 16384;

constexpr int RING_BYTES = 131072, LDS_BYTES = 163840, LDSCTL_OFF = LDS_BYTES - 1024, MISC_OFF = LDSCTL_OFF + 320;

#define LDS_WAIT() asm volatile("s_waitcnt lgkmcnt(0)" ::: "memory")
#define VM_WAIT() asm volatile("s_waitcnt vmcnt(0)" ::: "memory")
#define RLX_AGENT __ATOMIC_RELAXED, __HIP_MEMORY_SCOPE_AGENT
__device__ __forceinline__ unsigned pk2(float lo, float hi) { unsigned r; asm("v_cvt_pk_bf16_f32 %0, %1, %2" : "=v"(r) : "v"(lo), "v"(hi)); return r; }
__device__ __forceinline__ unsigned f2bf(float f) { return pk2(f, f) & 0xffffu; }
__device__ __forceinline__ float bflo(unsigned u) { return __builtin_bit_cast(float, u << 16); }
__device__ __forceinline__ float bfhi(unsigned u) { return __builtin_bit_cast(float, u & 0xffff0000u); }
__device__ __forceinline__ float bf1(bf16_t h) { return __builtin_bit_cast(float, (unsigned)h << 16); }
__device__ __forceinline__ float wave_sum(float v) {
#pragma unroll
    for (int o = 1; o < 64; o <<= 1) v += __shfl_xor(v, o);
    return v;
}
__device__ __forceinline__ float fast_rsq(float x) { return __builtin_amdgcn_rsqf(x); }
__device__ __forceinline__ float fast_exp2(float x) { return __builtin_amdgcn_exp2f(x); }
__device__ __forceinline__ float fast_rcp(float x) { return __builtin_amdgcn_rcpf(x); }
__device__ __forceinline__ float sigmoidf_(float x) { return fast_rcp(1.f + fast_exp2(-x * LOG2E)); }
__device__ __forceinline__ float siluf_(float x) { return x * sigmoidf_(x); }
__device__ __forceinline__ float gelu_tanh(float x) {
    constexpr float C1 = -2.f * 0.7978845608028654f * LOG2E, C2 = C1 * 0.044715f;
    const float t = x * (C1 + C2 * (x * x));
    return x * fast_rcp(1.f + fast_exp2(t));
}

__device__ __forceinline__ float sum_fq(float q) {
    const auto a = __builtin_amdgcn_permlane32_swap(__float_as_uint(q), __float_as_uint(q), false, false);
    const float s = __uint_as_float(a[0]) + __uint_as_float(a[1]);
    const auto b = __builtin_amdgcn_permlane16_swap(__float_as_uint(s), __float_as_uint(s), false, false);
    return __uint_as_float(b[0]) + __uint_as_float(b[1]);
}
__device__ __forceinline__ void st16_wt(void* p, u32x4 v) { asm volatile("global_store_dwordx4 %0, %1, off sc1\n\ts_nop 1" :: "v"(p), "v"(v) : "memory"); }
namespace pg8 {
constexpr int BM = 256, BK = 64, HALF = 128, HTB = HALF * BK * 2, STAGE_BYTES = 8 * HTB, NXCD = 8, WGM = 8;
__host__ __device__ __forceinline__ int lds_byte(int r, int c) { const int st = (r >> 4) * 2 + (c >> 5), rr = r & 15, cc = c & 31, ob = rr * 64 + cc * 2; return st * 1024 + (ob ^ (((ob >> 9) & 1) << 5)); }
__host__ __device__ __forceinline__ void stage_rc(int b, int& R, int& C) { const int st = b / 1024, sb = b % 1024, swz = sb ^ (((sb >> 9) & 1) << 5); R = (st >> 1) * 16 + swz / 64; C = (st & 1) * 32 + (swz % 64) / 2; }
__host__ __device__ __forceinline__ int perm32(int rho) { const int n = rho >> 4, i = rho & 15; return 8 * (i >> 2) + 4 * n + (i & 3); }

struct Unit { int pm, pn; bool last; };
#define PG8_ST16(u_, ptr, w) do { if ((u_).last) st16_wt((ptr), (w)); else *(u32x4*)(ptr) = (w); } while (0)
struct Gemm { const bf16_t* A; const bf16_t* Bt; long boff1, boff2; int K; };
__device__ __forceinline__ const char* bsel(const bf16_t* Bt, long boff1, long boff2, const Unit& u) { const long o = u.pm < 64 ? 0l : (u.pm < 128 ? boff1 : boff2); return (const char*)(Bt + o); }

struct Order {
    int nM, nN, nwg, G, c, nextra, xpm0, xpn0, xnpn, pn_off = 0;
    __device__ void init(int nM_, int nN_, int G_, int c_, int nextra_ = 0, int xpm0_ = 0, int xpn0_ = 0, int xnpn_ = 1) { nM = nM_; nN = nN_; nwg = nM * nN; G = G_; c = c_; nextra = nextra_; xpm0 = xpm0_; xpn0 = xpn0_; xnpn = xnpn_; }
    __device__ bool next(int i, Unit& u) const {
        const long L = (long)i * G + c;
        if (L >= nwg) { const int e = (int)(L - nwg); if (e >= nextra) return false; u.pm = xpm0 + e / xnpn; u.pn = xpn0 + e % xnpn; return true; }
        int wgid = (int)L; { const int q = nwg / NXCD, r = nwg % NXCD, xcd = wgid % NXCD, off = wgid / NXCD; wgid = (xcd < r ? xcd * (q + 1) : r * (q + 1) + (xcd - r) * q) + off; }
        const int nig = WGM * nN, gid = wgid / nig, fm = gid * WGM, gsz = (nM - fm) < WGM ? (nM - fm) : WGM;
        u.pm = fm + ((wgid % nig) % gsz); u.pn = (wgid % nig) / gsz + pn_off; return true;
    }
};

__device__ __forceinline__ unsigned cvt_pk_bf16(float lo, float hi) { return pk2(lo, hi); }


struct EpiPre { f32x4 bv[2][2]; float ssr[2][4]; };
struct EpiInProj {
    static constexpr bool PERM = true; static constexpr bool IDEMP = true;
    typedef EpiPre Pre;
    bf16_t* O; const float* ss; const float* bias;
    __device__ __forceinline__ void prefetch(const Unit& u, int wr, int wc, int fr, int fq, Pre& p) const {
        const int row0 = u.pm * BM + wr * 64 + fr, col0 = u.pn * BM + wc * 32 + 8 * fq;
        const int v = u.pm < 64 ? 0 : (u.pm < 128 ? 1 : 2);
        const float* bp = bias + (size_t)v * NIN0 + col0;
#pragma unroll
        for (int bj = 0; bj < 2; ++bj)
#pragma unroll
            for (int n = 0; n < 2; ++n) p.bv[bj][n] = *(const f32x4*)(bp + bj * HALF + 4 * n);
#pragma unroll
        for (int ai = 0; ai < 2; ++ai)
#pragma unroll
            for (int m = 0; m < 4; ++m) p.ssr[ai][m] = ss[row0 + ai * HALF + m * 16];
    }
    __device__ __forceinline__ void operator()(const f32x4 (&acc)[2][2][4][2], const Unit& u, const Pre& p, int wr, int wc, int fr, int fq) const {
        const int row0 = u.pm * BM + wr * 64 + fr, col0 = u.pn * BM + wc * 32 + 8 * fq;
#pragma unroll
        for (int ai = 0; ai < 2; ++ai)
#pragma unroll
            for (int m = 0; m < 4; ++m) { const int row = row0 + ai * HALF + m * 16; const float rs = fast_rsq(p.ssr[ai][m] * (1.f / D) + EPS); bf16_t* rowp = O + (size_t)row * NIN0 + col0;
#pragma unroll
                for (int bj = 0; bj < 2; ++bj) { const f32x4 v0 = acc[ai][bj][m][0] * rs + p.bv[bj][0], v1 = acc[ai][bj][m][1] * rs + p.bv[bj][1];
                    u32x4 w; w.x = cvt_pk_bf16(v0[0], v0[1]); w.y = cvt_pk_bf16(v0[2], v0[3]); w.z = cvt_pk_bf16(v1[0], v1[1]); w.w = cvt_pk_bf16(v1[2], v1[3]);
                    PG8_ST16(u, rowp + bj * HALF, w); } }
    }
};

__device__ __forceinline__ void tile_row_ssq(const float (&qv)[2][4], unsigned Paddr, float* ssq_panel, int wr, int wc, int fr, int fq) {
    if (fq == 0) {
#pragma unroll
        for (int ai = 0; ai < 2; ++ai)
#pragma unroll
            for (int m = 0; m < 4; ++m) { const unsigned a_ = Paddr + (unsigned)(((ai * HALF + wr * 64 + m * 16 + fr) * 4 + wc) * 4); asm volatile("ds_write_b32 %0, %1" :: "v"(a_), "v"(qv[ai][m]) : "memory"); }
    }
    asm volatile("s_waitcnt lgkmcnt(0)" ::: "memory"); __builtin_amdgcn_s_barrier(); asm volatile("" ::: "memory");
    if (threadIdx.x < 256) { f32x4 v; const unsigned a_ = Paddr + threadIdx.x * 16u;
        asm volatile("ds_read_b128 %0, %1\n\ts_waitcnt lgkmcnt(0)" : "=v"(v) : "v"(a_) : "memory");
        unsafeAtomicAdd(ssq_panel + threadIdx.x, (v[0] + v[1]) + (v[2] + v[3])); }
}
struct EpiPreG { f32x4 gv[2][2]; };
template <bool RES_F32, bool OUT_F32> struct EpiRes {
    static constexpr bool PERM = true; static constexpr bool IDEMP = false;
    typedef EpiPreG Pre;
    const float* resf; const bf16_t* resb; bf16_t* Ob; float* Of; const float* gate; float* ssq; unsigned Paddr;
    __device__ __forceinline__ void prefetch(const Unit& u, int wr, int wc, int fr, int fq, Pre& p) const {
        const float* gp = gate + (size_t)(u.pm >> 6) * 6144 + u.pn * BM + wc * 32 + 8 * fq;
#pragma unroll
        for (int bj = 0; bj < 2; ++bj)
#pragma unroll
            for (int n = 0; n < 2; ++n) p.gv[bj][n] = *(const f32x4*)(gp + bj * HALF + 4 * n);
    }
    __device__ __forceinline__ void operator()(const f32x4 (&acc)[2][2][4][2], const Unit& u, const Pre& p, int wr, int wc, int fr, int fq) const {
        const int row0 = u.pm * BM + wr * 64 + fr, col0 = u.pn * BM + wc * 32 + 8 * fq;
        float qv[2][4];
#pragma unroll
        for (int ai = 0; ai < 2; ++ai) {
            f32x4 rf[RES_F32 ? 4 : 1][2][2]; u32x4 rb[1][RES_F32 ? 1 : 4][2];
#pragma unroll
            for (int m = 0; m < 4; ++m) { const size_t off = (size_t)(row0 + ai * HALF + m * 16) * D + col0;
#pragma unroll
                for (int bj = 0; bj < 2; ++bj) {
                    if constexpr (RES_F32) { rf[m][bj][0] = *(const f32x4*)(resf + off + bj * HALF); rf[m][bj][1] = *(const f32x4*)(resf + off + bj * HALF + 4); }
                    else rb[0][m][bj] = *(const u32x4*)(resb + off + bj * HALF); } }
#pragma unroll
            for (int m = 0; m < 4; ++m) { const int row = row0 + ai * HALF + m * 16; const size_t off = (size_t)row * D + col0; float q = 0.f;
#pragma unroll
                for (int bj = 0; bj < 2; ++bj) {
                    f32x4 r0, r1;
                    if constexpr (RES_F32) { r0 = rf[m][bj][0]; r1 = rf[m][bj][1]; }
                    else { const u32x4 t = rb[0][m][bj]; r0 = (f32x4){bflo(t.x), bfhi(t.x), bflo(t.y), bfhi(t.y)}; r1 = (f32x4){bflo(t.z), bfhi(t.z), bflo(t.w), bfhi(t.w)}; }
                    const f32x4 v0 = r0 + p.gv[bj][0] * acc[ai][bj][m][0], v1 = r1 + p.gv[bj][1] * acc[ai][bj][m][1];
                    q += (v0[0] * v0[0] + v0[1] * v0[1]) + (v0[2] * v0[2] + v0[3] * v0[3]) + (v1[0] * v1[0] + v1[1] * v1[1]) + (v1[2] * v1[2] + v1[3] * v1[3]);
                    if constexpr (OUT_F32) { *(f32x4*)(Of + off + bj * HALF) = v0; *(f32x4*)(Of + off + bj * HALF + 4) = v1; }
                    else { u32x4 w; w.x = cvt_pk_bf16(v0[0], v0[1]); w.y = cvt_pk_bf16(v0[2], v0[3]); w.z = cvt_pk_bf16(v1[0], v1[1]); w.w = cvt_pk_bf16(v1[2], v1[3]); PG8_ST16(u, Ob + off + bj * HALF, w); }
                }
                q = sum_fq(q);
                qv[ai][m] = q; }
        }
        tile_row_ssq(qv, Paddr, ssq + u.pm * BM, wr, wc, fr, fq);
    }
};

struct EpiFinal {
    static constexpr bool PERM = true; static constexpr bool IDEMP = false;
    typedef EpiPreG Pre;
    const bf16_t* resb; float* Of; const float* gate; float* ssq; unsigned* pcnt; const float* fg; unsigned Paddr;
    __device__ __forceinline__ void prefetch(const Unit& u, int wr, int wc, int fr, int fq, Pre& p) const {
        const float* gp = gate + (size_t)(u.pm >> 6) * 6144 + u.pn * BM + wc * 32 + 8 * fq;
#pragma unroll
        for (int bj = 0; bj < 2; ++bj)
#pragma unroll
            for (int n = 0; n < 2; ++n) p.gv[bj][n] = *(const f32x4*)(gp + bj * HALF + 4 * n);
    }
    __device__ __forceinline__ void operator()(f32x4 (&acc)[2][2][4][2], const Unit& u, const Pre& p, int wr, int wc, int fr, int fq) const {
        const int row0 = u.pm * BM + wr * 64 + fr, col0 = u.pn * BM + wc * 32 + 8 * fq;
        float qv[2][4];
#pragma unroll
        for (int ai = 0; ai < 2; ++ai) {
            u32x4 rb[4][2];
#pragma unroll
            for (int m = 0; m < 4; ++m) { const size_t off = (size_t)(row0 + ai * HALF + m * 16) * D + col0;
#pragma unroll
                for (int bj = 0; bj < 2; ++bj) rb[m][bj] = *(const u32x4*)(resb + off + bj * HALF); }
#pragma unroll
            for (int m = 0; m < 4; ++m) { const int row = row0 + ai * HALF + m * 16; float q = 0.f;
#pragma unroll
                for (int bj = 0; bj < 2; ++bj) {
                    const u32x4 t = rb[m][bj]; const f32x4 r0 = (f32x4){bflo(t.x), bfhi(t.x), bflo(t.y), bfhi(t.y)}, r1 = (f32x4){bflo(t.z), bfhi(t.z), bflo(t.w), bfhi(t.w)};
                    const f32x4 v0 = r0 + p.gv[bj][0] * acc[ai][bj][m][0], v1 = r1 + p.gv[bj][1] * acc[ai][bj][m][1];
                    q += (v0[0] * v0[0] + v0[1] * v0[1]) + (v0[2] * v0[2] + v0[3] * v0[3]) + (v1[0] * v1[0] + v1[1] * v1[1]) + (v1[2] * v1[2] + v1[3] * v1[3]);
                    acc[ai][bj][m][0] = v0; acc[ai][bj][m][1] = v1;
                }
                q = sum_fq(q);
                qv[ai][m] = q; }
        }
        tile_row_ssq(qv, Paddr, ssq + u.pm * BM, wr, wc, fr, fq);
        asm volatile("s_waitcnt vmcnt(0)" ::: "memory");
        __syncthreads();
        if (threadIdx.x == 0) {
            unsigned* pc = pcnt + 64 * u.pm;
            (void)__hip_atomic_fetch_add(pc, 1u, __ATOMIC_RELAXED, __HIP_MEMORY_SCOPE_AGENT);
            unsigned sp = 0;
            while (__hip_atomic_load(pc, __ATOMIC_RELAXED, __HIP_MEMORY_SCOPE_AGENT) < 4u) { __builtin_amdgcn_s_sleep(1); if (++sp > (1u << 22)) break; }
        }
        __syncthreads();
        f32x4 fv[2][2];
#pragma unroll
        for (int bj = 0; bj < 2; ++bj)
#pragma unroll
            for (int n = 0; n < 2; ++n) fv[bj][n] = *(const f32x4*)(fg + col0 + bj * HALF + 4 * n);
        float ssv[2][4];
#pragma unroll
        for (int ai = 0; ai < 2; ++ai)
#pragma unroll
            for (int m = 0; m < 4; ++m) ssv[ai][m] = __hip_atomic_load(ssq + row0 + ai * HALF + m * 16, __ATOMIC_RELAXED, __HIP_MEMORY_SCOPE_AGENT);
#pragma unroll
        for (int ai = 0; ai < 2; ++ai)
#pragma unroll
            for (int m = 0; m < 4; ++m) { const float rs = fast_rsq(ssv[ai][m] * (1.f / D) + EPS); const size_t off = (size_t)(row0 + ai * HALF + m * 16) * D + col0;
#pragma unroll
                for (int bj = 0; bj < 2; ++bj) { *(f32x4*)(Of + off + bj * HALF) = acc[ai][bj][m][0] * rs * fv[bj][0]; *(f32x4*)(Of + off + bj * HALF + 4) = acc[ai][bj][m][1] * rs * fv[bj][1]; } }
    }
};

struct EpiSwiGLU {
    static constexpr bool PERM = true; static constexpr bool IDEMP = true;
    typedef EpiPre Pre;
    bf16_t* O; const float* ss; const float* bias;
    __device__ __forceinline__ void prefetch(const Unit& u, int wr, int wc, int fr, int fq, Pre& p) const {
        const int row0 = u.pm * BM + wr * 64 + fr, colw = u.pn * BM + wc * 32 + 8 * fq;
        const float* bp = bias + (size_t)(u.pm >> 6) * NGU + colw;
#pragma unroll
        for (int bj = 0; bj < 2; ++bj)
#pragma unroll
            for (int n = 0; n < 2; ++n) p.bv[bj][n] = *(const f32x4*)(bp + bj * HALF + 4 * n);
#pragma unroll
        for (int ai = 0; ai < 2; ++ai)
#pragma unroll
            for (int m = 0; m < 4; ++m) p.ssr[ai][m] = ss[row0 + ai * HALF + m * 16];
    }
    __device__ __forceinline__ void operator()(const f32x4 (&acc)[2][2][4][2], const Unit& u, const Pre& p, int wr, int wc, int fr, int fq) const {
        const int row0 = u.pm * BM + wr * 64 + fr, colo = u.pn * HALF + wc * 32 + 8 * fq;
        f32x4 bg[2], bu[2];
#pragma unroll
        for (int n = 0; n < 2; ++n) { bg[n] = p.bv[0][n] * LOG2E; bu[n] = p.bv[1][n] * (1.f / LOG2E); }
#pragma unroll
        for (int ai = 0; ai < 2; ++ai)
#pragma unroll
            for (int m = 0; m < 4; ++m) { const int row = row0 + ai * HALF + m * 16; const float rs = fast_rsq(p.ssr[ai][m] * (1.f / D) + EPS), rsg = rs * LOG2E, rsu = rs * (1.f / LOG2E);
                f32x4 h[2];
#pragma unroll
                for (int n = 0; n < 2; ++n) {
                    const f32x4 G = acc[ai][0][m][n], U = acc[ai][1][m][n];
                    const f32x2 g0 = G.lo * rsg + bg[n].lo, g1 = G.hi * rsg + bg[n].hi, u0 = U.lo * rsu + bu[n].lo, u1 = U.hi * rsu + bu[n].hi;
                    f32x2 d0 = (f32x2){fast_exp2(-g0.x), fast_exp2(-g0.y)} + 1.f, d1 = (f32x2){fast_exp2(-g1.x), fast_exp2(-g1.y)} + 1.f;
                    const f32x2 r0 = (f32x2){fast_rcp(d0.x), fast_rcp(d0.y)}, r1 = (f32x2){fast_rcp(d1.x), fast_rcp(d1.y)};
                    const f32x2 h0 = (g0 * u0) * r0, h1 = (g1 * u1) * r1;
                    h[n] = (f32x4){h0.x, h0.y, h1.x, h1.y}; }
                u32x4 w; w.x = cvt_pk_bf16(h[0][0], h[0][1]); w.y = cvt_pk_bf16(h[0][2], h[0][3]); w.z = cvt_pk_bf16(h[1][0], h[1][1]); w.w = cvt_pk_bf16(h[1][2], h[1][3]);
                PG8_ST16(u, O + (size_t)row * FF + colo, w); }
    }
};

struct EpiScIn {
    static constexpr bool PERM = true; static constexpr bool IDEMP = true;
    typedef EpiPre Pre;
    bf16_t* BG; bf16_t* P; const float* ss; const float* bias;
    __device__ __forceinline__ void prefetch(const Unit& u, int wr, int wc, int fr, int fq, Pre& p) const {
        const int row0 = u.pm * BM + wr * 64 + fr, colw = u.pn * BM + wc * 32 + 8 * fq;
        const float* bp = bias + (size_t)(u.pm >> 6) * NIN1 + colw;
#pragma unroll
        for (int bj = 0; bj < 2; ++bj)
#pragma unroll
            for (int n = 0; n < 2; ++n) p.bv[bj][n] = *(const f32x4*)(bp + bj * HALF + 4 * n);
#pragma unroll
        for (int ai = 0; ai < 2; ++ai)
#pragma unroll
            for (int m = 0; m < 4; ++m) p.ssr[ai][m] = ss[row0 + ai * HALF + m * 16];
    }
    __device__ __forceinline__ void operator()(const f32x4 (&acc)[2][2][4][2], const Unit& u, const Pre& p, int wr, int wc, int fr, int fq) const {
        const int row0 = u.pm * BM + wr * 64 + fr, colw = u.pn * BM + wc * 32 + 8 * fq;
        if (u.pn < 4) {
#pragma unroll
            for (int ai = 0; ai < 2; ++ai)
#pragma unroll
                for (int m = 0; m < 4; ++m) { const int row = row0 + ai * HALF + m * 16; const float rs = fast_rsq(p.ssr[ai][m] * (1.f / D) + EPS); bf16_t* rowp = BG + (size_t)row * D + colw;
#pragma unroll
                    for (int bj = 0; bj < 2; ++bj) { const f32x4 v0 = acc[ai][bj][m][0] * rs + p.bv[bj][0], v1 = acc[ai][bj][m][1] * rs + p.bv[bj][1];
                        u32x4 w; w.x = cvt_pk_bf16(v0[0], v0[1]); w.y = cvt_pk_bf16(v0[2], v0[3]); w.z = cvt_pk_bf16(v1[0], v1[1]); w.w = cvt_pk_bf16(v1[2], v1[3]);
                        PG8_ST16(u, rowp + bj * HALF, w); } }
        } else {
            const int colo = (u.pn - 4) * HALF + wc * 32 + 8 * fq;
#pragma unroll
            for (int ai = 0; ai < 2; ++ai)
#pragma unroll
                for (int m = 0; m < 4; ++m) { const int row = row0 + ai * HALF + m * 16; const float rs = fast_rsq(p.ssr[ai][m] * (1.f / D) + EPS);
                    f32x4 h[2];
#pragma unroll
                    for (int n = 0; n < 2; ++n) { const f32x4 cgv = acc[ai][0][m][n] * rs + p.bv[0][n], xv = acc[ai][1][m][n] * rs + p.bv[1][n]; h[n] = cgv * xv; }
                    u32x4 w; w.x = cvt_pk_bf16(h[0][0], h[0][1]); w.y = cvt_pk_bf16(h[0][2], h[0][3]); w.z = cvt_pk_bf16(h[1][0], h[1][1]); w.w = cvt_pk_bf16(h[1][2], h[1][3]);
                    PG8_ST16(u, P + (size_t)row * D + colo, w); }
        }
    }
};
struct EpiScGate {
    static constexpr bool PERM = true; static constexpr bool IDEMP = true;
    typedef EpiPre Pre;
    bf16_t* Y; const bf16_t* P; const float* ss; const float* bias; const float* cw;
    __device__ __forceinline__ void prefetch(const Unit& u, int wr, int wc, int fr, int fq, Pre& p) const {
        const int row0 = u.pm * BM + wr * 64 + fr, colw = u.pn * BM + wc * 32 + 8 * fq;
        const float* bp = bias + (size_t)(u.pm >> 6) * NIN1 + colw;
#pragma unroll
        for (int bj = 0; bj < 2; ++bj)
#pragma unroll
            for (int n = 0; n < 2; ++n) p.bv[bj][n] = *(const f32x4*)(bp + bj * HALF + 4 * n);
#pragma unroll
        for (int ai = 0; ai < 2; ++ai)
#pragma unroll
            for (int m = 0; m < 4; ++m) p.ssr[ai][m] = ss[row0 + ai * HALF + m * 16];
    }
    template <int AI, int BJ, int M0, int MC>
    __device__ __forceinline__ void batch(const f32x4 (&acc)[2][2][4][2], const Unit& u, const Pre& p, const f32x4 (&w)[3][2], int row0, int col, int sbeg, int send) const {
        u32x4 raw[MC][3];
#pragma unroll
        for (int mm = 0; mm < MC; ++mm)
#pragma unroll
            for (int j = 0; j < 3; ++j) { const int rr = row0 + AI * HALF + (M0 + mm) * 16 + j - 1;
                raw[mm][j] = (rr >= sbeg && rr < send) ? *(const u32x4*)(P + (size_t)rr * D + col) : (u32x4){0u, 0u, 0u, 0u}; }
        asm volatile("" ::: "memory"); __builtin_amdgcn_sched_barrier(0);
#pragma unroll
        for (int mm = 0; mm < MC; ++mm) { constexpr int dummy = 0; (void)dummy; const int m = M0 + mm; const int row = row0 + AI * HALF + m * 16; const float rs = fast_rsq(p.ssr[AI][m] * (1.f / D) + EPS);
            const f32x4 v0 = acc[AI][BJ][m][0] * rs + p.bv[BJ][0], v1 = acc[AI][BJ][m][1] * rs + p.bv[BJ][1];
            f32x4 c0 = (f32x4){0.f, 0.f, 0.f, 0.f}, c1 = c0;
#pragma unroll
            for (int j = 0; j < 3; ++j) { const u32x4 r = raw[mm][j];
                c0 += w[j][0] * (f32x4){bflo(r.x), bfhi(r.x), bflo(r.y), bfhi(r.y)}; c1 += w[j][1] * (f32x4){bflo(r.z), bfhi(r.z), bflo(r.w), bfhi(r.w)}; }
            const f32x4 y0 = v0 * c0, y1 = v1 * c1;
            u32x4 o; o.x = cvt_pk_bf16(y0[0], y0[1]); o.y = cvt_pk_bf16(y0[2], y0[3]); o.z = cvt_pk_bf16(y1[0], y1[1]); o.w = cvt_pk_bf16(y1[2], y1[3]);
            PG8_ST16(u, Y + (size_t)row * D + col, o); }
        asm volatile("" ::: "memory"); __builtin_amdgcn_sched_barrier(0);
    }
    __device__ __forceinline__ void operator()(const f32x4 (&acc)[2][2][4][2], const Unit& u, const Pre& p, int wr, int wc, int fr, int fq) const {
        const int row0 = u.pm * BM + wr * 64 + fr, colw = u.pn * BM + wc * 32 + 8 * fq;
        const int sbeg = (u.pm * BM / SEQ) * SEQ, send = sbeg + SEQ;
        { const int col = colw; f32x4 w[3][2];
#pragma unroll
          for (int j = 0; j < 3; ++j) { w[j][0] = *(const f32x4*)(cw + j * D + col); w[j][1] = *(const f32x4*)(cw + j * D + col + 4); }
          batch<0, 0, 0, 2>(acc, u, p, w, row0, col, sbeg, send); batch<0, 0, 2, 2>(acc, u, p, w, row0, col, sbeg, send);
          batch<1, 0, 0, 2>(acc, u, p, w, row0, col, sbeg, send); batch<1, 0, 2, 2>(acc, u, p, w, row0, col, sbeg, send); }
        { const int col = colw + HALF; f32x4 w[3][2];
#pragma unroll
          for (int j = 0; j < 3; ++j) { w[j][0] = *(const f32x4*)(cw + j * D + col); w[j][1] = *(const f32x4*)(cw + j * D + col + 4); }
          batch<0, 1, 0, 4>(acc, u, p, w, row0, col, sbeg, send); batch<1, 1, 0, 4>(acc, u, p, w, row0, col, sbeg, send); }
    }
};

template <class Epi, class Sched, bool ALIGN_EPI = false, bool SP2 = false>
__device__ __forceinline__ void gemm_phase(LAS unsigned char* lds, const Gemm g, const Sched& S, const Epi& E) {
    const int tid = threadIdx.x, wid = __builtin_amdgcn_readfirstlane(tid >> 6), lane = tid & 63, wr = wid >> 2, wc = wid & 3, fr = lane & 15, fq = lane >> 4;
    const int K = g.K, nt = K / BK;
    unsigned voffA[2], voffB[2];
#pragma unroll
    for (int i = 0; i < 2; ++i) { const int b_ = tid * 16 + i * 8192; const int R = b_ >> 7, C = 8 * (((b_ >> 4) & 7) ^ ((R >> 1) & 7)); const int Rb = Epi::PERM ? ((R & ~31) + perm32(R & 31)) : R;
        voffA[i] = (unsigned)(R * K + C) * 2u; voffB[i] = (unsigned)(Rb * K + C) * 2u; }
    const size_t kstep = (size_t)(BK * 2);
    const size_t hstep = (size_t)HALF * K * 2;
    const size_t tstep = 2 * hstep;
    const unsigned ldsw = (unsigned)wid * 1024u;
    int aoffk[2], boffk[2];
#pragma unroll
    for (int k = 0; k < 2; ++k) { const int sw = ((4 * k + fq) ^ ((fr >> 1) & 7)) << 4; aoffk[k] = (wr * 64 + fr) * 128 + sw; boffk[k] = (wc * 32 + fr) * 128 + sw; }
#define PG8_SA(b, h) (((b) * 2 + (h)) * HTB)
#define PG8_SB(b, h) ((4 + (b) * 2 + (h)) * HTB)
#define PG8_STAGE(bufoff, gbase, voff) do { _Pragma("unroll") for (int _i = 0; _i < 2; ++_i) \
        __builtin_amdgcn_global_load_lds((const unsigned*)((const char*)(gbase) + (voff)[_i]), (LAS unsigned*)(lds + (bufoff) + ldsw + _i * 8192), 16, 0, 0); } while (0)
#define PG8_LDA(dst, b, h) do { _Pragma("unroll") for (int m = 0; m < 4; ++m) _Pragma("unroll") for (int k = 0; k < 2; ++k) dst[m][k] = *(const LAS bf16x8*)(lds + PG8_SA(b, h) + aoffk[k] + m * 2048); } while (0)
#define PG8_LDB(dst, b, h) do { _Pragma("unroll") for (int n = 0; n < 2; ++n) _Pragma("unroll") for (int k = 0; k < 2; ++k) dst[n][k] = *(const LAS bf16x8*)(lds + PG8_SB(b, h) + boffk[k] + n * 2048); } while (0)
#define PG8_MMA(ai, bj, At, Bt) do { __builtin_amdgcn_s_setprio(1); _Pragma("unroll") for (int m = 0; m < 4; ++m) _Pragma("unroll") for (int n = 0; n < 2; ++n) _Pragma("unroll") for (int k = 0; k < 2; ++k) \
        acc[ai][bj][m][n] = __builtin_amdgcn_mfma_f32_16x16x32_bf16(Bt[n][k], At[m][k], acc[ai][bj][m][n], 0, 0, 0); __builtin_amdgcn_s_setprio(0); } while (0)
#define PG8_WAIT_V(n) asm volatile("s_waitcnt vmcnt(" #n ")" ::: "memory")
#define PG8_WAIT_L(n) asm volatile("s_waitcnt lgkmcnt(" #n ")" ::: "memory")
#define PG8_BAR __builtin_amdgcn_s_barrier()
#define PG8_SCHED __builtin_amdgcn_sched_barrier(0)
    Unit cur, nxt; int ui = 0;
    if (!S.next(0, cur)) return;
    f32x4 acc[2][2][4][2];
#pragma unroll
    for (int a = 0; a < 2; ++a)
#pragma unroll
        for (int b = 0; b < 2; ++b)
#pragma unroll
            for (int m = 0; m < 4; ++m)
#pragma unroll
                for (int n = 0; n < 2; ++n) acc[a][b][m][n] = (f32x4){0.f, 0.f, 0.f, 0.f};
    bf16x8 At[4][2], B0[2][2], B1[2][2];
    typename Epi::Pre pre; E.prefetch(cur, wr, wc, fr, fq, pre);
    const char* cA = (const char*)g.A + (size_t)cur.pm * tstep; const bf16_t* gBt = g.Bt; const long gb1 = g.boff1, gb2 = g.boff2;
    const char* cB = bsel(gBt, gb1, gb2, cur) + (size_t)cur.pn * tstep;
    if constexpr (SP2) {
        PG8_STAGE(PG8_SB(0, 0), cB, voffB); PG8_STAGE(PG8_SB(0, 1), cB + hstep, voffB); PG8_STAGE(PG8_SA(0, 0), cA, voffA); PG8_STAGE(PG8_SA(0, 1), cA + hstep, voffA);
        if (wr == 1) PG8_BAR;
        PG8_WAIT_V(2); PG8_BAR;
        PG8_STAGE(PG8_SB(1, 0), cB + kstep, voffB); PG8_STAGE(PG8_SA(1, 0), cA + kstep, voffA); PG8_STAGE(PG8_SB(1, 1), cB + hstep + kstep, voffB);
        PG8_WAIT_V(6); PG8_BAR;
    } else {
        PG8_STAGE(PG8_SB(0, 0), cB, voffB); PG8_STAGE(PG8_SA(0, 0), cA, voffA); PG8_STAGE(PG8_SB(0, 1), cB + hstep, voffB); PG8_STAGE(PG8_SA(0, 1), cA + hstep, voffA);
        if (wr == 1) PG8_BAR;
        PG8_WAIT_V(4); PG8_BAR;
        PG8_STAGE(PG8_SB(1, 0), cB + kstep, voffB); PG8_STAGE(PG8_SA(1, 0), cA + kstep, voffA); PG8_STAGE(PG8_SB(1, 1), cB + hstep + kstep, voffB);
        PG8_WAIT_V(6); PG8_BAR;
    }
    for (;;) {
        const bool has_next = S.next(ui + 1, nxt);
        cur.last = !has_next;
        const char* nA = has_next ? (const char*)g.A + (size_t)nxt.pm * tstep : cA; const char* nB = has_next ? bsel(gBt, gb1, gb2, nxt) + (size_t)nxt.pn * tstep : cB;
        for (int t = 0; t < nt; t += 2) {
            const bool last = (t == nt - 2);
            const char* a1 = cA + (size_t)(t + 1) * kstep;
            const char* a2 = last ? nA : cA + (size_t)(t + 2) * kstep; const char* b2 = last ? nB : cB + (size_t)(t + 2) * kstep;
            const char* a3 = a2 + kstep; const char* b3 = b2 + kstep;
            if constexpr (SP2) {
            PG8_LDB(B0, 0, 0); PG8_LDB(B1, 0, 1); PG8_SCHED; PG8_LDA(At, 0, 0); PG8_STAGE(PG8_SA(1, 1), a1 + hstep, voffA);
            PG8_WAIT_V(8); PG8_WAIT_L(0); PG8_BAR; PG8_MMA(0, 0, At, B0); PG8_MMA(0, 1, At, B1); PG8_BAR; PG8_SCHED;
            PG8_LDA(At, 0, 1); PG8_STAGE(PG8_SB(0, 0), b2, voffB); PG8_STAGE(PG8_SB(0, 1), b2 + hstep, voffB); PG8_STAGE(PG8_SA(0, 0), a2, voffA);
            PG8_WAIT_V(8); PG8_WAIT_L(0); PG8_BAR; PG8_MMA(1, 0, At, B0); PG8_MMA(1, 1, At, B1); PG8_BAR; PG8_SCHED;
            PG8_LDB(B0, 1, 0); PG8_LDB(B1, 1, 1); PG8_SCHED; PG8_LDA(At, 1, 0); PG8_STAGE(PG8_SA(0, 1), a2 + hstep, voffA);
            PG8_WAIT_V(8); PG8_WAIT_L(0); PG8_BAR; PG8_MMA(0, 0, At, B0); PG8_MMA(0, 1, At, B1); PG8_BAR; PG8_SCHED;
            PG8_LDA(At, 1, 1); PG8_STAGE(PG8_SB(1, 0), b3, voffB); PG8_STAGE(PG8_SB(1, 1), b3 + hstep, voffB); PG8_STAGE(PG8_SA(1, 0), a3, voffA);
            PG8_WAIT_V(8); PG8_WAIT_L(0); PG8_BAR; PG8_MMA(1, 0, At, B0); PG8_MMA(1, 1, At, B1); PG8_BAR; PG8_SCHED;
            } else {
            PG8_LDB(B0, 0, 0); PG8_SCHED; PG8_LDA(At, 0, 0); PG8_STAGE(PG8_SA(1, 1), a1 + hstep, voffA);
            PG8_WAIT_L(8); PG8_BAR; PG8_WAIT_L(0); PG8_MMA(0, 0, At, B0); PG8_BAR; PG8_SCHED;
            PG8_LDB(B1, 0, 1); PG8_STAGE(PG8_SB(0, 0), b2, voffB);
            PG8_BAR; PG8_WAIT_L(0); PG8_MMA(0, 1, At, B1); PG8_BAR;
            PG8_LDA(At, 0, 1); PG8_STAGE(PG8_SA(0, 0), a2, voffA);
            PG8_BAR; PG8_WAIT_L(0); PG8_MMA(1, 0, At, B0); PG8_BAR; PG8_SCHED;
            PG8_STAGE(PG8_SB(0, 1), b2 + hstep, voffB);
            PG8_WAIT_V(6); PG8_BAR; PG8_MMA(1, 1, At, B1); PG8_BAR;
            PG8_LDB(B0, 1, 0); PG8_SCHED; PG8_LDA(At, 1, 0); PG8_STAGE(PG8_SA(0, 1), a2 + hstep, voffA);
            PG8_WAIT_L(8); PG8_BAR; PG8_WAIT_L(0); PG8_MMA(0, 0, At, B0); PG8_BAR; PG8_SCHED;
            PG8_LDB(B1, 1, 1); PG8_STAGE(PG8_SB(1, 0), b3, voffB);
            PG8_BAR; PG8_WAIT_L(0); PG8_MMA(0, 1, At, B1); PG8_BAR;
            PG8_LDA(At, 1, 1); PG8_STAGE(PG8_SA(1, 0), a3, voffA);
            PG8_BAR; PG8_WAIT_L(0); PG8_MMA(1, 0, At, B0); PG8_BAR; PG8_SCHED;
            PG8_STAGE(PG8_SB(1, 1), b3 + hstep, voffB);
            PG8_WAIT_V(6); PG8_BAR; PG8_MMA(1, 1, At, B1); PG8_BAR;
            }
        }
        if constexpr (ALIGN_EPI) { if (wr == 0) PG8_BAR; }
        E(acc, cur, pre, wr, wc, fr, fq);
#ifdef PROBE_EPI2
        if constexpr (Epi::IDEMP) { asm volatile("" ::: "memory"); E(acc, cur, pre, wr, wc, fr, fq); }
#endif
        if (!has_next) break;
        E.prefetch(nxt, wr, wc, fr, fq, pre);
        { bf16x8 zz;
#pragma unroll
          for (int j = 0; j < 8; ++j) zz[j] = 0;
          asm volatile("s_nop 3" : "+v"(zz));
#pragma unroll
          for (int b = 0; b < 2; ++b)
#pragma unroll
              for (int m = 0; m < 4; ++m)
#pragma unroll
                  for (int n = 0; n < 2; ++n) { asm volatile("v_mfma_f32_16x16x32_bf16 %0, %1, %1, 0" : "=&v"(acc[1][b][m][n]) : "v"(zz));
                      acc[0][b][m][n] = (f32x4){0.f, 0.f, 0.f, 0.f}; } }
        cur = nxt; cA = nA; cB = nB; ++ui;
        if constexpr (ALIGN_EPI) { if (wr == 1) PG8_BAR; }
    }
    PG8_WAIT_V(0);
    if constexpr (!ALIGN_EPI) { if (wr == 0) PG8_BAR; }
    PG8_BAR;
#undef PG8_SA
#undef PG8_SB
#undef PG8_STAGE
#undef PG8_LDA
#undef PG8_LDB
#undef PG8_MMA
#undef PG8_WAIT_V
#undef PG8_WAIT_L
#undef PG8_BAR
#undef PG8_SCHED
}
}

#define XB_TMO      128
#define XB_XCNT(j)  (256  + 64 * (j))
#define XB_XSUB(j)  (1280 + 64 * (j))
#define XB_XGEN(j)  (2304 + 64 * (j))
#define XB_TOP      3328
#define XB_TOPGEN   3392
#define XCD_BAR_WORDS 3456
#define XB_SPIN_CAP (1u << 18)
__device__ __forceinline__ unsigned xb_ld(unsigned* p)              { return __hip_atomic_load(p, __ATOMIC_RELAXED, __HIP_MEMORY_SCOPE_AGENT); }
__device__ __forceinline__ unsigned xb_add(unsigned* p, unsigned v) { return __hip_atomic_fetch_add(p, v, __ATOMIC_RELAXED, __HIP_MEMORY_SCOPE_AGENT); }
__device__ __forceinline__ unsigned xb_xcc_id() { return (unsigned)__builtin_amdgcn_s_getreg((3 << 11) | 20) & 0xFu; }
#define XB_SPIN(cond, bar) do { unsigned _sp = 0; while (cond) { __builtin_amdgcn_s_sleep(1); \
    if ((++_sp & 255u) == 0u) { if (xb_ld(&(bar)[XB_TMO])) break; if (_sp > XB_SPIN_CAP) { atomicAdd(&(bar)[XB_TMO], 1u); break; } } } } while (0)
struct XcdBarrier { unsigned* bar; unsigned x; volatile LAS unsigned* st; };
__device__ __forceinline__ XcdBarrier xcd_barrier_post(unsigned* bar, volatile LAS unsigned* st) {
    XcdBarrier b; b.bar = bar; b.x = xb_xcc_id(); b.st = st;
    if (threadIdx.x == 0) (void)xb_add(&bar[XB_XCNT(b.x)], 1u);
    return b;
}
__device__ __forceinline__ void xcd_barrier_complete(unsigned* bar, unsigned x, unsigned& nloc, unsigned& nx) {
    const unsigned G = gridDim.x * gridDim.y * gridDim.z;
    unsigned sum, cnt, mine, sp = 0u;
    for (;;) {
        sum = 0u; cnt = 0u; mine = 0u;
#pragma unroll
        for (unsigned j = 0; j < 16; ++j) { const unsigned c = xb_ld(&bar[XB_XCNT(j)]); sum += c; cnt += (c > 0u) ? 1u : 0u; mine = (j == x) ? c : mine; }
        if (sum == G) break;
        __builtin_amdgcn_s_sleep(1);
        if ((++sp & 255u) == 0u) { if (xb_ld(&bar[XB_TMO])) break; if (sp > XB_SPIN_CAP) { atomicAdd(&bar[XB_TMO], 1u); break; } }
    }
    nloc = mine > 0u ? mine : 1u; nx = cnt > 0u ? cnt : 1u;
}
__device__ __forceinline__ void xcd_barrier(const XcdBarrier& b) {
    asm volatile("s_waitcnt vmcnt(0)" ::: "memory");
    __syncthreads();
    if (threadIdx.x == 0) {
        unsigned* bar = b.bar;
        __builtin_amdgcn_s_waitcnt(0);
        unsigned nloc = b.st[0], nx = b.st[1];
        if (nloc == 0u) { xcd_barrier_complete(bar, b.x, nloc, nx); b.st[0] = nloc; b.st[1] = nx; }
        const unsigned old = xb_add(&bar[XB_XSUB(b.x)], 1u);
        __builtin_amdgcn_fence(__ATOMIC_ACQUIRE, "agent");
        const unsigned gen = old / nloc;
        if (old + 1u == (gen + 1u) * nloc) {
            __builtin_amdgcn_fence(__ATOMIC_RELEASE, "agent");
            asm volatile("s_waitcnt vmcnt(0)" ::: "memory");
            const unsigned og = xb_add(&bar[XB_TOP], 1u);
            const unsigned tg = og / nx;
            if (og + 1u == (tg + 1u) * nx) {
#pragma unroll
                for (unsigned j = 0; j < 16; ++j) xb_add(&bar[XB_XGEN(j)], 1u);
            } else XB_SPIN(xb_ld(&bar[XB_XGEN(b.x)]) == gen, bar);
            asm volatile("s_waitcnt vmcnt(0)" ::: "memory");
        } else {
            XB_SPIN(xb_ld(&bar[XB_XGEN(b.x)]) == gen, bar);
            asm volatile("s_waitcnt vmcnt(0)" ::: "memory");
        }
    }
    __syncthreads();
}

struct Frame {
    LAS unsigned char* lds;
    int tid, lane, wave, G, gw, NGW;
    const float* in[N_IN]; float* out; unsigned char* ws;
};
#define WSP(T, off) ((T*)(F.ws + (off)))

__device__ __forceinline__ void p0_transpose_item(const float* W, int K, int N, bf16_t* WT, LAS float* scr, int item, int lane) {
    const int nblk = N / 32, kb = item / nblk, nb = item % nblk, k0 = 64 * kb, n0 = 32 * nb;
    float val[32];
    { const float* wp = W + (size_t)(k0 + (lane >> 5)) * N + n0 + (lane & 31);
#pragma unroll
      for (int i = 0; i < 32; ++i) val[i] = wp[(size_t)(2 * i) * N]; }
#pragma unroll
    for (int i = 0; i < 32; ++i) scr[(2 * i + (lane >> 5)) * 33 + (lane & 31)] = val[i];
    LDS_WAIT(); asm volatile("" ::: "memory");
    const int c = lane & 7;
#pragma unroll
    for (int j = 0; j < 4; ++j) { const int n = (lane >> 3) + 8 * j; const LAS float* s = scr + (8 * c) * 33 + n;
        u32x4 o; o.x = pk2(s[0 * 33], s[1 * 33]); o.y = pk2(s[2 * 33], s[3 * 33]); o.z = pk2(s[4 * 33], s[5 * 33]); o.w = pk2(s[6 * 33], s[7 * 33]);
        st16_wt(WT + (size_t)(n0 + n) * K + k0 + 8 * c, o); }
    LDS_WAIT(); asm volatile("" ::: "memory");
}
__device__ __forceinline__ void row2_to_bf16_ss(const float* x0, const float* x1, bf16_t* o0, bf16_t* o1, float* s0p, float* s1p, int lane) {
    const f32x4* a = (const f32x4*)x0 + lane; const f32x4* b = (const f32x4*)x1 + lane;
    f32x4 va[4], vb[4];
#pragma unroll
    for (int j = 0; j < 4; ++j) { va[j] = a[64 * j]; vb[j] = b[64 * j]; }
    float sa = 0.f, sb = 0.f;
#pragma unroll
    for (int j = 0; j < 4; ++j) { sa += (va[j].x * va[j].x + va[j].y * va[j].y) + (va[j].z * va[j].z + va[j].w * va[j].w); sb += (vb[j].x * vb[j].x + vb[j].y * vb[j].y) + (vb[j].z * vb[j].z + vb[j].w * vb[j].w); }
#pragma unroll
    for (int o = 1; o < 64; o <<= 1) { const float ta = __shfl_xor(sa, o), tb = __shfl_xor(sb, o); sa += ta; sb += tb; }
    u32x2* pa = (u32x2*)o0 + lane; u32x2* pb = (u32x2*)o1 + lane;
#pragma unroll
    for (int j = 0; j < 4; ++j) { u32x2 w; w.x = pk2(va[j].x, va[j].y); w.y = pk2(va[j].z, va[j].w); pa[64 * j] = w; u32x2 y; y.x = pk2(vb[j].x, vb[j].y); y.y = pk2(vb[j].z, vb[j].w); pb[64 * j] = y; }
    if (lane == 0) { *s0p = sa; *s1p = sb; }
}
__device__ __forceinline__ void row_to_bf16_ss(const float* xrow, bf16_t* orow, float* ssp, int lane) {
    const f32x4* xr = (const f32x4*)xrow + lane;
    f32x4 v[4]; float s = 0.f;
#pragma unroll
    for (int j = 0; j < 4; ++j) { v[j] = xr[64 * j]; s += (v[j].x * v[j].x + v[j].y * v[j].y) + (v[j].z * v[j].z + v[j].w * v[j].w); }
    s = wave_sum(s);
    u32x2* o8 = (u32x2*)orow + lane;
#pragma unroll
    for (int j = 0; j < 4; ++j) { u32x2 w; w.x = pk2(v[j].x, v[j].y); w.y = pk2(v[j].z, v[j].w); o8[64 * j] = w; }
    if (lane == 0) *ssp = s;
}
__device__ __forceinline__ void p0_mods_task(Frame& F, int task) {
    const int kh = task & 1, l = (task >> 1) / 48, n0 = ((task >> 1) % 48) * 128;
    LAS float* Sc = (LAS float*)F.lds;
    LAS float* R = (LAS float*)(F.lds + 16384);
    const float* c = F.in[I_C]; const float* cc = F.in[I_CCTX];
    for (int i = F.tid; i < 3 * 512; i += 512) { const int v = i >> 9, k = kh * 512 + (i & 511); const float cv = v == 0 ? c[k] : (v == 1 ? c[D + k] : cc[k]); Sc[i] = cv / (1.f + __expf(-cv)); }
    __syncthreads();
    float a[3][2] = {{0.f, 0.f}, {0.f, 0.f}, {0.f, 0.f}};
    const float* Wp = F.in[I_MODW] + (size_t)l * D * 6144 + (size_t)(kh * 512) * 6144 + n0 + 2 * F.lane;
    const int kb = F.wave * 64;
#pragma unroll 16
    for (int kk = 0; kk < 64; ++kk) { const int k = kb + kk; const f32x2 wv = *(const f32x2*)(Wp + (size_t)k * 6144);
#pragma unroll
        for (int v = 0; v < 3; ++v) { const float s = Sc[v * 512 + k]; a[v][0] += s * wv.x; a[v][1] += s * wv.y; } }
#pragma unroll
    for (int v = 0; v < 3; ++v) { R[(F.wave * 3 + v) * 128 + 2 * F.lane] = a[v][0]; R[(F.wave * 3 + v) * 128 + 2 * F.lane + 1] = a[v][1]; }
    __syncthreads();
    if (F.tid < 384) { const int v = F.tid >> 7, j = F.tid & 127; float s = kh == 0 ? F.in[I_MODB][l * 6144 + n0 + j] : 0.f;
#pragma unroll
        for (int w = 0; w < 8; ++w) s += R[(w * 3 + v) * 128 + j];
        unsafeAtomicAdd(WSP(float, WS_MODS) + (size_t)(l * 3 + v) * 6144 + n0 + j, s); }
    __syncthreads();
}
__device__ __forceinline__ void phase_p0(Frame& F, int part, int gw, int ngw) {
    LAS float* scr = (LAS float*)(F.lds + F.wave * 16384);
    if (part == 0) {
    bf16_t* XB = WSP(bf16_t, WS_A1); float* ss0 = WSP(float, WS_SS0);
    const int R1 = (F.G == 256) ? 3 * 64 * 8 : 0, R0 = MT - R1;
    { int m = F.gw;
      for (; m + F.NGW < R0; m += 2 * F.NGW) { const int m1 = m + F.NGW;
          const float* s0 = m < ML ? F.in[I_X] + (size_t)m * D : F.in[I_CTX] + (size_t)(m - ML) * D;
          const float* s1 = m1 < ML ? F.in[I_X] + (size_t)m1 * D : F.in[I_CTX] + (size_t)(m1 - ML) * D;
          row2_to_bf16_ss(s0, s1, XB + (size_t)m * D, XB + (size_t)m1 * D, ss0 + m, ss0 + m1, F.lane); }
      for (; m < R0; m += F.NGW) {
          const float* src = m < ML ? F.in[I_X] + (size_t)m * D : F.in[I_CTX] + (size_t)(m - ML) * D;
          row_to_bf16_ss(src, XB + (size_t)m * D, ss0 + m, F.lane); } }
    if (R1 > 0 && blockIdx.x >= 192)
        for (int m = R0 + ((int)blockIdx.x - 192) * 8 + F.wave; m < MT; m += 64 * 8) {
            const float* src = m < ML ? F.in[I_X] + (size_t)m * D : F.in[I_CTX] + (size_t)(m - ML) * D;
            row_to_bf16_ss(src, XB + (size_t)m * D, ss0 + m, F.lane);
        }
    for (int idx = (int)((blockIdx.x + 64u) % (unsigned)F.G) * 512 + F.tid; idx < 2 * 8 * 2 * 2 * 4 * 64; idx += F.G * 512) {
        const int ln = idx & 63, s_ = (idx >> 6) & 3, half = (idx >> 8) & 1, gate = (idx >> 9) & 1, g_ = (idx >> 10) & 7, d_ = idx >> 13;
        const float* wsrc = (gate ? F.in[I_LWI] : F.in[I_LWR]) + (size_t)((d_ * 8 + g_) * 64 + 16 * s_ + 8 * (ln >> 5)) * 64 + 32 * half + (ln & 31);
        constexpr float NL = -LOG2E;
        u32x4 o; o.x = pk2(NL * wsrc[0], NL * wsrc[64]); o.y = pk2(NL * wsrc[128], NL * wsrc[192]); o.z = pk2(NL * wsrc[256], NL * wsrc[320]); o.w = pk2(NL * wsrc[384], NL * wsrc[448]);
        st16_wt(WSP(u32x4, WS_LRUW) + idx, o);
    }
    return; }
    constexpr int I_O = (D / 64) * (D / 32), I_DN = (FF / 64) * (D / 32);
    for (int it = gw; it < I_O; it += ngw) p0_transpose_item(F.in[I_EWOUT], D, D, WSP(bf16_t, WS_WOUT0), scr, it, F.lane);
}

template <int NV> __device__ __forceinline__ void fold_task(const float* W, int N, int n0, int dst0, int Nd, int kc, float cs, const float* gam, const float* mods_l, int sc_off, int sh_off,
                                                           bf16_t* WT, float* biasp, LAS float* scr, int lane) {
    LAS float* vec = scr + 2176;
    for (int i = lane; i < NV * 256; i += 64) { const int v = i >> 8, kk = i & 255, k = kc * 256 + kk;
        vec[i] = gam[k] * (1.f + mods_l[(size_t)v * 6144 + sc_off + k]) * cs; vec[768 + i] = mods_l[(size_t)v * 6144 + sh_off + k] * cs; }
    LDS_WAIT(); asm volatile("" ::: "memory");
    float bacc[NV];
#pragma unroll
    for (int v = 0; v < NV; ++v) bacc[v] = 0.f;
    for (int it = 0; it < 4; ++it) {
        const int k0 = kc * 256 + 64 * it;
        float val[32];
        { const float* wp = W + (size_t)(k0 + (lane >> 5)) * N + n0 + (lane & 31);
#pragma unroll
          for (int i = 0; i < 32; ++i) val[i] = wp[(size_t)(2 * i) * N]; }
#pragma unroll
        for (int i = 0; i < 32; ++i) { const int kk = 2 * i + (lane >> 5); scr[kk * 33 + (lane & 31)] = val[i];
#pragma unroll
            for (int v = 0; v < NV; ++v) bacc[v] += vec[768 + v * 256 + 64 * it + kk] * val[i]; }
        LDS_WAIT(); asm volatile("" ::: "memory");
        const int c = lane & 7;
#pragma unroll
        for (int j = 0; j < 4; ++j) { const int n = (lane >> 3) + 8 * j; const LAS float* s = scr + (8 * c) * 33 + n;
#pragma unroll
            for (int v = 0; v < NV; ++v) { const LAS float* sv = vec + v * 256 + 64 * it + 8 * c;
                u32x4 o; o.x = pk2(s[0 * 33] * sv[0], s[1 * 33] * sv[1]); o.y = pk2(s[2 * 33] * sv[2], s[3 * 33] * sv[3]); o.z = pk2(s[4 * 33] * sv[4], s[5 * 33] * sv[5]); o.w = pk2(s[6 * 33] * sv[6], s[7 * 33] * sv[7]);
                st16_wt(WT + (size_t)v * Nd * D + (size_t)(dst0 + n) * D + k0 + 8 * c, o); } }
        LDS_WAIT(); asm volatile("" ::: "memory");
    }
#pragma unroll
    for (int v = 0; v < NV; ++v) { float b = bacc[v]; b += __shfl_xor(b, 32); if (lane < 32) unsafeAtomicAdd(biasp + (size_t)v * Nd + dst0 + lane, b); }
}
template <int NV> __device__ __forceinline__ void fold_item(const float* W, int N, int n0, int dst0, int Nd, int k0, float cs, const float* gam, const float* mods_l, int sc_off, int sh_off,
                                                           bf16_t* WT, float* biasp, LAS float* scr, int lane) {
    LAS float* vec = scr + 2176;
    float val[32];
    { const float* wp = W + (size_t)(k0 + (lane >> 5)) * N + n0 + (lane & 31);
#pragma unroll
      for (int i = 0; i < 32; ++i) val[i] = wp[(size_t)(2 * i) * N]; }
    { const int k = k0 + lane; const float gk = gam[k] * cs;
#pragma unroll
      for (int v = 0; v < NV; ++v) { vec[v * 64 + lane] = gk * (1.f + mods_l[(size_t)v * 6144 + sc_off + k]); vec[192 + v * 64 + lane] = mods_l[(size_t)v * 6144 + sh_off + k] * cs; } }
#pragma unroll
    for (int i = 0; i < 32; ++i) scr[(2 * i + (lane >> 5)) * 33 + (lane & 31)] = val[i];
    LDS_WAIT(); asm volatile("" ::: "memory");
    float bacc[NV];
#pragma unroll
    for (int v = 0; v < NV; ++v) bacc[v] = 0.f;
#pragma unroll
    for (int i = 0; i < 32; ++i)
#pragma unroll
        for (int v = 0; v < NV; ++v) bacc[v] += vec[192 + v * 64 + 2 * i + (lane >> 5)] * val[i];
    const int c = lane & 7;
#pragma unroll
    for (int j = 0; j < 4; ++j) { const int n = (lane >> 3) + 8 * j; const LAS float* s = scr + (8 * c) * 33 + n;
#pragma unroll
        for (int v = 0; v < NV; ++v) { const LAS float* sv = vec + v * 64 + 8 * c;
            u32x4 o; o.x = pk2(s[0 * 33] * sv[0], s[1 * 33] * sv[1]); o.y = pk2(s[2 * 33] * sv[2], s[3 * 33] * sv[3]); o.z = pk2(s[4 * 33] * sv[4], s[5 * 33] * sv[5]); o.w = pk2(s[6 * 33] * sv[6], s[7 * 33] * sv[7]);
            st16_wt(WT + (size_t)v * Nd * D + (size_t)(dst0 + n) * D + k0 + 8 * c, o); } }
    LDS_WAIT(); asm volatile("" ::: "memory");
#pragma unroll
    for (int v = 0; v < NV; ++v) { float b = bacc[v]; b += __shfl_xor(b, 32); if (lane < 32) unsafeAtomicAdd(biasp + (size_t)v * Nd + dst0 + lane, b); }
}
__device__ __forceinline__ int gu_dst(int n) { return n < FF ? (n >> 7) * 256 + (n & 127) : ((n - FF) >> 7) * 256 + 128 + ((n - FF) & 127); }
__device__ __forceinline__ int in1_dst(int n) { if (n < 1024) return n; if (n < 2048) { const int q = n - 1024; return 1024 + (q >> 7) * 256 + (q & 127); } const int q = n - 2048; return 1024 + (q >> 7) * 256 + 128 + (q & 127); }
__device__ __forceinline__ void phase_p1(Frame& F, int part, int gw, int ngw) {
    LAS float* scr = (LAS float*)(F.lds + F.wave * 16384);
    const float* mods = WSP(float, WS_MODS);
    if (part == 0) {
        for (int it = gw; it < (NIN0 / 32) * 16; it += ngw) { const int ks = it & 15, n0 = (it >> 4) * 32;
            fold_item<3>(F.in[I_EWIN], NIN0, n0, n0, NIN0, 64 * ks, n0 < 512 ? QSCALE : 1.f, F.in[I_N1G], mods, 1024, 0, WSP(bf16_t, WS_WIN0), WSP(float, WS_B_IN0), scr, F.lane); }
    } else {
        for (int it = gw; it < (NGU / 32) * 16; it += ngw) { const int ks = it & 15, n0 = (it >> 4) * 32;
            fold_item<2>(F.in[I_WGU], NGU, n0, gu_dst(n0), NGU, 64 * ks, 1.f, F.in[I_N2G], mods, 4096, 3072, WSP(bf16_t, WS_WGU0), WSP(float, WS_B_GU0), scr, F.lane); }
    }
}

__device__ __forceinline__ void conv4_task(Frame& F, int task) {
    const bf16_t* QKV = WSP(bf16_t, WS_BIG); bf16_t* XC = WSP(bf16_t, WS_XCONV);
    const int row0 = task * 16, lane = F.lane;
    int sbeg, send;
    if (row0 < ML) { sbeg = (row0 / SEQ) * SEQ; send = sbeg + SEQ; } else { sbeg = ML + ((row0 - ML) / NCTX) * NCTX; send = sbeg + NCTX; }
    u32x4 raw[19];
#pragma unroll
    for (int i = 0; i < 19; ++i) { const int r = row0 + i - 2; raw[i] = (r >= sbeg && r < send) ? *(const u32x4*)(QKV + (size_t)r * NIN0 + 1536 + 8 * lane) : (u32x4){0u, 0u, 0u, 0u}; }
    float w[4][8], bs[8];
#pragma unroll
    for (int j = 0; j < 4; ++j) { const f32x4 a = *(const f32x4*)(F.in[I_ECW] + j * 512 + 8 * lane), b = *(const f32x4*)(F.in[I_ECW] + j * 512 + 8 * lane + 4);
        w[j][0] = a.x; w[j][1] = a.y; w[j][2] = a.z; w[j][3] = a.w; w[j][4] = b.x; w[j][5] = b.y; w[j][6] = b.z; w[j][7] = b.w; }
    { const f32x4 a = *(const f32x4*)(F.in[I_ECB] + 8 * lane), b = *(const f32x4*)(F.in[I_ECB] + 8 * lane + 4); bs[0] = a.x; bs[1] = a.y; bs[2] = a.z; bs[3] = a.w; bs[4] = b.x; bs[5] = b.y; bs[6] = b.z; bs[7] = b.w; }
#pragma unroll
    for (int t = 0; t < 16; ++t) {
        float o[8];
#pragma unroll
        for (int e = 0; e < 8; ++e) o[e] = bs[e];
#pragma unroll
        for (int j = 0; j < 4; ++j) { const u32x4 r = raw[t + j];
            o[0] += w[j][0] * bflo(r.x); o[1] += w[j][1] * bfhi(r.x); o[2] += w[j][2] * bflo(r.y); o[3] += w[j][3] * bfhi(r.y);
            o[4] += w[j][4] * bflo(r.z); o[5] += w[j][5] * bfhi(r.z); o[6] += w[j][6] * bflo(r.w); o[7] += w[j][7] * bfhi(r.w); }
        u32x4 pk; pk.x = pk2(o[0], o[1]); pk.y = pk2(o[2], o[3]); pk.z = pk2(o[4], o[5]); pk.w = pk2(o[6], o[7]);
        *(u32x4*)(XC + (size_t)(row0 + t) * 512 + 8 * lane) = pk;
    }
}

__device__ __forceinline__ int crow(int r, int hi) { return (r & 3) + 8 * (r >> 2) + 4 * hi; }
__device__ __forceinline__ void qkt(f32x16& p0, f32x16& p1, const bf16x8 (&b0)[4], const bf16x8 (&b1)[4], const bf16x8* qr, const f32x16& c0, const f32x16& c1) {
    p0 = __builtin_amdgcn_mfma_f32_32x32x16_bf16(b0[0], qr[0], c0, 0, 0, 0);
    p1 = __builtin_amdgcn_mfma_f32_32x32x16_bf16(b1[0], qr[0], c1, 0, 0, 0);
#pragma unroll
    for (int d0 = 1; d0 < 4; ++d0) {
        p0 = __builtin_amdgcn_mfma_f32_32x32x16_bf16(b0[d0], qr[d0], p0, 0, 0, 0);
        p1 = __builtin_amdgcn_mfma_f32_32x32x16_bf16(b1[d0], qr[d0], p1, 0, 0, 0);
    }
}
__device__ __forceinline__ void pv(f32x16* o, unsigned vb0, unsigned vb1, bf16x8 pa0, bf16x8 pa1, bf16x8 pa2, bf16x8 pa3, bool use0, bool use3) {
    s16x4 lo[2][4], hi[2][4];
#define PV_RD(ks) do { \
        lo[0][ks] = __builtin_amdgcn_ds_read_tr16_b64_v4i16((LAS s16x4*)(uintptr_t)(vb0 + (ks) * 2048)); \
        hi[0][ks] = __builtin_amdgcn_ds_read_tr16_b64_v4i16((LAS s16x4*)(uintptr_t)(vb0 + (ks) * 2048 + 1024)); \
        lo[1][ks] = __builtin_amdgcn_ds_read_tr16_b64_v4i16((LAS s16x4*)(uintptr_t)(vb1 + (ks) * 2048)); \
        hi[1][ks] = __builtin_amdgcn_ds_read_tr16_b64_v4i16((LAS s16x4*)(uintptr_t)(vb1 + (ks) * 2048 + 1024)); } while (0)
#define PK(d, k) (bf16x8){lo[d][k][0], lo[d][k][1], lo[d][k][2], lo[d][k][3], hi[d][k][0], hi[d][k][1], hi[d][k][2], hi[d][k][3]}
    PV_RD(1); PV_RD(2);
    if (use0) {
        PV_RD(0);
        asm volatile("s_waitcnt lgkmcnt(0)" ::: "memory");
        o[0] = __builtin_amdgcn_mfma_f32_32x32x16_bf16(PK(0, 0), pa0, o[0], 0, 0, 0);
        o[1] = __builtin_amdgcn_mfma_f32_32x32x16_bf16(PK(1, 0), pa0, o[1], 0, 0, 0);
    }
    if (use3) PV_RD(3);
    asm volatile("s_waitcnt lgkmcnt(0)" ::: "memory"); __builtin_amdgcn_sched_barrier(0);
    o[0] = __builtin_amdgcn_mfma_f32_32x32x16_bf16(PK(0, 1), pa1, o[0], 0, 0, 0);
    o[1] = __builtin_amdgcn_mfma_f32_32x32x16_bf16(PK(1, 1), pa1, o[1], 0, 0, 0);
    o[0] = __builtin_amdgcn_mfma_f32_32x32x16_bf16(PK(0, 2), pa2, o[0], 0, 0, 0);
    o[1] = __builtin_amdgcn_mfma_f32_32x32x16_bf16(PK(1, 2), pa2, o[1], 0, 0, 0);
    if (use3) {
        o[0] = __builtin_amdgcn_mfma_f32_32x32x16_bf16(PK(0, 3), pa3, o[0], 0, 0, 0);
        o[1] = __builtin_amdgcn_mfma_f32_32x32x16_bf16(PK(1, 3), pa3, o[1], 0, 0, 0);
    }
#undef PK
#undef PV_RD
}
__device__ __forceinline__ float max3f(float a, float b, float c) { float r; asm("v_max3_f32 %0, %1, %2, %3" : "=v"(r) : "v"(a), "v"(b), "v"(c)); return r; }
__device__ __forceinline__ float max2f(float a, float b) { float r; asm("v_max_f32 %0, %1, %2" : "=v"(r) : "v"(a), "v"(b)); return r; }
__device__ __forceinline__ float half_swap_max(float m) { auto rr = __builtin_amdgcn_permlane32_swap(__float_as_uint(m), __float_as_uint(m), false, false); return max2f(__uint_as_float(rr[0]), __uint_as_float(rr[1])); }
__device__ __forceinline__ float half_swap_sum(float m) { auto rr = __builtin_amdgcn_permlane32_swap(__float_as_uint(m), __float_as_uint(m), false, false); return __uint_as_float(rr[0]) + __uint_as_float(rr[1]); }

constexpr int AT_SLOT = 32768, AT_NSLOT = 3, AT_BIAS = AT_NSLOT * AT_SLOT, AT_WSF = AT_BIAS + 2 * 15 * 128 * 4, AT_QST = AT_WSF + 3072, AT_NTASK = NB * 128 * 4;
static_assert(AT_QST + 8 * 4096 <= LDSCTL_OFF, "attention LDS map");
constexpr float AT_THR = 8.f;
__device__ __forceinline__ void attn_phase(Frame& F) {
    const bf16_t* QKV = WSP(bf16_t, WS_BIG); bf16_t* MIX = WSP(bf16_t, WS_A2);
    const int lane = F.lane, w = F.wave, r32 = lane & 31, hi = lane >> 5;
    const int hsel = w >> 2, rsel = (w >> 1) & 1, qh = w & 1;
    LAS unsigned char* lds = F.lds;
    LAS float* BIAS = (LAS float*)(lds + AT_BIAS);
    LAS float* wsf = (LAS float*)(lds + AT_WSF) + w * 64;
    const int qc = 32 * qh + r32, cs = min(max(qc - 8, 0), 48);
    const int krow_ = 8 * w + (lane >> 3), kchunk_ = (lane & 7) ^ ((krow_ >> 1) & 7);
    int koff[4];
#pragma unroll
    for (int d0 = 0; d0 < 4; ++d0) koff[d0] = r32 * 128 + (((2 * d0 + hi) ^ ((r32 >> 1) & 7)) << 4);
    const unsigned ldsw = (unsigned)w * 1024u;
    unsigned vboff0, vboff1;
    { const int q_ = (lane & 15) >> 2, p_ = lane & 3, blk_ = (lane >> 4) & 1, fl_ = (q_ >> 1) << 2;
      vboff0 = (unsigned)((4 * hi + q_) * 128 + (((0 + 2 * blk_ + (p_ >> 1)) ^ fl_) << 4) + 8 * (p_ & 1));
      vboff1 = (unsigned)((4 * hi + q_) * 128 + (((4 + 2 * blk_ + (p_ >> 1)) ^ fl_) << 4) + 8 * (p_ & 1)); }
#define AT_DMA(bb, Rlo, s, sl) do { const int s_ = (s); const size_t base_ = (s_ < 4 ? (size_t)(ML + (bb) * NCTX + 64 * s_) : (size_t)((bb) * SEQ + ((Rlo) + s_ - 4) * 64)) * NIN0; \
        LAS unsigned char* sl_ = lds + (sl) * AT_SLOT + ldsw; \
        __builtin_amdgcn_global_load_lds((const unsigned*)(ksrc + base_), (LAS unsigned*)(sl_), 16, 0, 0); \
        __builtin_amdgcn_global_load_lds((const unsigned*)(ksrc + base_ + 64), (LAS unsigned*)(sl_ + 8192), 16, 0, 0); \
        __builtin_amdgcn_global_load_lds((const unsigned*)(vsrc + base_), (LAS unsigned*)(sl_ + 16384), 16, 0, 0); \
        __builtin_amdgcn_global_load_lds((const unsigned*)(vsrc + base_ + 64), (LAS unsigned*)(sl_ + 24576), 16, 0, 0); } while (0)
#define AT_DMAROW(trow, sl) do { const size_t base_ = (size_t)(trow) * NIN0; LAS unsigned char* sl_ = lds + (sl) * AT_SLOT + ldsw; \
        __builtin_amdgcn_global_load_lds((const unsigned*)(ksrc + base_), (LAS unsigned*)(sl_), 16, 0, 0); \
        __builtin_amdgcn_global_load_lds((const unsigned*)(ksrc + base_ + 64), (LAS unsigned*)(sl_ + 8192), 16, 0, 0); \
        __builtin_amdgcn_global_load_lds((const unsigned*)(vsrc + base_), (LAS unsigned*)(sl_ + 16384), 16, 0, 0); \
        __builtin_amdgcn_global_load_lds((const unsigned*)(vsrc + base_ + 64), (LAS unsigned*)(sl_ + 24576), 16, 0, 0); } while (0)
#define AT_DMAQ(bb, rr, hh) do { const bf16_t* qp_ = QKV + (size_t)((bb) * SEQ + (rr) * 64 + 32 * qh + r32) * NIN0 + (hh) * 64 + 8 * hi; LAS unsigned char* ql_ = lds + AT_QST + w * 4096; \
        __builtin_amdgcn_global_load_lds((const unsigned*)(qp_), (LAS unsigned*)(ql_), 16, 0, 0); __builtin_amdgcn_global_load_lds((const unsigned*)(qp_ + 16), (LAS unsigned*)(ql_ + 1024), 16, 0, 0); \
        __builtin_amdgcn_global_load_lds((const unsigned*)(qp_ + 32), (LAS unsigned*)(ql_ + 2048), 16, 0, 0); __builtin_amdgcn_global_load_lds((const unsigned*)(qp_ + 48), (LAS unsigned*)(ql_ + 3072), 16, 0, 0); } while (0)
#define AT_LOADQ(bb, rr, hh) do { const bf16_t* qp_ = QKV + (size_t)((bb) * SEQ + (rr) * 64 + 32 * qh + r32) * NIN0 + (hh) * 64 + 8 * hi; \
        qr[0] = *(const bf16x8*)(qp_); qr[1] = *(const bf16x8*)(qp_ + 16); qr[2] = *(const bf16x8*)(qp_ + 32); qr[3] = *(const bf16x8*)(qp_ + 48); } while (0)
    bf16x8 qr[4];
    if (w >= 4) __builtin_amdgcn_s_setprio(1);
    int bias_hp = -1, gs0 = 0;
    bool primed = false;
#pragma unroll 1
    for (int task = blockIdx.x; task < AT_NTASK; task += F.G) {
    const int b = task >> 9, rp = (task >> 2) & 127, hp = task & 3;
    const int h = 2 * hp + hsel, r = 2 * rp + rsel;
    const int rs_r = min(max(r - 4, 0), 248);
    const int R_lo = min(max(2 * rp - 4, 0), 248), R_hi = min(max(2 * rp + 1 - 4, 0), 248) + 7, nsteps = 4 + (R_hi - R_lo + 1);
    const int tn = task + F.G, bn = tn >> 9, rpn = (tn >> 2) & 127;
    const bool cont = tn < AT_NTASK && (tn & 3) == hp;
    const int R_lo_n = min(max(2 * rpn - 4, 0), 248);
    const bf16_t* ksrc = QKV + (size_t)krow_ * NIN0 + 512 + (2 * hp) * 64 + 8 * kchunk_;
    const bf16_t* vsrc = QKV + (size_t)krow_ * NIN0 + 1024 + (2 * hp) * 64 + 8 * ((lane & 7) ^ (((krow_ >> 1) & 1) << 2));
    if (!primed) {
        if (bias_hp != hp) {
            for (int i = F.tid; i < 2 * 15 * 128; i += 512) { const int hh = i / 1920, dr = (i >> 7) % 15, dc = (i & 127) - 48;
                BIAS[i] = (dc >= 0 && dc <= 30) ? F.in[I_RPB][(size_t)(2 * hp + hh) * 465 + dr * 31 + dc] * LOG2E : 0.f; }
            bias_hp = hp;
        }
        AT_LOADQ(b, r, h);
        asm volatile("s_waitcnt vmcnt(0)" ::: "memory");
        AT_DMA(b, R_lo, 0, gs0); AT_DMA(b, R_lo, 1, gs0 == 2 ? 0 : gs0 + 1);
    } else {
        asm volatile("s_waitcnt vmcnt(0)" ::: "memory");
#pragma unroll
        for (int d0 = 0; d0 < 4; ++d0) qr[d0] = *(LAS const bf16x8*)(lds + AT_QST + w * 4096 + d0 * 1024 + lane * 16);
    }
    float mref = 0.f, lrun = 0.f; f32x16 o[2], c0, c1;
#pragma unroll
    for (int i = 0; i < 16; ++i) { o[0][i] = 0.f; o[1][i] = 0.f; c0[i] = 0.f; c1[i] = 0.f; }
    const int cbase2 = ML + b * NCTX + 128, wbase2 = b * SEQ + (R_lo - 2) * 64, nbase = ML + bn * NCTX;
    int slc = gs0, sl2 = gs0 == 0 ? 2 : gs0 - 1;
    auto step = [&](const int s, auto win_t, auto qh_t) __attribute__((always_inline)) {
        constexpr bool WIN = decltype(win_t)::value; constexpr int QHC = decltype(qh_t)::value;
        if (WIN ? !(s + 1 < nsteps || cont) : (s == 0 && primed)) asm volatile("s_waitcnt vmcnt(0)" ::: "memory"); else asm volatile("s_waitcnt vmcnt(4)" ::: "memory");
        asm volatile("s_waitcnt lgkmcnt(0)" ::: "memory"); __builtin_amdgcn_s_barrier(); asm volatile("" ::: "memory");
        if constexpr (!WIN) { AT_DMAROW((s < 2 ? cbase2 : wbase2) + 64 * s, sl2); }
        else { const bool own = s + 2 < nsteps;
               if (own || cont) AT_DMAROW(own ? wbase2 + 64 * s : nbase + 64 * (s + 2 - nsteps), sl2);
               if (s == nsteps - 1 && cont) AT_DMAQ(bn, 2 * rpn + rsel, h); }
        const int kr = R_lo + s - 4;
        const bool active = !WIN || (kr >= rs_r && kr <= rs_r + 7);
        if (active) {
            LAS const unsigned char* Kslot = lds + slc * AT_SLOT + hsel * 8192;
            const unsigned vbs = (unsigned)(uintptr_t)(lds + slc * AT_SLOT + 16384 + hsel * 8192);
            f32x16 p0, p1;
            constexpr bool win = WIN; const bool l0a = !WIN || qh == 0, l1b = !WIN || qh == 1;
            bf16x8 kb0[4], kb1[4];
#pragma unroll
            for (int d0 = 0; d0 < 4; ++d0) { kb0[d0] = *(LAS const bf16x8*)(Kslot + koff[d0]); kb1[d0] = *(LAS const bf16x8*)(Kslot + koff[d0] + 4096); }
            if (win) {
                f32x16 cc0, cc1;
                const int dr = kr - r + 7;
                LAS const float* T = BIAS + (hsel * 15 + dr) * 128 + (63 - qc);
                float tb0[16], tb1[16];
#pragma unroll
                for (int i = 0; i < 16; ++i) { tb0[i] = T[crow(i, hi)]; tb1[i] = T[crow(i, hi) + 32]; }
#pragma unroll
                for (int i = 0; i < 16; ++i) { cc0[i] = c0[i] + tb0[i]; cc1[i] = c1[i] + tb1[i]; }
                qkt(p0, p1, kb0, kb1, qr, cc0, cc1);
            } else qkt(p0, p1, kb0, kb1, qr, c0, c1);
            float ra = max3f(p0[12], p0[13], p1[0]), rb = max3f(p0[14], p0[15], p1[1]); ra = max3f(ra, p1[2], p1[3]);
            if (l0a) {
#pragma unroll
                for (int i = 0; i < 12; i += 4) { ra = max3f(ra, p0[i], p0[i + 1]); rb = max3f(rb, p0[i + 2], p0[i + 3]); }
            }
            if (l1b) {
#pragma unroll
                for (int i = 4; i < 16; i += 4) { ra = max3f(ra, p1[i], p1[i + 1]); rb = max3f(rb, p1[i + 2], p1[i + 3]); }
            }
            float rm = half_swap_max(max2f(ra, rb));
            if ((!WIN && s == 0) || __any(rm > AT_THR)) {
                const float dl = (!WIN && s == 0) ? rm : max2f(rm, 0.f);
                mref += dl;
#pragma unroll
                for (int i = 0; i < 16; ++i) { p0[i] -= dl; p1[i] -= dl; c0[i] -= dl; c1[i] -= dl; }
                const float f = (!WIN && s == 0) ? 1.f : fast_exp2(-dl);
                lrun *= f;
#pragma unroll
                for (int i = 0; i < 16; ++i) { o[0][i] *= f; o[1][i] *= f; }
            }
            float ls = 0.f;
            u32x4 pw0, pw1, pw2, pw3;
            if (l0a) {
#pragma unroll
                for (int i = 0; i < 12; ++i) { p0[i] = fast_exp2(p0[i]); ls += p0[i]; }
                pw0.x = pg8::cvt_pk_bf16(p0[0], p0[1]); pw0.y = pg8::cvt_pk_bf16(p0[2], p0[3]); pw0.z = pg8::cvt_pk_bf16(p0[4], p0[5]); pw0.w = pg8::cvt_pk_bf16(p0[6], p0[7]);
                pw1.x = pg8::cvt_pk_bf16(p0[8], p0[9]); pw1.y = pg8::cvt_pk_bf16(p0[10], p0[11]);
            } else { pw0 = (u32x4){0u, 0u, 0u, 0u}; pw1.x = 0u; pw1.y = 0u; }
#pragma unroll
            for (int i = 12; i < 16; ++i) { p0[i] = fast_exp2(p0[i]); ls += p0[i]; }
#pragma unroll
            for (int i = 0; i < 4; ++i) { p1[i] = fast_exp2(p1[i]); ls += p1[i]; }
            pw1.z = pg8::cvt_pk_bf16(p0[12], p0[13]); pw1.w = pg8::cvt_pk_bf16(p0[14], p0[15]);
            pw2.x = pg8::cvt_pk_bf16(p1[0], p1[1]); pw2.y = pg8::cvt_pk_bf16(p1[2], p1[3]);
            if (l1b) {
#pragma unroll
                for (int i = 4; i < 16; ++i) { p1[i] = fast_exp2(p1[i]); ls += p1[i]; }
                pw2.z = pg8::cvt_pk_bf16(p1[4], p1[5]); pw2.w = pg8::cvt_pk_bf16(p1[6], p1[7]);
                pw3.x = pg8::cvt_pk_bf16(p1[8], p1[9]); pw3.y = pg8::cvt_pk_bf16(p1[10], p1[11]); pw3.z = pg8::cvt_pk_bf16(p1[12], p1[13]); pw3.w = pg8::cvt_pk_bf16(p1[14], p1[15]);
            } else { pw2.z = 0u; pw2.w = 0u; pw3 = (u32x4){0u, 0u, 0u, 0u}; }
            lrun += ls;
            LDS_WAIT();
            pv(o, vbs + vboff0, vbs + vboff1, __builtin_bit_cast(bf16x8, pw0), __builtin_bit_cast(bf16x8, pw1), __builtin_bit_cast(bf16x8, pw2), __builtin_bit_cast(bf16x8, pw3), l0a, l1b);
        }
            slc = slc == 2 ? 0 : slc + 1; sl2 = sl2 == 2 ? 0 : sl2 + 1;
    };
    int s_ = 0;
#pragma unroll 1
    for (; s_ < 4; ++s_) step(s_, std::false_type{}, std::integral_constant<int, -1>{});
    {
#pragma unroll
        for (int i = 0; i < 16; ++i) { const int k0_ = crow(i, hi); c0[i] = ((unsigned)(k0_ - cs) < 16u) ? c0[i] : -INFINITY; c1[i] = ((unsigned)(k0_ + 32 - cs) < 16u) ? c1[i] : -INFINITY; }
    }
#pragma unroll 1
    for (; s_ < nsteps; ++s_) step(s_, std::true_type{}, std::integral_constant<int, -1>{});
    const float ri = fast_rcp(half_swap_sum(lrun));
    unsigned char* orow = (unsigned char*)(MIX + (size_t)(b * SEQ + r * 64 + 32 * qh + r32) * D + h * 64) + (hi ? 16 : 0);
#pragma unroll
    for (int db = 0; db < 2; ++db) {
        unsigned gx[4], gy[4];
#pragma unroll
        for (int g = 0; g < 4; ++g) { gx[g] = pk2(o[db][4 * g] * ri, o[db][4 * g + 1] * ri); gy[g] = pk2(o[db][4 * g + 2] * ri, o[db][4 * g + 3] * ri); }
#pragma unroll
        for (int k = 0; k < 4; k += 2) {
            const auto rx = __builtin_amdgcn_permlane32_swap(gx[k], gx[k + 1], false, false);
            const auto ry = __builtin_amdgcn_permlane32_swap(gy[k], gy[k + 1], false, false);
            *(u32x4*)(orow + db * 64 + 16 * k) = (u32x4){rx[0], ry[0], rx[1], ry[1]};
        }
    }
    asm volatile("s_waitcnt lgkmcnt(0)" ::: "memory");
    if (!cont) { asm volatile("s_waitcnt vmcnt(0)" ::: "memory"); __builtin_amdgcn_s_barrier(); asm volatile("" ::: "memory"); }
    gs0 = (gs0 + nsteps) % 3; primed = cont;
    }
    __builtin_amdgcn_s_setprio(0);
#undef AT_DMA
#undef AT_LOADQ
#undef AT_DMAQ
#undef AT_DMAROW
}

struct LruW { bf16x8 wr[4], wi[4]; f32x16 cr, ci; float cn; };
constexpr int LRU_LW = 0, LRU_LC = 32768, LRU_HF = 36864, LRU_AF = LRU_HF + 65536;
static_assert(LRU_AF + 8 * 4096 <= LDSCTL_OFF, "LRU LDS map");
__device__ __forceinline__ void lru_stage_w(Frame& F, int g) {
    const u32x4* src = WSP(u32x4, WS_LRUW);
    LAS u32x4* dst = (LAS u32x4*)(F.lds + LRU_LW);
#pragma unroll
    for (int i = 0; i < 4; ++i) { const int idx = F.tid + 512 * i;
        const int d = idx >> 10, rest = idx & 1023;
        dst[idx] = src[(size_t)((d * 8 + g) * 1024) + rest]; }
    if (F.tid < 128) { const int d = F.tid >> 6, ch = d * 512 + g * 64 + (F.tid & 63);
        LAS float* lc = (LAS float*)(F.lds + LRU_LC) + F.tid * 4;
        lc[0] = -LOG2E * F.in[I_LBR][ch]; lc[1] = -LOG2E * F.in[I_LBI][ch]; lc[2] = -8.f * LOG2E * log1pf(__expf(-F.in[I_LAM][ch])); }
    __syncthreads();
}
__device__ __forceinline__ void lru_load_w(Frame& F, LruW& W, int d, int half, int lane) {
    LAS const bf16x8* wf = (LAS const bf16x8*)(F.lds + LRU_LW) + d * 1024 + lane;
#pragma unroll
    for (int s = 0; s < 4; ++s) { W.wr[s] = wf[((0 * 2 + half) * 4 + s) * 64]; W.wi[s] = wf[((1 * 2 + half) * 4 + s) * 64]; }
    LAS const float* lc = (LAS const float*)(F.lds + LRU_LC) + (d * 64 + 32 * half + (lane & 31)) * 4;
    { const float br = lc[0], bi = lc[1];
#pragma unroll
      for (int i = 0; i < 16; ++i) { W.cr[i] = br; W.ci[i] = bi; } }
    W.cn = lc[2];
}
__device__ __forceinline__ void lru_dma_af(const bf16_t* XC, size_t t0, int g, int lane, LAS unsigned char* afb) {
    const int rr = lane >> 3, sl = lane & 7;
#pragma unroll
    for (int i = 0; i < 4; ++i) { const int row = 8 * i + rr;
        __builtin_amdgcn_global_load_lds((const unsigned*)(XC + (t0 + row) * 512 + 64 * g + 8 * (sl ^ ((row >> 1) & 7))), (LAS unsigned*)(afb + i * 1024), 16, 0, 0); }
}
__device__ __forceinline__ void lru_read_af(LAS const unsigned char* afb, int r32, int hi, bf16x8 (&af)[4]) {
#pragma unroll
    for (int s = 0; s < 4; ++s) af[s] = *(LAS const bf16x8*)(afb + r32 * 128 + (((2 * s + hi) ^ ((r32 >> 1) & 7)) << 4));
}
__device__ __forceinline__ void lru_gates(const bf16x8 (&af)[4], const LruW& W, int half, bf16x8 I0, bf16x8 I1, float (&a)[16], float (&b)[16]) {
    f32x16 R, I, X;
#pragma unroll
    for (int i = 0; i < 16; ++i) X[i] = 0.f;
    R = __builtin_amdgcn_mfma_f32_32x32x16_bf16(af[0], W.wr[0], W.cr, 0, 0, 0); I = __builtin_amdgcn_mfma_f32_32x32x16_bf16(af[0], W.wi[0], W.ci, 0, 0, 0);
#pragma unroll
    for (int s = 1; s < 4; ++s) { R = __builtin_amdgcn_mfma_f32_32x32x16_bf16(af[s], W.wr[s], R, 0, 0, 0); I = __builtin_amdgcn_mfma_f32_32x32x16_bf16(af[s], W.wi[s], I, 0, 0, 0); }
    const bf16x8 ax0 = half ? af[2] : af[0], ax1 = half ? af[3] : af[1];
    X = __builtin_amdgcn_mfma_f32_32x32x16_bf16(ax0, I0, X, 0, 0, 0);
    X = __builtin_amdgcn_mfma_f32_32x32x16_bf16(ax1, I1, X, 0, 0, 0);
    const float cn = W.cn;
#pragma unroll
    for (int i = 0; i < 16; ++i) {
        const float rr = fast_rcp(1.f + fast_exp2(R[i])), ii = fast_rcp(1.f + fast_exp2(I[i]));
        const float av = fast_exp2(rr * cn);
        a[i] = av; b[i] = __builtin_amdgcn_sqrtf(1.f - av * av) * ii * X[i]; }
}
__device__ __forceinline__ float partner32(float x, int hi) { auto rr = __builtin_amdgcn_permlane32_swap(__float_as_uint(x), __float_as_uint(x), false, false); return __uint_as_float(hi ? rr[0] : rr[1]); }
template <bool REV, bool WANT_H> __device__ __forceinline__ void lru_scan_tile(const float (&a)[16], const float (&b)[16], int hi, float& H, float (&h)[16], float& ap) {
    float SA[4], SB[4], EAv[4], OAv[4], EBv[4], OBv[4];
#pragma unroll
    for (int q = 0; q < 4; ++q) { const float a0 = a[4 * q], a1 = a[4 * q + 1], a2 = a[4 * q + 2], a3 = a[4 * q + 3], b0 = b[4 * q], b1 = b[4 * q + 1], b2 = b[4 * q + 2], b3 = b[4 * q + 3];
        SA[q] = (a0 * a1) * (a2 * a3);
        SB[q] = REV ? ((b3 * a2 + b2) * a1 + b1) * a0 + b0 : ((b0 * a1 + b1) * a2 + b2) * a3 + b3; }
#pragma unroll
    for (int q = 0; q < 4; ++q) { auto ra_ = __builtin_amdgcn_permlane32_swap(__float_as_uint(SA[q]), __float_as_uint(SA[q]), false, false); EAv[q] = __uint_as_float(ra_[0]); OAv[q] = __uint_as_float(ra_[1]);
        auto rb_ = __builtin_amdgcn_permlane32_swap(__float_as_uint(SB[q]), __float_as_uint(SB[q]), false, false); EBv[q] = __uint_as_float(rb_[0]); OBv[q] = __uint_as_float(rb_[1]); }
    float cin[4];
    if (!REV) {
#pragma unroll
        for (int q = 0; q < 4; ++q) { const float EA = EAv[q], EB = EBv[q], OA = OAv[q], OB = OBv[q];
            const float he = H; H = EA * H + EB; const float ho = H; H = OA * H + OB; cin[q] = hi ? ho : he; if (!WANT_H) ap *= EA * OA; }
    } else {
#pragma unroll
        for (int q = 3; q >= 0; --q) { const float EA = EAv[q], EB = EBv[q], OA = OAv[q], OB = OBv[q];
            const float ho = H; H = OA * H + OB; const float he = H; H = EA * H + EB; cin[q] = hi ? ho : he; if (!WANT_H) ap *= EA * OA; }
    }
    if (WANT_H) {
#pragma unroll
        for (int q = 0; q < 4; ++q) { float hh = cin[q];
            if (!REV) {
#pragma unroll
                for (int e = 0; e < 4; ++e) { hh = a[4 * q + e] * hh + b[4 * q + e]; h[4 * q + e] = hh; }
            } else {
#pragma unroll
                for (int e = 3; e >= 0; --e) { hh = a[4 * q + e] * hh + b[4 * q + e]; h[4 * q + e] = hh; }
            } }
    }
}
__device__ __forceinline__ void lru_ident(int r32, int hi, bf16x8& I0, bf16x8& I1) {
#pragma unroll
    for (int j = 0; j < 8; ++j) { I0[j] = (8 * hi + j == r32) ? (short)0x3F80 : (short)0; I1[j] = (16 + 8 * hi + j == r32) ? (short)0x3F80 : (short)0; }
}
template <bool REV, int MODE> __device__ __forceinline__ void lru_subpass(Frame& F, size_t row0, int ntile, int g, int half, float& H, float& ap, LAS unsigned* HFL, bf16x8 (&af)[4], bool have) {
    const bf16_t* XC = WSP(bf16_t, WS_XCONV);
    const int lane = F.lane, r32 = lane & 31, hi = lane >> 5;
    LAS unsigned char* afb = F.lds + LRU_AF + F.wave * 4096;
    bf16x8 I0, I1; lru_ident(r32, hi, I0, I1);
    LruW W; lru_load_w(F, W, REV ? 1 : 0, half, lane);
    if (!have) {
        lru_dma_af(XC, row0 + (REV ? 32 * (ntile - 1) : 0), g, lane, afb);
        asm volatile("s_waitcnt vmcnt(0)" ::: "memory");
        lru_read_af(afb, r32, hi, af);
        asm volatile("s_waitcnt lgkmcnt(0)" ::: "memory");
    }
#pragma unroll 1
    for (int tt = 0; tt < ntile; ++tt) {
        const int ti = REV ? ntile - 1 - tt : tt;
        const bool more = tt + 1 < ntile;
        if (more) lru_dma_af(XC, row0 + 32 * (REV ? ti - 1 : ti + 1), g, lane, afb);
        const size_t t0 = row0 + 32 * ti;
        bf16_t grw[16];
        if (MODE == 2) { const bf16_t* gp = WSP(bf16_t, WS_BIG) + t0 * NIN0 + 2048 + 64 * g + 32 * half;
            const unsigned lo_ = (unsigned)(4 * hi * NIN0 + r32);
#pragma unroll
            for (int i = 0; i < 16; ++i) grw[i] = gp[lo_ + (unsigned)(((i & 3) + 8 * (i >> 2)) * NIN0)]; }
        float a[16], bb[16], h[16];
        lru_gates(af, W, half, I0, I1, a, bb);
        lru_scan_tile<REV, MODE != 0>(a, bb, hi, H, h, ap);
        asm volatile("s_waitcnt vmcnt(0)" ::: "memory");
        if (more) lru_read_af(afb, r32, hi, af);
        if (MODE == 1) {
#pragma unroll
            for (int p = 0; p < 8; ++p) HFL[(ti * 8 + p) * 64 + lane] = pk2(h[2 * p], h[2 * p + 1]);
        }
        if (MODE == 2) {
            bf16_t* op = WSP(bf16_t, WS_A2) + t0 * D + 512 + 64 * g + 32 * half;
            const unsigned so_ = (unsigned)(4 * hi * D + r32);
#pragma unroll
            for (int p = 0; p < 8; ++p) { const unsigned hf = HFL[(ti * 8 + p) * 64 + lane];
                const unsigned pr_ = pk2((bflo(hf) + h[2 * p]) * gelu_tanh(bf1(grw[2 * p])), (bfhi(hf) + h[2 * p + 1]) * gelu_tanh(bf1(grw[2 * p + 1])));
                op[so_ + (unsigned)((((2 * p) & 3) + 8 * ((2 * p) >> 2)) * D)] = (bf16_t)(pr_ & 0xffffu);
                op[so_ + (unsigned)((((2 * p + 1) & 3) + 8 * ((2 * p + 1) >> 2)) * D)] = (bf16_t)(pr_ >> 16); }
        }
        asm volatile("s_waitcnt lgkmcnt(0)" ::: "memory");
    }
    asm volatile("" ::: "memory");
}
template <bool REV> __device__ __forceinline__ void lru_subpass0(Frame& F, size_t row0, int ntile, int g, int half, float& H, float& ap) {
    const bf16_t* XC = WSP(bf16_t, WS_XCONV);
    const int lane = F.lane, r32 = lane & 31, hi = lane >> 5;
    LAS unsigned char* buf0 = F.lds + LRU_AF + F.wave * 4096; LAS unsigned char* buf1 = F.lds + LRU_HF + 8192 + F.wave * 4096;
    bf16x8 I0, I1; lru_ident(r32, hi, I0, I1);
    LruW W; lru_load_w(F, W, REV ? 1 : 0, half, lane);
    bf16x8 af[4];
#define LRU0_ROW(tt) (row0 + 32 * (REV ? ntile - 1 - (tt) : (tt)))
    lru_dma_af(XC, LRU0_ROW(0), g, lane, buf0);
    if (ntile > 1) { lru_dma_af(XC, LRU0_ROW(1), g, lane, buf1); asm volatile("s_waitcnt vmcnt(4)" ::: "memory"); } else asm volatile("s_waitcnt vmcnt(0)" ::: "memory");
    lru_read_af(buf0, r32, hi, af);
    asm volatile("s_waitcnt lgkmcnt(0)" ::: "memory");
#pragma unroll 1
    for (int tt = 0; tt < ntile; ++tt) {
        LAS unsigned char* bcur = (tt & 1) ? buf1 : buf0; LAS unsigned char* bnxt = (tt & 1) ? buf0 : buf1;
        if (tt + 2 < ntile) lru_dma_af(XC, LRU0_ROW(tt + 2), g, lane, bcur);
        float a[16], bb[16], h[16];
        lru_gates(af, W, half, I0, I1, a, bb);
        lru_scan_tile<REV, false>(a, bb, hi, H, h, ap);
        if (tt + 1 < ntile) {
            if (tt + 2 < ntile) asm volatile("s_waitcnt vmcnt(4)" ::: "memory"); else asm volatile("s_waitcnt vmcnt(0)" ::: "memory");
            lru_read_af(bnxt, r32, hi, af);
            asm volatile("s_waitcnt lgkmcnt(0)" ::: "memory");
        }
    }
#undef LRU0_ROW
    asm volatile("" ::: "memory");
}
__device__ __forceinline__ void conv4_local(Frame& F, size_t r0, int ngrp, size_t sbeg, size_t send, int g) {
    const bf16_t* QKV = WSP(bf16_t, WS_BIG); bf16_t* XC = WSP(bf16_t, WS_XCONV);
    const int lane = F.lane, rgrp = lane >> 3, cl = lane & 7, ch = 64 * g + 8 * cl;
    if (rgrp < ngrp) {
        const size_t row0 = r0 + 16 * rgrp;
        u32x4 raw[19];
#pragma unroll
        for (int i = 0; i < 19; ++i) { const size_t r = row0 + i - 2; raw[i] = (r >= sbeg && r < send) ? *(const u32x4*)(QKV + r * NIN0 + 1536 + ch) : (u32x4){0u, 0u, 0u, 0u}; }
        float w[4][8], bs[8];
#pragma unroll
        for (int j = 0; j < 4; ++j) { const f32x4 a = *(const f32x4*)(F.in[I_ECW] + j * 512 + ch), b = *(const f32x4*)(F.in[I_ECW] + j * 512 + ch + 4);
            w[j][0] = a.x; w[j][1] = a.y; w[j][2] = a.z; w[j][3] = a.w; w[j][4] = b.x; w[j][5] = b.y; w[j][6] = b.z; w[j][7] = b.w; }
        { const f32x4 a = *(const f32x4*)(F.in[I_ECB] + ch), b = *(const f32x4*)(F.in[I_ECB] + ch + 4); bs[0] = a.x; bs[1] = a.y; bs[2] = a.z; bs[3] = a.w; bs[4] = b.x; bs[5] = b.y; bs[6] = b.z; bs[7] = b.w; }
#pragma unroll
        for (int t = 0; t < 16; ++t) {
            float o[8];
#pragma unroll
            for (int e = 0; e < 8; ++e) o[e] = bs[e];
#pragma unroll
            for (int j = 0; j < 4; ++j) { const u32x4 r = raw[t + j];
                o[0] += w[j][0] * bflo(r.x); o[1] += w[j][1] * bfhi(r.x); o[2] += w[j][2] * bflo(r.y); o[3] += w[j][3] * bfhi(r.y);
                o[4] += w[j][4] * bflo(r.z); o[5] += w[j][5] * bfhi(r.z); o[6] += w[j][6] * bflo(r.w); o[7] += w[j][7] * bfhi(r.w); }
            u32x4 pk; pk.x = pk2(o[0], o[1]); pk.y = pk2(o[2], o[3]); pk.z = pk2(o[4], o[5]); pk.w = pk2(o[6], o[7]);
            *(u32x4*)(XC + (row0 + t) * 512 + ch) = pk;
        }
    }
    asm volatile("s_waitcnt vmcnt(0)" ::: "memory");
}
template <bool REV> __device__ __forceinline__ void lru_subpass2(Frame& F, size_t row0, int ntile, int g, float (&H)[2], float (&ap)[2]) {
    const bf16_t* XC = WSP(bf16_t, WS_XCONV);
    const int lane = F.lane, r32 = lane & 31, hi = lane >> 5;
    LAS unsigned char* afb = F.lds + LRU_AF + F.wave * 4096;
    bf16x8 I0, I1; lru_ident(r32, hi, I0, I1);
    LruW W0, W1; lru_load_w(F, W0, REV ? 1 : 0, 0, lane); lru_load_w(F, W1, REV ? 1 : 0, 1, lane);
    bf16x8 af[4];
    lru_dma_af(XC, row0 + (REV ? 32 * (ntile - 1) : 0), g, lane, afb);
    asm volatile("s_waitcnt vmcnt(0)" ::: "memory");
    lru_read_af(afb, r32, hi, af);
    asm volatile("s_waitcnt lgkmcnt(0)" ::: "memory");
#pragma unroll 1
    for (int tt = 0; tt < ntile; ++tt) {
        const int ti = REV ? ntile - 1 - tt : tt;
        const bool more = tt + 1 < ntile;
        if (more) lru_dma_af(XC, row0 + 32 * (REV ? ti - 1 : ti + 1), g, lane, afb);
        float a0[16], b0[16], a1[16], b1[16], hd[16];
        lru_gates(af, W0, 0, I0, I1, a0, b0);
        lru_gates(af, W1, 1, I0, I1, a1, b1);
        lru_scan_tile<REV, false>(a0, b0, hi, H[0], hd, ap[0]);
        lru_scan_tile<REV, false>(a1, b1, hi, H[1], hd, ap[1]);
        asm volatile("s_waitcnt vmcnt(0)" ::: "memory");
        if (more) lru_read_af(afb, r32, hi, af);
        asm volatile("s_waitcnt lgkmcnt(0)" ::: "memory");
    }
    asm volatile("" ::: "memory");
}
__device__ __forceinline__ void lru_pass1_wg(Frame& F, int wg) {
    const int j = wg & 15, g = (wg >> 4) & 7, b = wg >> 7, w = F.wave, lane = F.lane, hi = lane >> 5;
    f32x2* TOT = WSP(f32x2, WS_TOT); f32x2* TOTG = WSP(f32x2, WS_TOTG); f32x2* TOTC = WSP(f32x2, WS_TOTC);
    LAS f32x2* CB = (LAS f32x2*)(F.lds + LRU_HF);
    lru_stage_w(F, g);
    const int c = 8 * j + w, sub = w - 2;
    const int njobs = (w == 2 || w == 4) ? 2 : 1;
    if (njobs == 2) __builtin_amdgcn_s_setprio(1);
#pragma unroll 1
    for (int job = 0; job < njobs; ++job) {
        const size_t r0 = job == 0 ? (size_t)b * SEQ + (size_t)c * CHUNK : (size_t)ML + (size_t)b * NCTX + 32 * (j & 7);
        const int nt = job == 0 ? 4 : 1;
        { const size_t sb_ = job == 0 ? (size_t)b * SEQ : (size_t)ML + (size_t)b * NCTX, se_ = job == 0 ? sb_ + SEQ : sb_ + NCTX;
          asm volatile("" ::: "memory"); __builtin_amdgcn_sched_barrier(0);
          conv4_local(F, r0, job == 0 ? 8 : 2, sb_, se_, g);
          asm volatile("" ::: "memory"); __builtin_amdgcn_sched_barrier(0); }
        f32x2 tot[2] = {(f32x2){1.f, 0.f}, (f32x2){1.f, 0.f}};
#pragma unroll 1
        for (int half = 0; half < 2; ++half) {
            if (job != 0 && half != (j >> 3)) continue;
            if (job == 0 || sub < 2) { float H = 0.f, ap = 1.f; lru_subpass0<false>(F, r0, nt, g, half, H, ap); if (hi == half) tot[0] = (f32x2){ap, H}; }
            if (job == 0 || sub >= 2) { float H = 0.f, ap = 1.f; lru_subpass0<true>(F, r0, nt, g, half, H, ap); if (hi == half) tot[1] = (f32x2){ap, H}; }
        }
        if (job == 0) {
#pragma unroll
            for (int d = 0; d < 2; ++d) { TOT[(size_t)((b * 2 + d) * NCHUNK + c) * 512 + 64 * g + lane] = tot[d]; CB[(d * 8 + w) * 64 + lane] = tot[d]; }
        } else {
            if (hi == (j >> 3)) TOTC[(size_t)((b * 2 + (sub >> 1)) * 8 + (j & 7)) * 512 + 64 * g + lane] = (sub >> 1) ? tot[1] : tot[0];
        }
    }
    __builtin_amdgcn_s_setprio(0);
    __syncthreads();
    if (w < 2) { const int d = w; float A = 1.f, B = 0.f;
#pragma unroll
        for (int k = 0; k < 8; ++k) { const f32x2 t = CB[(d * 8 + (d == 0 ? k : 7 - k)) * 64 + lane]; B = t.x * B + t.y; A *= t.x; }
        TOTG[(size_t)((b * 2 + d) * 16 + j) * 512 + 64 * g + lane] = (f32x2){A, B}; }
    __syncthreads();
}
__device__ __forceinline__ void lru_pass3_wg(Frame& F, int wg) {
    const int j = wg & 15, g = (wg >> 4) & 7, b = wg >> 7, w = F.wave, lane = F.lane, r32 = lane & 31;
    const f32x2* TOT = WSP(f32x2, WS_TOT); const f32x2* TOTG = WSP(f32x2, WS_TOTG); const f32x2* TOTC = WSP(f32x2, WS_TOTC);
    LAS unsigned* HFL = (LAS unsigned*)(F.lds + LRU_HF + w * 8192);
    lru_stage_w(F, g);
    const int c = 8 * j + w;
    const size_t row0 = (size_t)b * SEQ + (size_t)c * CHUNK;
    float Cf = 0.f, Cb = 0.f;
    {
        const f32x2 id = (f32x2){1.f, 0.f};
        const size_t chn = 64 * g + lane;
        f32x2 t[15];
#pragma unroll
        for (int k = 0; k < 8; ++k) t[k] = TOTC[(size_t)((b * 2 + 0) * 8 + k) * 512 + chn];
#pragma unroll
        for (int k = 0; k < 7; ++k) t[8 + k] = (k < w) ? TOT[(size_t)((b * 2 + 0) * NCHUNK + 8 * j + k) * 512 + chn] : id;
        f32x2 u[15];
#pragma unroll
        for (int k = 0; k < 15; ++k) u[k] = (k < j) ? TOTG[(size_t)((b * 2 + 0) * 16 + k) * 512 + chn] : id;
        f32x2 tb[15], ub[15];
#pragma unroll
        for (int k = 0; k < 8; ++k) tb[k] = TOTC[(size_t)((b * 2 + 1) * 8 + (7 - k)) * 512 + chn];
#pragma unroll
        for (int k = 0; k < 7; ++k) tb[8 + k] = (7 - k > w) ? TOT[(size_t)((b * 2 + 1) * NCHUNK + 8 * j + (7 - k)) * 512 + chn] : id;
#pragma unroll
        for (int k = 0; k < 15; ++k) ub[k] = (15 - k > j) ? TOTG[(size_t)((b * 2 + 1) * 16 + (15 - k)) * 512 + chn] : id;
#pragma unroll
        for (int k = 0; k < 8; ++k) Cf = t[k].x * Cf + t[k].y;
#pragma unroll
        for (int k = 0; k < 15; ++k) Cf = u[k].x * Cf + u[k].y;
#pragma unroll
        for (int k = 0; k < 7; ++k) Cf = t[8 + k].x * Cf + t[8 + k].y;
#pragma unroll
        for (int k = 0; k < 8; ++k) Cb = tb[k].x * Cb + tb[k].y;
#pragma unroll
        for (int k = 0; k < 15; ++k) Cb = ub[k].x * Cb + ub[k].y;
#pragma unroll
        for (int k = 0; k < 7; ++k) Cb = tb[8 + k].x * Cb + tb[8 + k].y;
        asm volatile("" ::: "memory");
    }
    float dummy = 1.f, H;
    bf16x8 af[4];
#pragma unroll 1
    for (int half = 0; half < 2; ++half) {
        H = __shfl(Cf, 32 * half + r32); lru_subpass<false, 1>(F, row0, 4, g, half, H, dummy, HFL, af, half != 0);
        H = __shfl(Cb, 32 * half + r32); lru_subpass<true, 2>(F, row0, 4, g, half, H, dummy, HFL, af, true);
    }
    LDS_WAIT();
    __syncthreads();
}

__device__ __forceinline__ void conv3_task(Frame& F, int task) {
    bf16_t* BG = WSP(bf16_t, WS_A1); const bf16_t* P = WSP(bf16_t, WS_A3);
    const int lane = F.lane, half = task & 1, row0 = (task >> 1) * 16, ch = half * 512 + 8 * lane;
    const int sbeg = (row0 / SEQ) * SEQ, send = sbeg + SEQ;
    u32x4 raw[18];
#pragma unroll
    for (int i = 0; i < 18; ++i) { const int r = row0 + i - 1; raw[i] = (r >= sbeg && r < send) ? *(const u32x4*)(P + (size_t)r * D + ch) : (u32x4){0u, 0u, 0u, 0u}; }
    u32x4 bgr[16];
#pragma unroll
    for (int t = 0; t < 16; ++t) bgr[t] = *(const u32x4*)(BG + (size_t)(row0 + t) * D + ch);
    float w[3][8];
#pragma unroll
    for (int j = 0; j < 3; ++j) { const f32x4 a = *(const f32x4*)(F.in[I_OCW] + j * D + ch), b = *(const f32x4*)(F.in[I_OCW] + j * D + ch + 4);
        w[j][0] = a.x; w[j][1] = a.y; w[j][2] = a.z; w[j][3] = a.w; w[j][4] = b.x; w[j][5] = b.y; w[j][6] = b.z; w[j][7] = b.w; }
#pragma unroll
    for (int t = 0; t < 16; ++t) {
        float o[8];
#pragma unroll
        for (int e = 0; e < 8; ++e) o[e] = 0.f;
#pragma unroll
        for (int j = 0; j < 3; ++j) { const u32x4 r = raw[t + j];
            o[0] += w[j][0] * bflo(r.x); o[1] += w[j][1] * bfhi(r.x); o[2] += w[j][2] * bflo(r.y); o[3] += w[j][3] * bfhi(r.y);
            o[4] += w[j][4] * bflo(r.z); o[5] += w[j][5] * bfhi(r.z); o[6] += w[j][6] * bflo(r.w); o[7] += w[j][7] * bfhi(r.w); }
        bf16_t* bp = BG + (size_t)(row0 + t) * D + ch;
        const u32x4 bgv = bgr[t];
        u32x4 pk; pk.x = pk2(o[0] * bflo(bgv.x), o[1] * bfhi(bgv.x)); pk.y = pk2(o[2] * bflo(bgv.y), o[3] * bfhi(bgv.y)); pk.z = pk2(o[4] * bflo(bgv.z), o[5] * bfhi(bgv.z)); pk.w = pk2(o[6] * bflo(bgv.w), o[7] * bfhi(bgv.w));
        st16_wt(bp, pk);
    }
}

__device__ __forceinline__ void final_row(Frame& F, int m) {
    f32x4* xr = (f32x4*)(F.out + (size_t)m * D) + F.lane;
    const float rs = fast_rsq(WSP(float, WS_SSQ)[3 * ML + m] * (1.f / D) + EPS);
    const f32x4* gp = (const f32x4*)F.in[I_FG] + F.lane;
#pragma unroll
    for (int j = 0; j < 4; ++j) { const f32x4 v = xr[64 * j], g = gp[64 * j]; xr[64 * j] = v * rs * g; }
}

__device__ __forceinline__ void ctx_proj_wg(Frame& F) {
    const int lane = F.lane, w = F.wave, r32 = lane & 31, hi = lane >> 5;
    const bf16_t* XB = WSP(bf16_t, WS_A1) + (size_t)ML * D;
    const bf16_t* W2 = WSP(bf16_t, WS_WIN0) + (size_t)2 * NIN0 * D;
    const float* ss = WSP(float, WS_SS0) + ML; const float* bias = WSP(float, WS_B_IN0) + (size_t)2 * NIN0;
    bf16_t* O = WSP(bf16_t, WS_BIG) + (size_t)ML * NIN0;
    LAS float* red = (LAS float*)F.lds;
    constexpr int NSTRIP = (NB * NCTX / 32) * (1536 / 96);
    for (int st = blockIdx.x; st < NSTRIP; st += (int)F.G) {
        const int rb = st >> 4, c0 = 512 + 96 * (st & 15);
        const bf16_t* ap = XB + (size_t)(32 * rb + r32) * D + 128 * w + 8 * hi;
        const bf16_t* bp = W2 + (size_t)(c0 + r32) * D + 128 * w + 8 * hi;
        bf16x8 a[8], b[3][8];
#pragma unroll
        for (int j = 0; j < 8; ++j) { a[j] = *(const bf16x8*)(ap + 16 * j);
#pragma unroll
            for (int t = 0; t < 3; ++t) b[t][j] = *(const bf16x8*)(bp + (size_t)(32 * t) * D + 16 * j); }
        f32x16 acc[3];
#pragma unroll
        for (int t = 0; t < 3; ++t) {
#pragma unroll
            for (int i = 0; i < 16; ++i) acc[t][i] = 0.f;
#pragma unroll
            for (int j = 0; j < 8; ++j) acc[t] = __builtin_amdgcn_mfma_f32_32x32x16_bf16(a[j], b[t][j], acc[t], 0, 0, 0);
#pragma unroll
            for (int i = 0; i < 16; ++i) red[((w * 3 + t) * 16 + i) * 64 + lane] = acc[t][i];
        }
        __syncthreads();
#pragma unroll
        for (int q = 0; q < 6; ++q) { const int p = w * 6 + q, t = p >> 4, i = p & 15, row = 32 * rb + crow(i, hi), col = c0 + 32 * t + r32;
            float v = 0.f;
#pragma unroll
            for (int k = 0; k < 8; ++k) v += red[((k * 3 + t) * 16 + i) * 64 + lane];
            v = v * fast_rsq(ss[row] * (1.f / D) + EPS) + bias[col];
            O[(size_t)row * NIN0 + col] = (bf16_t)f2bf(v); }
        __syncthreads();
    }
}

constexpr int PI_O = (D / 64) * (D / 32), PI_GU = (NGU / 32) * 16, PI_DN = (FF / 64) * (D / 32), PI_IN1 = (NIN1 / 32) * 16;
constexpr int PE0 = PI_O, PE1 = PE0 + PI_GU, PE2 = PE1 + PI_DN, PE3 = PE2 + PI_IN1, PE4 = PE3 + PI_O, PE5 = PE4 + PI_GU, L1_ITEMS = PE5 + PI_DN;
constexpr int PREP_SLICES = 10, PREP_PER = (L1_ITEMS + PREP_SLICES - 1) / PREP_SLICES;
__device__ __forceinline__ int prep_slice_begin(int k) { return PREP_PER * k; }
static_assert(3 * PREP_PER >= PE0 && 4 * PREP_PER >= PE1 && 5 * PREP_PER >= PE2 && 6 * PREP_PER >= PE3 && 8 * PREP_PER >= PE4 && 9 * PREP_PER >= PE5 && 10 * PREP_PER >= L1_ITEMS && PREP_PER <= 7 * 256, "prep deadlines");
__device__ __forceinline__ void prep_l1_item(Frame& F, int item) {
    LAS float* scr = (LAS float*)(F.lds + F.wave * 16384);
    const bool fold0 = item >= PE0 && item < PE1, fold_in1 = item >= PE2 && item < PE3, fold1 = item >= PE4 && item < PE5;
    if (fold0 || fold_in1 || fold1) {
        const bool gu = !fold_in1; const int l = fold0 ? 0 : 1;
        const int r = item - (fold0 ? PE0 : (fold_in1 ? PE2 : PE4)), ks = r & 15, n0 = (r >> 4) * 32;
        const int N = gu ? NGU : NIN1;
        fold_item<2>(gu ? F.in[I_WGU] + (size_t)l * D * NGU : F.in[I_OWIN], N, n0, gu ? gu_dst(n0) : in1_dst(n0), N, 64 * ks, 1.f, (gu ? F.in[I_N2G] : F.in[I_N1G]) + l * D, WSP(float, WS_MODS) + l * 3 * 6144,
                     gu ? 4096 : 1024, gu ? 3072 : 0, gu ? (l ? WSP(bf16_t, WS_WGU1) : WSP(bf16_t, WS_WGU0)) : WSP(bf16_t, WS_WIN1), gu ? (l ? WSP(float, WS_B_GU1) : WSP(float, WS_B_GU0)) : WSP(float, WS_B_IN1), scr, F.lane);
    } else {
        const int which = item < PE0 ? 0 : (item < PE2 ? 1 : (item < PE4 ? 2 : 3));
        const float* W = which == 0 ? F.in[I_EWOUT] : (which == 1 ? F.in[I_WDN] : (which == 2 ? F.in[I_OWOUT] : F.in[I_WDN] + (size_t)FF * D));
        bf16_t* WT = which == 0 ? WSP(bf16_t, WS_WOUT0) : (which == 1 ? WSP(bf16_t, WS_WDN0) : (which == 2 ? WSP(bf16_t, WS_WOUT1) : WSP(bf16_t, WS_WDN1)));
        p0_transpose_item(W, (which & 1) ? FF : D, D, WT, scr, which == 0 ? item : (which == 1 ? item - PE1 : (which == 2 ? item - PE3 : item - PE5)), F.lane);
    }
}
__device__ __forceinline__ void xcd_barrier_prep(const XcdBarrier& b, Frame& F, int slice) {
    asm volatile("s_waitcnt vmcnt(0)" ::: "memory");
    __syncthreads();
    if (F.wave == 0) {
        if (threadIdx.x == 0) {
            unsigned* bar = b.bar;
            __builtin_amdgcn_s_waitcnt(0);
            unsigned nloc = b.st[0], nx = b.st[1];
            if (nloc == 0u) { xcd_barrier_complete(bar, b.x, nloc, nx); b.st[0] = nloc; b.st[1] = nx; }
            const unsigned old = xb_add(&bar[XB_XSUB(b.x)], 1u);
            __builtin_amdgcn_fence(__ATOMIC_ACQUIRE, "agent");
            const unsigned gen = old / nloc;
            if (old + 1u == (gen + 1u) * nloc) {
                __builtin_amdgcn_fence(__ATOMIC_RELEASE, "agent");
                asm volatile("s_waitcnt vmcnt(0)" ::: "memory");
                const unsigned og = xb_add(&bar[XB_TOP], 1u);
                const unsigned tg = og / nx;
                if (og + 1u == (tg + 1u) * nx) {
#pragma unroll
                    for (unsigned j = 0; j < 16; ++j) xb_add(&bar[XB_XGEN(j)], 1u);
                } else XB_SPIN(xb_ld(&bar[XB_XGEN(b.x)]) == gen, bar);
                asm volatile("s_waitcnt vmcnt(0)" ::: "memory");
            } else {
                XB_SPIN(xb_ld(&bar[XB_XGEN(b.x)]) == gen, bar);
                asm volatile("s_waitcnt vmcnt(0)" ::: "memory");
            }
        }
    } else {
        const int w = (7 - F.wave) * (int)F.G + (int)blockIdx.x, item = prep_slice_begin(slice) + w;
        if (item < prep_slice_begin(slice + 1) && item < L1_ITEMS) prep_l1_item(F, item);
    }
    __syncthreads();
}

struct Args { const float* in[N_IN]; float* out; unsigned char* ws; int ph_lo, ph_hi; };
__global__ void __launch_bounds__(512, 2) dit_fwd(Args args) {
    extern __shared__ __attribute__((aligned(16))) unsigned char lds_raw[];
    Frame F;
    F.lds = (LAS unsigned char*)lds_raw;
    F.tid = threadIdx.x; F.lane = F.tid & 63; F.wave = __builtin_amdgcn_readfirstlane(F.tid >> 6);
    F.G = gridDim.x; F.gw = blockIdx.x * 8 + F.wave; F.NGW = F.G * 8;
#pragma unroll
    for (int i = 0; i < N_IN; ++i) F.in[i] = args.in[i];
    F.out = args.out; F.ws = args.ws;
    for (int u = F.tid; u < (LDS_BYTES - LDSCTL_OFF) / 4; u += 512) ((LAS unsigned*)(F.lds + LDSCTL_OFF))[u] = 0u;
    __syncthreads();
    volatile LAS unsigned* MISC = (volatile LAS unsigned*)(F.lds + MISC_OFF);
    XcdBarrier bar; bar.bar = (unsigned*)(F.ws + WS_CTL) + CW_BAR; bar.x = 0; bar.st = nullptr;
    const int lo = args.ph_lo, hi = args.ph_hi;
    if (hi - lo > 1) bar = xcd_barrier_post((unsigned*)(F.ws + WS_CTL) + CW_BAR, MISC + 8);
#ifdef ONLY_PHASE
#define IN(k) ((k) == ONLY_PHASE)
#else
#define IN(k) (lo <= (k) && (k) < hi)
#endif
#define SEAM(k) do { if (IN(k) && IN((k) + 1)) xcd_barrier(bar); } while (0)
#define SEAMP(k, sl) do { if (IN(k) && IN((k) + 1)) xcd_barrier_prep(bar, F, sl); } while (0)
    float* SSQ = WSP(float, WS_SSQ);
    const float* mods = WSP(float, WS_MODS);

    if (IN(0)) {
        unsigned* mt = (unsigned*)(F.ws + WS_CTL) + CW_MODS;
        for (int t = blockIdx.x; t < 192; t += F.G) {
            p0_mods_task(F, t);
            asm volatile("s_waitcnt vmcnt(0)" ::: "memory");
            __syncthreads();
            if (F.tid == 0) (void)__hip_atomic_fetch_add(mt, 1u, __ATOMIC_RELAXED, __HIP_MEMORY_SCOPE_AGENT);
        }
        phase_p0(F, 0, F.gw, F.NGW);
        if (F.tid == 0) { unsigned sp = 0; while (__hip_atomic_load(mt, __ATOMIC_RELAXED, __HIP_MEMORY_SCOPE_AGENT) < 192u) { __builtin_amdgcn_s_sleep(2); if (++sp > (1u << 22)) break; }
            __builtin_amdgcn_fence(__ATOMIC_ACQUIRE, "agent"); asm volatile("s_waitcnt vmcnt(0)" ::: "memory"); }
        __syncthreads();
        phase_p1(F, 0, F.wave * F.G + blockIdx.x, F.NGW);
    } SEAMP(0, 0);
    if (IN(2)) { for (int rep_ = 0; rep_ <= ((PROBE_REP_MASK >> 2) & 1); ++rep_) { if (rep_) xcd_barrier(bar);
        pg8::Gemm g{WSP(bf16_t, WS_A1), WSP(bf16_t, WS_WIN0), (long)NIN0 * D, (long)2 * NIN0 * D, D};
        pg8::Order S; S.init(ML / 256, NIN0 / 256, F.G, blockIdx.x);
        pg8::EpiInProj E{WSP(bf16_t, WS_BIG), WSP(float, WS_SS0), WSP(float, WS_B_IN0)};
        pg8::gemm_phase<pg8::EpiInProj, pg8::Order, true, true>(F.lds, g, S, E);
        __syncthreads();
        ctx_proj_wg(F);
    } } SEAMP(2, 1);
    if (IN(3)) { for (int rep_ = 0; rep_ <= ((PROBE_REP_MASK >> 3) & 1); ++rep_) { if (rep_) xcd_barrier(bar);
        attn_phase(F);
        __syncthreads();
        for (int t = blockIdx.x; t < 256; t += F.G) lru_pass1_wg(F, t);
    } } SEAMP(3, 2);
    if (IN(5)) { for (int rep_ = 0; rep_ <= ((PROBE_REP_MASK >> 5) & 1); ++rep_) { if (rep_) xcd_barrier(bar); for (int t = blockIdx.x; t < 256; t += F.G) lru_pass3_wg(F, t); } } SEAMP(5, 3);
    if (IN(6)) { for (int rep_ = 0; rep_ <= ((PROBE_REP_MASK >> 6) & 1); ++rep_) { if (rep_) xcd_barrier(bar);
        pg8::Gemm g{WSP(bf16_t, WS_A2), WSP(bf16_t, WS_WOUT0), 0l, 0l, D};
        pg8::Order S; S.init(ML / 256, D / 256, F.G, blockIdx.x);
        pg8::EpiRes<false, false> E{nullptr, WSP(bf16_t, WS_A1), WSP(bf16_t, WS_A3), nullptr, mods + 2048, SSQ, (unsigned)(uintptr_t)(F.lds + 132096)};
        pg8::gemm_phase<pg8::EpiRes<false, false>, pg8::Order, true, true>(F.lds, g, S, E);
    } } SEAMP(6, 4);
    if (IN(7)) { for (int rep_ = 0; rep_ <= ((PROBE_REP_MASK >> 7) & 1); ++rep_) { if (rep_) xcd_barrier(bar);
        pg8::Gemm g{WSP(bf16_t, WS_A3), WSP(bf16_t, WS_WGU0), (long)NGU * D, 0l, D};
        pg8::Order S; S.init(ML / 256, NGU / 256, F.G, blockIdx.x);
        pg8::EpiSwiGLU E{WSP(bf16_t, WS_BIG), SSQ, WSP(float, WS_B_GU0)};
        pg8::gemm_phase<pg8::EpiSwiGLU, pg8::Order, true, true>(F.lds, g, S, E);
    } } SEAMP(7, 5);
    if (IN(8)) { for (int rep_ = 0; rep_ <= ((PROBE_REP_MASK >> 8) & 1); ++rep_) { if (rep_) xcd_barrier(bar);
        pg8::Gemm g{WSP(bf16_t, WS_BIG), WSP(bf16_t, WS_WDN0), 0l, 0l, FF};
        pg8::Order S; S.init(ML / 256, D / 256, F.G, blockIdx.x);
        pg8::EpiRes<false, false> E{nullptr, WSP(bf16_t, WS_A3), WSP(bf16_t, WS_A2), nullptr, mods + 5120, SSQ + ML, (unsigned)(uintptr_t)(F.lds + 132096)};
        pg8::gemm_phase<pg8::EpiRes<false, false>, pg8::Order, true, true>(F.lds, g, S, E);
    } } SEAMP(8, 6);
    if (IN(9)) { for (int rep_ = 0; rep_ <= ((PROBE_REP_MASK >> 9) & 1); ++rep_) { if (rep_) xcd_barrier(bar);
        pg8::Gemm g{WSP(bf16_t, WS_A2), WSP(bf16_t, WS_WIN1), (long)NIN1 * D, 0l, D};
        pg8::Order S; S.init(ML / 256, 8, F.G, blockIdx.x); S.pn_off = 4;
        pg8::EpiScIn E{WSP(bf16_t, WS_A1), WSP(bf16_t, WS_A3), SSQ + ML, WSP(float, WS_B_IN1)};
        pg8::gemm_phase<pg8::EpiScIn, pg8::Order, true, true>(F.lds, g, S, E);
    } } SEAMP(9, 7);
    if (IN(10)) { for (int rep_ = 0; rep_ <= ((PROBE_REP_MASK >> 10) & 1); ++rep_) { if (rep_) xcd_barrier(bar);
        pg8::Gemm g{WSP(bf16_t, WS_A2), WSP(bf16_t, WS_WIN1), (long)NIN1 * D, 0l, D};
        pg8::Order S; S.init(ML / 256, 4, F.G, blockIdx.x);
        pg8::EpiScGate E{WSP(bf16_t, WS_A1), WSP(bf16_t, WS_A3), SSQ + ML, WSP(float, WS_B_IN1), F.in[I_OCW]};
        pg8::gemm_phase<pg8::EpiScGate, pg8::Order, true, true>(F.lds, g, S, E);
    } } SEAMP(10, 8);
    if (IN(11)) { for (int rep_ = 0; rep_ <= ((PROBE_REP_MASK >> 11) & 1); ++rep_) { if (rep_) xcd_barrier(bar);
        pg8::Gemm g{WSP(bf16_t, WS_A1), WSP(bf16_t, WS_WOUT1), 0l, 0l, D};
        pg8::Order S; S.init(ML / 256, D / 256, F.G, blockIdx.x);
        pg8::EpiRes<false, false> E{nullptr, WSP(bf16_t, WS_A2), WSP(bf16_t, WS_A3), nullptr, mods + 3 * 6144 + 2048, SSQ + 2 * ML, (unsigned)(uintptr_t)(F.lds + 132096)};
        pg8::gemm_phase<pg8::EpiRes<false, false>, pg8::Order, true, true>(F.lds, g, S, E);
    } } SEAMP(11, 9);
    if (IN(12)) { for (int rep_ = 0; rep_ <= ((PROBE_REP_MASK >> 12) & 1); ++rep_) { if (rep_) xcd_barrier(bar);
        pg8::Gemm g{WSP(bf16_t, WS_A3), WSP(bf16_t, WS_WGU1), (long)NGU * D, 0l, D};
        pg8::Order S; S.init(ML / 256, NGU / 256, F.G, blockIdx.x);
        pg8::EpiSwiGLU E{WSP(bf16_t, WS_BIG), SSQ + 2 * ML, WSP(float, WS_B_GU1)};
        pg8::gemm_phase<pg8::EpiSwiGLU, pg8::Order, true, true>(F.lds, g, S, E);
    } } SEAM(12);
    if (IN(13)) { for (int rep_ = 0; rep_ <= ((PROBE_REP_MASK >> 13) & 1); ++rep_) { if (rep_) xcd_barrier(bar);
        pg8::Gemm g{WSP(bf16_t, WS_BIG), WSP(bf16_t, WS_WDN1), 0l, 0l, FF};
        pg8::Order S; S.init(ML / 256, D / 256, F.G, blockIdx.x);
        pg8::EpiFinal E{WSP(bf16_t, WS_A3), F.out, mods + 3 * 6144 + 5120, SSQ + 3 * ML, (unsigned*)(F.ws + WS_CTL) + CW_PCNT, F.in[I_FG], (unsigned)(uintptr_t)(F.lds + 132096)};
        pg8::gemm_phase<pg8::EpiFinal, pg8::Order, true, true>(F.lds, g, S, E);
    } }
#undef IN
#undef SEAM
#undef SEAMP
}

extern "C" void kernel_launch(void* const* d_in, const int* in_sizes, int n_in, void* d_out, int out_size, void* d_ws, size_t ws_size, hipStream_t stream) {
    static int grid = 0;
    if (grid == 0) {
        if (n_in != N_IN || in_sizes[0] != ML * D || out_size != ML * D || ws_size < WS_END) { fprintf(stderr, "kernel_launch: unexpected shapes (n_in %d, in0 %d, out %d, ws %zu)\n", n_in, n_in > 0 ? in_sizes[0] : -1, out_size, ws_size); grid = -1; return; }
        int dev = 0, cus = 0;
        if (hipGetDevice(&dev) != hipSuccess || hipDeviceGetAttribute(&cus, hipDeviceAttributeMultiprocessorCount, dev) != hipSuccess) { grid = -1; return; }
        if (hipFuncSetAttribute((const void*)dit_fwd, hipFuncAttributeMaxDynamicSharedMemorySize, LDS_BYTES) != hipSuccess) { fprintf(stderr, "kernel_launch: hipFuncSetAttribute failed\n"); grid = -1; return; }
        int per_cu = 0;
        if (hipOccupancyMaxActiveBlocksPerMultiprocessor(&per_cu, (const void*)dit_fwd, 512, LDS_BYTES) != hipSuccess || per_cu < 1) fprintf(stderr, "kernel_launch: note: occupancy query reports %d\n", per_cu);
        (void)hipGetLastError();
        grid = cus;
    }
    if (grid < 0) return;
    if (hipMemsetAsync((char*)d_ws + WS_CTL, 0, CTL_ZERO_BYTES, stream) != hipSuccess) { fprintf(stderr, "kernel_launch: memset failed\n"); return; }
    Args a{};
    for (int i = 0; i < N_IN; ++i) a.in[i] = (const float*)d_in[i];
    a.out = (float*)d_out; a.ws = (unsigned char*)d_ws;
    constexpr int NPH = 14;
#if MK_PER_PHASE
    for (int p = 0; p < NPH; ++p) { a.ph_lo = p; a.ph_hi = p + 1; hipLaunchKernelGGL(dit_fwd, dim3(grid), dim3(512), LDS_BYTES, stream, a); }
#else
    a.ph_lo = 0; a.ph_hi = NPH;
    hipLaunchKernelGGL(dit_fwd, dim3(grid), dim3(512), LDS_BYTES, stream, a);
#endif
    const hipError_t le = hipPeekAtLastError();
    if (le != hipSuccess) fprintf(stderr, "kernel_launch: launch failed: %s\n", hipGetErrorName(le));
}
```

```cpp
#include <hip/hip_runtime.h>
#include <cstdio>
#include <cstdint>
#include <type_traits>

#ifndef PROBE_REP_MASK
#define PROBE_REP_MASK 0
#endif
#ifndef MK_PER_PHASE
#define MK_PER_PHASE 0
#endif

#define GAS __attribute__((address_space(1)))
#define LAS __attribute__((address_space(3)))
typedef unsigned short bf16_t;
typedef short bf16x8 __attribute__((ext_vector_type(8)));
typedef short s16x4 __attribute__((ext_vector_type(4)));
typedef float f32x4 __attribute__((ext_vector_type(4)));
typedef float f32x2 __attribute__((ext_vector_type(2)));
typedef float f32x16 __attribute__((ext_vector_type(16)));
typedef unsigned u32x4 __attribute__((ext_vector_type(4)));
typedef unsigned u32x2 __attribute__((ext_vector_type(2)));

constexpr int D = 1024, NB = 2, SEQ = 16384, ML = NB * SEQ, NCTX = 256, MC = NB * NCTX, MT = ML + MC;
constexpr int NIN0 = 2560, FF = 2816, NGU = 2 * FF, NIN1 = 3072;
constexpr int NCHUNK = 128, CHUNK = SEQ / NCHUNK  , NCI = NCHUNK + 2;
constexpr float EPS = 1e-6f;
constexpr float LOG2E = 1.4426950408889634f;
constexpr float QSCALE = 0.125f * LOG2E;
enum { I_X = 0, I_C, I_CTX, I_CCTX, I_MODW, I_MODB, I_N1G, I_N2G, I_WGU, I_WDN, I_EWIN, I_EWOUT, I_ECW, I_ECB, I_LWR, I_LBR, I_LWI, I_LBI, I_LAM, I_RPB, I_OWIN, I_OCW, I_OWOUT, I_FG, N_IN };

constexpr size_t MiB = 1u << 20;
constexpr size_t WS_CTL = 0, CTL_ZERO_BYTES = 1 * MiB + 160 * 1024;
constexpr size_t WS_SSQ = 256 * 1024;
constexpr size_t WS_B_IN0 = 768 * 1024;
constexpr size_t WS_B_GU0 = WS_B_IN0 + 3 * 2560 * 4;
constexpr size_t WS_B_IN1 = WS_B_GU0 + 2 * 5632 * 4;
constexpr size_t WS_B_GU1 = WS_B_IN1 + 2 * 3072 * 4;
static_assert(WS_B_GU1 + 2 * 5632 * 4 <= 1024 * 1024, "zeroed region");
constexpr size_t WS_MODS = 1 * MiB;
constexpr size_t WS_SS0 = WS_MODS + 160 * 1024;
constexpr size_t WS_BP_IN0 = WS_SS0 + 136 * 1024;
constexpr size_t WS_BP_GU0 = WS_BP_IN0 + 128 * 1024;
constexpr size_t WS_BP_IN1 = WS_BP_GU0 + 192 * 1024;
constexpr size_t WS_BP_GU1 = WS_BP_IN1 + 128 * 1024;
static_assert(WS_BP_GU1 + 192 * 1024 <= 4 * MiB, "small map");
constexpr size_t WS_TOT = 4 * MiB;
constexpr size_t WS_TOTG = 6 * MiB;
constexpr size_t WS_TOTC = 6 * MiB + 256 * 1024;
constexpr size_t WS_LRUW = 6 * MiB + 512 * 1024;
constexpr size_t WS_WIN0 = 8 * MiB;
constexpr size_t WS_WOUT0 = 23 * MiB;
constexpr size_t WS_WGU0 = 25 * MiB;
constexpr size_t WS_WDN0 = 47 * MiB;
constexpr size_t WS_WIN1 = 53 * MiB;
constexpr size_t WS_WOUT1 = 65 * MiB;
constexpr size_t WS_WGU1 = 67 * MiB;
constexpr size_t WS_WDN1 = 89 * MiB;
constexpr size_t WS_A1 = 96 * MiB;
constexpr size_t WS_A2 = 161 * MiB;
constexpr size_t WS_A3 = 225 * MiB;
constexpr size_t WS_BIG = 289 * MiB;
constexpr size_t WS_XCONV = 465 * MiB;
constexpr size_t WS_END = 498 * MiB;

constexpr int CW_BAR = 4096;
constexpr int CW_MODS = 3968;
constexpr int CW_PCNT = 16384;

constexpr int RING_BYTES = 131072, LDS_BYTES = 163840, LDSCTL_OFF = LDS_BYTES - 1024, MISC_OFF = LDSCTL_OFF + 320;

#define LDS_WAIT() asm volatile("s_waitcnt lgkmcnt(0)" ::: "memory")
#define VM_WAIT() asm volatile("s_waitcnt vmcnt(0)" ::: "memory")
#define RLX_AGENT __ATOMIC_RELAXED, __HIP_MEMORY_SCOPE_AGENT
__device__ __forceinline__ unsigned pk2(float lo, float hi) { unsigned r; asm("v_cvt_pk_bf16_f32 %0, %1, %2" : "=v"(r) : "v"(lo), "v"(hi)); return r; }
__device__ __forceinline__ unsigned f2bf(float f) { return pk2(f, f) & 0xffffu; }
__device__ __forceinline__ float bflo(unsigned u) { return __builtin_bit_cast(float, u << 16); }
__device__ __forceinline__ float bfhi(unsigned u) { return __builtin_bit_cast(float, u & 0xffff0000u); }
__device__ __forceinline__ float bf1(bf16_t h) { return __builtin_bit_cast(float, (unsigned)h << 16); }
__device__ __forceinline__ float wave_sum(float v) {
#pragma unroll
    for (int o = 1; o < 64; o <<= 1) v += __shfl_xor(v, o);
    return v;
}
__device__ __forceinline__ float fast_rsq(float x) { return __builtin_amdgcn_rsqf(x); }
__device__ __forceinline__ float fast_exp2(float x) { return __builtin_amdgcn_exp2f(x); }
__device__ __forceinline__ float fast_rcp(float x) { return __builtin_amdgcn_rcpf(x); }
__device__ __forceinline__ float sigmoidf_(float x) { return fast_rcp(1.f + fast_exp2(-x * LOG2E)); }
__device__ __forceinline__ float siluf_(float x) { return x * sigmoidf_(x); }
__device__ __forceinline__ float gelu_tanh(float x) {
    constexpr float C1 = -2.f * 0.7978845608028654f * LOG2E, C2 = C1 * 0.044715f;
    const float t = x * (C1 + C2 * (x * x));
    return x * fast_rcp(1.f + fast_exp2(t));
}

__device__ __forceinline__ float sum_fq(float q) {
    const auto a = __builtin_amdgcn_permlane32_swap(__float_as_uint(q), __float_as_uint(q), false, false);
    const float s = __uint_as_float(a[0]) + __uint_as_float(a[1]);
    const auto b = __builtin_amdgcn_permlane16_swap(__float_as_uint(s), __float_as_uint(s), false, false);
    return __uint_as_float(b[0]) + __uint_as_float(b[1]);
}
__device__ __forceinline__ void st16_wt(void* p, u32x4 v) { asm volatile("global_store_dwordx4 %0, %1, off sc1\n\ts_nop 1" :: "v"(p), "v"(v) : "memory"); }
namespace pg8 {
constexpr int BM = 256, BK = 64, HALF = 128, HTB = HALF * BK * 2, STAGE_BYTES = 8 * HTB, NXCD = 8, WGM = 8;
__host__ __device__ __forceinline__ int lds_byte(int r, int c) { const int st = (r >> 4) * 2 + (c >> 5), rr = r & 15, cc = c & 31, ob = rr * 64 + cc * 2; return st * 1024 + (ob ^ (((ob >> 9) & 1) << 5)); }
__host__ __device__ __forceinline__ void stage_rc(int b, int& R, int& C) { const int st = b / 1024, sb = b % 1024, swz = sb ^ (((sb >> 9) & 1) << 5); R = (st >> 1) * 16 + swz / 64; C = (st & 1) * 32 + (swz % 64) / 2; }
__host__ __device__ __forceinline__ int perm32(int rho) { const int n = rho >> 4, i = rho & 15; return 8 * (i >> 2) + 4 * n + (i & 3); }

struct Unit { int pm, pn; bool last; };
#define PG8_ST16(u_, ptr, w) do { if ((u_).last) st16_wt((ptr), (w)); else *(u32x4*)(ptr) = (w); } while (0)
struct Gemm { const bf16_t* A; const bf16_t* Bt; long boff1, boff2; int K; };
__device__ __forceinline__ const char* bsel(const bf16_t* Bt, long boff1, long boff2, const Unit& u) { const long o = u.pm < 64 ? 0l : (u.pm < 128 ? boff1 : boff2); return (const char*)(Bt + o); }

struct Order {
    int nM, nN, nwg, G, c, nextra, xpm0, xpn0, xnpn, pn_off = 0;
    __device__ void init(int nM_, int nN_, int G_, int c_, int nextra_ = 0, int xpm0_ = 0, int xpn0_ = 0, int xnpn_ = 1) { nM = nM_; nN = nN_; nwg = nM * nN; G = G_; c = c_; nextra = nextra_; xpm0 = xpm0_; xpn0 = xpn0_; xnpn = xnpn_; }
    __device__ bool next(int i, Unit& u) const {
        const long L = (long)i * G + c;
        if (L >= nwg) { const int e = (int)(L - nwg); if (e >= nextra) return false; u.pm = xpm0 + e / xnpn; u.pn = xpn0 + e % xnpn; return true; }
        int wgid = (int)L; { const int q = nwg / NXCD, r = nwg % NXCD, xcd = wgid % NXCD, off = wgid / NXCD; wgid = (xcd < r ? xcd * (q + 1) : r * (q + 1) + (xcd - r) * q) + off; }
        const int nig = WGM * nN, gid = wgid / nig, fm = gid * WGM, gsz = (nM - fm) < WGM ? (nM - fm) : WGM;
        u.pm = fm + ((wgid % nig) % gsz); u.pn = (wgid % nig) / gsz + pn_off; return true;
    }
};

__device__ __forceinline__ unsigned cvt_pk_bf16(float lo, float hi) { return pk2(lo, hi); }


struct EpiPre { f32x4 bv[2][2]; float ssr[2][4]; };
struct EpiInProj {
    static constexpr bool PERM = true; static constexpr bool IDEMP = true;
    typedef EpiPre Pre;
    bf16_t* O; const float* ss; const float* bias;
    __device__ __forceinline__ void prefetch(const Unit& u, int wr, int wc, int fr, int fq, Pre& p) const {
        const int row0 = u.pm * BM + wr * 64 + fr, col0 = u.pn * BM + wc * 32 + 8 * fq;
        const int v = u.pm < 64 ? 0 : (u.pm < 128 ? 1 : 2);
        const float* bp = bias + (size_t)v * NIN0 + col0;
#pragma unroll
        for (int bj = 0; bj < 2; ++bj)
#pragma unroll
            for (int n = 0; n < 2; ++n) p.bv[bj][n] = *(const f32x4*)(bp + bj * HALF + 4 * n);
#pragma unroll
        for (int ai = 0; ai < 2; ++ai)
#pragma unroll
            for (int m = 0; m < 4; ++m) p.ssr[ai][m] = ss[row0 + ai * HALF + m * 16];
    }
    __device__ __forceinline__ void operator()(const f32x4 (&acc)[2][2][4][2], const Unit& u, const Pre& p, int wr, int wc, int fr, int fq) const {
        const int row0 = u.pm * BM + wr * 64 + fr, col0 = u.pn * BM + wc * 32 + 8 * fq;
#pragma unroll
        for (int ai = 0; ai < 2; ++ai)
#pragma unroll
            for (int m = 0; m < 4; ++m) { const int row = row0 + ai * HALF + m * 16; const float rs = fast_rsq(p.ssr[ai][m] * (1.f / D) + EPS); bf16_t* rowp = O + (size_t)row * NIN0 + col0;
#pragma unroll
                for (int bj = 0; bj < 2; ++bj) { const f32x4 v0 = acc[ai][bj][m][0] * rs + p.bv[bj][0], v1 = acc[ai][bj][m][1] * rs + p.bv[bj][1];
                    u32x4 w; w.x = cvt_pk_bf16(v0[0], v0[1]); w.y = cvt_pk_bf16(v0[2], v0[3]); w.z = cvt_pk_bf16(v1[0], v1[1]); w.w = cvt_pk_bf16(v1[2], v1[3]);
                    PG8_ST16(u, rowp + bj * HALF, w); } }
    }
};

__device__ __forceinline__ void tile_row_ssq(const float (&qv)[2][4], unsigned Paddr, float* ssq_panel, int wr, int wc, int fr, int fq) {
    if (fq == 0) {
#pragma unroll
        for (int ai = 0; ai < 2; ++ai)
#pragma unroll
            for (int m = 0; m < 4; ++m) { const unsigned a_ = Paddr + (unsigned)(((ai * HALF + wr * 64 + m * 16 + fr) * 4 + wc) * 4); asm volatile("ds_write_b32 %0, %1" :: "v"(a_), "v"(qv[ai][m]) : "memory"); }
    }
    asm volatile("s_waitcnt lgkmcnt(0)" ::: "memory"); __builtin_amdgcn_s_barrier(); asm volatile("" ::: "memory");
    if (threadIdx.x < 256) { f32x4 v; const unsigned a_ = Paddr + threadIdx.x * 16u;
        asm volatile("ds_read_b128 %0, %1\n\ts_waitcnt lgkmcnt(0)" : "=v"(v) : "v"(a_) : "memory");
        unsafeAtomicAdd(ssq_panel + threadIdx.x, (v[0] + v[1]) + (v[2] + v[3])); }
}
struct EpiPreG { f32x4 gv[2][2]; };
template <bool RES_F32, bool OUT_F32> struct EpiRes {
    static constexpr bool PERM = true; static constexpr bool IDEMP = false;
    typedef EpiPreG Pre;
    const float* resf; const bf16_t* resb; bf16_t* Ob; float* Of; const float* gate; float* ssq; unsigned Paddr;
    __device__ __forceinline__ void prefetch(const Unit& u, int wr, int wc, int fr, int fq, Pre& p) const {
        const float* gp = gate + (size_t)(u.pm >> 6) * 6144 + u.pn * BM + wc * 32 + 8 * fq;
#pragma unroll
        for (int bj = 0; bj < 2; ++bj)
#pragma unroll
            for (int n = 0; n < 2; ++n) p.gv[bj][n] = *(const f32x4*)(gp + bj * HALF + 4 * n);
    }
    __device__ __forceinline__ void operator()(const f32x4 (&acc)[2][2][4][2], const Unit& u, const Pre& p, int wr, int wc, int fr, int fq) const {
        const int row0 = u.pm * BM + wr * 64 + fr, col0 = u.pn * BM + wc * 32 + 8 * fq;
        float qv[2][4];
#pragma unroll
        for (int ai = 0; ai < 2; ++ai) {
            f32x4 rf[RES_F32 ? 4 : 1][2][2]; u32x4 rb[1][RES_F32 ? 1 : 4][2];
#pragma unroll
            for (int m = 0; m < 4; ++m) { const size_t off = (size_t)(row0 + ai * HALF + m * 16) * D + col0;
#pragma unroll
                for (int bj = 0; bj < 2; ++bj) {
                    if constexpr (RES_F32) { rf[m][bj][0] = *(const f32x4*)(resf + off + bj * HALF); rf[m][bj][1] = *(const f32x4*)(resf + off + bj * HALF + 4); }
                    else rb[0][m][bj] = *(const u32x4*)(resb + off + bj * HALF); } }
#pragma unroll
            for (int m = 0; m < 4; ++m) { const int row = row0 + ai * HALF + m * 16; const size_t off = (size_t)row * D + col0; float q = 0.f;
#pragma unroll
                for (int bj = 0; bj < 2; ++bj) {
                    f32x4 r0, r1;
                    if constexpr (RES_F32) { r0 = rf[m][bj][0]; r1 = rf[m][bj][1]; }
                    else { const u32x4 t = rb[0][m][bj]; r0 = (f32x4){bflo(t.x), bfhi(t.x), bflo(t.y), bfhi(t.y)}; r1 = (f32x4){bflo(t.z), bfhi(t.z), bflo(t.w), bfhi(t.w)}; }
                    const f32x4 v0 = r0 + p.gv[bj][0] * acc[ai][bj][m][0], v1 = r1 + p.gv[bj][1] * acc[ai][bj][m][1];
                    q += (v0[0] * v0[0] + v0[1] * v0[1]) + (v0[2] * v0[2] + v0[3] * v0[3]) + (v1[0] * v1[0] + v1[1] * v1[1]) + (v1[2] * v1[2] + v1[3] * v1[3]);
                    if constexpr (OUT_F32) { *(f32x4*)(Of + off + bj * HALF) = v0; *(f32x4*)(Of + off + bj * HALF + 4) = v1; }
                    else { u32x4 w; w.x = cvt_pk_bf16(v0[0], v0[1]); w.y = cvt_pk_bf16(v0[2], v0[3]); w.z = cvt_pk_bf16(v1[0], v1[1]); w.w = cvt_pk_bf16(v1[2], v1[3]); PG8_ST16(u, Ob + off + bj * HALF, w); }
                }
                q = sum_fq(q);
                qv[ai][m] = q; }
        }
        tile_row_ssq(qv, Paddr, ssq + u.pm * BM, wr, wc, fr, fq);
    }
};

struct EpiFinal {
    static constexpr bool PERM = true; static constexpr bool IDEMP = false;
    typedef EpiPreG Pre;
    const bf16_t* resb; float* Of; const float* gate; float* ssq; unsigned* pcnt; const float* fg; unsigned Paddr;
    __device__ __forceinline__ void prefetch(const Unit& u, int wr, int wc, int fr, int fq, Pre& p) const {
        const float* gp = gate + (size_t)(u.pm >> 6) * 6144 + u.pn * BM + wc * 32 + 8 * fq;
#pragma unroll
        for (int bj = 0; bj < 2; ++bj)
#pragma unroll
            for (int n = 0; n < 2; ++n) p.gv[bj][n] = *(const f32x4*)(gp + bj * HALF + 4 * n);
    }
    __device__ __forceinline__ void operator()(f32x4 (&acc)[2][2][4][2], const Unit& u, const Pre& p, int wr, int wc, int fr, int fq) const {
        const int row0 = u.pm * BM + wr * 64 + fr, col0 = u.pn * BM + wc * 32 + 8 * fq;
        float qv[2][4];
#pragma unroll
        for (int ai = 0; ai < 2; ++ai) {
            u32x4 rb[4][2];
#pragma unroll
            for (int m = 0; m < 4; ++m) { const size_t off = (size_t)(row0 + ai * HALF + m * 16) * D + col0;
#pragma unroll
                for (int bj = 0; bj < 2; ++bj) rb[m][bj] = *(const u32x4*)(resb + off + bj * HALF); }
#pragma unroll
            for (int m = 0; m < 4; ++m) { const int row = row0 + ai * HALF + m * 16; float q = 0.f;
#pragma unroll
                for (int bj = 0; bj < 2; ++bj) {
                    const u32x4 t = rb[m][bj]; const f32x4 r0 = (f32x4){bflo(t.x), bfhi(t.x), bflo(t.y), bfhi(t.y)}, r1 = (f32x4){bflo(t.z), bfhi(t.z), bflo(t.w), bfhi(t.w)};
                    const f32x4 v0 = r0 + p.gv[bj][0] * acc[ai][bj][m][0], v1 = r1 + p.gv[bj][1] * acc[ai][bj][m][1];
                    q += (v0[0] * v0[0] + v0[1] * v0[1]) + (v0[2] * v0[2] + v0[3] * v0[3]) + (v1[0] * v1[0] + v1[1] * v1[1]) + (v1[2] * v1[2] + v1[3] * v1[3]);
                    acc[ai][bj][m][0] = v0; acc[ai][bj][m][1] = v1;
                }
                q = sum_fq(q);
                qv[ai][m] = q; }
        }
        tile_row_ssq(qv, Paddr, ssq + u.pm * BM, wr, wc, fr, fq);
        asm volatile("s_waitcnt vmcnt(0)" ::: "memory");
        __syncthreads();
        if (threadIdx.x == 0) {
            unsigned* pc = pcnt + 64 * u.pm;
            (void)__hip_atomic_fetch_add(pc, 1u, __ATOMIC_RELAXED, __HIP_MEMORY_SCOPE_AGENT);
            unsigned sp = 0;
            while (__hip_atomic_load(pc, __ATOMIC_RELAXED, __HIP_MEMORY_SCOPE_AGENT) < 4u) { __builtin_amdgcn_s_sleep(1); if (++sp > (1u << 22)) break; }
        }
        __syncthreads();
        f32x4 fv[2][2];
#pragma unroll
        for (int bj = 0; bj < 2; ++bj)
#pragma unroll
            for (int n = 0; n < 2; ++n) fv[bj][n] = *(const f32x4*)(fg + col0 + bj * HALF + 4 * n);
        float ssv[2][4];
#pragma unroll
        for (int ai = 0; ai < 2; ++ai)
#pragma unroll
            for (int m = 0; m < 4; ++m) ssv[ai][m] = __hip_atomic_load(ssq + row0 + ai * HALF + m * 16, __ATOMIC_RELAXED, __HIP_MEMORY_SCOPE_AGENT);
#pragma unroll
        for (int ai = 0; ai < 2; ++ai)
#pragma unroll
            for (int m = 0; m < 4; ++m) { const float rs = fast_rsq(ssv[ai][m] * (1.f / D) + EPS); const size_t off = (size_t)(row0 + ai * HALF + m * 16) * D + col0;
#pragma unroll
                for (int bj = 0; bj < 2; ++bj) { *(f32x4*)(Of + off + bj * HALF) = acc[ai][bj][m][0] * rs * fv[bj][0]; *(f32x4*)(Of + off + bj * HALF + 4) = acc[ai][bj][m][1] * rs * fv[bj][1]; } }
    }
};

struct EpiSwiGLU {
    static constexpr bool PERM = true; static constexpr bool IDEMP = true;
    typedef EpiPre Pre;
    bf16_t* O; const float* ss; const float* bias;
    __device__ __forceinline__ void prefetch(const Unit& u, int wr, int wc, int fr, int fq, Pre& p) const {
        const int row0 = u.pm * BM + wr * 64 + fr, colw = u.pn * BM + wc * 32 + 8 * fq;
        const float* bp = bias + (size_t)(u.pm >> 6) * NGU + colw;
#pragma unroll
        for (int bj = 0; bj < 2; ++bj)
#pragma unroll
            for (int n = 0; n < 2; ++n) p.bv[bj][n] = *(const f32x4*)(bp + bj * HALF + 4 * n);
#pragma unroll
        for (int ai = 0; ai < 2; ++ai)
#pragma unroll
            for (int m = 0; m < 4; ++m) p.ssr[ai][m] = ss[row0 + ai * HALF + m * 16];
    }
    __device__ __forceinline__ void operator()(const f32x4 (&acc)[2][2][4][2], const Unit& u, const Pre& p, int wr, int wc, int fr, int fq) const {
        const int row0 = u.pm * BM + wr * 64 + fr, colo = u.pn * HALF + wc * 32 + 8 * fq;
        f32x4 bg[2], bu[2];
#pragma unroll
        for (int n = 0; n < 2; ++n) { bg[n] = p.bv[0][n] * LOG2E; bu[n] = p.bv[1][n] * (1.f / LOG2E); }
#pragma unroll
        for (int ai = 0; ai < 2; ++ai)
#pragma unroll
            for (int m = 0; m < 4; ++m) { const int row = row0 + ai * HALF + m * 16; const float rs = fast_rsq(p.ssr[ai][m] * (1.f / D) + EPS), rsg = rs * LOG2E, rsu = rs * (1.f / LOG2E);
                f32x4 h[2];
#pragma unroll
                for (int n = 0; n < 2; ++n) {
                    const f32x4 G = acc[ai][0][m][n], U = acc[ai][1][m][n];
                    const f32x2 g0 = G.lo * rsg + bg[n].lo, g1 = G.hi * rsg + bg[n].hi, u0 = U.lo * rsu + bu[n].lo, u1 = U.hi * rsu + bu[n].hi;
                    f32x2 d0 = (f32x2){fast_exp2(-g0.x), fast_exp2(-g0.y)} + 1.f, d1 = (f32x2){fast_exp2(-g1.x), fast_exp2(-g1.y)} + 1.f;
                    const f32x2 r0 = (f32x2){fast_rcp(d0.x), fast_rcp(d0.y)}, r1 = (f32x2){fast_rcp(d1.x), fast_rcp(d1.y)};
                    const f32x2 h0 = (g0 * u0) * r0, h1 = (g1 * u1) * r1;
                    h[n] = (f32x4){h0.x, h0.y, h1.x, h1.y}; }
                u32x4 w; w.x = cvt_pk_bf16(h[0][0], h[0][1]); w.y = cvt_pk_bf16(h[0][2], h[0][3]); w.z = cvt_pk_bf16(h[1][0], h[1][1]); w.w = cvt_pk_bf16(h[1][2], h[1][3]);
                PG8_ST16(u, O + (size_t)row * FF + colo, w); }
    }
};

struct EpiScIn {
    static constexpr bool PERM = true; static constexpr bool IDEMP = true;
    typedef EpiPre Pre;
    bf16_t* BG; bf16_t* P; const float* ss; const float* bias;
    __device__ __forceinline__ void prefetch(const Unit& u, int wr, int wc, int fr, int fq, Pre& p) const {
        const int row0 = u.pm * BM + wr * 64 + fr, colw = u.pn * BM + wc * 32 + 8 * fq;
        const float* bp = bias + (size_t)(u.pm >> 6) * NIN1 + colw;
#pragma unroll
        for (int bj = 0; bj < 2; ++bj)
#pragma unroll
            for (int n = 0; n < 2; ++n) p.bv[bj][n] = *(const f32x4*)(bp + bj * HALF + 4 * n);
#pragma unroll
        for (int ai = 0; ai < 2; ++ai)
#pragma unroll
            for (int m = 0; m < 4; ++m) p.ssr[ai][m] = ss[row0 + ai * HALF + m * 16];
    }
    __device__ __forceinline__ void operator()(const f32x4 (&acc)[2][2][4][2], const Unit& u, const Pre& p, int wr, int wc, int fr, int fq) const {
        const int row0 = u.pm * BM + wr * 64 + fr, colw = u.pn * BM + wc * 32 + 8 * fq;
        if (u.pn < 4) {
#pragma unroll
            for (int ai = 0; ai < 2; ++ai)
#pragma unroll
                for (int m = 0; m < 4; ++m) { const int row = row0 + ai * HALF + m * 16; const float rs = fast_rsq(p.ssr[ai][m] * (1.f / D) + EPS); bf16_t* rowp = BG + (size_t)row * D + colw;
#pragma unroll
                    for (int bj = 0; bj < 2; ++bj) { const f32x4 v0 = acc[ai][bj][m][0] * rs + p.bv[bj][0], v1 = acc[ai][bj][m][1] * rs + p.bv[bj][1];
                        u32x4 w; w.x = cvt_pk_bf16(v0[0], v0[1]); w.y = cvt_pk_bf16(v0[2], v0[3]); w.z = cvt_pk_bf16(v1[0], v1[1]); w.w = cvt_pk_bf16(v1[2], v1[3]);
                        PG8_ST16(u, rowp + bj * HALF, w); } }
        } else {
            const int colo = (u.pn - 4) * HALF + wc * 32 + 8 * fq;
#pragma unroll
            for (int ai = 0; ai < 2; ++ai)
#pragma unroll
                for (int m = 0; m < 4; ++m) { const int row = row0 + ai * HALF + m * 16; const float rs = fast_rsq(p.ssr[ai][m] * (1.f / D) + EPS);
                    f32x4 h[2];
#pragma unroll
                    for (int n = 0; n < 2; ++n) { const f32x4 cgv = acc[ai][0][m][n] * rs + p.bv[0][n], xv = acc[ai][1][m][n] * rs + p.bv[1][n]; h[n] = cgv * xv; }
                    u32x4 w; w.x = cvt_pk_bf16(h[0][0], h[0][1]); w.y = cvt_pk_bf16(h[0][2], h[0][3]); w.z = cvt_pk_bf16(h[1][0], h[1][1]); w.w = cvt_pk_bf16(h[1][2], h[1][3]);
                    PG8_ST16(u, P + (size_t)row * D + colo, w); }
        }
    }
};
struct EpiScGate {
    static constexpr bool PERM = true; static constexpr bool IDEMP = true;
    typedef EpiPre Pre;
    bf16_t* Y; const bf16_t* P; const float* ss; const float* bias; const float* cw;
    __device__ __forceinline__ void prefetch(const Unit& u, int wr, int wc, int fr, int fq, Pre& p) const {
        const int row0 = u.pm * BM + wr * 64 + fr, colw = u.pn * BM + wc * 32 + 8 * fq;
        const float* bp = bias + (size_t)(u.pm >> 6) * NIN1 + colw;
#pragma unroll
        for (int bj = 0; bj < 2; ++bj)
#pragma unroll
            for (int n = 0; n < 2; ++n) p.bv[bj][n] = *(const f32x4*)(bp + bj * HALF + 4 * n);
#pragma unroll
        for (int ai = 0; ai < 2; ++ai)
#pragma unroll
            for (int m = 0; m < 4; ++m) p.ssr[ai][m] = ss[row0 + ai * HALF + m * 16];
    }
    template <int AI, int BJ, int M0, int MC>
    __device__ __forceinline__ void batch(const f32x4 (&acc)[2][2][4][2], const Unit& u, const Pre& p, const f32x4 (&w)[3][2], int row0, int col, int sbeg, int send) const {
        u32x4 raw[MC][3];
#pragma unroll
        for (int mm = 0; mm < MC; ++mm)
#pragma unroll
            for (int j = 0; j < 3; ++j) { const int rr = row0 + AI * HALF + (M0 + mm) * 16 + j - 1;
                raw[mm][j] = (rr >= sbeg && rr < send) ? *(const u32x4*)(P + (size_t)rr * D + col) : (u32x4){0u, 0u, 0u, 0u}; }
        asm volatile("" ::: "memory"); __builtin_amdgcn_sched_barrier(0);
#pragma unroll
        for (int mm = 0; mm < MC; ++mm) { constexpr int dummy = 0; (void)dummy; const int m = M0 + mm; const int row = row0 + AI * HALF + m * 16; const float rs = fast_rsq(p.ssr[AI][m] * (1.f / D) + EPS);
            const f32x4 v0 = acc[AI][BJ][m][0] * rs + p.bv[BJ][0], v1 = acc[AI][BJ][m][1] * rs + p.bv[BJ][1];
            f32x4 c0 = (f32x4){0.f, 0.f, 0.f, 0.f}, c1 = c0;
#pragma unroll
            for (int j = 0; j < 3; ++j) { const u32x4 r = raw[mm][j];
                c0 += w[j][0] * (f32x4){bflo(r.x), bfhi(r.x), bflo(r.y), bfhi(r.y)}; c1 += w[j][1] * (f32x4){bflo(r.z), bfhi(r.z), bflo(r.w), bfhi(r.w)}; }
            const f32x4 y0 = v0 * c0, y1 = v1 * c1;
            u32x4 o; o.x = cvt_pk_bf16(y0[0], y0[1]); o.y = cvt_pk_bf16(y0[2], y0[3]); o.z = cvt_pk_bf16(y1[0], y1[1]); o.w = cvt_pk_bf16(y1[2], y1[3]);
            PG8_ST16(u, Y + (size_t)row * D + col, o); }
        asm volatile("" ::: "memory"); __builtin_amdgcn_sched_barrier(0);
    }
    __device__ __forceinline__ void operator()(const f32x4 (&acc)[2][2][4][2], const Unit& u, const Pre& p, int wr, int wc, int fr, int fq) const {
        const int row0 = u.pm * BM + wr * 64 + fr, colw = u.pn * BM + wc * 32 + 8 * fq;
        const int sbeg = (u.pm * BM / SEQ) * SEQ, send = sbeg + SEQ;
        { const int col = colw; f32x4 w[3][2];
#pragma unroll
          for (int j = 0; j < 3; ++j) { w[j][0] = *(const f32x4*)(cw + j * D + col); w[j][1] = *(const f32x4*)(cw + j * D + col + 4); }
          batch<0, 0, 0, 2>(acc, u, p, w, row0, col, sbeg, send); batch<0, 0, 2, 2>(acc, u, p, w, row0, col, sbeg, send);
          batch<1, 0, 0, 2>(acc, u, p, w, row0, col, sbeg, send); batch<1, 0, 2, 2>(acc, u, p, w, row0, col, sbeg, send); }
        { const int col = colw + HALF; f32x4 w[3][2];
#pragma unroll
          for (int j = 0; j < 3; ++j) { w[j][0] = *(const f32x4*)(cw + j * D + col); w[j][1] = *(const f32x4*)(cw + j * D + col + 4); }
          batch<0, 1, 0, 4>(acc, u, p, w, row0, col, sbeg, send); batch<1, 1, 0, 4>(acc, u, p, w, row0, col, sbeg, send); }
    }
};

template <class Epi, class Sched, bool ALIGN_EPI = false, bool SP2 = false>
__device__ __forceinline__ void gemm_phase(LAS unsigned char* lds, const Gemm g, const Sched& S, const Epi& E) {
    const int tid = threadIdx.x, wid = __builtin_amdgcn_readfirstlane(tid >> 6), lane = tid & 63, wr = wid >> 2, wc = wid & 3, fr = lane & 15, fq = lane >> 4;
    const int K = g.K, nt = K / BK;
    unsigned voffA[2], voffB[2];
#pragma unroll
    for (int i = 0; i < 2; ++i) { const int b_ = tid * 16 + i * 8192; const int R = b_ >> 7, C = 8 * (((b_ >> 4) & 7) ^ ((R >> 1) & 7)); const int Rb = Epi::PERM ? ((R & ~31) + perm32(R & 31)) : R;
        voffA[i] = (unsigned)(R * K + C) * 2u; voffB[i] = (unsigned)(Rb * K + C) * 2u; }
    const size_t kstep = (size_t)(BK * 2);
    const size_t hstep = (size_t)HALF * K * 2;
    const size_t tstep = 2 * hstep;
    const unsigned ldsw = (unsigned)wid * 1024u;
    int aoffk[2], boffk[2];
#pragma unroll
    for (int k = 0; k < 2; ++k) { const int sw = ((4 * k + fq) ^ ((fr >> 1) & 7)) << 4; aoffk[k] = (wr * 64 + fr) * 128 + sw; boffk[k] = (wc * 32 + fr) * 128 + sw; }
#define PG8_SA(b, h) (((b) * 2 + (h)) * HTB)
#define PG8_SB(b, h) ((4 + (b) * 2 + (h)) * HTB)
#define PG8_STAGE(bufoff, gbase, voff) do { _Pragma("unroll") for (int _i = 0; _i < 2; ++_i) \
        __builtin_amdgcn_global_load_lds((const unsigned*)((const char*)(gbase) + (voff)[_i]), (LAS unsigned*)(lds + (bufoff) + ldsw + _i * 8192), 16, 0, 0); } while (0)
#define PG8_LDA(dst, b, h) do { _Pragma("unroll") for (int m = 0; m < 4; ++m) _Pragma("unroll") for (int k = 0; k < 2; ++k) dst[m][k] = *(const LAS bf16x8*)(lds + PG8_SA(b, h) + aoffk[k] + m * 2048); } while (0)
#define PG8_LDB(dst, b, h) do { _Pragma("unroll") for (int n = 0; n < 2; ++n) _Pragma("unroll") for (int k = 0; k < 2; ++k) dst[n][k] = *(const LAS bf16x8*)(lds + PG8_SB(b, h) + boffk[k] + n * 2048); } while (0)
#define PG8_MMA(ai, bj, At, Bt) do { __builtin_amdgcn_s_setprio(1); _Pragma("unroll") for (int m = 0; m < 4; ++m) _Pragma("unroll") for (int n = 0; n < 2; ++n) _Pragma("unroll") for (int k = 0; k < 2; ++k) \
        acc[ai][bj][m][n] = __builtin_amdgcn_mfma_f32_16x16x32_bf16(Bt[n][k], At[m][k], acc[ai][bj][m][n], 0, 0, 0); __builtin_amdgcn_s_setprio(0); } while (0)
#define PG8_WAIT_V(n) asm volatile("s_waitcnt vmcnt(" #n ")" ::: "memory")
#define PG8_WAIT_L(n) asm volatile("s_waitcnt lgkmcnt(" #n ")" ::: "memory")
#define PG8_BAR __builtin_amdgcn_s_barrier()
#define PG8_SCHED __builtin_amdgcn_sched_barrier(0)
    Unit cur, nxt; int ui = 0;
    if (!S.next(0, cur)) return;
    f32x4 acc[2][2][4][2];
#pragma unroll
    for (int a = 0; a < 2; ++a)
#pragma unroll
        for (int b = 0; b < 2; ++b)
#pragma unroll
            for (int m = 0; m < 4; ++m)
#pragma unroll
                for (int n = 0; n < 2; ++n) acc[a][b][m][n] = (f32x4){0.f, 0.f, 0.f, 0.f};
    bf16x8 At[4][2], B0[2][2], B1[2][2];
    typename Epi::Pre pre; E.prefetch(cur, wr, wc, fr, fq, pre);
    const char* cA = (const char*)g.A + (size_t)cur.pm * tstep; const bf16_t* gBt = g.Bt; const long gb1 = g.boff1, gb2 = g.boff2;
    const char* cB = bsel(gBt, gb1, gb2, cur) + (size_t)cur.pn * tstep;
    if constexpr (SP2) {
        PG8_STAGE(PG8_SB(0, 0), cB, voffB); PG8_STAGE(PG8_SB(0, 1), cB + hstep, voffB); PG8_STAGE(PG8_SA(0, 0), cA, voffA); PG8_STAGE(PG8_SA(0, 1), cA + hstep, voffA);
        if (wr == 1) PG8_BAR;
        PG8_WAIT_V(2); PG8_BAR;
        PG8_STAGE(PG8_SB(1, 0), cB + kstep, voffB); PG8_STAGE(PG8_SA(1, 0), cA + kstep, voffA); PG8_STAGE(PG8_SB(1, 1), cB + hstep + kstep, voffB);
        PG8_WAIT_V(6); PG8_BAR;
    } else {
        PG8_STAGE(PG8_SB(0, 0), cB, voffB); PG8_STAGE(PG8_SA(0, 0), cA, voffA); PG8_STAGE(PG8_SB(0, 1), cB + hstep, voffB); PG8_STAGE(PG8_SA(0, 1), cA + hstep, voffA);
        if (wr == 1) PG8_BAR;
        PG8_WAIT_V(4); PG8_BAR;
        PG8_STAGE(PG8_SB(1, 0), cB + kstep, voffB); PG8_STAGE(PG8_SA(1, 0), cA + kstep, voffA); PG8_STAGE(PG8_SB(1, 1), cB + hstep + kstep, voffB);
        PG8_WAIT_V(6); PG8_BAR;
    }
    for (;;) {
        const bool has_next = S.next(ui + 1, nxt);
        cur.last = !has_next;
        const char* nA = has_next ? (const char*)g.A + (size_t)nxt.pm * tstep : cA; const char* nB = has_next ? bsel(gBt, gb1, gb2, nxt) + (size_t)nxt.pn * tstep : cB;
        for (int t = 0; t < nt; t += 2) {
            const bool last = (t == nt - 2);
            const char* a1 = cA + (size_t)(t + 1) * kstep;
            const char* a2 = last ? nA : cA + (size_t)(t + 2) * kstep; const char* b2 = last ? nB : cB + (size_t)(t + 2) * kstep;
            const char* a3 = a2 + kstep; const char* b3 = b2 + kstep;
            if constexpr (SP2) {
            PG8_LDB(B0, 0, 0); PG8_LDB(B1, 0, 1); PG8_SCHED; PG8_LDA(At, 0, 0); PG8_STAGE(PG8_SA(1, 1), a1 + hstep, voffA);
            PG8_WAIT_V(8); PG8_WAIT_L(0); PG8_BAR; PG8_MMA(0, 0, At, B0); PG8_MMA(0, 1, At, B1); PG8_BAR; PG8_SCHED;
            PG8_LDA(At, 0, 1); PG8_STAGE(PG8_SB(0, 0), b2, voffB); PG8_STAGE(PG8_SB(0, 1), b2 + hstep, voffB); PG8_STAGE(PG8_SA(0, 0), a2, voffA);
            PG8_WAIT_V(8); PG8_WAIT_L(0); PG8_BAR; PG8_MMA(1, 0, At, B0); PG8_MMA(1, 1, At, B1); PG8_BAR; PG8_SCHED;
            PG8_LDB(B0, 1, 0); PG8_LDB(B1, 1, 1); PG8_SCHED; PG8_LDA(At, 1, 0); PG8_STAGE(PG8_SA(0, 1), a2 + hstep, voffA);
            PG8_WAIT_V(8); PG8_WAIT_L(0); PG8_BAR; PG8_MMA(0, 0, At, B0); PG8_MMA(0, 1, At, B1); PG8_BAR; PG8_SCHED;
            PG8_LDA(At, 1, 1); PG8_STAGE(PG8_SB(1, 0), b3, voffB); PG8_STAGE(PG8_SB(1, 1), b3 + hstep, voffB); PG8_STAGE(PG8_SA(1, 0), a3, voffA);
            PG8_WAIT_V(8); PG8_WAIT_L(0); PG8_BAR; PG8_MMA(1, 0, At, B0); PG8_MMA(1, 1, At, B1); PG8_BAR; PG8_SCHED;
            } else {
            PG8_LDB(B0, 0, 0); PG8_SCHED; PG8_LDA(At, 0, 0); PG8_STAGE(PG8_SA(1, 1), a1 + hstep, voffA);
            PG8_WAIT_L(8); PG8_BAR; PG8_WAIT_L(0); PG8_MMA(0, 0, At, B0); PG8_BAR; PG8_SCHED;
            PG8_LDB(B1, 0, 1); PG8_STAGE(PG8_SB(0, 0), b2, voffB);
            PG8_BAR; PG8_WAIT_L(0); PG8_MMA(0, 1, At, B1); PG8_BAR;
            PG8_LDA(At, 0, 1); PG8_STAGE(PG8_SA(0, 0), a2, voffA);
            PG8_BAR; PG8_WAIT_L(0); PG8_MMA(1, 0, At, B0); PG8_BAR; PG8_SCHED;
            PG8_STAGE(PG8_SB(0, 1), b2 + hstep, voffB);
            PG8_WAIT_V(6); PG8_BAR; PG8_MMA(1, 1, At, B1); PG8_BAR;
            PG8_LDB(B0, 1, 0); PG8_SCHED; PG8_LDA(At, 1, 0); PG8_STAGE(PG8_SA(0, 1), a2 + hstep, voffA);
            PG8_WAIT_L(8); PG8_BAR; PG8_WAIT_L(0); PG8_MMA(0, 0, At, B0); PG8_BAR; PG8_SCHED;
            PG8_LDB(B1, 1, 1); PG8_STAGE(PG8_SB(1, 0), b3, voffB);
            PG8_BAR; PG8_WAIT_L(0); PG8_MMA(0, 1, At, B1); PG8_BAR;
            PG8_LDA(At, 1, 1); PG8_STAGE(PG8_SA(1, 0), a3, voffA);
            PG8_BAR; PG8_WAIT_L(0); PG8_MMA(1, 0, At, B0); PG8_BAR; PG8_SCHED;
            PG8_STAGE(PG8_SB(1, 1), b3 + hstep, voffB);
            PG8_WAIT_V(6); PG8_BAR; PG8_MMA(1, 1, At, B1); PG8_BAR;
            }
        }
        if constexpr (ALIGN_EPI) { if (wr == 0) PG8_BAR; }
        E(acc, cur, pre, wr, wc, fr, fq);
#ifdef PROBE_EPI2
        if constexpr (Epi::IDEMP) { asm volatile("" ::: "memory"); E(acc, cur, pre, wr, wc, fr, fq); }
#endif
        if (!has_next) break;
        E.prefetch(nxt, wr, wc, fr, fq, pre);
        { bf16x8 zz;
#pragma unroll
          for (int j = 0; j < 8; ++j) zz[j] = 0;
          asm volatile("s_nop 3" : "+v"(zz));
#pragma unroll
          for (int b = 0; b < 2; ++b)
#pragma unroll
              for (int m = 0; m < 4; ++m)
#pragma unroll
                  for (int n = 0; n < 2; ++n) { asm volatile("v_mfma_f32_16x16x32_bf16 %0, %1, %1, 0" : "=&v"(acc[1][b][m][n]) : "v"(zz));
                      acc[0][b][m][n] = (f32x4){0.f, 0.f, 0.f, 0.f}; } }
        cur = nxt; cA = nA; cB = nB; ++ui;
        if constexpr (ALIGN_EPI) { if (wr == 1) PG8_BAR; }
    }
    PG8_WAIT_V(0);
    if constexpr (!ALIGN_EPI) { if (wr == 0) PG8_BAR; }
    PG8_BAR;
#undef PG8_SA
#undef PG8_SB
#undef PG8_STAGE
#undef PG8_LDA
#undef PG8_LDB
#undef PG8_MMA
#undef PG8_WAIT_V
#undef PG8_WAIT_L
#undef PG8_BAR
#undef PG8_SCHED
}
}

#define XB_TMO      128
#define XB_XCNT(j)  (256  + 64 * (j))
#define XB_XSUB(j)  (1280 + 64 * (j))
#define XB_XGEN(j)  (2304 + 64 * (j))
#define XB_TOP      3328
#define XB_TOPGEN   3392
#define XCD_BAR_WORDS 3456
#define XB_SPIN_CAP (1u << 18)
__device__ __forceinline__ unsigned xb_ld(unsigned* p)              { return __hip_atomic_load(p, __ATOMIC_RELAXED, __HIP_MEMORY_SCOPE_AGENT); }
__device__ __forceinline__ unsigned xb_add(unsigned* p, unsigned v) { return __hip_atomic_fetch_add(p, v, __ATOMIC_RELAXED, __HIP_MEMORY_SCOPE_AGENT); }
__device__ __forceinline__ unsigned xb_xcc_id() { return (unsigned)__builtin_amdgcn_s_getreg((3 << 11) | 20) & 0xFu; }
#define XB_SPIN(cond, bar) do { unsigned _sp = 0; while (cond) { __builtin_amdgcn_s_sleep(1); \
    if ((++_sp & 255u) == 0u) { if (xb_ld(&(bar)[XB_TMO])) break; if (_sp > XB_SPIN_CAP) { atomicAdd(&(bar)[XB_TMO], 1u); break; } } } } while (0)
struct XcdBarrier { unsigned* bar; unsigned x; volatile LAS unsigned* st; };
__device__ __forceinline__ XcdBarrier xcd_barrier_post(unsigned* bar, volatile LAS unsigned* st) {
    XcdBarrier b; b.bar = bar; b.x = xb_xcc_id(); b.st = st;
    if (threadIdx.x == 0) (void)xb_add(&bar[XB_XCNT(b.x)], 1u);
    return b;
}
__device__ __forceinline__ void xcd_barrier_complete(unsigned* bar, unsigned x, unsigned& nloc, unsigned& nx) {
    const unsigned G = gridDim.x * gridDim.y * gridDim.z;
    unsigned sum, cnt, mine, sp = 0u;
    for (;;) {
        sum = 0u; cnt = 0u; mine = 0u;
#pragma unroll
        for (unsigned j = 0; j < 16; ++j) { const unsigned c = xb_ld(&bar[XB_XCNT(j)]); sum += c; cnt += (c > 0u) ? 1u : 0u; mine = (j == x) ? c : mine; }
        if (sum == G) break;
        __builtin_amdgcn_s_sleep(1);
        if ((++sp & 255u) == 0u) { if (xb_ld(&bar[XB_TMO])) break; if (sp > XB_SPIN_CAP) { atomicAdd(&bar[XB_TMO], 1u); break; } }
    }
    nloc = mine > 0u ? mine : 1u; nx = cnt > 0u ? cnt : 1u;
}
__device__ __forceinline__ void xcd_barrier(const XcdBarrier& b) {
    asm volatile("s_waitcnt vmcnt(0)" ::: "memory");
    __syncthreads();
    if (threadIdx.x == 0) {
        unsigned* bar = b.bar;
        __builtin_amdgcn_s_waitcnt(0);
        unsigned nloc = b.st[0], nx = b.st[1];
        if (nloc == 0u) { xcd_barrier_complete(bar, b.x, nloc, nx); b.st[0] = nloc; b.st[1] = nx; }
        const unsigned old = xb_add(&bar[XB_XSUB(b.x)], 1u);
        __builtin_amdgcn_fence(__ATOMIC_ACQUIRE, "agent");
        const unsigned gen = old / nloc;
        if (old + 1u == (gen + 1u) * nloc) {
            __builtin_amdgcn_fence(__ATOMIC_RELEASE, "agent");
            asm volatile("s_waitcnt vmcnt(0)" ::: "memory");
            const unsigned og = xb_add(&bar[XB_TOP], 1u);
            const unsigned tg = og / nx;
            if (og + 1u == (tg + 1u) * nx) {
#pragma unroll
                for (unsigned j = 0; j < 16; ++j) xb_add(&bar[XB_XGEN(j)], 1u);
            } else XB_SPIN(xb_ld(&bar[XB_XGEN(b.x)]) == gen, bar);
            asm volatile("s_waitcnt vmcnt(0)" ::: "memory");
        } else {
            XB_SPIN(xb_ld(&bar[XB_XGEN(b.x)]) == gen, bar);
            asm volatile("s_waitcnt vmcnt(0)" ::: "memory");
        }
    }
    __syncthreads();
}

struct Frame {
    LAS unsigned char* lds;
    int tid, lane, wave, G, gw, NGW;
    const float* in[N_IN]; float* out; unsigned char* ws;
};
#define WSP(T, off) ((T*)(F.ws + (off)))

__device__ __forceinline__ void p0_transpose_item(const float* W, int K, int N, bf16_t* WT, LAS float* scr, int item, int lane) {
    const int nblk = N / 32, kb = item / nblk, nb = item % nblk, k0 = 64 * kb, n0 = 32 * nb;
    float val[32];
    { const float* wp = W + (size_t)(k0 + (lane >> 5)) * N + n0 + (lane & 31);
#pragma unroll
      for (int i = 0; i < 32; ++i) val[i] = wp[(size_t)(2 * i) * N]; }
#pragma unroll
    for (int i = 0; i < 32; ++i) scr[(2 * i + (lane >> 5)) * 33 + (lane & 31)] = val[i];
    LDS_WAIT(); asm volatile("" ::: "memory");
    const int c = lane & 7;
#pragma unroll
    for (int j = 0; j < 4; ++j) { const int n = (lane >> 3) + 8 * j; const LAS float* s = scr + (8 * c) * 33 + n;
        u32x4 o; o.x = pk2(s[0 * 33], s[1 * 33]); o.y = pk2(s[2 * 33], s[3 * 33]); o.z = pk2(s[4 * 33], s[5 * 33]); o.w = pk2(s[6 * 33], s[7 * 33]);
        st16_wt(WT + (size_t)(n0 + n) * K + k0 + 8 * c, o); }
    LDS_WAIT(); asm volatile("" ::: "memory");
}
__device__ __forceinline__ void row_to_bf16_ss(const float* xrow, bf16_t* orow, float* ssp, int lane) {
    const f32x4* xr = (const f32x4*)xrow + lane;
    f32x4 v[4]; float s = 0.f;
#pragma unroll
    for (int j = 0; j < 4; ++j) { v[j] = xr[64 * j]; s += (v[j].x * v[j].x + v[j].y * v[j].y) + (v[j].z * v[j].z + v[j].w * v[j].w); }
    s = wave_sum(s);
    u32x2* o8 = (u32x2*)orow + lane;
#pragma unroll
    for (int j = 0; j < 4; ++j) { u32x2 w; w.x = pk2(v[j].x, v[j].y); w.y = pk2(v[j].z, v[j].w); o8[64 * j] = w; }
    if (lane == 0) *ssp = s;
}
__device__ __forceinline__ void p0_mods_task(Frame& F, int task) {
    const int kh = task & 1, l = (task >> 1) / 48, n0 = ((task >> 1) % 48) * 128;
    LAS float* Sc = (LAS float*)F.lds;
    LAS float* R = (LAS float*)(F.lds + 16384);
    const float* c = F.in[I_C]; const float* cc = F.in[I_CCTX];
    for (int i = F.tid; i < 3 * 512; i += 512) { const int v = i >> 9, k = kh * 512 + (i & 511); const float cv = v == 0 ? c[k] : (v == 1 ? c[D + k] : cc[k]); Sc[i] = cv / (1.f + __expf(-cv)); }
    __syncthreads();
    float a[3][2] = {{0.f, 0.f}, {0.f, 0.f}, {0.f, 0.f}};
    const float* Wp = F.in[I_MODW] + (size_t)l * D * 6144 + (size_t)(kh * 512) * 6144 + n0 + 2 * F.lane;
    const int kb = F.wave * 64;
#pragma unroll 16
    for (int kk = 0; kk < 64; ++kk) { const int k = kb + kk; const f32x2 wv = *(const f32x2*)(Wp + (size_t)k * 6144);
#pragma unroll
        for (int v = 0; v < 3; ++v) { const float s = Sc[v * 512 + k]; a[v][0] += s * wv.x; a[v][1] += s * wv.y; } }
#pragma unroll
    for (int v = 0; v < 3; ++v) { R[(F.wave * 3 + v) * 128 + 2 * F.lane] = a[v][0]; R[(F.wave * 3 + v) * 128 + 2 * F.lane + 1] = a[v][1]; }
    __syncthreads();
    if (F.tid < 384) { const int v = F.tid >> 7, j = F.tid & 127; float s = kh == 0 ? F.in[I_MODB][l * 6144 + n0 + j] : 0.f;
#pragma unroll
        for (int w = 0; w < 8; ++w) s += R[(w * 3 + v) * 128 + j];
        unsafeAtomicAdd(WSP(float, WS_MODS) + (size_t)(l * 3 + v) * 6144 + n0 + j, s); }
    __syncthreads();
}
__device__ __forceinline__ void phase_p0(Frame& F, int part, int gw, int ngw) {
    LAS float* scr = (LAS float*)(F.lds + F.wave * 16384);
    if (part == 0) {
    bf16_t* XB = WSP(bf16_t, WS_A1); float* ss0 = WSP(float, WS_SS0);
    const int R1 = (F.G == 256) ? 3 * 64 * 8 : 0, R0 = MT - R1;
    for (int m = F.gw; m < R0; m += F.NGW) {
        const float* src = m < ML ? F.in[I_X] + (size_t)m * D : F.in[I_CTX] + (size_t)(m - ML) * D;
        row_to_bf16_ss(src, XB + (size_t)m * D, ss0 + m, F.lane);
    }
    if (R1 > 0 && blockIdx.x >= 192)
        for (int m = R0 + ((int)blockIdx.x - 192) * 8 + F.wave; m < MT; m += 64 * 8) {
            const float* src = m < ML ? F.in[I_X] + (size_t)m * D : F.in[I_CTX] + (size_t)(m - ML) * D;
            row_to_bf16_ss(src, XB + (size_t)m * D, ss0 + m, F.lane);
        }
    for (int idx = (int)((blockIdx.x + 64u) % (unsigned)F.G) * 512 + F.tid; idx < 2 * 8 * 2 * 2 * 4 * 64; idx += F.G * 512) {
        const int ln = idx & 63, s_ = (idx >> 6) & 3, half = (idx >> 8) & 1, gate = (idx >> 9) & 1, g_ = (idx >> 10) & 7, d_ = idx >> 13;
        const float* wsrc = (gate ? F.in[I_LWI] : F.in[I_LWR]) + (size_t)((d_ * 8 + g_) * 64 + 16 * s_ + 8 * (ln >> 5)) * 64 + 32 * half + (ln & 31);
        constexpr float NL = -LOG2E;
        u32x4 o; o.x = pk2(NL * wsrc[0], NL * wsrc[64]); o.y = pk2(NL * wsrc[128], NL * wsrc[192]); o.z = pk2(NL * wsrc[256], NL * wsrc[320]); o.w = pk2(NL * wsrc[384], NL * wsrc[448]);
        st16_wt(WSP(u32x4, WS_LRUW) + idx, o);
    }
    return; }
    constexpr int I_O = (D / 64) * (D / 32), I_DN = (FF / 64) * (D / 32);
    for (int it = gw; it < I_O; it += ngw) p0_transpose_item(F.in[I_EWOUT], D, D, WSP(bf16_t, WS_WOUT0), scr, it, F.lane);
}

template <int NV> __device__ __forceinline__ void fold_task(const float* W, int N, int n0, int dst0, int Nd, int kc, float cs, const float* gam, const float* mods_l, int sc_off, int sh_off,
                                                           bf16_t* WT, float* biasp, LAS float* scr, int lane) {
    LAS float* vec = scr + 2176;
    for (int i = lane; i < NV * 256; i += 64) { const int v = i >> 8, kk = i & 255, k = kc * 256 + kk;
        vec[i] = gam[k] * (1.f + mods_l[(size_t)v * 6144 + sc_off + k]) * cs; vec[768 + i] = mods_l[(size_t)v * 6144 + sh_off + k] * cs; }
    LDS_WAIT(); asm volatile("" ::: "memory");
    float bacc[NV];
#pragma unroll
    for (int v = 0; v < NV; ++v) bacc[v] = 0.f;
    for (int it = 0; it < 4; ++it) {
        const int k0 = kc * 256 + 64 * it;
        float val[32];
        { const float* wp = W + (size_t)(k0 + (lane >> 5)) * N + n0 + (lane & 31);
#pragma unroll
          for (int i = 0; i < 32; ++i) val[i] = wp[(size_t)(2 * i) * N]; }
#pragma unroll
        for (int i = 0; i < 32; ++i) { const int kk = 2 * i + (lane >> 5); scr[kk * 33 + (lane & 31)] = val[i];
#pragma unroll
            for (int v = 0; v < NV; ++v) bacc[v] += vec[768 + v * 256 + 64 * it + kk] * val[i]; }
        LDS_WAIT(); asm volatile("" ::: "memory");
        const int c = lane & 7;
#pragma unroll
        for (int j = 0; j < 4; ++j) { const int n = (lane >> 3) + 8 * j; const LAS float* s = scr + (8 * c) * 33 + n;
#pragma unroll
            for (int v = 0; v < NV; ++v) { const LAS float* sv = vec + v * 256 + 64 * it + 8 * c;
                u32x4 o; o.x = pk2(s[0 * 33] * sv[0], s[1 * 33] * sv[1]); o.y = pk2(s[2 * 33] * sv[2], s[3 * 33] * sv[3]); o.z = pk2(s[4 * 33] * sv[4], s[5 * 33] * sv[5]); o.w = pk2(s[6 * 33] * sv[6], s[7 * 33] * sv[7]);
                st16_wt(WT + (size_t)v * Nd * D + (size_t)(dst0 + n) * D + k0 + 8 * c, o); } }
        LDS_WAIT(); asm volatile("" ::: "memory");
    }
#pragma unroll
    for (int v = 0; v < NV; ++v) { float b = bacc[v]; b += __shfl_xor(b, 32); if (lane < 32) unsafeAtomicAdd(biasp + (size_t)v * Nd + dst0 + lane, b); }
}
template <int NV> __device__ __forceinline__ void fold_item(const float* W, int N, int n0, int dst0, int Nd, int k0, float cs, const float* gam, const float* mods_l, int sc_off, int sh_off,
                                                           bf16_t* WT, float* biasp, LAS float* scr, int lane) {
    LAS float* vec = scr + 2176;
    float val[32];
    { const float* wp = W + (size_t)(k0 + (lane >> 5)) * N + n0 + (lane & 31);
#pragma unroll
      for (int i = 0; i < 32; ++i) val[i] = wp[(size_t)(2 * i) * N]; }
    { const int k = k0 + lane; const float gk = gam[k] * cs;
#pragma unroll
      for (int v = 0; v < NV; ++v) { vec[v * 64 + lane] = gk * (1.f + mods_l[(size_t)v * 6144 + sc_off + k]); vec[192 + v * 64 + lane] = mods_l[(size_t)v * 6144 + sh_off + k] * cs; } }
#pragma unroll
    for (int i = 0; i < 32; ++i) scr[(2 * i + (lane >> 5)) * 33 + (lane & 31)] = val[i];
    LDS_WAIT(); asm volatile("" ::: "memory");
    float bacc[NV];
#pragma unroll
    for (int v = 0; v < NV; ++v) bacc[v] = 0.f;
#pragma unroll
    for (int i = 0; i < 32; ++i)
#pragma unroll
        for (int v = 0; v < NV; ++v) bacc[v] += vec[192 + v * 64 + 2 * i + (lane >> 5)] * val[i];
    const int c = lane & 7;
#pragma unroll
    for (int j = 0; j < 4; ++j) { const int n = (lane >> 3) + 8 * j; const LAS float* s = scr + (8 * c) * 33 + n;
#pragma unroll
        for (int v = 0; v < NV; ++v) { const LAS float* sv = vec + v * 64 + 8 * c;
            u32x4 o; o.x = pk2(s[0 * 33] * sv[0], s[1 * 33] * sv[1]); o.y = pk2(s[2 * 33] * sv[2], s[3 * 33] * sv[3]); o.z = pk2(s[4 * 33] * sv[4], s[5 * 33] * sv[5]); o.w = pk2(s[6 * 33] * sv[6], s[7 * 33] * sv[7]);
            st16_wt(WT + (size_t)v * Nd * D + (size_t)(dst0 + n) * D + k0 + 8 * c, o); } }
    LDS_WAIT(); asm volatile("" ::: "memory");
#pragma unroll
    for (int v = 0; v < NV; ++v) { float b = bacc[v]; b += __shfl_xor(b, 32); if (lane < 32) unsafeAtomicAdd(biasp + (size_t)v * Nd + dst0 + lane, b); }
}
__device__ __forceinline__ int gu_dst(int n) { return n < FF ? (n >> 7) * 256 + (n & 127) : ((n - FF) >> 7) * 256 + 128 + ((n - FF) & 127); }
__device__ __forceinline__ int in1_dst(int n) { if (n < 1024) return n; if (n < 2048) { const int q = n - 1024; return 1024 + (q >> 7) * 256 + (q & 127); } const int q = n - 2048; return 1024 + (q >> 7) * 256 + 128 + (q & 127); }
__device__ __forceinline__ void phase_p1(Frame& F, int part, int gw, int ngw) {
    LAS float* scr = (LAS float*)(F.lds + F.wave * 16384);
    const float* mods = WSP(float, WS_MODS);
    if (part == 0) {
        for (int it = gw; it < (NIN0 / 32) * 16; it += ngw) { const int ks = it & 15, n0 = (it >> 4) * 32;
            fold_item<3>(F.in[I_EWIN], NIN0, n0, n0, NIN0, 64 * ks, n0 < 512 ? QSCALE : 1.f, F.in[I_N1G], mods, 1024, 0, WSP(bf16_t, WS_WIN0), WSP(float, WS_B_IN0), scr, F.lane); }
    } else {
        for (int it = gw; it < (NGU / 32) * 16; it += ngw) { const int ks = it & 15, n0 = (it >> 4) * 32;
            fold_item<2>(F.in[I_WGU], NGU, n0, gu_dst(n0), NGU, 64 * ks, 1.f, F.in[I_N2G], mods, 4096, 3072, WSP(bf16_t, WS_WGU0), WSP(float, WS_B_GU0), scr, F.lane); }
    }
}

__device__ __forceinline__ void conv4_task(Frame& F, int task) {
    const bf16_t* QKV = WSP(bf16_t, WS_BIG); bf16_t* XC = WSP(bf16_t, WS_XCONV);
    const int row0 = task * 16, lane = F.lane;
    int sbeg, send;
    if (row0 < ML) { sbeg = (row0 / SEQ) * SEQ; send = sbeg + SEQ; } else { sbeg = ML + ((row0 - ML) / NCTX) * NCTX; send = sbeg + NCTX; }
    u32x4 raw[19];
#pragma unroll
    for (int i = 0; i < 19; ++i) { const int r = row0 + i - 2; raw[i] = (r >= sbeg && r < send) ? *(const u32x4*)(QKV + (size_t)r * NIN0 + 1536 + 8 * lane) : (u32x4){0u, 0u, 0u, 0u}; }
    float w[4][8], bs[8];
#pragma unroll
    for (int j = 0; j < 4; ++j) { const f32x4 a = *(const f32x4*)(F.in[I_ECW] + j * 512 + 8 * lane), b = *(const f32x4*)(F.in[I_ECW] + j * 512 + 8 * lane + 4);
        w[j][0] = a.x; w[j][1] = a.y; w[j][2] = a.z; w[j][3] = a.w; w[j][4] = b.x; w[j][5] = b.y; w[j][6] = b.z; w[j][7] = b.w; }
    { const f32x4 a = *(const f32x4*)(F.in[I_ECB] + 8 * lane), b = *(const f32x4*)(F.in[I_ECB] + 8 * lane + 4); bs[0] = a.x; bs[1] = a.y; bs[2] = a.z; bs[3] = a.w; bs[4] = b.x; bs[5] = b.y; bs[6] = b.z; bs[7] = b.w; }
#pragma unroll
    for (int t = 0; t < 16; ++t) {
        float o[8];
#pragma unroll
        for (int e = 0; e < 8; ++e) o[e] = bs[e];
#pragma unroll
        for (int j = 0; j < 4; ++j) { const u32x4 r = raw[t + j];
            o[0] += w[j][0] * bflo(r.x); o[1] += w[j][1] * bfhi(r.x); o[2] += w[j][2] * bflo(r.y); o[3] += w[j][3] * bfhi(r.y);
            o[4] += w[j][4] * bflo(r.z); o[5] += w[j][5] * bfhi(r.z); o[6] += w[j][6] * bflo(r.w); o[7] += w[j][7] * bfhi(r.w); }
        u32x4 pk; pk.x = pk2(o[0], o[1]); pk.y = pk2(o[2], o[3]); pk.z = pk2(o[4], o[5]); pk.w = pk2(o[6], o[7]);
        *(u32x4*)(XC + (size_t)(row0 + t) * 512 + 8 * lane) = pk;
    }
}

__device__ __forceinline__ int crow(int r, int hi) { return (r & 3) + 8 * (r >> 2) + 4 * hi; }
__device__ __forceinline__ void qkt(f32x16& p0, f32x16& p1, const bf16x8 (&b0)[4], const bf16x8 (&b1)[4], const bf16x8* qr, const f32x16& c0, const f32x16& c1) {
    p0 = __builtin_amdgcn_mfma_f32_32x32x16_bf16(b0[0], qr[0], c0, 0, 0, 0);
    p1 = __builtin_amdgcn_mfma_f32_32x32x16_bf16(b1[0], qr[0], c1, 0, 0, 0);
#pragma unroll
    for (int d0 = 1; d0 < 4; ++d0) {
        p0 = __builtin_amdgcn_mfma_f32_32x32x16_bf16(b0[d0], qr[d0], p0, 0, 0, 0);
        p1 = __builtin_amdgcn_mfma_f32_32x32x16_bf16(b1[d0], qr[d0], p1, 0, 0, 0);
    }
}
__device__ __forceinline__ void pv(f32x16* o, unsigned vb0, unsigned vb1, bf16x8 pa0, bf16x8 pa1, bf16x8 pa2, bf16x8 pa3, bool use0, bool use3) {
    s16x4 lo[2][4], hi[2][4];
#define PV_RD(ks) do { \
        lo[0][ks] = __builtin_amdgcn_ds_read_tr16_b64_v4i16((LAS s16x4*)(uintptr_t)(vb0 + (ks) * 2048)); \
        hi[0][ks] = __builtin_amdgcn_ds_read_tr16_b64_v4i16((LAS s16x4*)(uintptr_t)(vb0 + (ks) * 2048 + 1024)); \
        lo[1][ks] = __builtin_amdgcn_ds_read_tr16_b64_v4i16((LAS s16x4*)(uintptr_t)(vb1 + (ks) * 2048)); \
        hi[1][ks] = __builtin_amdgcn_ds_read_tr16_b64_v4i16((LAS s16x4*)(uintptr_t)(vb1 + (ks) * 2048 + 1024)); } while (0)
#define PK(d, k) (bf16x8){lo[d][k][0], lo[d][k][1], lo[d][k][2], lo[d][k][3], hi[d][k][0], hi[d][k][1], hi[d][k][2], hi[d][k][3]}
    PV_RD(1); PV_RD(2);
    if (use0) {
        PV_RD(0);
        asm volatile("s_waitcnt lgkmcnt(0)" ::: "memory");
        o[0] = __builtin_amdgcn_mfma_f32_32x32x16_bf16(PK(0, 0), pa0, o[0], 0, 0, 0);
        o[1] = __builtin_amdgcn_mfma_f32_32x32x16_bf16(PK(1, 0), pa0, o[1], 0, 0, 0);
    }
    if (use3) PV_RD(3);
    asm volatile("s_waitcnt lgkmcnt(0)" ::: "memory"); __builtin_amdgcn_sched_barrier(0);
    o[0] = __builtin_amdgcn_mfma_f32_32x32x16_bf16(PK(0, 1), pa1, o[0], 0, 0, 0);
    o[1] = __builtin_amdgcn_mfma_f32_32x32x16_bf16(PK(1, 1), pa1, o[1], 0, 0, 0);
    o[0] = __builtin_amdgcn_mfma_f32_32x32x16_bf16(PK(0, 2), pa2, o[0], 0, 0, 0);
    o[1] = __builtin_amdgcn_mfma_f32_32x32x16_bf16(PK(1, 2), pa2, o[1], 0, 0, 0);
    if (use3) {
        o[0] = __builtin_amdgcn_mfma_f32_32x32x16_bf16(PK(0, 3), pa3, o[0], 0, 0, 0);
        o[1] = __builtin_amdgcn_mfma_f32_32x32x16_bf16(PK(1, 3), pa3, o[1], 0, 0, 0);
    }
#undef PK
#undef PV_RD
}
__device__ __forceinline__ float max3f(float a, float b, float c) { float r; asm("v_max3_f32 %0, %1, %2, %3" : "=v"(r) : "v"(a), "v"(b), "v"(c)); return r; }
__device__ __forceinline__ float max2f(float a, float b) { float r; asm("v_max_f32 %0, %1, %2" : "=v"(r) : "v"(a), "v"(b)); return r; }
__device__ __forceinline__ float half_swap_max(float m) { auto rr = __builtin_amdgcn_permlane32_swap(__float_as_uint(m), __float_as_uint(m), false, false); return max2f(__uint_as_float(rr[0]), __uint_as_float(rr[1])); }
__device__ __forceinline__ float half_swap_sum(float m) { auto rr = __builtin_amdgcn_permlane32_swap(__float_as_uint(m), __float_as_uint(m), false, false); return __uint_as_float(rr[0]) + __uint_as_float(rr[1]); }

constexpr int AT_SLOT = 32768, AT_NSLOT = 3, AT_BIAS = AT_NSLOT * AT_SLOT, AT_WSF = AT_BIAS + 2 * 15 * 128 * 4, AT_QST = AT_WSF + 3072, AT_NTASK = NB * 128 * 4;
static_assert(AT_QST + 8 * 4096 <= LDSCTL_OFF, "attention LDS map");
constexpr float AT_THR = 8.f;
__device__ __forceinline__ void attn_phase(Frame& F) {
    const bf16_t* QKV = WSP(bf16_t, WS_BIG); bf16_t* MIX = WSP(bf16_t, WS_A2);
    const int lane = F.lane, w = F.wave, r32 = lane & 31, hi = lane >> 5;
    const int hsel = w >> 2, rsel = (w >> 1) & 1, qh = w & 1;
    LAS unsigned char* lds = F.lds;
    LAS float* BIAS = (LAS float*)(lds + AT_BIAS);
    LAS float* wsf = (LAS float*)(lds + AT_WSF) + w * 64;
    const int qc = 32 * qh + r32, cs = min(max(qc - 8, 0), 48);
    const int krow_ = 8 * w + (lane >> 3), kchunk_ = (lane & 7) ^ ((krow_ >> 1) & 7);
    int koff[4];
#pragma unroll
    for (int d0 = 0; d0 < 4; ++d0) koff[d0] = r32 * 128 + (((2 * d0 + hi) ^ ((r32 >> 1) & 7)) << 4);
    const unsigned ldsw = (unsigned)w * 1024u;
    unsigned vboff0, vboff1;
    { const int q_ = (lane & 15) >> 2, p_ = lane & 3, blk_ = (lane >> 4) & 1, fl_ = (q_ >> 1) << 2;
      vboff0 = (unsigned)((4 * hi + q_) * 128 + (((0 + 2 * blk_ + (p_ >> 1)) ^ fl_) << 4) + 8 * (p_ & 1));
      vboff1 = (unsigned)((4 * hi + q_) * 128 + (((4 + 2 * blk_ + (p_ >> 1)) ^ fl_) << 4) + 8 * (p_ & 1)); }
#define AT_DMA(bb, Rlo, s, sl) do { const int s_ = (s); const size_t base_ = (s_ < 4 ? (size_t)(ML + (bb) * NCTX + 64 * s_) : (size_t)((bb) * SEQ + ((Rlo) + s_ - 4) * 64)) * NIN0; \
        LAS unsigned char* sl_ = lds + (sl) * AT_SLOT + ldsw; \
        __builtin_amdgcn_global_load_lds((const unsigned*)(ksrc + base_), (LAS unsigned*)(sl_), 16, 0, 0); \
        __builtin_amdgcn_global_load_lds((const unsigned*)(ksrc + base_ + 64), (LAS unsigned*)(sl_ + 8192), 16, 0, 0); \
        __builtin_amdgcn_global_load_lds((const unsigned*)(vsrc + base_), (LAS unsigned*)(sl_ + 16384), 16, 0, 0); \
        __builtin_amdgcn_global_load_lds((const unsigned*)(vsrc + base_ + 64), (LAS unsigned*)(sl_ + 24576), 16, 0, 0); } while (0)
#define AT_DMAROW(trow, sl) do { const size_t base_ = (size_t)(trow) * NIN0; LAS unsigned char* sl_ = lds + (sl) * AT_SLOT + ldsw; \
        __builtin_amdgcn_global_load_lds((const unsigned*)(ksrc + base_), (LAS unsigned*)(sl_), 16, 0, 0); \
        __builtin_amdgcn_global_load_lds((const unsigned*)(ksrc + base_ + 64), (LAS unsigned*)(sl_ + 8192), 16, 0, 0); \
        __builtin_amdgcn_global_load_lds((const unsigned*)(vsrc + base_), (LAS unsigned*)(sl_ + 16384), 16, 0, 0); \
        __builtin_amdgcn_global_load_lds((const unsigned*)(vsrc + base_ + 64), (LAS unsigned*)(sl_ + 24576), 16, 0, 0); } while (0)
#define AT_DMAQ(bb, rr, hh) do { const bf16_t* qp_ = QKV + (size_t)((bb) * SEQ + (rr) * 64 + 32 * qh + r32) * NIN0 + (hh) * 64 + 8 * hi; LAS unsigned char* ql_ = lds + AT_QST + w * 4096; \
        __builtin_amdgcn_global_load_lds((const unsigned*)(qp_), (LAS unsigned*)(ql_), 16, 0, 0); __builtin_amdgcn_global_load_lds((const unsigned*)(qp_ + 16), (LAS unsigned*)(ql_ + 1024), 16, 0, 0); \
        __builtin_amdgcn_global_load_lds((const unsigned*)(qp_ + 32), (LAS unsigned*)(ql_ + 2048), 16, 0, 0); __builtin_amdgcn_global_load_lds((const unsigned*)(qp_ + 48), (LAS unsigned*)(ql_ + 3072), 16, 0, 0); } while (0)
#define AT_LOADQ(bb, rr, hh) do { const bf16_t* qp_ = QKV + (size_t)((bb) * SEQ + (rr) * 64 + 32 * qh + r32) * NIN0 + (hh) * 64 + 8 * hi; \
        qr[0] = *(const bf16x8*)(qp_); qr[1] = *(const bf16x8*)(qp_ + 16); qr[2] = *(const bf16x8*)(qp_ + 32); qr[3] = *(const bf16x8*)(qp_ + 48); } while (0)
    bf16x8 qr[4];
    if (w >= 4) __builtin_amdgcn_s_setprio(1);
    int bias_hp = -1, gs0 = 0;
    bool primed = false;
#pragma unroll 1
    for (int task = blockIdx.x; task < AT_NTASK; task += F.G) {
    const int b = task >> 9, rp = (task >> 2) & 127, hp = task & 3;
    const int h = 2 * hp + hsel, r = 2 * rp + rsel;
    const int rs_r = min(max(r - 4, 0), 248);
    const int R_lo = min(max(2 * rp - 4, 0), 248), R_hi = min(max(2 * rp + 1 - 4, 0), 248) + 7, nsteps = 4 + (R_hi - R_lo + 1);
    const int tn = task + F.G, bn = tn >> 9, rpn = (tn >> 2) & 127;
    const bool cont = tn < AT_NTASK && (tn & 3) == hp;
    const int R_lo_n = min(max(2 * rpn - 4, 0), 248);
    const bf16_t* ksrc = QKV + (size_t)krow_ * NIN0 + 512 + (2 * hp) * 64 + 8 * kchunk_;
    const bf16_t* vsrc = QKV + (size_t)krow_ * NIN0 + 1024 + (2 * hp) * 64 + 8 * ((lane & 7) ^ (((krow_ >> 1) & 1) << 2));
    if (!primed) {
        if (bias_hp != hp) {
            for (int i = F.tid; i < 2 * 15 * 128; i += 512) { const int hh = i / 1920, dr = (i >> 7) % 15, dc = (i & 127) - 48;
                BIAS[i] = (dc >= 0 && dc <= 30) ? F.in[I_RPB][(size_t)(2 * hp + hh) * 465 + dr * 31 + dc] * LOG2E : 0.f; }
            bias_hp = hp;
        }
        AT_LOADQ(b, r, h);
        asm volatile("s_waitcnt vmcnt(0)" ::: "memory");
        AT_DMA(b, R_lo, 0, gs0); AT_DMA(b, R_lo, 1, gs0 == 2 ? 0 : gs0 + 1);
    } else {
        asm volatile("s_waitcnt vmcnt(0)" ::: "memory");
#pragma unroll
        for (int d0 = 0; d0 < 4; ++d0) qr[d0] = *(LAS const bf16x8*)(lds + AT_QST + w * 4096 + d0 * 1024 + lane * 16);
    }
    float mref = 0.f, lrun = 0.f; f32x16 o[2], c0, c1;
#pragma unroll
    for (int i = 0; i < 16; ++i) { o[0][i] = 0.f; o[1][i] = 0.f; c0[i] = 0.f; c1[i] = 0.f; }
    const int cbase2 = ML + b * NCTX + 128, wbase2 = b * SEQ + (R_lo - 2) * 64, nbase = ML + bn * NCTX;
    int slc = gs0, sl2 = gs0 == 0 ? 2 : gs0 - 1;
    auto step = [&](const int s, auto win_t, auto qh_t) __attribute__((always_inline)) {
        constexpr bool WIN = decltype(win_t)::value; constexpr int QHC = decltype(qh_t)::value;
        if (WIN ? !(s + 1 < nsteps || cont) : (s == 0 && primed)) asm volatile("s_waitcnt vmcnt(0)" ::: "memory"); else asm volatile("s_waitcnt vmcnt(4)" ::: "memory");
        asm volatile("s_waitcnt lgkmcnt(0)" ::: "memory"); __builtin_amdgcn_s_barrier(); asm volatile("" ::: "memory");
        if constexpr (!WIN) { AT_DMAROW((s < 2 ? cbase2 : wbase2) + 64 * s, sl2); }
        else { const bool own = s + 2 < nsteps;
               if (own || cont) AT_DMAROW(own ? wbase2 + 64 * s : nbase + 64 * (s + 2 - nsteps), sl2);
               if (s == nsteps - 1 && cont) AT_DMAQ(bn, 2 * rpn + rsel, h); }
        const int kr = R_lo + s - 4;
        const bool active = !WIN || (kr >= rs_r && kr <= rs_r + 7);
        if (active) {
            LAS const unsigned char* Kslot = lds + slc * AT_SLOT + hsel * 8192;
            const unsigned vbs = (unsigned)(uintptr_t)(lds + slc * AT_SLOT + 16384 + hsel * 8192);
            f32x16 p0, p1;
            constexpr bool win = WIN; const bool l0a = !WIN || qh == 0, l1b = !WIN || qh == 1;
            bf16x8 kb0[4], kb1[4];
#pragma unroll
            for (int d0 = 0; d0 < 4; ++d0) { kb0[d0] = *(LAS const bf16x8*)(Kslot + koff[d0]); kb1[d0] = *(LAS const bf16x8*)(Kslot + koff[d0] + 4096); }
            if (win) {
                f32x16 cc0, cc1;
                const int dr = kr - r + 7;
                LAS const float* T = BIAS + (hsel * 15 + dr) * 128 + (63 - qc);
                float tb0[16], tb1[16];
#pragma unroll
                for (int i = 0; i < 16; ++i) { tb0[i] = T[crow(i, hi)]; tb1[i] = T[crow(i, hi) + 32]; }
#pragma unroll
                for (int i = 0; i < 16; ++i) { cc0[i] = c0[i] + tb0[i]; cc1[i] = c1[i] + tb1[i]; }
                qkt(p0, p1, kb0, kb1, qr, cc0, cc1);
            } else qkt(p0, p1, kb0, kb1, qr, c0, c1);
            float ra = max3f(p0[12], p0[13], p1[0]), rb = max3f(p0[14], p0[15], p1[1]); ra = max3f(ra, p1[2], p1[3]);
            if (l0a) {
#pragma unroll
                for (int i = 0; i < 12; i += 4) { ra = max3f(ra, p0[i], p0[i + 1]); rb = max3f(rb, p0[i + 2], p0[i + 3]); }
            }
            if (l1b) {
#pragma unroll
                for (int i = 4; i < 16; i += 4) { ra = max3f(ra, p1[i], p1[i + 1]); rb = max3f(rb, p1[i + 2], p1[i + 3]); }
            }
            float rm = half_swap_max(max2f(ra, rb));
            if ((!WIN && s == 0) || __any(rm > AT_THR)) {
                const float dl = (!WIN && s == 0) ? rm : max2f(rm, 0.f);
                mref += dl;
#pragma unroll
                for (int i = 0; i < 16; ++i) { p0[i] -= dl; p1[i] -= dl; c0[i] -= dl; c1[i] -= dl; }
                const float f = (!WIN && s == 0) ? 1.f : fast_exp2(-dl);
                lrun *= f;
#pragma unroll
                for (int i = 0; i < 16; ++i) { o[0][i] *= f; o[1][i] *= f; }
            }
            float ls = 0.f;
            u32x4 pw0, pw1, pw2, pw3;
            if (l0a) {
#pragma unroll
                for (int i = 0; i < 12; ++i) { p0[i] = fast_exp2(p0[i]); ls += p0[i]; }
                pw0.x = pg8::cvt_pk_bf16(p0[0], p0[1]); pw0.y = pg8::cvt_pk_bf16(p0[2], p0[3]); pw0.z = pg8::cvt_pk_bf16(p0[4], p0[5]); pw0.w = pg8::cvt_pk_bf16(p0[6], p0[7]);
                pw1.x = pg8::cvt_pk_bf16(p0[8], p0[9]); pw1.y = pg8::cvt_pk_bf16(p0[10], p0[11]);
            } else { pw0 = (u32x4){0u, 0u, 0u, 0u}; pw1.x = 0u; pw1.y = 0u; }
#pragma unroll
            for (int i = 12; i < 16; ++i) { p0[i] = fast_exp2(p0[i]); ls += p0[i]; }
#pragma unroll
            for (int i = 0; i < 4; ++i) { p1[i] = fast_exp2(p1[i]); ls += p1[i]; }
            pw1.z = pg8::cvt_pk_bf16(p0[12], p0[13]); pw1.w = pg8::cvt_pk_bf16(p0[14], p0[15]);
            pw2.x = pg8::cvt_pk_bf16(p1[0], p1[1]); pw2.y = pg8::cvt_pk_bf16(p1[2], p1[3]);
            if (l1b) {
#pragma unroll
                for (int i = 4; i < 16; ++i) { p1[i] = fast_exp2(p1[i]); ls += p1[i]; }
                pw2.z = pg8::cvt_pk_bf16(p1[4], p1[5]); pw2.w = pg8::cvt_pk_bf16(p1[6], p1[7]);
                pw3.x = pg8::cvt_pk_bf16(p1[8], p1[9]); pw3.y = pg8::cvt_pk_bf16(p1[10], p1[11]); pw3.z = pg8::cvt_pk_bf16(p1[12], p1[13]); pw3.w = pg8::cvt_pk_bf16(p1[14], p1[15]);
            } else { pw2.z = 0u; pw2.w = 0u; pw3 = (u32x4){0u, 0u, 0u, 0u}; }
            lrun += ls;
            LDS_WAIT();
            pv(o, vbs + vboff0, vbs + vboff1, __builtin_bit_cast(bf16x8, pw0), __builtin_bit_cast(bf16x8, pw1), __builtin_bit_cast(bf16x8, pw2), __builtin_bit_cast(bf16x8, pw3), l0a, l1b);
        }
            slc = slc == 2 ? 0 : slc + 1; sl2 = sl2 == 2 ? 0 : sl2 + 1;
    };
    int s_ = 0;
#pragma unroll 1
    for (; s_ < 4; ++s_) step(s_, std::false_type{}, std::integral_constant<int, -1>{});
    {
#pragma unroll
        for (int i = 0; i < 16; ++i) { const int k0_ = crow(i, hi); c0[i] = ((unsigned)(k0_ - cs) < 16u) ? c0[i] : -INFINITY; c1[i] = ((unsigned)(k0_ + 32 - cs) < 16u) ? c1[i] : -INFINITY; }
    }
#pragma unroll 1
    for (; s_ < nsteps; ++s_) step(s_, std::true_type{}, std::integral_constant<int, -1>{});
    const float ri = fast_rcp(half_swap_sum(lrun));
    unsigned char* orow = (unsigned char*)(MIX + (size_t)(b * SEQ + r * 64 + 32 * qh + r32) * D + h * 64) + (hi ? 16 : 0);
#pragma unroll
    for (int db = 0; db < 2; ++db) {
        unsigned gx[4], gy[4];
#pragma unroll
        for (int g = 0; g < 4; ++g) { gx[g] = pk2(o[db][4 * g] * ri, o[db][4 * g + 1] * ri); gy[g] = pk2(o[db][4 * g + 2] * ri, o[db][4 * g + 3] * ri); }
#pragma unroll
        for (int k = 0; k < 4; k += 2) {
            const auto rx = __builtin_amdgcn_permlane32_swap(gx[k], gx[k + 1], false, false);
            const auto ry = __builtin_amdgcn_permlane32_swap(gy[k], gy[k + 1], false, false);
            *(u32x4*)(orow + db * 64 + 16 * k) = (u32x4){rx[0], ry[0], rx[1], ry[1]};
        }
    }
    asm volatile("s_waitcnt lgkmcnt(0)" ::: "memory");
    if (!cont) { asm volatile("s_waitcnt vmcnt(0)" ::: "memory"); __builtin_amdgcn_s_barrier(); asm volatile("" ::: "memory"); }
    gs0 = (gs0 + nsteps) % 3; primed = cont;
    }
    __builtin_amdgcn_s_setprio(0);
#undef AT_DMA
#undef AT_LOADQ
#undef AT_DMAQ
#undef AT_DMAROW
}

struct LruW { bf16x8 wr[4], wi[4]; f32x16 cr, ci; float cn; };
constexpr int LRU_LW = 0, LRU_LC = 32768, LRU_HF = 36864, LRU_AF = LRU_HF + 65536;
static_assert(LRU_AF + 8 * 4096 <= LDSCTL_OFF, "LRU LDS map");
__device__ __forceinline__ void lru_stage_w(Frame& F, int g) {
    const u32x4* src = WSP(u32x4, WS_LRUW);
    LAS u32x4* dst = (LAS u32x4*)(F.lds + LRU_LW);
#pragma unroll
    for (int i = 0; i < 4; ++i) { const int idx = F.tid + 512 * i;
        const int d = idx >> 10, rest = idx & 1023;
        dst[idx] = src[(size_t)((d * 8 + g) * 1024) + rest]; }
    if (F.tid < 128) { const int d = F.tid >> 6, ch = d * 512 + g * 64 + (F.tid & 63);
        LAS float* lc = (LAS float*)(F.lds + LRU_LC) + F.tid * 4;
        lc[0] = -LOG2E * F.in[I_LBR][ch]; lc[1] = -LOG2E * F.in[I_LBI][ch]; lc[2] = -8.f * LOG2E * log1pf(__expf(-F.in[I_LAM][ch])); }
    __syncthreads();
}
__device__ __forceinline__ void lru_load_w(Frame& F, LruW& W, int d, int half, int lane) {
    LAS const bf16x8* wf = (LAS const bf16x8*)(F.lds + LRU_LW) + d * 1024 + lane;
#pragma unroll
    for (int s = 0; s < 4; ++s) { W.wr[s] = wf[((0 * 2 + half) * 4 + s) * 64]; W.wi[s] = wf[((1 * 2 + half) * 4 + s) * 64]; }
    LAS const float* lc = (LAS const float*)(F.lds + LRU_LC) + (d * 64 + 32 * half + (lane & 31)) * 4;
    { const float br = lc[0], bi = lc[1];
#pragma unroll
      for (int i = 0; i < 16; ++i) { W.cr[i] = br; W.ci[i] = bi; } }
    W.cn = lc[2];
}
__device__ __forceinline__ void lru_dma_af(const bf16_t* XC, size_t t0, int g, int lane, LAS unsigned char* afb) {
    const int rr = lane >> 3, sl = lane & 7;
#pragma unroll
    for (int i = 0; i < 4; ++i) { const int row = 8 * i + rr;
        __builtin_amdgcn_global_load_lds((const unsigned*)(XC + (t0 + row) * 512 + 64 * g + 8 * (sl ^ ((row >> 1) & 7))), (LAS unsigned*)(afb + i * 1024), 16, 0, 0); }
}
__device__ __forceinline__ void lru_read_af(LAS const unsigned char* afb, int r32, int hi, bf16x8 (&af)[4]) {
#pragma unroll
    for (int s = 0; s < 4; ++s) af[s] = *(LAS const bf16x8*)(afb + r32 * 128 + (((2 * s + hi) ^ ((r32 >> 1) & 7)) << 4));
}
__device__ __forceinline__ void lru_gates(const bf16x8 (&af)[4], const LruW& W, int half, bf16x8 I0, bf16x8 I1, float (&a)[16], float (&b)[16]) {
    f32x16 R, I, X;
#pragma unroll
    for (int i = 0; i < 16; ++i) X[i] = 0.f;
    R = __builtin_amdgcn_mfma_f32_32x32x16_bf16(af[0], W.wr[0], W.cr, 0, 0, 0); I = __builtin_amdgcn_mfma_f32_32x32x16_bf16(af[0], W.wi[0], W.ci, 0, 0, 0);
#pragma unroll
    for (int s = 1; s < 4; ++s) { R = __builtin_amdgcn_mfma_f32_32x32x16_bf16(af[s], W.wr[s], R, 0, 0, 0); I = __builtin_amdgcn_mfma_f32_32x32x16_bf16(af[s], W.wi[s], I, 0, 0, 0); }
    const bf16x8 ax0 = half ? af[2] : af[0], ax1 = half ? af[3] : af[1];
    X = __builtin_amdgcn_mfma_f32_32x32x16_bf16(ax0, I0, X, 0, 0, 0);
    X = __builtin_amdgcn_mfma_f32_32x32x16_bf16(ax1, I1, X, 0, 0, 0);
    const float cn = W.cn;
#pragma unroll
    for (int i = 0; i < 16; ++i) {
        const float rr = fast_rcp(1.f + fast_exp2(R[i])), ii = fast_rcp(1.f + fast_exp2(I[i]));
        const float av = fast_exp2(rr * cn);
        a[i] = av; b[i] = __builtin_amdgcn_sqrtf(1.f - av * av) * ii * X[i]; }
}
__device__ __forceinline__ float partner32(float x, int hi) { auto rr = __builtin_amdgcn_permlane32_swap(__float_as_uint(x), __float_as_uint(x), false, false); return __uint_as_float(hi ? rr[0] : rr[1]); }
template <bool REV, bool WANT_H> __device__ __forceinline__ void lru_scan_tile(const float (&a)[16], const float (&b)[16], int hi, float& H, float (&h)[16], float& ap) {
    float SA[4], SB[4], EAv[4], OAv[4], EBv[4], OBv[4];
#pragma unroll
    for (int q = 0; q < 4; ++q) { const float a0 = a[4 * q], a1 = a[4 * q + 1], a2 = a[4 * q + 2], a3 = a[4 * q + 3], b0 = b[4 * q], b1 = b[4 * q + 1], b2 = b[4 * q + 2], b3 = b[4 * q + 3];
        SA[q] = (a0 * a1) * (a2 * a3);
        SB[q] = REV ? ((b3 * a2 + b2) * a1 + b1) * a0 + b0 : ((b0 * a1 + b1) * a2 + b2) * a3 + b3; }
#pragma unroll
    for (int q = 0; q < 4; ++q) { auto ra_ = __builtin_amdgcn_permlane32_swap(__float_as_uint(SA[q]), __float_as_uint(SA[q]), false, false); EAv[q] = __uint_as_float(ra_[0]); OAv[q] = __uint_as_float(ra_[1]);
        auto rb_ = __builtin_amdgcn_permlane32_swap(__float_as_uint(SB[q]), __float_as_uint(SB[q]), false, false); EBv[q] = __uint_as_float(rb_[0]); OBv[q] = __uint_as_float(rb_[1]); }
    float cin[4];
    if (!REV) {
#pragma unroll
        for (int q = 0; q < 4; ++q) { const float EA = EAv[q], EB = EBv[q], OA = OAv[q], OB = OBv[q];
            const float he = H; H = EA * H + EB; const float ho = H; H = OA * H + OB; cin[q] = hi ? ho : he; if (!WANT_H) ap *= EA * OA; }
    } else {
#pragma unroll
        for (int q = 3; q >= 0; --q) { const float EA = EAv[q], EB = EBv[q], OA = OAv[q], OB = OBv[q];
            const float ho = H; H = OA * H + OB; const float he = H; H = EA * H + EB; cin[q] = hi ? ho : he; if (!WANT_H) ap *= EA * OA; }
    }
    if (WANT_H) {
#pragma unroll
        for (int q = 0; q < 4; ++q) { float hh = cin[q];
            if (!REV) {
#pragma unroll
                for (int e = 0; e < 4; ++e) { hh = a[4 * q + e] * hh + b[4 * q + e]; h[4 * q + e] = hh; }
            } else {
#pragma unroll
                for (int e = 3; e >= 0; --e) { hh = a[4 * q + e] * hh + b[4 * q + e]; h[4 * q + e] = hh; }
            } }
    }
}
__device__ __forceinline__ void lru_ident(int r32, int hi, bf16x8& I0, bf16x8& I1) {
#pragma unroll
    for (int j = 0; j < 8; ++j) { I0[j] = (8 * hi + j == r32) ? (short)0x3F80 : (short)0; I1[j] = (16 + 8 * hi + j == r32) ? (short)0x3F80 : (short)0; }
}
template <bool REV, int MODE> __device__ __forceinline__ void lru_subpass(Frame& F, size_t row0, int ntile, int g, int half, float& H, float& ap, LAS unsigned* HFL, bf16x8 (&af)[4], bool have) {
    const bf16_t* XC = WSP(bf16_t, WS_XCONV);
    const int lane = F.lane, r32 = lane & 31, hi = lane >> 5;
    LAS unsigned char* afb = F.lds + LRU_AF + F.wave * 4096;
    bf16x8 I0, I1; lru_ident(r32, hi, I0, I1);
    LruW W; lru_load_w(F, W, REV ? 1 : 0, half, lane);
    if (!have) {
        lru_dma_af(XC, row0 + (REV ? 32 * (ntile - 1) : 0), g, lane, afb);
        asm volatile("s_waitcnt vmcnt(0)" ::: "memory");
        lru_read_af(afb, r32, hi, af);
        asm volatile("s_waitcnt lgkmcnt(0)" ::: "memory");
    }
#pragma unroll 1
    for (int tt = 0; tt < ntile; ++tt) {
        const int ti = REV ? ntile - 1 - tt : tt;
        const bool more = tt + 1 < ntile;
        if (more) lru_dma_af(XC, row0 + 32 * (REV ? ti - 1 : ti + 1), g, lane, afb);
        const size_t t0 = row0 + 32 * ti;
        bf16_t grw[16];
        if (MODE == 2) { const bf16_t* gp = WSP(bf16_t, WS_BIG) + t0 * NIN0 + 2048 + 64 * g + 32 * half;
            const unsigned lo_ = (unsigned)(4 * hi * NIN0 + r32);
#pragma unroll
            for (int i = 0; i < 16; ++i) grw[i] = gp[lo_ + (unsigned)(((i & 3) + 8 * (i >> 2)) * NIN0)]; }
        float a[16], bb[16], h[16];
        lru_gates(af, W, half, I0, I1, a, bb);
        lru_scan_tile<REV, MODE != 0>(a, bb, hi, H, h, ap);
        asm volatile("s_waitcnt vmcnt(0)" ::: "memory");
        if (more) lru_read_af(afb, r32, hi, af);
        if (MODE == 1) {
#pragma unroll
            for (int p = 0; p < 8; ++p) HFL[(ti * 8 + p) * 64 + lane] = pk2(h[2 * p], h[2 * p + 1]);
        }
        if (MODE == 2) {
            bf16_t* op = WSP(bf16_t, WS_A2) + t0 * D + 512 + 64 * g + 32 * half;
            const unsigned so_ = (unsigned)(4 * hi * D + r32);
#pragma unroll
            for (int p = 0; p < 8; ++p) { const unsigned hf = HFL[(ti * 8 + p) * 64 + lane];
                const unsigned pr_ = pk2((bflo(hf) + h[2 * p]) * gelu_tanh(bf1(grw[2 * p])), (bfhi(hf) + h[2 * p + 1]) * gelu_tanh(bf1(grw[2 * p + 1])));
                op[so_ + (unsigned)((((2 * p) & 3) + 8 * ((2 * p) >> 2)) * D)] = (bf16_t)(pr_ & 0xffffu);
                op[so_ + (unsigned)((((2 * p + 1) & 3) + 8 * ((2 * p + 1) >> 2)) * D)] = (bf16_t)(pr_ >> 16); }
        }
        asm volatile("s_waitcnt lgkmcnt(0)" ::: "memory");
    }
    asm volatile("" ::: "memory");
}
template <bool REV> __device__ __forceinline__ void lru_subpass0(Frame& F, size_t row0, int ntile, int g, int half, float& H, float& ap) {
    const bf16_t* XC = WSP(bf16_t, WS_XCONV);
    const int lane = F.lane, r32 = lane & 31, hi = lane >> 5;
    LAS unsigned char* buf0 = F.lds + LRU_AF + F.wave * 4096; LAS unsigned char* buf1 = F.lds + LRU_HF + 8192 + F.wave * 4096;
    bf16x8 I0, I1; lru_ident(r32, hi, I0, I1);
    LruW W; lru_load_w(F, W, REV ? 1 : 0, half, lane);
    bf16x8 af[4];
#define LRU0_ROW(tt) (row0 + 32 * (REV ? ntile - 1 - (tt) : (tt)))
    lru_dma_af(XC, LRU0_ROW(0), g, lane, buf0);
    if (ntile > 1) { lru_dma_af(XC, LRU0_ROW(1), g, lane, buf1); asm volatile("s_waitcnt vmcnt(4)" ::: "memory"); } else asm volatile("s_waitcnt vmcnt(0)" ::: "memory");
    lru_read_af(buf0, r32, hi, af);
    asm volatile("s_waitcnt lgkmcnt(0)" ::: "memory");
#pragma unroll 1
    for (int tt = 0; tt < ntile; ++tt) {
        LAS unsigned char* bcur = (tt & 1) ? buf1 : buf0; LAS unsigned char* bnxt = (tt & 1) ? buf0 : buf1;
        if (tt + 2 < ntile) lru_dma_af(XC, LRU0_ROW(tt + 2), g, lane, bcur);
        float a[16], bb[16], h[16];
        lru_gates(af, W, half, I0, I1, a, bb);
        lru_scan_tile<REV, false>(a, bb, hi, H, h, ap);
        if (tt + 1 < ntile) {
            if (tt + 2 < ntile) asm volatile("s_waitcnt vmcnt(4)" ::: "memory"); else asm volatile("s_waitcnt vmcnt(0)" ::: "memory");
            lru_read_af(bnxt, r32, hi, af);
            asm volatile("s_waitcnt lgkmcnt(0)" ::: "memory");
        }
    }
#undef LRU0_ROW
    asm volatile("" ::: "memory");
}
__device__ __forceinline__ void conv4_local(Frame& F, size_t r0, int ngrp, size_t sbeg, size_t send, int g) {
    const bf16_t* QKV = WSP(bf16_t, WS_BIG); bf16_t* XC = WSP(bf16_t, WS_XCONV);
    const int lane = F.lane, rgrp = lane >> 3, cl = lane & 7, ch = 64 * g + 8 * cl;
    if (rgrp < ngrp) {
        const size_t row0 = r0 + 16 * rgrp;
        u32x4 raw[19];
#pragma unroll
        for (int i = 0; i < 19; ++i) { const size_t r = row0 + i - 2; raw[i] = (r >= sbeg && r < send) ? *(const u32x4*)(QKV + r * NIN0 + 1536 + ch) : (u32x4){0u, 0u, 0u, 0u}; }
        float w[4][8], bs[8];
#pragma unroll
        for (int j = 0; j < 4; ++j) { const f32x4 a = *(const f32x4*)(F.in[I_ECW] + j * 512 + ch), b = *(const f32x4*)(F.in[I_ECW] + j * 512 + ch + 4);
            w[j][0] = a.x; w[j][1] = a.y; w[j][2] = a.z; w[j][3] = a.w; w[j][4] = b.x; w[j][5] = b.y; w[j][6] = b.z; w[j][7] = b.w; }
        { const f32x4 a = *(const f32x4*)(F.in[I_ECB] + ch), b = *(const f32x4*)(F.in[I_ECB] + ch + 4); bs[0] = a.x; bs[1] = a.y; bs[2] = a.z; bs[3] = a.w; bs[4] = b.x; bs[5] = b.y; bs[6] = b.z; bs[7] = b.w; }
#pragma unroll
        for (int t = 0; t < 16; ++t) {
            float o[8];
#pragma unroll
            for (int e = 0; e < 8; ++e) o[e] = bs[e];
#pragma unroll
            for (int j = 0; j < 4; ++j) { const u32x4 r = raw[t + j];
                o[0] += w[j][0] * bflo(r.x); o[1] += w[j][1] * bfhi(r.x); o[2] += w[j][2] * bflo(r.y); o[3] += w[j][3] * bfhi(r.y);
                o[4] += w[j][4] * bflo(r.z); o[5] += w[j][5] * bfhi(r.z); o[6] += w[j][6] * bflo(r.w); o[7] += w[j][7] * bfhi(r.w); }
            u32x4 pk; pk.x = pk2(o[0], o[1]); pk.y = pk2(o[2], o[3]); pk.z = pk2(o[4], o[5]); pk.w = pk2(o[6], o[7]);
            *(u32x4*)(XC + (row0 + t) * 512 + ch) = pk;
        }
    }
    asm volatile("s_waitcnt vmcnt(0)" ::: "memory");
}
template <bool REV> __device__ __forceinline__ void lru_subpass2(Frame& F, size_t row0, int ntile, int g, float (&H)[2], float (&ap)[2]) {
    const bf16_t* XC = WSP(bf16_t, WS_XCONV);
    const int lane = F.lane, r32 = lane & 31, hi = lane >> 5;
    LAS unsigned char* afb = F.lds + LRU_AF + F.wave * 4096;
    bf16x8 I0, I1; lru_ident(r32, hi, I0, I1);
    LruW W0, W1; lru_load_w(F, W0, REV ? 1 : 0, 0, lane); lru_load_w(F, W1, REV ? 1 : 0, 1, lane);
    bf16x8 af[4];
    lru_dma_af(XC, row0 + (REV ? 32 * (ntile - 1) : 0), g, lane, afb);
    asm volatile("s_waitcnt vmcnt(0)" ::: "memory");
    lru_read_af(afb, r32, hi, af);
    asm volatile("s_waitcnt lgkmcnt(0)" ::: "memory");
#pragma unroll 1
    for (int tt = 0; tt < ntile; ++tt) {
        const int ti = REV ? ntile - 1 - tt : tt;
        const bool more = tt + 1 < ntile;
        if (more) lru_dma_af(XC, row0 + 32 * (REV ? ti - 1 : ti + 1), g, lane, afb);
        float a0[16], b0[16], a1[16], b1[16], hd[16];
        lru_gates(af, W0, 0, I0, I1, a0, b0);
        lru_gates(af, W1, 1, I0, I1, a1, b1);
        lru_scan_tile<REV, false>(a0, b0, hi, H[0], hd, ap[0]);
        lru_scan_tile<REV, false>(a1, b1, hi, H[1], hd, ap[1]);
        asm volatile("s_waitcnt vmcnt(0)" ::: "memory");
        if (more) lru_read_af(afb, r32, hi, af);
        asm volatile("s_waitcnt lgkmcnt(0)" ::: "memory");
    }
    asm volatile("" ::: "memory");
}
__device__ __forceinline__ void lru_pass1_wg(Frame& F, int wg) {
    const int j = wg & 15, g = (wg >> 4) & 7, b = wg >> 7, w = F.wave, lane = F.lane, hi = lane >> 5;
    f32x2* TOT = WSP(f32x2, WS_TOT); f32x2* TOTG = WSP(f32x2, WS_TOTG); f32x2* TOTC = WSP(f32x2, WS_TOTC);
    LAS f32x2* CB = (LAS f32x2*)(F.lds + LRU_HF);
    lru_stage_w(F, g);
    const int c = 8 * j + w, sub = w - 2;
    const int njobs = (w == 2 || w == 4) ? 2 : 1;
    if (njobs == 2) __builtin_amdgcn_s_setprio(1);
#pragma unroll 1
    for (int job = 0; job < njobs; ++job) {
        const size_t r0 = job == 0 ? (size_t)b * SEQ + (size_t)c * CHUNK : (size_t)ML + (size_t)b * NCTX + 32 * (j & 7);
        const int nt = job == 0 ? 4 : 1;
        { const size_t sb_ = job == 0 ? (size_t)b * SEQ : (size_t)ML + (size_t)b * NCTX, se_ = job == 0 ? sb_ + SEQ : sb_ + NCTX;
          asm volatile("" ::: "memory"); __builtin_amdgcn_sched_barrier(0);
          conv4_local(F, r0, job == 0 ? 8 : 2, sb_, se_, g);
          asm volatile("" ::: "memory"); __builtin_amdgcn_sched_barrier(0); }
        f32x2 tot[2] = {(f32x2){1.f, 0.f}, (f32x2){1.f, 0.f}};
#pragma unroll 1
        for (int half = 0; half < 2; ++half) {
            if (job != 0 && half != (j >> 3)) continue;
            if (job == 0 || sub < 2) { float H = 0.f, ap = 1.f; lru_subpass0<false>(F, r0, nt, g, half, H, ap); if (hi == half) tot[0] = (f32x2){ap, H}; }
            if (job == 0 || sub >= 2) { float H = 0.f, ap = 1.f; lru_subpass0<true>(F, r0, nt, g, half, H, ap); if (hi == half) tot[1] = (f32x2){ap, H}; }
        }
        if (job == 0) {
#pragma unroll
            for (int d = 0; d < 2; ++d) { TOT[(size_t)((b * 2 + d) * NCHUNK + c) * 512 + 64 * g + lane] = tot[d]; CB[(d * 8 + w) * 64 + lane] = tot[d]; }
        } else {
            if (hi == (j >> 3)) TOTC[(size_t)((b * 2 + (sub >> 1)) * 8 + (j & 7)) * 512 + 64 * g + lane] = (sub >> 1) ? tot[1] : tot[0];
        }
    }
    __builtin_amdgcn_s_setprio(0);
    __syncthreads();
    if (w < 2) { const int d = w; float A = 1.f, B = 0.f;
#pragma unroll
        for (int k = 0; k < 8; ++k) { const f32x2 t = CB[(d * 8 + (d == 0 ? k : 7 - k)) * 64 + lane]; B = t.x * B + t.y; A *= t.x; }
        TOTG[(size_t)((b * 2 + d) * 16 + j) * 512 + 64 * g + lane] = (f32x2){A, B}; }
    __syncthreads();
}
__device__ __forceinline__ void lru_pass3_wg(Frame& F, int wg) {
    const int j = wg & 15, g = (wg >> 4) & 7, b = wg >> 7, w = F.wave, lane = F.lane, r32 = lane & 31;
    const f32x2* TOT = WSP(f32x2, WS_TOT); const f32x2* TOTG = WSP(f32x2, WS_TOTG); const f32x2* TOTC = WSP(f32x2, WS_TOTC);
    LAS unsigned* HFL = (LAS unsigned*)(F.lds + LRU_HF + w * 8192);
    const int c = 8 * j + w;
    const size_t row0 = (size_t)b * SEQ + (size_t)c * CHUNK;
    float Cf = 0.f, Cb = 0.f;
    {
        const f32x2 id = (f32x2){1.f, 0.f};
        const size_t chn = 64 * g + lane;
        f32x2 t[15];
#pragma unroll
        for (int k = 0; k < 8; ++k) t[k] = TOTC[(size_t)((b * 2 + 0) * 8 + k) * 512 + chn];
#pragma unroll
        for (int k = 0; k < 7; ++k) t[8 + k] = (k < w) ? TOT[(size_t)((b * 2 + 0) * NCHUNK + 8 * j + k) * 512 + chn] : id;
        f32x2 u[15];
#pragma unroll
        for (int k = 0; k < 15; ++k) u[k] = (k < j) ? TOTG[(size_t)((b * 2 + 0) * 16 + k) * 512 + chn] : id;
        f32x2 tb[15], ub[15];
#pragma unroll
        for (int k = 0; k < 8; ++k) tb[k] = TOTC[(size_t)((b * 2 + 1) * 8 + (7 - k)) * 512 + chn];
#pragma unroll
        for (int k = 0; k < 7; ++k) tb[8 + k] = (7 - k > w) ? TOT[(size_t)((b * 2 + 1) * NCHUNK + 8 * j + (7 - k)) * 512 + chn] : id;
#pragma unroll
        for (int k = 0; k < 15; ++k) ub[k] = (15 - k > j) ? TOTG[(size_t)((b * 2 + 1) * 16 + (15 - k)) * 512 + chn] : id;
        lru_stage_w(F, g);
#pragma unroll
        for (int k = 0; k < 8; ++k) Cf = t[k].x * Cf + t[k].y;
#pragma unroll
        for (int k = 0; k < 15; ++k) Cf = u[k].x * Cf + u[k].y;
#pragma unroll
        for (int k = 0; k < 7; ++k) Cf = t[8 + k].x * Cf + t[8 + k].y;
#pragma unroll
        for (int k = 0; k < 8; ++k) Cb = tb[k].x * Cb + tb[k].y;
#pragma unroll
        for (int k = 0; k < 15; ++k) Cb = ub[k].x * Cb + ub[k].y;
#pragma unroll
        for (int k = 0; k < 7; ++k) Cb = tb[8 + k].x * Cb + tb[8 + k].y;
        asm volatile("" ::: "memory");
    }
    float dummy = 1.f, H;
    bf16x8 af[4];
#pragma unroll 1
    for (int half = 0; half < 2; ++half) {
        H = __shfl(Cf, 32 * half + r32); lru_subpass<false, 1>(F, row0, 4, g, half, H, dummy, HFL, af, half != 0);
        H = __shfl(Cb, 32 * half + r32); lru_subpass<true, 2>(F, row0, 4, g, half, H, dummy, HFL, af, true);
    }
    LDS_WAIT();
    __syncthreads();
}

__device__ __forceinline__ void conv3_task(Frame& F, int task) {
    bf16_t* BG = WSP(bf16_t, WS_A1); const bf16_t* P = WSP(bf16_t, WS_A3);
    const int lane = F.lane, half = task & 1, row0 = (task >> 1) * 16, ch = half * 512 + 8 * lane;
    const int sbeg = (row0 / SEQ) * SEQ, send = sbeg + SEQ;
    u32x4 raw[18];
#pragma unroll
    for (int i = 0; i < 18; ++i) { const int r = row0 + i - 1; raw[i] = (r >= sbeg && r < send) ? *(const u32x4*)(P + (size_t)r * D + ch) : (u32x4){0u, 0u, 0u, 0u}; }
    u32x4 bgr[16];
#pragma unroll
    for (int t = 0; t < 16; ++t) bgr[t] = *(const u32x4*)(BG + (size_t)(row0 + t) * D + ch);
    float w[3][8];
#pragma unroll
    for (int j = 0; j < 3; ++j) { const f32x4 a = *(const f32x4*)(F.in[I_OCW] + j * D + ch), b = *(const f32x4*)(F.in[I_OCW] + j * D + ch + 4);
        w[j][0] = a.x; w[j][1] = a.y; w[j][2] = a.z; w[j][3] = a.w; w[j][4] = b.x; w[j][5] = b.y; w[j][6] = b.z; w[j][7] = b.w; }
#pragma unroll
    for (int t = 0; t < 16; ++t) {
        float o[8];
#pragma unroll
        for (int e = 0; e < 8; ++e) o[e] = 0.f;
#pragma unroll
        for (int j = 0; j < 3; ++j) { const u32x4 r = raw[t + j];
            o[0] += w[j][0] * bflo(r.x); o[1] += w[j][1] * bfhi(r.x); o[2] += w[j][2] * bflo(r.y); o[3] += w[j][3] * bfhi(r.y);
            o[4] += w[j][4] * bflo(r.z); o[5] += w[j][5] * bfhi(r.z); o[6] += w[j][6] * bflo(r.w); o[7] += w[j][7] * bfhi(r.w); }
        bf16_t* bp = BG + (size_t)(row0 + t) * D + ch;
        const u32x4 bgv = bgr[t];
        u32x4 pk; pk.x = pk2(o[0] * bflo(bgv.x), o[1] * bfhi(bgv.x)); pk.y = pk2(o[2] * bflo(bgv.y), o[3] * bfhi(bgv.y)); pk.z = pk2(o[4] * bflo(bgv.z), o[5] * bfhi(bgv.z)); pk.w = pk2(o[6] * bflo(bgv.w), o[7] * bfhi(bgv.w));
        st16_wt(bp, pk);
    }
}

__device__ __forceinline__ void final_row(Frame& F, int m) {
    f32x4* xr = (f32x4*)(F.out + (size_t)m * D) + F.lane;
    const float rs = fast_rsq(WSP(float, WS_SSQ)[3 * ML + m] * (1.f / D) + EPS);
    const f32x4* gp = (const f32x4*)F.in[I_FG] + F.lane;
#pragma unroll
    for (int j = 0; j < 4; ++j) { const f32x4 v = xr[64 * j], g = gp[64 * j]; xr[64 * j] = v * rs * g; }
}

__device__ __forceinline__ void ctx_proj_wg(Frame& F) {
    const int lane = F.lane, w = F.wave, r32 = lane & 31, hi = lane >> 5;
    const bf16_t* XB = WSP(bf16_t, WS_A1) + (size_t)ML * D;
    const bf16_t* W2 = WSP(bf16_t, WS_WIN0) + (size_t)2 * NIN0 * D;
    const float* ss = WSP(float, WS_SS0) + ML; const float* bias = WSP(float, WS_B_IN0) + (size_t)2 * NIN0;
    bf16_t* O = WSP(bf16_t, WS_BIG) + (size_t)ML * NIN0;
    LAS float* red = (LAS float*)F.lds;
    constexpr int NSTRIP = (NB * NCTX / 32) * (1536 / 96);
    for (int st = blockIdx.x; st < NSTRIP; st += (int)F.G) {
        const int rb = st >> 4, c0 = 512 + 96 * (st & 15);
        const bf16_t* ap = XB + (size_t)(32 * rb + r32) * D + 128 * w + 8 * hi;
        const bf16_t* bp = W2 + (size_t)(c0 + r32) * D + 128 * w + 8 * hi;
        bf16x8 a[8], b[3][8];
#pragma unroll
        for (int j = 0; j < 8; ++j) { a[j] = *(const bf16x8*)(ap + 16 * j);
#pragma unroll
            for (int t = 0; t < 3; ++t) b[t][j] = *(const bf16x8*)(bp + (size_t)(32 * t) * D + 16 * j); }
        f32x16 acc[3];
#pragma unroll
        for (int t = 0; t < 3; ++t) {
#pragma unroll
            for (int i = 0; i < 16; ++i) acc[t][i] = 0.f;
#pragma unroll
            for (int j = 0; j < 8; ++j) acc[t] = __builtin_amdgcn_mfma_f32_32x32x16_bf16(a[j], b[t][j], acc[t], 0, 0, 0);
#pragma unroll
            for (int i = 0; i < 16; ++i) red[((w * 3 + t) * 16 + i) * 64 + lane] = acc[t][i];
        }
        __syncthreads();
#pragma unroll
        for (int q = 0; q < 6; ++q) { const int p = w * 6 + q, t = p >> 4, i = p & 15, row = 32 * rb + crow(i, hi), col = c0 + 32 * t + r32;
            float v = 0.f;
#pragma unroll
            for (int k = 0; k < 8; ++k) v += red[((k * 3 + t) * 16 + i) * 64 + lane];
            v = v * fast_rsq(ss[row] * (1.f / D) + EPS) + bias[col];
            O[(size_t)row * NIN0 + col] = (bf16_t)f2bf(v); }
        __syncthreads();
    }
}

constexpr int PI_O = (D / 64) * (D / 32), PI_GU = (NGU / 32) * 16, PI_DN = (FF / 64) * (D / 32), PI_IN1 = (NIN1 / 32) * 16;
constexpr int PE0 = PI_O, PE1 = PE0 + PI_GU, PE2 = PE1 + PI_DN, PE3 = PE2 + PI_IN1, PE4 = PE3 + PI_O, PE5 = PE4 + PI_GU, L1_ITEMS = PE5 + PI_DN;
constexpr int PREP_SLICES = 10, PREP_PER = (L1_ITEMS + PREP_SLICES - 1) / PREP_SLICES;
__device__ __forceinline__ int prep_slice_begin(int k) { return PREP_PER * k; }
static_assert(3 * PREP_PER >= PE0 && 4 * PREP_PER >= PE1 && 5 * PREP_PER >= PE2 && 6 * PREP_PER >= PE3 && 8 * PREP_PER >= PE4 && 9 * PREP_PER >= PE5 && 10 * PREP_PER >= L1_ITEMS && PREP_PER <= 7 * 256, "prep deadlines");
__device__ __forceinline__ void prep_l1_item(Frame& F, int item) {
    LAS float* scr = (LAS float*)(F.lds + F.wave * 16384);
    const bool fold0 = item >= PE0 && item < PE1, fold_in1 = item >= PE2 && item < PE3, fold1 = item >= PE4 && item < PE5;
    if (fold0 || fold_in1 || fold1) {
        const bool gu = !fold_in1; const int l = fold0 ? 0 : 1;
        const int r = item - (fold0 ? PE0 : (fold_in1 ? PE2 : PE4)), ks = r & 15, n0 = (r >> 4) * 32;
        const int N = gu ? NGU : NIN1;
        fold_item<2>(gu ? F.in[I_WGU] + (size_t)l * D * NGU : F.in[I_OWIN], N, n0, gu ? gu_dst(n0) : in1_dst(n0), N, 64 * ks, 1.f, (gu ? F.in[I_N2G] : F.in[I_N1G]) + l * D, WSP(float, WS_MODS) + l * 3 * 6144,
                     gu ? 4096 : 1024, gu ? 3072 : 0, gu ? (l ? WSP(bf16_t, WS_WGU1) : WSP(bf16_t, WS_WGU0)) : WSP(bf16_t, WS_WIN1), gu ? (l ? WSP(float, WS_B_GU1) : WSP(float, WS_B_GU0)) : WSP(float, WS_B_IN1), scr, F.lane);
    } else {
        const int which = item < PE0 ? 0 : (item < PE2 ? 1 : (item < PE4 ? 2 : 3));
        const float* W = which == 0 ? F.in[I_EWOUT] : (which == 1 ? F.in[I_WDN] : (which == 2 ? F.in[I_OWOUT] : F.in[I_WDN] + (size_t)FF * D));
        bf16_t* WT = which == 0 ? WSP(bf16_t, WS_WOUT0) : (which == 1 ? WSP(bf16_t, WS_WDN0) : (which == 2 ? WSP(bf16_t, WS_WOUT1) : WSP(bf16_t, WS_WDN1)));
        p0_transpose_item(W, (which & 1) ? FF : D, D, WT, scr, which == 0 ? item : (which == 1 ? item - PE1 : (which == 2 ? item - PE3 : item - PE5)), F.lane);
    }
}
__device__ __forceinline__ void xcd_barrier_prep(const XcdBarrier& b, Frame& F, int slice) {
    asm volatile("s_waitcnt vmcnt(0)" ::: "memory");
    __syncthreads();
    if (F.wave == 0) {
        if (threadIdx.x == 0) {
            unsigned* bar = b.bar;
            __builtin_amdgcn_s_waitcnt(0);
            unsigned nloc = b.st[0], nx = b.st[1];
            if (nloc == 0u) { xcd_barrier_complete(bar, b.x, nloc, nx); b.st[0] = nloc; b.st[1] = nx; }
            const unsigned old = xb_add(&bar[XB_XSUB(b.x)], 1u);
            __builtin_amdgcn_fence(__ATOMIC_ACQUIRE, "agent");
            const unsigned gen = old / nloc;
            if (old + 1u == (gen + 1u) * nloc) {
                __builtin_amdgcn_fence(__ATOMIC_RELEASE, "agent");
                asm volatile("s_waitcnt vmcnt(0)" ::: "memory");
                const unsigned og = xb_add(&bar[XB_TOP], 1u);
                const unsigned tg = og / nx;
                if (og + 1u == (tg + 1u) * nx) {
#pragma unroll
                    for (unsigned j = 0; j < 16; ++j) xb_add(&bar[XB_XGEN(j)], 1u);
                } else XB_SPIN(xb_ld(&bar[XB_XGEN(b.x)]) == gen, bar);
                asm volatile("s_waitcnt vmcnt(0)" ::: "memory");
            } else {
                XB_SPIN(xb_ld(&bar[XB_XGEN(b.x)]) == gen, bar);
                asm volatile("s_waitcnt vmcnt(0)" ::: "memory");
            }
        }
    } else {
        const int w = (7 - F.wave) * (int)F.G + (int)blockIdx.x, item = prep_slice_begin(slice) + w;
        if (item < prep_slice_begin(slice + 1) && item < L1_ITEMS) prep_l1_item(F, item);
    }
    __syncthreads();
}

struct Args { const float* in[N_IN]; float* out; unsigned char* ws; int ph_lo, ph_hi; };
__global__ void __launch_bounds__(512, 2) dit_fwd(Args args) {
    extern __shared__ __attribute__((aligned(16))) unsigned char lds_raw[];
    Frame F;
    F.lds = (LAS unsigned char*)lds_raw;
    F.tid = threadIdx.x; F.lane = F.tid & 63; F.wave = __builtin_amdgcn_readfirstlane(F.tid >> 6);
    F.G = gridDim.x; F.gw = blockIdx.x * 8 + F.wave; F.NGW = F.G * 8;
#pragma unroll
    for (int i = 0; i < N_IN; ++i) F.in[i] = args.in[i];
    F.out = args.out; F.ws = args.ws;
    for (int u = F.tid; u < (LDS_BYTES - LDSCTL_OFF) / 4; u += 512) ((LAS unsigned*)(F.lds + LDSCTL_OFF))[u] = 0u;
    __syncthreads();
    volatile LAS unsigned* MISC = (volatile LAS unsigned*)(F.lds + MISC_OFF);
    XcdBarrier bar; bar.bar = (unsigned*)(F.ws + WS_CTL) + CW_BAR; bar.x = 0; bar.st = nullptr;
    const int lo = args.ph_lo, hi = args.ph_hi;
    if (hi - lo > 1) bar = xcd_barrier_post((unsigned*)(F.ws + WS_CTL) + CW_BAR, MISC + 8);
#ifdef ONLY_PHASE
#define IN(k) ((k) == ONLY_PHASE)
#else
#define IN(k) (lo <= (k) && (k) < hi)
#endif
#define SEAM(k) do { if (IN(k) && IN((k) + 1)) xcd_barrier(bar); } while (0)
#define SEAMP(k, sl) do { if (IN(k) && IN((k) + 1)) xcd_barrier_prep(bar, F, sl); } while (0)
    float* SSQ = WSP(float, WS_SSQ);
    const float* mods = WSP(float, WS_MODS);

    if (IN(0)) {
        unsigned* mt = (unsigned*)(F.ws + WS_CTL) + CW_MODS;
        for (int t = blockIdx.x; t < 192; t += F.G) {
            p0_mods_task(F, t);
            asm volatile("s_waitcnt vmcnt(0)" ::: "memory");
            __syncthreads();
            if (F.tid == 0) (void)__hip_atomic_fetch_add(mt, 1u, __ATOMIC_RELAXED, __HIP_MEMORY_SCOPE_AGENT);
        }
        phase_p0(F, 0, F.gw, F.NGW);
        if (F.tid == 0) { unsigned sp = 0; while (__hip_atomic_load(mt, __ATOMIC_RELAXED, __HIP_MEMORY_SCOPE_AGENT) < 192u) { __builtin_amdgcn_s_sleep(2); if (++sp > (1u << 22)) break; }
            __builtin_amdgcn_fence(__ATOMIC_ACQUIRE, "agent"); asm volatile("s_waitcnt vmcnt(0)" ::: "memory"); }
        __syncthreads();
        phase_p1(F, 0, F.wave * F.G + blockIdx.x, F.NGW);
    } SEAMP(0, 0);
    if (IN(2)) { for (int rep_ = 0; rep_ <= ((PROBE_REP_MASK >> 2) & 1); ++rep_) { if (rep_) xcd_barrier(bar);
        pg8::Gemm g{WSP(bf16_t, WS_A1), WSP(bf16_t, WS_WIN0), (long)NIN0 * D, (long)2 * NIN0 * D, D};
        pg8::Order S; S.init(ML / 256, NIN0 / 256, F.G, blockIdx.x);
        pg8::EpiInProj E{WSP(bf16_t, WS_BIG), WSP(float, WS_SS0), WSP(float, WS_B_IN0)};
        pg8::gemm_phase<pg8::EpiInProj, pg8::Order, true, true>(F.lds, g, S, E);
        __syncthreads();
        ctx_proj_wg(F);
    } } SEAMP(2, 1);
    if (IN(3)) { for (int rep_ = 0; rep_ <= ((PROBE_REP_MASK >> 3) & 1); ++rep_) { if (rep_) xcd_barrier(bar);
        attn_phase(F);
        __syncthreads();
        for (int t = blockIdx.x; t < 256; t += F.G) lru_pass1_wg(F, t);
    } } SEAMP(3, 2);
    if (IN(5)) { for (int rep_ = 0; rep_ <= ((PROBE_REP_MASK >> 5) & 1); ++rep_) { if (rep_) xcd_barrier(bar); for (int t = blockIdx.x; t < 256; t += F.G) lru_pass3_wg(F, t); } } SEAMP(5, 3);
    if (IN(6)) { for (int rep_ = 0; rep_ <= ((PROBE_REP_MASK >> 6) & 1); ++rep_) { if (rep_) xcd_barrier(bar);
        pg8::Gemm g{WSP(bf16_t, WS_A2), WSP(bf16_t, WS_WOUT0), 0l, 0l, D};
        pg8::Order S; S.init(ML / 256, D / 256, F.G, blockIdx.x);
        pg8::EpiRes<false, false> E{nullptr, WSP(bf16_t, WS_A1), WSP(bf16_t, WS_A3), nullptr, mods + 2048, SSQ, (unsigned)(uintptr_t)(F.lds + 132096)};
        pg8::gemm_phase<pg8::EpiRes<false, false>, pg8::Order, true, true>(F.lds, g, S, E);
    } } SEAMP(6, 4);
    if (IN(7)) { for (int rep_ = 0; rep_ <= ((PROBE_REP_MASK >> 7) & 1); ++rep_) { if (rep_) xcd_barrier(bar);
        pg8::Gemm g{WSP(bf16_t, WS_A3), WSP(bf16_t, WS_WGU0), (long)NGU * D, 0l, D};
        pg8::Order S; S.init(ML / 256, NGU / 256, F.G, blockIdx.x);
        pg8::EpiSwiGLU E{WSP(bf16_t, WS_BIG), SSQ, WSP(float, WS_B_GU0)};
        pg8::gemm_phase<pg8::EpiSwiGLU, pg8::Order, true, true>(F.lds, g, S, E);
    } } SEAMP(7, 5);
    if (IN(8)) { for (int rep_ = 0; rep_ <= ((PROBE_REP_MASK >> 8) & 1); ++rep_) { if (rep_) xcd_barrier(bar);
        pg8::Gemm g{WSP(bf16_t, WS_BIG), WSP(bf16_t, WS_WDN0), 0l, 0l, FF};
        pg8::Order S; S.init(ML / 256, D / 256, F.G, blockIdx.x);
        pg8::EpiRes<false, false> E{nullptr, WSP(bf16_t, WS_A3), WSP(bf16_t, WS_A2), nullptr, mods + 5120, SSQ + ML, (unsigned)(uintptr_t)(F.lds + 132096)};
        pg8::gemm_phase<pg8::EpiRes<false, false>, pg8::Order, true, true>(F.lds, g, S, E);
    } } SEAMP(8, 6);
    if (IN(9)) { for (int rep_ = 0; rep_ <= ((PROBE_REP_MASK >> 9) & 1); ++rep_) { if (rep_) xcd_barrier(bar);
        pg8::Gemm g{WSP(bf16_t, WS_A2), WSP(bf16_t, WS_WIN1), (long)NIN1 * D, 0l, D};
        pg8::Order S; S.init(ML / 256, 8, F.G, blockIdx.x); S.pn_off = 4;
        pg8::EpiScIn E{WSP(bf16_t, WS_A1), WSP(bf16_t, WS_A3), SSQ + ML, WSP(float, WS_B_IN1)};
        pg8::gemm_phase<pg8::EpiScIn, pg8::Order, true, true>(F.lds, g, S, E);
    } } SEAMP(9, 7);
    if (IN(10)) { for (int rep_ = 0; rep_ <= ((PROBE_REP_MASK >> 10) & 1); ++rep_) { if (rep_) xcd_barrier(bar);
        pg8::Gemm g{WSP(bf16_t, WS_A2), WSP(bf16_t, WS_WIN1), (long)NIN1 * D, 0l, D};
        pg8::Order S; S.init(ML / 256, 4, F.G, blockIdx.x);
        pg8::EpiScGate E{WSP(bf16_t, WS_A1), WSP(bf16_t, WS_A3), SSQ + ML, WSP(float, WS_B_IN1), F.in[I_OCW]};
        pg8::gemm_phase<pg8::EpiScGate, pg8::Order, true, true>(F.lds, g, S, E);
    } } SEAMP(10, 8);
    if (IN(11)) { for (int rep_ = 0; rep_ <= ((PROBE_REP_MASK >> 11) & 1); ++rep_) { if (rep_) xcd_barrier(bar);
        pg8::Gemm g{WSP(bf16_t, WS_A1), WSP(bf16_t, WS_WOUT1), 0l, 0l, D};
        pg8::Order S; S.init(ML / 256, D / 256, F.G, blockIdx.x);
        pg8::EpiRes<false, false> E{nullptr, WSP(bf16_t, WS_A2), WSP(bf16_t, WS_A3), nullptr, mods + 3 * 6144 + 2048, SSQ + 2 * ML, (unsigned)(uintptr_t)(F.lds + 132096)};
        pg8::gemm_phase<pg8::EpiRes<false, false>, pg8::Order, true, true>(F.lds, g, S, E);
    } } SEAMP(11, 9);
    if (IN(12)) { for (int rep_ = 0; rep_ <= ((PROBE_REP_MASK >> 12) & 1); ++rep_) { if (rep_) xcd_barrier(bar);
        pg8::Gemm g{WSP(bf16_t, WS_A3), WSP(bf16_t, WS_WGU1), (long)NGU * D, 0l, D};
        pg8::Order S; S.init(ML / 256, NGU / 256, F.G, blockIdx.x);
        pg8::EpiSwiGLU E{WSP(bf16_t, WS_BIG), SSQ + 2 * ML, WSP(float, WS_B_GU1)};
        pg8::gemm_phase<pg8::EpiSwiGLU, pg8::Order, true, true>(F.lds, g, S, E);
    } } SEAM(12);
    if (IN(13)) { for (int rep_ = 0; rep_ <= ((PROBE_REP_MASK >> 13) & 1); ++rep_) { if (rep_) xcd_barrier(bar);
        pg8::Gemm g{WSP(bf16_t, WS_BIG), WSP(bf16_t, WS_WDN1), 0l, 0l, FF};
        pg8::Order S; S.init(ML / 256, D / 256, F.G, blockIdx.x);
        pg8::EpiFinal E{WSP(bf16_t, WS_A3), F.out, mods + 3 * 6144 + 5120, SSQ + 3 * ML, (unsigned*)(F.ws + WS_CTL) + CW_PCNT, F.in[I_FG], (unsigned)(uintptr_t)(F.lds + 132096)};
        pg8::gemm_phase<pg8::EpiFinal, pg8::Order, true, true>(F.lds, g, S, E);
    } }
#undef IN
#undef SEAM
#undef SEAMP
}

extern "C" void kernel_launch(void* const* d_in, const int* in_sizes, int n_in, void* d_out, int out_size, void* d_ws, size_t ws_size, hipStream_t stream) {
    static int grid = 0;
    if (grid == 0) {
        if (n_in != N_IN || in_sizes[0] != ML * D || out_size != ML * D || ws_size < WS_END) { fprintf(stderr, "kernel_launch: unexpected shapes (n_in %d, in0 %d, out %d, ws %zu)\n", n_in, n_in > 0 ? in_sizes[0] : -1, out_size, ws_size); grid = -1; return; }
        int dev = 0, cus = 0;
        if (hipGetDevice(&dev) != hipSuccess || hipDeviceGetAttribute(&cus, hipDeviceAttributeMultiprocessorCount, dev) != hipSuccess) { grid = -1; return; }
        if (hipFuncSetAttribute((const void*)dit_fwd, hipFuncAttributeMaxDynamicSharedMemorySize, LDS_BYTES) != hipSuccess) { fprintf(stderr, "kernel_launch: hipFuncSetAttribute failed\n"); grid = -1; return; }
        int per_cu = 0;
        if (hipOccupancyMaxActiveBlocksPerMultiprocessor(&per_cu, (const void*)dit_fwd, 512, LDS_BYTES) != hipSuccess || per_cu < 1) fprintf(stderr, "kernel_launch: note: occupancy query reports %d\n", per_cu);
        (void)hipGetLastError();
        grid = cus;
    }
    if (grid < 0) return;
    if (hipMemsetAsync((char*)d_ws + WS_CTL, 0, CTL_ZERO_BYTES, stream) != hipSuccess) { fprintf(stderr, "kernel_launch: memset failed\n"); return; }
    Args a{};
    for (int i = 0; i < N_IN; ++i) a.in[i] = (const float*)d_in[i];
    a.out = (float*)d_out; a.ws = (unsigned char*)d_ws;
    constexpr int NPH = 14;
#if MK_PER_PHASE
    for (int p = 0; p < NPH; ++p) { a.ph_lo = p; a.ph_hi = p + 1; hipLaunchKernelGGL(dit_fwd, dim3(grid), dim3(512), LDS_BYTES, stream, a); }
#else
    a.ph_lo = 0; a.ph_hi = NPH;
    hipLaunchKernelGGL(dit_fwd, dim3(grid), dim3(512), LDS_BYTES, stream, a);
#endif
    const hipError_t le = hipPeekAtLastError();
    if (le != hipSuccess) fprintf(stderr, "kernel_launch: launch failed: %s\n", hipGetErrorName(le));
}
```

```cpp
#include <hip/hip_runtime.h>
#include <cstdio>
#include <cstdint>
#include <type_traits>

#ifndef PROBE_REP_MASK
#define PROBE_REP_MASK 0
#endif
#ifndef MK_PER_PHASE
#define MK_PER_PHASE 0
#endif

#define GAS __attribute__((address_space(1)))
#define LAS __attribute__((address_space(3)))
typedef unsigned short bf16_t;
typedef short bf16x8 __attribute__((ext_vector_type(8)));
typedef short s16x4 __attribute__((ext_vector_type(4)));
typedef float f32x4 __attribute__((ext_vector_type(4)));
typedef float f32x2 __attribute__((ext_vector_type(2)));
typedef float f32x16 __attribute__((ext_vector_type(16)));
typedef unsigned u32x4 __attribute__((ext_vector_type(4)));
typedef unsigned u32x2 __attribute__((ext_vector_type(2)));

constexpr int D = 1024, NB = 2, SEQ = 16384, ML = NB * SEQ, NCTX = 256, MC = NB * NCTX, MT = ML + MC;
constexpr int NIN0 = 2560, FF = 2816, NGU = 2 * FF, NIN1 = 3072;
constexpr int NCHUNK = 128, CHUNK = SEQ / NCHUNK  , NCI = NCHUNK + 2;
constexpr float EPS = 1e-6f;
constexpr float LOG2E = 1.4426950408889634f;
constexpr float QSCALE = 0.125f * LOG2E;
enum { I_X = 0, I_C, I_CTX, I_CCTX, I_MODW, I_MODB, I_N1G, I_N2G, I_WGU, I_WDN, I_EWIN, I_EWOUT, I_ECW, I_ECB, I_LWR, I_LBR, I_LWI, I_LBI, I_LAM, I_RPB, I_OWIN, I_OCW, I_OWOUT, I_FG, N_IN };

constexpr size_t MiB = 1u << 20;
constexpr size_t WS_CTL = 0, CTL_ZERO_BYTES = 1 * MiB + 160 * 1024;
constexpr size_t WS_SSQ = 256 * 1024;
constexpr size_t WS_B_IN0 = 768 * 1024;
constexpr size_t WS_B_GU0 = WS_B_IN0 + 3 * 2560 * 4;
constexpr size_t WS_B_IN1 = WS_B_GU0 + 2 * 5632 * 4;
constexpr size_t WS_B_GU1 = WS_B_IN1 + 2 * 3072 * 4;
static_assert(WS_B_GU1 + 2 * 5632 * 4 <= 1024 * 1024, "zeroed region");
constexpr size_t WS_MODS = 1 * MiB;
constexpr size_t WS_SS0 = WS_MODS + 160 * 1024;
constexpr size_t WS_BP_IN0 = WS_SS0 + 136 * 1024;
constexpr size_t WS_BP_GU0 = WS_BP_IN0 + 128 * 1024;
constexpr size_t WS_BP_IN1 = WS_BP_GU0 + 192 * 1024;
constexpr size_t WS_BP_GU1 = WS_BP_IN1 + 128 * 1024;
static_assert(WS_BP_GU1 + 192 * 1024 <= 4 * MiB, "small map");
constexpr size_t WS_TOT = 4 * MiB;
constexpr size_t WS_TOTG = 6 * MiB;
constexpr size_t WS_TOTC = 6 * MiB + 256 * 1024;
constexpr size_t WS_LRUW = 6 * MiB + 512 * 1024;
constexpr size_t WS_WIN0 = 8 * MiB;
constexpr size_t WS_WOUT0 = 23 * MiB;
constexpr size_t WS_WGU0 = 25 * MiB;
constexpr size_t WS_WDN0 = 47 * MiB;
constexpr size_t WS_WIN1 = 53 * MiB;
constexpr size_t WS_WOUT1 = 65 * MiB;
constexpr size_t WS_WGU1 = 67 * MiB;
constexpr size_t WS_WDN1 = 89 * MiB;
constexpr size_t WS_A1 = 96 * MiB;
constexpr size_t WS_A2 = 161 * MiB;
constexpr size_t WS_A3 = 225 * MiB;
constexpr size_t WS_BIG = 289 * MiB;
constexpr size_t WS_XCONV = 465 * MiB;
constexpr size_t WS_END = 498 * MiB;

constexpr int CW_BAR = 4096;
constexpr int CW_MODS = 3968;
constexpr int CW_LRUG = 16384 + 8192;
constexpr int CW_PCNT = 16384;

constexpr int RING_BYTES = 131072, LDS_BYTES = 163840, LDSCTL_OFF = LDS_BYTES - 1024, MISC_OFF = LDSCTL_OFF + 320;

#define LDS_WAIT() asm volatile("s_waitcnt lgkmcnt(0)" ::: "memory")
#define VM_WAIT() asm volatile("s_waitcnt vmcnt(0)" ::: "memory")
#define RLX_AGENT __ATOMIC_RELAXED, __HIP_MEMORY_SCOPE_AGENT
__device__ __forceinline__ unsigned pk2(float lo, float hi) { unsigned r; asm("v_cvt_pk_bf16_f32 %0, %1, %2" : "=v"(r) : "v"(lo), "v"(hi)); return r; }
__device__ __forceinline__ unsigned f2bf(float f) { return pk2(f, f) & 0xffffu; }
__device__ __forceinline__ float bflo(unsigned u) { return __builtin_bit_cast(float, u << 16); }
__device__ __forceinline__ float bfhi(unsigned u) { return __builtin_bit_cast(float, u & 0xffff0000u); }
__device__ __forceinline__ float bf1(bf16_t h) { return __builtin_bit_cast(float, (unsigned)h << 16); }
__device__ __forceinline__ float wave_sum(float v) {
#pragma unroll
    for (int o = 1; o < 64; o <<= 1) v += __shfl_xor(v, o);
    return v;
}
__device__ __forceinline__ float fast_rsq(float x) { return __builtin_amdgcn_rsqf(x); }
__device__ __forceinline__ float fast_exp2(float x) { return __builtin_amdgcn_exp2f(x); }
__device__ __forceinline__ float fast_rcp(float x) { return __builtin_amdgcn_rcpf(x); }
__device__ __forceinline__ float sigmoidf_(float x) { return fast_rcp(1.f + fast_exp2(-x * LOG2E)); }
__device__ __forceinline__ float siluf_(float x) { return x * sigmoidf_(x); }
__device__ __forceinline__ float gelu_tanh(float x) {
    constexpr float C1 = -2.f * 0.7978845608028654f * LOG2E, C2 = C1 * 0.044715f;
    const float t = x * (C1 + C2 * (x * x));
    return x * fast_rcp(1.f + fast_exp2(t));
}

__device__ __forceinline__ float sum_fq(float q) {
    const auto a = __builtin_amdgcn_permlane32_swap(__float_as_uint(q), __float_as_uint(q), false, false);
    const float s = __uint_as_float(a[0]) + __uint_as_float(a[1]);
    const auto b = __builtin_amdgcn_permlane16_swap(__float_as_uint(s), __float_as_uint(s), false, false);
    return __uint_as_float(b[0]) + __uint_as_float(b[1]);
}
__device__ __forceinline__ void st8_wt(void* p, f32x2 v) { asm volatile("global_store_dwordx2 %0, %1, off sc1\n\ts_nop 1" :: "v"(p), "v"(v) : "memory"); }
__device__ __forceinline__ f32x2 ld8_sc1(const f32x2* p) { const unsigned long long u = __hip_atomic_load((const unsigned long long*)p, __ATOMIC_RELAXED, __HIP_MEMORY_SCOPE_AGENT); return __builtin_bit_cast(f32x2, u); }
__device__ __forceinline__ void st16_wt(void* p, u32x4 v) { asm volatile("global_store_dwordx4 %0, %1, off sc1\n\ts_nop 1" :: "v"(p), "v"(v) : "memory"); }
namespace pg8 {
constexpr int BM = 256, BK = 64, HALF = 128, HTB = HALF * BK * 2, STAGE_BYTES = 8 * HTB, NXCD = 8, WGM = 8;
__host__ __device__ __forceinline__ int lds_byte(int r, int c) { const int st = (r >> 4) * 2 + (c >> 5), rr = r & 15, cc = c & 31, ob = rr * 64 + cc * 2; return st * 1024 + (ob ^ (((ob >> 9) & 1) << 5)); }
__host__ __device__ __forceinline__ void stage_rc(int b, int& R, int& C) { const int st = b / 1024, sb = b % 1024, swz = sb ^ (((sb >> 9) & 1) << 5); R = (st >> 1) * 16 + swz / 64; C = (st & 1) * 32 + (swz % 64) / 2; }
__host__ __device__ __forceinline__ int perm32(int rho) { const int n = rho >> 4, i = rho & 15; return 8 * (i >> 2) + 4 * n + (i & 3); }

struct Unit { int pm, pn; bool last; };
#define PG8_ST16(u_, ptr, w) do { if ((u_).last) st16_wt((ptr), (w)); else *(u32x4*)(ptr) = (w); } while (0)
struct Gemm { const bf16_t* A; const bf16_t* Bt; long boff1, boff2; int K; };
__device__ __forceinline__ const char* bsel(const bf16_t* Bt, long boff1, long boff2, const Unit& u) { const long o = u.pm < 64 ? 0l : (u.pm < 128 ? boff1 : boff2); return (const char*)(Bt + o); }

struct Order {
    int nM, nN, nwg, G, c, nextra, xpm0, xpn0, xnpn, pn_off = 0;
    __device__ void init(int nM_, int nN_, int G_, int c_, int nextra_ = 0, int xpm0_ = 0, int xpn0_ = 0, int xnpn_ = 1) { nM = nM_; nN = nN_; nwg = nM * nN; G = G_; c = c_; nextra = nextra_; xpm0 = xpm0_; xpn0 = xpn0_; xnpn = xnpn_; }
    __device__ bool next(int i, Unit& u) const {
        const long L = (long)i * G + c;
        if (L >= nwg) { const int e = (int)(L - nwg); if (e >= nextra) return false; u.pm = xpm0 + e / xnpn; u.pn = xpn0 + e % xnpn; return true; }
        int wgid = (int)L; { const int q = nwg / NXCD, r = nwg % NXCD, xcd = wgid % NXCD, off = wgid / NXCD; wgid = (xcd < r ? xcd * (q + 1) : r * (q + 1) + (xcd - r) * q) + off; }
        const int nig = WGM * nN, gid = wgid / nig, fm = gid * WGM, gsz = (nM - fm) < WGM ? (nM - fm) : WGM;
        u.pm = fm + ((wgid % nig) % gsz); u.pn = (wgid % nig) / gsz + pn_off; return true;
    }
};

__device__ __forceinline__ unsigned cvt_pk_bf16(float lo, float hi) { return pk2(lo, hi); }


struct EpiPre { f32x4 bv[2][2]; float ssr[2][4]; };
struct EpiInProj {
    static constexpr bool PERM = true; static constexpr bool IDEMP = true;
    typedef EpiPre Pre;
    bf16_t* O; const float* ss; const float* bias;
    __device__ __forceinline__ void prefetch(const Unit& u, int wr, int wc, int fr, int fq, Pre& p) const {
        const int row0 = u.pm * BM + wr * 64 + fr, col0 = u.pn * BM + wc * 32 + 8 * fq;
        const int v = u.pm < 64 ? 0 : (u.pm < 128 ? 1 : 2);
        const float* bp = bias + (size_t)v * NIN0 + col0;
#pragma unroll
        for (int bj = 0; bj < 2; ++bj)
#pragma unroll
            for (int n = 0; n < 2; ++n) p.bv[bj][n] = *(const f32x4*)(bp + bj * HALF + 4 * n);
#pragma unroll
        for (int ai = 0; ai < 2; ++ai)
#pragma unroll
            for (int m = 0; m < 4; ++m) p.ssr[ai][m] = ss[row0 + ai * HALF + m * 16];
    }
    __device__ __forceinline__ void operator()(const f32x4 (&acc)[2][2][4][2], const Unit& u, const Pre& p, int wr, int wc, int fr, int fq) const {
        const int row0 = u.pm * BM + wr * 64 + fr, col0 = u.pn * BM + wc * 32 + 8 * fq;
#pragma unroll
        for (int ai = 0; ai < 2; ++ai)
#pragma unroll
            for (int m = 0; m < 4; ++m) { const int row = row0 + ai * HALF + m * 16; const float rs = fast_rsq(p.ssr[ai][m] * (1.f / D) + EPS); bf16_t* rowp = O + (size_t)row * NIN0 + col0;
#pragma unroll
                for (int bj = 0; bj < 2; ++bj) { const f32x4 v0 = acc[ai][bj][m][0] * rs + p.bv[bj][0], v1 = acc[ai][bj][m][1] * rs + p.bv[bj][1];
                    u32x4 w; w.x = cvt_pk_bf16(v0[0], v0[1]); w.y = cvt_pk_bf16(v0[2], v0[3]); w.z = cvt_pk_bf16(v1[0], v1[1]); w.w = cvt_pk_bf16(v1[2], v1[3]);
                    PG8_ST16(u, rowp + bj * HALF, w); } }
    }
};

__device__ __forceinline__ void tile_row_ssq(const float (&qv)[2][4], unsigned Paddr, float* ssq_panel, int wr, int wc, int fr, int fq) {
    if (fq == 0) {
#pragma unroll
        for (int ai = 0; ai < 2; ++ai)
#pragma unroll
            for (int m = 0; m < 4; ++m) { const unsigned a_ = Paddr + (unsigned)(((ai * HALF + wr * 64 + m * 16 + fr) * 4 + wc) * 4); asm volatile("ds_write_b32 %0, %1" :: "v"(a_), "v"(qv[ai][m]) : "memory"); }
    }
    asm volatile("s_waitcnt lgkmcnt(0)" ::: "memory"); __builtin_amdgcn_s_barrier(); asm volatile("" ::: "memory");
    if (threadIdx.x < 256) { f32x4 v; const unsigned a_ = Paddr + threadIdx.x * 16u;
        asm volatile("ds_read_b128 %0, %1\n\ts_waitcnt lgkmcnt(0)" : "=v"(v) : "v"(a_) : "memory");
        unsafeAtomicAdd(ssq_panel + threadIdx.x, (v[0] + v[1]) + (v[2] + v[3])); }
}
struct EpiPreG { f32x4 gv[2][2]; };
template <bool RES_F32, bool OUT_F32> struct EpiRes {
    static constexpr bool PERM = true; static constexpr bool IDEMP = false;
    typedef EpiPreG Pre;
    const float* resf; const bf16_t* resb; bf16_t* Ob; float* Of; const float* gate; float* ssq; unsigned Paddr;
    __device__ __forceinline__ void prefetch(const Unit& u, int wr, int wc, int fr, int fq, Pre& p) const {
        const float* gp = gate + (size_t)(u.pm >> 6) * 6144 + u.pn * BM + wc * 32 + 8 * fq;
#pragma unroll
        for (int bj = 0; bj < 2; ++bj)
#pragma unroll
            for (int n = 0; n < 2; ++n) p.gv[bj][n] = *(const f32x4*)(gp + bj * HALF + 4 * n);
    }
    __device__ __forceinline__ void operator()(const f32x4 (&acc)[2][2][4][2], const Unit& u, const Pre& p, int wr, int wc, int fr, int fq) const {
        const int row0 = u.pm * BM + wr * 64 + fr, col0 = u.pn * BM + wc * 32 + 8 * fq;
        float qv[2][4];
#pragma unroll
        for (int ai = 0; ai < 2; ++ai) {
            f32x4 rf[RES_F32 ? 4 : 1][2][2]; u32x4 rb[1][RES_F32 ? 1 : 4][2];
#pragma unroll
            for (int m = 0; m < 4; ++m) { const size_t off = (size_t)(row0 + ai * HALF + m * 16) * D + col0;
#pragma unroll
                for (int bj = 0; bj < 2; ++bj) {
                    if constexpr (RES_F32) { rf[m][bj][0] = *(const f32x4*)(resf + off + bj * HALF); rf[m][bj][1] = *(const f32x4*)(resf + off + bj * HALF + 4); }
                    else rb[0][m][bj] = *(const u32x4*)(resb + off + bj * HALF); } }
#pragma unroll
            for (int m = 0; m < 4; ++m) { const int row = row0 + ai * HALF + m * 16; const size_t off = (size_t)row * D + col0; float q = 0.f;
#pragma unroll
                for (int bj = 0; bj < 2; ++bj) {
                    f32x4 r0, r1;
                    if constexpr (RES_F32) { r0 = rf[m][bj][0]; r1 = rf[m][bj][1]; }
                    else { const u32x4 t = rb[0][m][bj]; r0 = (f32x4){bflo(t.x), bfhi(t.x), bflo(t.y), bfhi(t.y)}; r1 = (f32x4){bflo(t.z), bfhi(t.z), bflo(t.w), bfhi(t.w)}; }
                    const f32x4 v0 = r0 + p.gv[bj][0] * acc[ai][bj][m][0], v1 = r1 + p.gv[bj][1] * acc[ai][bj][m][1];
                    q += (v0[0] * v0[0] + v0[1] * v0[1]) + (v0[2] * v0[2] + v0[3] * v0[3]) + (v1[0] * v1[0] + v1[1] * v1[1]) + (v1[2] * v1[2] + v1[3] * v1[3]);
                    if constexpr (OUT_F32) { *(f32x4*)(Of + off + bj * HALF) = v0; *(f32x4*)(Of + off + bj * HALF + 4) = v1; }
                    else { u32x4 w; w.x = cvt_pk_bf16(v0[0], v0[1]); w.y = cvt_pk_bf16(v0[2], v0[3]); w.z = cvt_pk_bf16(v1[0], v1[1]); w.w = cvt_pk_bf16(v1[2], v1[3]); PG8_ST16(u, Ob + off + bj * HALF, w); }
                }
                q = sum_fq(q);
                qv[ai][m] = q; }
        }
        tile_row_ssq(qv, Paddr, ssq + u.pm * BM, wr, wc, fr, fq);
    }
};

struct EpiFinal {
    static constexpr bool PERM = true; static constexpr bool IDEMP = false;
    typedef EpiPreG Pre;
    const bf16_t* resb; float* Of; const float* gate; float* ssq; unsigned* pcnt; const float* fg; unsigned Paddr;
    __device__ __forceinline__ void prefetch(const Unit& u, int wr, int wc, int fr, int fq, Pre& p) const {
        const float* gp = gate + (size_t)(u.pm >> 6) * 6144 + u.pn * BM + wc * 32 + 8 * fq;
#pragma unroll
        for (int bj = 0; bj < 2; ++bj)
#pragma unroll
            for (int n = 0; n < 2; ++n) p.gv[bj][n] = *(const f32x4*)(gp + bj * HALF + 4 * n);
    }
    __device__ __forceinline__ void operator()(f32x4 (&acc)[2][2][4][2], const Unit& u, const Pre& p, int wr, int wc, int fr, int fq) const {
        const int row0 = u.pm * BM + wr * 64 + fr, col0 = u.pn * BM + wc * 32 + 8 * fq;
        float qv[2][4];
#pragma unroll
        for (int ai = 0; ai < 2; ++ai) {
            u32x4 rb[4][2];
#pragma unroll
            for (int m = 0; m < 4; ++m) { const size_t off = (size_t)(row0 + ai * HALF + m * 16) * D + col0;
#pragma unroll
                for (int bj = 0; bj < 2; ++bj) rb[m][bj] = *(const u32x4*)(resb + off + bj * HALF); }
#pragma unroll
            for (int m = 0; m < 4; ++m) { const int row = row0 + ai * HALF + m * 16; float q = 0.f;
#pragma unroll
                for (int bj = 0; bj < 2; ++bj) {
                    const u32x4 t = rb[m][bj]; const f32x4 r0 = (f32x4){bflo(t.x), bfhi(t.x), bflo(t.y), bfhi(t.y)}, r1 = (f32x4){bflo(t.z), bfhi(t.z), bflo(t.w), bfhi(t.w)};
                    const f32x4 v0 = r0 + p.gv[bj][0] * acc[ai][bj][m][0], v1 = r1 + p.gv[bj][1] * acc[ai][bj][m][1];
                    q += (v0[0] * v0[0] + v0[1] * v0[1]) + (v0[2] * v0[2] + v0[3] * v0[3]) + (v1[0] * v1[0] + v1[1] * v1[1]) + (v1[2] * v1[2] + v1[3] * v1[3]);
                    acc[ai][bj][m][0] = v0; acc[ai][bj][m][1] = v1;
                }
                q = sum_fq(q);
                qv[ai][m] = q; }
        }
        tile_row_ssq(qv, Paddr, ssq + u.pm * BM, wr, wc, fr, fq);
        asm volatile("s_waitcnt vmcnt(0)" ::: "memory");
        __syncthreads();
        if (threadIdx.x == 0) {
            unsigned* pc = pcnt + 64 * u.pm;
            (void)__hip_atomic_fetch_add(pc, 1u, __ATOMIC_RELAXED, __HIP_MEMORY_SCOPE_AGENT);
            unsigned sp = 0;
            while (__hip_atomic_load(pc, __ATOMIC_RELAXED, __HIP_MEMORY_SCOPE_AGENT) < 4u) { __builtin_amdgcn_s_sleep(1); if (++sp > (1u << 22)) break; }
        }
        __syncthreads();
        f32x4 fv[2][2];
#pragma unroll
        for (int bj = 0; bj < 2; ++bj)
#pragma unroll
            for (int n = 0; n < 2; ++n) fv[bj][n] = *(const f32x4*)(fg + col0 + bj * HALF + 4 * n);
        float ssv[2][4];
#pragma unroll
        for (int ai = 0; ai < 2; ++ai)
#pragma unroll
            for (int m = 0; m < 4; ++m) ssv[ai][m] = __hip_atomic_load(ssq + row0 + ai * HALF + m * 16, __ATOMIC_RELAXED, __HIP_MEMORY_SCOPE_AGENT);
#pragma unroll
        for (int ai = 0; ai < 2; ++ai)
#pragma unroll
            for (int m = 0; m < 4; ++m) { const float rs = fast_rsq(ssv[ai][m] * (1.f / D) + EPS); const size_t off = (size_t)(row0 + ai * HALF + m * 16) * D + col0;
#pragma unroll
                for (int bj = 0; bj < 2; ++bj) { *(f32x4*)(Of + off + bj * HALF) = acc[ai][bj][m][0] * rs * fv[bj][0]; *(f32x4*)(Of + off + bj * HALF + 4) = acc[ai][bj][m][1] * rs * fv[bj][1]; } }
    }
};

struct EpiSwiGLU {
    static constexpr bool PERM = true; static constexpr bool IDEMP = true;
    typedef EpiPre Pre;
    bf16_t* O; const float* ss; const float* bias;
    __device__ __forceinline__ void prefetch(const Unit& u, int wr, int wc, int fr, int fq, Pre& p) const {
        const int row0 = u.pm * BM + wr * 64 + fr, colw = u.pn * BM + wc * 32 + 8 * fq;
        const float* bp = bias + (size_t)(u.pm >> 6) * NGU + colw;
#pragma unroll
        for (int bj = 0; bj < 2; ++bj)
#pragma unroll
            for (int n = 0; n < 2; ++n) p.bv[bj][n] = *(const f32x4*)(bp + bj * HALF + 4 * n);
#pragma unroll
        for (int ai = 0; ai < 2; ++ai)
#pragma unroll
            for (int m = 0; m < 4; ++m) p.ssr[ai][m] = ss[row0 + ai * HALF + m * 16];
    }
    __device__ __forceinline__ void operator()(const f32x4 (&acc)[2][2][4][2], const Unit& u, const Pre& p, int wr, int wc, int fr, int fq) const {
        const int row0 = u.pm * BM + wr * 64 + fr, colo = u.pn * HALF + wc * 32 + 8 * fq;
        f32x4 bg[2], bu[2];
#pragma unroll
        for (int n = 0; n < 2; ++n) { bg[n] = p.bv[0][n] * LOG2E; bu[n] = p.bv[1][n] * (1.f / LOG2E); }
#pragma unroll
        for (int ai = 0; ai < 2; ++ai)
#pragma unroll
            for (int m = 0; m < 4; ++m) { const int row = row0 + ai * HALF + m * 16; const float rs = fast_rsq(p.ssr[ai][m] * (1.f / D) + EPS), rsg = rs * LOG2E, rsu = rs * (1.f / LOG2E);
                f32x4 h[2];
#pragma unroll
                for (int n = 0; n < 2; ++n) {
                    const f32x4 G = acc[ai][0][m][n], U = acc[ai][1][m][n];
                    const f32x2 g0 = G.lo * rsg + bg[n].lo, g1 = G.hi * rsg + bg[n].hi, u0 = U.lo * rsu + bu[n].lo, u1 = U.hi * rsu + bu[n].hi;
                    f32x2 d0 = (f32x2){fast_exp2(-g0.x), fast_exp2(-g0.y)} + 1.f, d1 = (f32x2){fast_exp2(-g1.x), fast_exp2(-g1.y)} + 1.f;
                    const f32x2 r0 = (f32x2){fast_rcp(d0.x), fast_rcp(d0.y)}, r1 = (f32x2){fast_rcp(d1.x), fast_rcp(d1.y)};
                    const f32x2 h0 = (g0 * u0) * r0, h1 = (g1 * u1) * r1;
                    h[n] = (f32x4){h0.x, h0.y, h1.x, h1.y}; }
                u32x4 w; w.x = cvt_pk_bf16(h[0][0], h[0][1]); w.y = cvt_pk_bf16(h[0][2], h[0][3]); w.z = cvt_pk_bf16(h[1][0], h[1][1]); w.w = cvt_pk_bf16(h[1][2], h[1][3]);
                PG8_ST16(u, O + (size_t)row * FF + colo, w); }
    }
};

struct EpiScIn {
    static constexpr bool PERM = true; static constexpr bool IDEMP = true;
    typedef EpiPre Pre;
    bf16_t* BG; bf16_t* P; const float* ss; const float* bias;
    __device__ __forceinline__ void prefetch(const Unit& u, int wr, int wc, int fr, int fq, Pre& p) const {
        const int row0 = u.pm * BM + wr * 64 + fr, colw = u.pn * BM + wc * 32 + 8 * fq;
        const float* bp = bias + (size_t)(u.pm >> 6) * NIN1 + colw;
#pragma unroll
        for (int bj = 0; bj < 2; ++bj)
#pragma unroll
            for (int n = 0; n < 2; ++n) p.bv[bj][n] = *(const f32x4*)(bp + bj * HALF + 4 * n);
#pragma unroll
        for (int ai = 0; ai < 2; ++ai)
#pragma unroll
            for (int m = 0; m < 4; ++m) p.ssr[ai][m] = ss[row0 + ai * HALF + m * 16];
    }
    __device__ __forceinline__ void operator()(const f32x4 (&acc)[2][2][4][2], const Unit& u, const Pre& p, int wr, int wc, int fr, int fq) const {
        const int row0 = u.pm * BM + wr * 64 + fr, colw = u.pn * BM + wc * 32 + 8 * fq;
        if (u.pn < 4) {
#pragma unroll
            for (int ai = 0; ai < 2; ++ai)
#pragma unroll
                for (int m = 0; m < 4; ++m) { const int row = row0 + ai * HALF + m * 16; const float rs = fast_rsq(p.ssr[ai][m] * (1.f / D) + EPS); bf16_t* rowp = BG + (size_t)row * D + colw;
#pragma unroll
                    for (int bj = 0; bj < 2; ++bj) { const f32x4 v0 = acc[ai][bj][m][0] * rs + p.bv[bj][0], v1 = acc[ai][bj][m][1] * rs + p.bv[bj][1];
                        u32x4 w; w.x = cvt_pk_bf16(v0[0], v0[1]); w.y = cvt_pk_bf16(v0[2], v0[3]); w.z = cvt_pk_bf16(v1[0], v1[1]); w.w = cvt_pk_bf16(v1[2], v1[3]);
                        PG8_ST16(u, rowp + bj * HALF, w); } }
        } else {
            const int colo = (u.pn - 4) * HALF + wc * 32 + 8 * fq;
#pragma unroll
            for (int ai = 0; ai < 2; ++ai)
#pragma unroll
                for (int m = 0; m < 4; ++m) { const int row = row0 + ai * HALF + m * 16; const float rs = fast_rsq(p.ssr[ai][m] * (1.f / D) + EPS);
                    f32x4 h[2];
#pragma unroll
                    for (int n = 0; n < 2; ++n) { const f32x4 cgv = acc[ai][0][m][n] * rs + p.bv[0][n], xv = acc[ai][1][m][n] * rs + p.bv[1][n]; h[n] = cgv * xv; }
                    u32x4 w; w.x = cvt_pk_bf16(h[0][0], h[0][1]); w.y = cvt_pk_bf16(h[0][2], h[0][3]); w.z = cvt_pk_bf16(h[1][0], h[1][1]); w.w = cvt_pk_bf16(h[1][2], h[1][3]);
                    PG8_ST16(u, P + (size_t)row * D + colo, w); }
        }
    }
};
struct EpiScGate {
    static constexpr bool PERM = true; static constexpr bool IDEMP = true;
    typedef EpiPre Pre;
    bf16_t* Y; const bf16_t* P; const float* ss; const float* bias; const float* cw;
    __device__ __forceinline__ void prefetch(const Unit& u, int wr, int wc, int fr, int fq, Pre& p) const {
        const int row0 = u.pm * BM + wr * 64 + fr, colw = u.pn * BM + wc * 32 + 8 * fq;
        const float* bp = bias + (size_t)(u.pm >> 6) * NIN1 + colw;
#pragma unroll
        for (int bj = 0; bj < 2; ++bj)
#pragma unroll
            for (int n = 0; n < 2; ++n) p.bv[bj][n] = *(const f32x4*)(bp + bj * HALF + 4 * n);
#pragma unroll
        for (int ai = 0; ai < 2; ++ai)
#pragma unroll
            for (int m = 0; m < 4; ++m) p.ssr[ai][m] = ss[row0 + ai * HALF + m * 16];
    }
    template <int AI, int BJ, int M0, int MC>
    __device__ __forceinline__ void batch(const f32x4 (&acc)[2][2][4][2], const Unit& u, const Pre& p, const f32x4 (&w)[3][2], int row0, int col, int sbeg, int send) const {
        u32x4 raw[MC][3];
#pragma unroll
        for (int mm = 0; mm < MC; ++mm)
#pragma unroll
            for (int j = 0; j < 3; ++j) { const int rr = row0 + AI * HALF + (M0 + mm) * 16 + j - 1;
                raw[mm][j] = (rr >= sbeg && rr < send) ? *(const u32x4*)(P + (size_t)rr * D + col) : (u32x4){0u, 0u, 0u, 0u}; }
        asm volatile("" ::: "memory"); __builtin_amdgcn_sched_barrier(0);
#pragma unroll
        for (int mm = 0; mm < MC; ++mm) { constexpr int dummy = 0; (void)dummy; const int m = M0 + mm; const int row = row0 + AI * HALF + m * 16; const float rs = fast_rsq(p.ssr[AI][m] * (1.f / D) + EPS);
            const f32x4 v0 = acc[AI][BJ][m][0] * rs + p.bv[BJ][0], v1 = acc[AI][BJ][m][1] * rs + p.bv[BJ][1];
            f32x4 c0 = (f32x4){0.f, 0.f, 0.f, 0.f}, c1 = c0;
#pragma unroll
            for (int j = 0; j < 3; ++j) { const u32x4 r = raw[mm][j];
                c0 += w[j][0] * (f32x4){bflo(r.x), bfhi(r.x), bflo(r.y), bfhi(r.y)}; c1 += w[j][1] * (f32x4){bflo(r.z), bfhi(r.z), bflo(r.w), bfhi(r.w)}; }
            const f32x4 y0 = v0 * c0, y1 = v1 * c1;
            u32x4 o; o.x = cvt_pk_bf16(y0[0], y0[1]); o.y = cvt_pk_bf16(y0[2], y0[3]); o.z = cvt_pk_bf16(y1[0], y1[1]); o.w = cvt_pk_bf16(y1[2], y1[3]);
            PG8_ST16(u, Y + (size_t)row * D + col, o); }
        asm volatile("" ::: "memory"); __builtin_amdgcn_sched_barrier(0);
    }
    __device__ __forceinline__ void operator()(const f32x4 (&acc)[2][2][4][2], const Unit& u, const Pre& p, int wr, int wc, int fr, int fq) const {
        const int row0 = u.pm * BM + wr * 64 + fr, colw = u.pn * BM + wc * 32 + 8 * fq;
        const int sbeg = (u.pm * BM / SEQ) * SEQ, send = sbeg + SEQ;
        { const int col = colw; f32x4 w[3][2];
#pragma unroll
          for (int j = 0; j < 3; ++j) { w[j][0] = *(const f32x4*)(cw + j * D + col); w[j][1] = *(const f32x4*)(cw + j * D + col + 4); }
          batch<0, 0, 0, 2>(acc, u, p, w, row0, col, sbeg, send); batch<0, 0, 2, 2>(acc, u, p, w, row0, col, sbeg, send);
          batch<1, 0, 0, 2>(acc, u, p, w, row0, col, sbeg, send); batch<1, 0, 2, 2>(acc, u, p, w, row0, col, sbeg, send); }
        { const int col = colw + HALF; f32x4 w[3][2];
#pragma unroll
          for (int j = 0; j < 3; ++j) { w[j][0] = *(const f32x4*)(cw + j * D + col); w[j][1] = *(const f32x4*)(cw + j * D + col + 4); }
          batch<0, 1, 0, 4>(acc, u, p, w, row0, col, sbeg, send); batch<1, 1, 0, 4>(acc, u, p, w, row0, col, sbeg, send); }
    }
};

template <class Epi, class Sched, bool ALIGN_EPI = false, bool SP2 = false>
__device__ __forceinline__ void gemm_phase(LAS unsigned char* lds, const Gemm g, const Sched& S, const Epi& E) {
    const int tid = threadIdx.x, wid = __builtin_amdgcn_readfirstlane(tid >> 6), lane = tid & 63, wr = wid >> 2, wc = wid & 3, fr = lane & 15, fq = lane >> 4;
    const int K = g.K, nt = K / BK;
    unsigned voffA[2], voffB[2];
#pragma unroll
    for (int i = 0; i < 2; ++i) { const int b_ = tid * 16 + i * 8192; const int R = b_ >> 7, C = 8 * (((b_ >> 4) & 7) ^ ((R >> 1) & 7)); const int Rb = Epi::PERM ? ((R & ~31) + perm32(R & 31)) : R;
        voffA[i] = (unsigned)(R * K + C) * 2u; voffB[i] = (unsigned)(Rb * K + C) * 2u; }
    const size_t kstep = (size_t)(BK * 2);
    const size_t hstep = (size_t)HALF * K * 2;
    const size_t tstep = 2 * hstep;
    const unsigned ldsw = (unsigned)wid * 1024u;
    int aoffk[2], boffk[2];
#pragma unroll
    for (int k = 0; k < 2; ++k) { const int sw = ((4 * k + fq) ^ ((fr >> 1) & 7)) << 4; aoffk[k] = (wr * 64 + fr) * 128 + sw; boffk[k] = (wc * 32 + fr) * 128 + sw; }
#define PG8_SA(b, h) (((b) * 2 + (h)) * HTB)
#define PG8_SB(b, h) ((4 + (b) * 2 + (h)) * HTB)
#define PG8_STAGE(bufoff, gbase, voff) do { _Pragma("unroll") for (int _i = 0; _i < 2; ++_i) \
        __builtin_amdgcn_global_load_lds((const unsigned*)((const char*)(gbase) + (voff)[_i]), (LAS unsigned*)(lds + (bufoff) + ldsw + _i * 8192), 16, 0, 0); } while (0)
#define PG8_LDA(dst, b, h) do { _Pragma("unroll") for (int m = 0; m < 4; ++m) _Pragma("unroll") for (int k = 0; k < 2; ++k) dst[m][k] = *(const LAS bf16x8*)(lds + PG8_SA(b, h) + aoffk[k] + m * 2048); } while (0)
#define PG8_LDB(dst, b, h) do { _Pragma("unroll") for (int n = 0; n < 2; ++n) _Pragma("unroll") for (int k = 0; k < 2; ++k) dst[n][k] = *(const LAS bf16x8*)(lds + PG8_SB(b, h) + boffk[k] + n * 2048); } while (0)
#define PG8_MMA(ai, bj, At, Bt) do { __builtin_amdgcn_s_setprio(1); _Pragma("unroll") for (int m = 0; m < 4; ++m) _Pragma("unroll") for (int n = 0; n < 2; ++n) _Pragma("unroll") for (int k = 0; k < 2; ++k) \
        acc[ai][bj][m][n] = __builtin_amdgcn_mfma_f32_16x16x32_bf16(Bt[n][k], At[m][k], acc[ai][bj][m][n], 0, 0, 0); __builtin_amdgcn_s_setprio(0); } while (0)
#define PG8_WAIT_V(n) asm volatile("s_waitcnt vmcnt(" #n ")" ::: "memory")
#define PG8_WAIT_L(n) asm volatile("s_waitcnt lgkmcnt(" #n ")" ::: "memory")
#define PG8_BAR __builtin_amdgcn_s_barrier()
#define PG8_SCHED __builtin_amdgcn_sched_barrier(0)
    Unit cur, nxt; int ui = 0;
    if (!S.next(0, cur)) return;
    f32x4 acc[2][2][4][2];
#pragma unroll
    for (int a = 0; a < 2; ++a)
#pragma unroll
        for (int b = 0; b < 2; ++b)
#pragma unroll
            for (int m = 0; m < 4; ++m)
#pragma unroll
                for (int n = 0; n < 2; ++n) acc[a][b][m][n] = (f32x4){0.f, 0.f, 0.f, 0.f};
    bf16x8 At[4][2], B0[2][2], B1[2][2];
    typename Epi::Pre pre; E.prefetch(cur, wr, wc, fr, fq, pre);
    const char* cA = (const char*)g.A + (size_t)cur.pm * tstep; const bf16_t* gBt = g.Bt; const long gb1 = g.boff1, gb2 = g.boff2;
    const char* cB = bsel(gBt, gb1, gb2, cur) + (size_t)cur.pn * tstep;
    if constexpr (SP2) {
        PG8_STAGE(PG8_SB(0, 0), cB, voffB); PG8_STAGE(PG8_SB(0, 1), cB + hstep, voffB); PG8_STAGE(PG8_SA(0, 0), cA, voffA); PG8_STAGE(PG8_SA(0, 1), cA + hstep, voffA);
        if (wr == 1) PG8_BAR;
        PG8_WAIT_V(2); PG8_BAR;
        PG8_STAGE(PG8_SB(1, 0), cB + kstep, voffB); PG8_STAGE(PG8_SA(1, 0), cA + kstep, voffA); PG8_STAGE(PG8_SB(1, 1), cB + hstep + kstep, voffB);
        PG8_WAIT_V(6); PG8_BAR;
    } else {
        PG8_STAGE(PG8_SB(0, 0), cB, voffB); PG8_STAGE(PG8_SA(0, 0), cA, voffA); PG8_STAGE(PG8_SB(0, 1), cB + hstep, voffB); PG8_STAGE(PG8_SA(0, 1), cA + hstep, voffA);
        if (wr == 1) PG8_BAR;
        PG8_WAIT_V(4); PG8_BAR;
        PG8_STAGE(PG8_SB(1, 0), cB + kstep, voffB); PG8_STAGE(PG8_SA(1, 0), cA + kstep, voffA); PG8_STAGE(PG8_SB(1, 1), cB + hstep + kstep, voffB);
        PG8_WAIT_V(6); PG8_BAR;
    }
    for (;;) {
        const bool has_next = S.next(ui + 1, nxt);
        cur.last = !has_next;
        const char* nA = has_next ? (const char*)g.A + (size_t)nxt.pm * tstep : cA; const char* nB = has_next ? bsel(gBt, gb1, gb2, nxt) + (size_t)nxt.pn * tstep : cB;
        for (int t = 0; t < nt; t += 2) {
            const bool last = (t == nt - 2);
            const char* a1 = cA + (size_t)(t + 1) * kstep;
            const char* a2 = last ? nA : cA + (size_t)(t + 2) * kstep; const char* b2 = last ? nB : cB + (size_t)(t + 2) * kstep;
            const char* a3 = a2 + kstep; const char* b3 = b2 + kstep;
            if constexpr (SP2) {
            PG8_LDB(B0, 0, 0); PG8_LDB(B1, 0, 1); PG8_SCHED; PG8_LDA(At, 0, 0); PG8_STAGE(PG8_SA(1, 1), a1 + hstep, voffA);
            PG8_WAIT_V(8); PG8_WAIT_L(0); PG8_BAR; PG8_MMA(0, 0, At, B0); PG8_MMA(0, 1, At, B1); PG8_BAR; PG8_SCHED;
            PG8_LDA(At, 0, 1); PG8_STAGE(PG8_SB(0, 0), b2, voffB); PG8_STAGE(PG8_SB(0, 1), b2 + hstep, voffB); PG8_STAGE(PG8_SA(0, 0), a2, voffA);
            PG8_WAIT_V(8); PG8_WAIT_L(0); PG8_BAR; PG8_MMA(1, 0, At, B0); PG8_MMA(1, 1, At, B1); PG8_BAR; PG8_SCHED;
            PG8_LDB(B0, 1, 0); PG8_LDB(B1, 1, 1); PG8_SCHED; PG8_LDA(At, 1, 0); PG8_STAGE(PG8_SA(0, 1), a2 + hstep, voffA);
            PG8_WAIT_V(8); PG8_WAIT_L(0); PG8_BAR; PG8_MMA(0, 0, At, B0); PG8_MMA(0, 1, At, B1); PG8_BAR; PG8_SCHED;
            PG8_LDA(At, 1, 1); PG8_STAGE(PG8_SB(1, 0), b3, voffB); PG8_STAGE(PG8_SB(1, 1), b3 + hstep, voffB); PG8_STAGE(PG8_SA(1, 0), a3, voffA);
            PG8_WAIT_V(8); PG8_WAIT_L(0); PG8_BAR; PG8_MMA(1, 0, At, B0); PG8_MMA(1, 1, At, B1); PG8_BAR; PG8_SCHED;
            } else {
            PG8_LDB(B0, 0, 0); PG8_SCHED; PG8_LDA(At, 0, 0); PG8_STAGE(PG8_SA(1, 1), a1 + hstep, voffA);
            PG8_WAIT_L(8); PG8_BAR; PG8_WAIT_L(0); PG8_MMA(0, 0, At, B0); PG8_BAR; PG8_SCHED;
            PG8_LDB(B1, 0, 1); PG8_STAGE(PG8_SB(0, 0), b2, voffB);
            PG8_BAR; PG8_WAIT_L(0); PG8_MMA(0, 1, At, B1); PG8_BAR;
            PG8_LDA(At, 0, 1); PG8_STAGE(PG8_SA(0, 0), a2, voffA);
            PG8_BAR; PG8_WAIT_L(0); PG8_MMA(1, 0, At, B0); PG8_BAR; PG8_SCHED;
            PG8_STAGE(PG8_SB(0, 1), b2 + hstep, voffB);
            PG8_WAIT_V(6); PG8_BAR; PG8_MMA(1, 1, At, B1); PG8_BAR;
            PG8_LDB(B0, 1, 0); PG8_SCHED; PG8_LDA(At, 1, 0); PG8_STAGE(PG8_SA(0, 1), a2 + hstep, voffA);
            PG8_WAIT_L(8); PG8_BAR; PG8_WAIT_L(0); PG8_MMA(0, 0, At, B0); PG8_BAR; PG8_SCHED;
            PG8_LDB(B1, 1, 1); PG8_STAGE(PG8_SB(1, 0), b3, voffB);
            PG8_BAR; PG8_WAIT_L(0); PG8_MMA(0, 1, At, B1); PG8_BAR;
            PG8_LDA(At, 1, 1); PG8_STAGE(PG8_SA(1, 0), a3, voffA);
            PG8_BAR; PG8_WAIT_L(0); PG8_MMA(1, 0, At, B0); PG8_BAR; PG8_SCHED;
            PG8_STAGE(PG8_SB(1, 1), b3 + hstep, voffB);
            PG8_WAIT_V(6); PG8_BAR; PG8_MMA(1, 1, At, B1); PG8_BAR;
            }
        }
        if constexpr (ALIGN_EPI) { if (wr == 0) PG8_BAR; }
        E(acc, cur, pre, wr, wc, fr, fq);
#ifdef PROBE_EPI2
        if constexpr (Epi::IDEMP) { asm volatile("" ::: "memory"); E(acc, cur, pre, wr, wc, fr, fq); }
#endif
        if (!has_next) break;
        E.prefetch(nxt, wr, wc, fr, fq, pre);
        { bf16x8 zz;
#pragma unroll
          for (int j = 0; j < 8; ++j) zz[j] = 0;
          asm volatile("s_nop 3" : "+v"(zz));
#pragma unroll
          for (int b = 0; b < 2; ++b)
#pragma unroll
              for (int m = 0; m < 4; ++m)
#pragma unroll
                  for (int n = 0; n < 2; ++n) { asm volatile("v_mfma_f32_16x16x32_bf16 %0, %1, %1, 0" : "=&v"(acc[1][b][m][n]) : "v"(zz));
                      acc[0][b][m][n] = (f32x4){0.f, 0.f, 0.f, 0.f}; } }
        cur = nxt; cA = nA; cB = nB; ++ui;
        if constexpr (ALIGN_EPI) { if (wr == 1) PG8_BAR; }
    }
    PG8_WAIT_V(0);
    if constexpr (!ALIGN_EPI) { if (wr == 0) PG8_BAR; }
    PG8_BAR;
#undef PG8_SA
#undef PG8_SB
#undef PG8_STAGE
#undef PG8_LDA
#undef PG8_LDB
#undef PG8_MMA
#undef PG8_WAIT_V
#undef PG8_WAIT_L
#undef PG8_BAR
#undef PG8_SCHED
}
}

#define XB_TMO      128
#define XB_XCNT(j)  (256  + 64 * (j))
#define XB_XSUB(j)  (1280 + 64 * (j))
#define XB_XGEN(j)  (2304 + 64 * (j))
#define XB_TOP      3328
#define XB_TOPGEN   3392
#define XCD_BAR_WORDS 3456
#define XB_SPIN_CAP (1u << 18)
__device__ __forceinline__ unsigned xb_ld(unsigned* p)              { return __hip_atomic_load(p, __ATOMIC_RELAXED, __HIP_MEMORY_SCOPE_AGENT); }
__device__ __forceinline__ unsigned xb_add(unsigned* p, unsigned v) { return __hip_atomic_fetch_add(p, v, __ATOMIC_RELAXED, __HIP_MEMORY_SCOPE_AGENT); }
__device__ __forceinline__ unsigned xb_xcc_id() { return (unsigned)__builtin_amdgcn_s_getreg((3 << 11) | 20) & 0xFu; }
#define XB_SPIN(cond, bar) do { unsigned _sp = 0; while (cond) { __builtin_amdgcn_s_sleep(1); \
    if ((++_sp & 255u) == 0u) { if (xb_ld(&(bar)[XB_TMO])) break; if (_sp > XB_SPIN_CAP) { atomicAdd(&(bar)[XB_TMO], 1u); break; } } } } while (0)
struct XcdBarrier { unsigned* bar; unsigned x; volatile LAS unsigned* st; };
__device__ __forceinline__ XcdBarrier xcd_barrier_post(unsigned* bar, volatile LAS unsigned* st) {
    XcdBarrier b; b.bar = bar; b.x = xb_xcc_id(); b.st = st;
    if (threadIdx.x == 0) (void)xb_add(&bar[XB_XCNT(b.x)], 1u);
    return b;
}
__device__ __forceinline__ void xcd_barrier_complete(unsigned* bar, unsigned x, unsigned& nloc, unsigned& nx) {
    const unsigned G = gridDim.x * gridDim.y * gridDim.z;
    unsigned sum, cnt, mine, sp = 0u;
    for (;;) {
        sum = 0u; cnt = 0u; mine = 0u;
#pragma unroll
        for (unsigned j = 0; j < 16; ++j) { const unsigned c = xb_ld(&bar[XB_XCNT(j)]); sum += c; cnt += (c > 0u) ? 1u : 0u; mine = (j == x) ? c : mine; }
        if (sum == G) break;
        __builtin_amdgcn_s_sleep(1);
        if ((++sp & 255u) == 0u) { if (xb_ld(&bar[XB_TMO])) break; if (sp > XB_SPIN_CAP) { atomicAdd(&bar[XB_TMO], 1u); break; } }
    }
    nloc = mine > 0u ? mine : 1u; nx = cnt > 0u ? cnt : 1u;
}
__device__ __forceinline__ void xcd_barrier(const XcdBarrier& b) {
    asm volatile("s_waitcnt vmcnt(0)" ::: "memory");
    __syncthreads();
    if (threadIdx.x == 0) {
        unsigned* bar = b.bar;
        __builtin_amdgcn_s_waitcnt(0);
        unsigned nloc = b.st[0], nx = b.st[1];
        if (nloc == 0u) { xcd_barrier_complete(bar, b.x, nloc, nx); b.st[0] = nloc; b.st[1] = nx; }
        const unsigned old = xb_add(&bar[XB_XSUB(b.x)], 1u);
        __builtin_amdgcn_fence(__ATOMIC_ACQUIRE, "agent");
        const unsigned gen = old / nloc;
        if (old + 1u == (gen + 1u) * nloc) {
            __builtin_amdgcn_fence(__ATOMIC_RELEASE, "agent");
            asm volatile("s_waitcnt vmcnt(0)" ::: "memory");
            const unsigned og = xb_add(&bar[XB_TOP], 1u);
            const unsigned tg = og / nx;
            if (og + 1u == (tg + 1u) * nx) {
#pragma unroll
                for (unsigned j = 0; j < 16; ++j) xb_add(&bar[XB_XGEN(j)], 1u);
            } else XB_SPIN(xb_ld(&bar[XB_XGEN(b.x)]) == gen, bar);
            asm volatile("s_waitcnt vmcnt(0)" ::: "memory");
        } else {
            XB_SPIN(xb_ld(&bar[XB_XGEN(b.x)]) == gen, bar);
            asm volatile("s_waitcnt vmcnt(0)" ::: "memory");
        }
    }
    __syncthreads();
}

struct Frame {
    LAS unsigned char* lds;
    int tid, lane, wave, G, gw, NGW;
    const float* in[N_IN]; float* out; unsigned char* ws;
};
#define WSP(T, off) ((T*)(F.ws + (off)))

__device__ __forceinline__ void p0_transpose_item(const float* W, int K, int N, bf16_t* WT, LAS float* scr, int item, int lane) {
    const int nblk = N / 32, kb = item / nblk, nb = item % nblk, k0 = 64 * kb, n0 = 32 * nb;
    float val[32];
    { const float* wp = W + (size_t)(k0 + (lane >> 5)) * N + n0 + (lane & 31);
#pragma unroll
      for (int i = 0; i < 32; ++i) val[i] = wp[(size_t)(2 * i) * N]; }
#pragma unroll
    for (int i = 0; i < 32; ++i) scr[(2 * i + (lane >> 5)) * 33 + (lane & 31)] = val[i];
    LDS_WAIT(); asm volatile("" ::: "memory");
    const int c = lane & 7;
#pragma unroll
    for (int j = 0; j < 4; ++j) { const int n = (lane >> 3) + 8 * j; const LAS float* s = scr + (8 * c) * 33 + n;
        u32x4 o; o.x = pk2(s[0 * 33], s[1 * 33]); o.y = pk2(s[2 * 33], s[3 * 33]); o.z = pk2(s[4 * 33], s[5 * 33]); o.w = pk2(s[6 * 33], s[7 * 33]);
        st16_wt(WT + (size_t)(n0 + n) * K + k0 + 8 * c, o); }
    LDS_WAIT(); asm volatile("" ::: "memory");
}
__device__ __forceinline__ void row_to_bf16_ss(const float* xrow, bf16_t* orow, float* ssp, int lane) {
    const f32x4* xr = (const f32x4*)xrow + lane;
    f32x4 v[4]; float s = 0.f;
#pragma unroll
    for (int j = 0; j < 4; ++j) { v[j] = xr[64 * j]; s += (v[j].x * v[j].x + v[j].y * v[j].y) + (v[j].z * v[j].z + v[j].w * v[j].w); }
    s = wave_sum(s);
    u32x2* o8 = (u32x2*)orow + lane;
#pragma unroll
    for (int j = 0; j < 4; ++j) { u32x2 w; w.x = pk2(v[j].x, v[j].y); w.y = pk2(v[j].z, v[j].w); o8[64 * j] = w; }
    if (lane == 0) *ssp = s;
}
__device__ __forceinline__ void p0_mods_task(Frame& F, int task) {
    const int kh = task & 1, l = (task >> 1) / 48, n0 = ((task >> 1) % 48) * 128;
    LAS float* Sc = (LAS float*)F.lds;
    LAS float* R = (LAS float*)(F.lds + 16384);
    const float* c = F.in[I_C]; const float* cc = F.in[I_CCTX];
    for (int i = F.tid; i < 3 * 512; i += 512) { const int v = i >> 9, k = kh * 512 + (i & 511); const float cv = v == 0 ? c[k] : (v == 1 ? c[D + k] : cc[k]); Sc[i] = cv / (1.f + __expf(-cv)); }
    __syncthreads();
    float a[3][2] = {{0.f, 0.f}, {0.f, 0.f}, {0.f, 0.f}};
    const float* Wp = F.in[I_MODW] + (size_t)l * D * 6144 + (size_t)(kh * 512) * 6144 + n0 + 2 * F.lane;
    const int kb = F.wave * 64;
#pragma unroll 16
    for (int kk = 0; kk < 64; ++kk) { const int k = kb + kk; const f32x2 wv = *(const f32x2*)(Wp + (size_t)k * 6144);
#pragma unroll
        for (int v = 0; v < 3; ++v) { const float s = Sc[v * 512 + k]; a[v][0] += s * wv.x; a[v][1] += s * wv.y; } }
#pragma unroll
    for (int v = 0; v < 3; ++v) { R[(F.wave * 3 + v) * 128 + 2 * F.lane] = a[v][0]; R[(F.wave * 3 + v) * 128 + 2 * F.lane + 1] = a[v][1]; }
    __syncthreads();
    if (F.tid < 384) { const int v = F.tid >> 7, j = F.tid & 127; float s = kh == 0 ? F.in[I_MODB][l * 6144 + n0 + j] : 0.f;
#pragma unroll
        for (int w = 0; w < 8; ++w) s += R[(w * 3 + v) * 128 + j];
        unsafeAtomicAdd(WSP(float, WS_MODS) + (size_t)(l * 3 + v) * 6144 + n0 + j, s); }
    __syncthreads();
}
__device__ __forceinline__ void phase_p0(Frame& F, int part, int gw, int ngw) {
    LAS float* scr = (LAS float*)(F.lds + F.wave * 16384);
    if (part == 0) {
    bf16_t* XB = WSP(bf16_t, WS_A1); float* ss0 = WSP(float, WS_SS0);
    const int R1 = (F.G == 256) ? 3 * 64 * 8 : 0, R0 = MT - R1;
    for (int m = F.gw; m < R0; m += F.NGW) {
        const float* src = m < ML ? F.in[I_X] + (size_t)m * D : F.in[I_CTX] + (size_t)(m - ML) * D;
        row_to_bf16_ss(src, XB + (size_t)m * D, ss0 + m, F.lane);
    }
    if (R1 > 0 && blockIdx.x >= 192)
        for (int m = R0 + ((int)blockIdx.x - 192) * 8 + F.wave; m < MT; m += 64 * 8) {
            const float* src = m < ML ? F.in[I_X] + (size_t)m * D : F.in[I_CTX] + (size_t)(m - ML) * D;
            row_to_bf16_ss(src, XB + (size_t)m * D, ss0 + m, F.lane);
        }
    for (int idx = (int)((blockIdx.x + 64u) % (unsigned)F.G) * 512 + F.tid; idx < 2 * 8 * 2 * 2 * 4 * 64; idx += F.G * 512) {
        const int ln = idx & 63, s_ = (idx >> 6) & 3, half = (idx >> 8) & 1, gate = (idx >> 9) & 1, g_ = (idx >> 10) & 7, d_ = idx >> 13;
        const float* wsrc = (gate ? F.in[I_LWI] : F.in[I_LWR]) + (size_t)((d_ * 8 + g_) * 64 + 16 * s_ + 8 * (ln >> 5)) * 64 + 32 * half + (ln & 31);
        constexpr float NL = -LOG2E;
        u32x4 o; o.x = pk2(NL * wsrc[0], NL * wsrc[64]); o.y = pk2(NL * wsrc[128], NL * wsrc[192]); o.z = pk2(NL * wsrc[256], NL * wsrc[320]); o.w = pk2(NL * wsrc[384], NL * wsrc[448]);
        st16_wt(WSP(u32x4, WS_LRUW) + idx, o);
    }
    return; }
    constexpr int I_O = (D / 64) * (D / 32), I_DN = (FF / 64) * (D / 32);
    for (int it = gw; it < I_O; it += ngw) p0_transpose_item(F.in[I_EWOUT], D, D, WSP(bf16_t, WS_WOUT0), scr, it, F.lane);
}

template <int NV> __device__ __forceinline__ void fold_task(const float* W, int N, int n0, int dst0, int Nd, int kc, float cs, const float* gam, const float* mods_l, int sc_off, int sh_off,
                                                           bf16_t* WT, float* biasp, LAS float* scr, int lane) {
    LAS float* vec = scr + 2176;
    for (int i = lane; i < NV * 256; i += 64) { const int v = i >> 8, kk = i & 255, k = kc * 256 + kk;
        vec[i] = gam[k] * (1.f + mods_l[(size_t)v * 6144 + sc_off + k]) * cs; vec[768 + i] = mods_l[(size_t)v * 6144 + sh_off + k] * cs; }
    LDS_WAIT(); asm volatile("" ::: "memory");
    float bacc[NV];
#pragma unroll
    for (int v = 0; v < NV; ++v) bacc[v] = 0.f;
    for (int it = 0; it < 4; ++it) {
        const int k0 = kc * 256 + 64 * it;
        float val[32];
        { const float* wp = W + (size_t)(k0 + (lane >> 5)) * N + n0 + (lane & 31);
#pragma unroll
          for (int i = 0; i < 32; ++i) val[i] = wp[(size_t)(2 * i) * N]; }
#pragma unroll
        for (int i = 0; i < 32; ++i) { const int kk = 2 * i + (lane >> 5); scr[kk * 33 + (lane & 31)] = val[i];
#pragma unroll
            for (int v = 0; v < NV; ++v) bacc[v] += vec[768 + v * 256 + 64 * it + kk] * val[i]; }
        LDS_WAIT(); asm volatile("" ::: "memory");
        const int c = lane & 7;
#pragma unroll
        for (int j = 0; j < 4; ++j) { const int n = (lane >> 3) + 8 * j; const LAS float* s = scr + (8 * c) * 33 + n;
#pragma unroll
            for (int v = 0; v < NV; ++v) { const LAS float* sv = vec + v * 256 + 64 * it + 8 * c;
                u32x4 o; o.x = pk2(s[0 * 33] * sv[0], s[1 * 33] * sv[1]); o.y = pk2(s[2 * 33] * sv[2], s[3 * 33] * sv[3]); o.z = pk2(s[4 * 33] * sv[4], s[5 * 33] * sv[5]); o.w = pk2(s[6 * 33] * sv[6], s[7 * 33] * sv[7]);
                st16_wt(WT + (size_t)v * Nd * D + (size_t)(dst0 + n) * D + k0 + 8 * c, o); } }
        LDS_WAIT(); asm volatile("" ::: "memory");
    }
#pragma unroll
    for (int v = 0; v < NV; ++v) { float b = bacc[v]; b += __shfl_xor(b, 32); if (lane < 32) unsafeAtomicAdd(biasp + (size_t)v * Nd + dst0 + lane, b); }
}
template <int NV> __device__ __forceinline__ void fold_item(const float* W, int N, int n0, int dst0, int Nd, int k0, float cs, const float* gam, const float* mods_l, int sc_off, int sh_off,
                                                           bf16_t* WT, float* biasp, LAS float* scr, int lane) {
    LAS float* vec = scr + 2176;
    float val[32];
    { const float* wp = W + (size_t)(k0 + (lane >> 5)) * N + n0 + (lane & 31);
#pragma unroll
      for (int i = 0; i < 32; ++i) val[i] = wp[(size_t)(2 * i) * N]; }
    { const int k = k0 + lane; const float gk = gam[k] * cs;
#pragma unroll
      for (int v = 0; v < NV; ++v) { vec[v * 64 + lane] = gk * (1.f + mods_l[(size_t)v * 6144 + sc_off + k]); vec[192 + v * 64 + lane] = mods_l[(size_t)v * 6144 + sh_off + k] * cs; } }
#pragma unroll
    for (int i = 0; i < 32; ++i) scr[(2 * i + (lane >> 5)) * 33 + (lane & 31)] = val[i];
    LDS_WAIT(); asm volatile("" ::: "memory");
    float bacc[NV];
#pragma unroll
    for (int v = 0; v < NV; ++v) bacc[v] = 0.f;
#pragma unroll
    for (int i = 0; i < 32; ++i)
#pragma unroll
        for (int v = 0; v < NV; ++v) bacc[v] += vec[192 + v * 64 + 2 * i + (lane >> 5)] * val[i];
    const int c = lane & 7;
#pragma unroll
    for (int j = 0; j < 4; ++j) { const int n = (lane >> 3) + 8 * j; const LAS float* s = scr + (8 * c) * 33 + n;
#pragma unroll
        for (int v = 0; v < NV; ++v) { const LAS float* sv = vec + v * 64 + 8 * c;
            u32x4 o; o.x = pk2(s[0 * 33] * sv[0], s[1 * 33] * sv[1]); o.y = pk2(s[2 * 33] * sv[2], s[3 * 33] * sv[3]); o.z = pk2(s[4 * 33] * sv[4], s[5 * 33] * sv[5]); o.w = pk2(s[6 * 33] * sv[6], s[7 * 33] * sv[7]);
            st16_wt(WT + (size_t)v * Nd * D + (size_t)(dst0 + n) * D + k0 + 8 * c, o); } }
    LDS_WAIT(); asm volatile("" ::: "memory");
#pragma unroll
    for (int v = 0; v < NV; ++v) { float b = bacc[v]; b += __shfl_xor(b, 32); if (lane < 32) unsafeAtomicAdd(biasp + (size_t)v * Nd + dst0 + lane, b); }
}
__device__ __forceinline__ int gu_dst(int n) { return n < FF ? (n >> 7) * 256 + (n & 127) : ((n - FF) >> 7) * 256 + 128 + ((n - FF) & 127); }
__device__ __forceinline__ int in1_dst(int n) { if (n < 1024) return n; if (n < 2048) { const int q = n - 1024; return 1024 + (q >> 7) * 256 + (q & 127); } const int q = n - 2048; return 1024 + (q >> 7) * 256 + 128 + (q & 127); }
__device__ __forceinline__ void phase_p1(Frame& F, int part, int gw, int ngw) {
    LAS float* scr = (LAS float*)(F.lds + F.wave * 16384);
    const float* mods = WSP(float, WS_MODS);
    if (part == 0) {
        for (int it = gw; it < (NIN0 / 32) * 16; it += ngw) { const int ks = it & 15, n0 = (it >> 4) * 32;
            fold_item<3>(F.in[I_EWIN], NIN0, n0, n0, NIN0, 64 * ks, n0 < 512 ? QSCALE : 1.f, F.in[I_N1G], mods, 1024, 0, WSP(bf16_t, WS_WIN0), WSP(float, WS_B_IN0), scr, F.lane); }
    } else {
        for (int it = gw; it < (NGU / 32) * 16; it += ngw) { const int ks = it & 15, n0 = (it >> 4) * 32;
            fold_item<2>(F.in[I_WGU], NGU, n0, gu_dst(n0), NGU, 64 * ks, 1.f, F.in[I_N2G], mods, 4096, 3072, WSP(bf16_t, WS_WGU0), WSP(float, WS_B_GU0), scr, F.lane); }
    }
}

__device__ __forceinline__ void conv4_task(Frame& F, int task) {
    const bf16_t* QKV = WSP(bf16_t, WS_BIG); bf16_t* XC = WSP(bf16_t, WS_XCONV);
    const int row0 = task * 16, lane = F.lane;
    int sbeg, send;
    if (row0 < ML) { sbeg = (row0 / SEQ) * SEQ; send = sbeg + SEQ; } else { sbeg = ML + ((row0 - ML) / NCTX) * NCTX; send = sbeg + NCTX; }
    u32x4 raw[19];
#pragma unroll
    for (int i = 0; i < 19; ++i) { const int r = row0 + i - 2; raw[i] = (r >= sbeg && r < send) ? *(const u32x4*)(QKV + (size_t)r * NIN0 + 1536 + 8 * lane) : (u32x4){0u, 0u, 0u, 0u}; }
    float w[4][8], bs[8];
#pragma unroll
    for (int j = 0; j < 4; ++j) { const f32x4 a = *(const f32x4*)(F.in[I_ECW] + j * 512 + 8 * lane), b = *(const f32x4*)(F.in[I_ECW] + j * 512 + 8 * lane + 4);
        w[j][0] = a.x; w[j][1] = a.y; w[j][2] = a.z; w[j][3] = a.w; w[j][4] = b.x; w[j][5] = b.y; w[j][6] = b.z; w[j][7] = b.w; }
    { const f32x4 a = *(const f32x4*)(F.in[I_ECB] + 8 * lane), b = *(const f32x4*)(F.in[I_ECB] + 8 * lane + 4); bs[0] = a.x; bs[1] = a.y; bs[2] = a.z; bs[3] = a.w; bs[4] = b.x; bs[5] = b.y; bs[6] = b.z; bs[7] = b.w; }
#pragma unroll
    for (int t = 0; t < 16; ++t) {
        float o[8];
#pragma unroll
        for (int e = 0; e < 8; ++e) o[e] = bs[e];
#pragma unroll
        for (int j = 0; j < 4; ++j) { const u32x4 r = raw[t + j];
            o[0] += w[j][0] * bflo(r.x); o[1] += w[j][1] * bfhi(r.x); o[2] += w[j][2] * bflo(r.y); o[3] += w[j][3] * bfhi(r.y);
            o[4] += w[j][4] * bflo(r.z); o[5] += w[j][5] * bfhi(r.z); o[6] += w[j][6] * bflo(r.w); o[7] += w[j][7] * bfhi(r.w); }
        u32x4 pk; pk.x = pk2(o[0], o[1]); pk.y = pk2(o[2], o[3]); pk.z = pk2(o[4], o[5]); pk.w = pk2(o[6], o[7]);
        *(u32x4*)(XC + (size_t)(row0 + t) * 512 + 8 * lane) = pk;
    }
}

__device__ __forceinline__ int crow(int r, int hi) { return (r & 3) + 8 * (r >> 2) + 4 * hi; }
__device__ __forceinline__ void qkt(f32x16& p0, f32x16& p1, const bf16x8 (&b0)[4], const bf16x8 (&b1)[4], const bf16x8* qr, const f32x16& c0, const f32x16& c1) {
    p0 = __builtin_amdgcn_mfma_f32_32x32x16_bf16(b0[0], qr[0], c0, 0, 0, 0);
    p1 = __builtin_amdgcn_mfma_f32_32x32x16_bf16(b1[0], qr[0], c1, 0, 0, 0);
#pragma unroll
    for (int d0 = 1; d0 < 4; ++d0) {
        p0 = __builtin_amdgcn_mfma_f32_32x32x16_bf16(b0[d0], qr[d0], p0, 0, 0, 0);
        p1 = __builtin_amdgcn_mfma_f32_32x32x16_bf16(b1[d0], qr[d0], p1, 0, 0, 0);
    }
}
__device__ __forceinline__ void pv(f32x16* o, unsigned vb0, unsigned vb1, bf16x8 pa0, bf16x8 pa1, bf16x8 pa2, bf16x8 pa3, bool use0, bool use3) {
    s16x4 lo[2][4], hi[2][4];
#define PV_RD(ks) do { \
        lo[0][ks] = __builtin_amdgcn_ds_read_tr16_b64_v4i16((LAS s16x4*)(uintptr_t)(vb0 + (ks) * 2048)); \
        hi[0][ks] = __builtin_amdgcn_ds_read_tr16_b64_v4i16((LAS s16x4*)(uintptr_t)(vb0 + (ks) * 2048 + 1024)); \
        lo[1][ks] = __builtin_amdgcn_ds_read_tr16_b64_v4i16((LAS s16x4*)(uintptr_t)(vb1 + (ks) * 2048)); \
        hi[1][ks] = __builtin_amdgcn_ds_read_tr16_b64_v4i16((LAS s16x4*)(uintptr_t)(vb1 + (ks) * 2048 + 1024)); } while (0)
#define PK(d, k) (bf16x8){lo[d][k][0], lo[d][k][1], lo[d][k][2], lo[d][k][3], hi[d][k][0], hi[d][k][1], hi[d][k][2], hi[d][k][3]}
    PV_RD(1); PV_RD(2);
    if (use0) {
        PV_RD(0);
        asm volatile("s_waitcnt lgkmcnt(0)" ::: "memory");
        o[0] = __builtin_amdgcn_mfma_f32_32x32x16_bf16(PK(0, 0), pa0, o[0], 0, 0, 0);
        o[1] = __builtin_amdgcn_mfma_f32_32x32x16_bf16(PK(1, 0), pa0, o[1], 0, 0, 0);
    }
    if (use3) PV_RD(3);
    asm volatile("s_waitcnt lgkmcnt(0)" ::: "memory"); __builtin_amdgcn_sched_barrier(0);
    o[0] = __builtin_amdgcn_mfma_f32_32x32x16_bf16(PK(0, 1), pa1, o[0], 0, 0, 0);
    o[1] = __builtin_amdgcn_mfma_f32_32x32x16_bf16(PK(1, 1), pa1, o[1], 0, 0, 0);
    o[0] = __builtin_amdgcn_mfma_f32_32x32x16_bf16(PK(0, 2), pa2, o[0], 0, 0, 0);
    o[1] = __builtin_amdgcn_mfma_f32_32x32x16_bf16(PK(1, 2), pa2, o[1], 0, 0, 0);
    if (use3) {
        o[0] = __builtin_amdgcn_mfma_f32_32x32x16_bf16(PK(0, 3), pa3, o[0], 0, 0, 0);
        o[1] = __builtin_amdgcn_mfma_f32_32x32x16_bf16(PK(1, 3), pa3, o[1], 0, 0, 0);
    }
#undef PK
#undef PV_RD
}
__device__ __forceinline__ float max3f(float a, float b, float c) { float r; asm("v_max3_f32 %0, %1, %2, %3" : "=v"(r) : "v"(a), "v"(b), "v"(c)); return r; }
__device__ __forceinline__ float max2f(float a, float b) { float r; asm("v_max_f32 %0, %1, %2" : "=v"(r) : "v"(a), "v"(b)); return r; }
__device__ __forceinline__ float half_swap_max(float m) { auto rr = __builtin_amdgcn_permlane32_swap(__float_as_uint(m), __float_as_uint(m), false, false); return max2f(__uint_as_float(rr[0]), __uint_as_float(rr[1])); }
__device__ __forceinline__ float half_swap_sum(float m) { auto rr = __builtin_amdgcn_permlane32_swap(__float_as_uint(m), __float_as_uint(m), false, false); return __uint_as_float(rr[0]) + __uint_as_float(rr[1]); }

constexpr int AT_SLOT = 32768, AT_NSLOT = 3, AT_BIAS = AT_NSLOT * AT_SLOT, AT_WSF = AT_BIAS + 2 * 15 * 128 * 4, AT_QST = AT_WSF + 3072, AT_NTASK = NB * 128 * 4;
static_assert(AT_QST + 8 * 4096 <= LDSCTL_OFF, "attention LDS map");
constexpr float AT_THR = 8.f;
__device__ __forceinline__ void attn_phase(Frame& F) {
    const bf16_t* QKV = WSP(bf16_t, WS_BIG); bf16_t* MIX = WSP(bf16_t, WS_A2);
    const int lane = F.lane, w = F.wave, r32 = lane & 31, hi = lane >> 5;
    const int hsel = w >> 2, rsel = (w >> 1) & 1, qh = w & 1;
    LAS unsigned char* lds = F.lds;
    LAS float* BIAS = (LAS float*)(lds + AT_BIAS);
    LAS float* wsf = (LAS float*)(lds + AT_WSF) + w * 64;
    const int qc = 32 * qh + r32, cs = min(max(qc - 8, 0), 48);
    const int krow_ = 8 * w + (lane >> 3), kchunk_ = (lane & 7) ^ ((krow_ >> 1) & 7);
    int koff[4];
#pragma unroll
    for (int d0 = 0; d0 < 4; ++d0) koff[d0] = r32 * 128 + (((2 * d0 + hi) ^ ((r32 >> 1) & 7)) << 4);
    const unsigned ldsw = (unsigned)w * 1024u;
    unsigned vboff0, vboff1;
    { const int q_ = (lane & 15) >> 2, p_ = lane & 3, blk_ = (lane >> 4) & 1, fl_ = (q_ >> 1) << 2;
      vboff0 = (unsigned)((4 * hi + q_) * 128 + (((0 + 2 * blk_ + (p_ >> 1)) ^ fl_) << 4) + 8 * (p_ & 1));
      vboff1 = (unsigned)((4 * hi + q_) * 128 + (((4 + 2 * blk_ + (p_ >> 1)) ^ fl_) << 4) + 8 * (p_ & 1)); }
#define AT_DMA(bb, Rlo, s, sl) do { const int s_ = (s); const size_t base_ = (s_ < 4 ? (size_t)(ML + (bb) * NCTX + 64 * s_) : (size_t)((bb) * SEQ + ((Rlo) + s_ - 4) * 64)) * NIN0; \
        LAS unsigned char* sl_ = lds + (sl) * AT_SLOT + ldsw; \
        __builtin_amdgcn_global_load_lds((const unsigned*)(ksrc + base_), (LAS unsigned*)(sl_), 16, 0, 0); \
        __builtin_amdgcn_global_load_lds((const unsigned*)(ksrc + base_ + 64), (LAS unsigned*)(sl_ + 8192), 16, 0, 0); \
        __builtin_amdgcn_global_load_lds((const unsigned*)(vsrc + base_), (LAS unsigned*)(sl_ + 16384), 16, 0, 0); \
        __builtin_amdgcn_global_load_lds((const unsigned*)(vsrc + base_ + 64), (LAS unsigned*)(sl_ + 24576), 16, 0, 0); } while (0)
#define AT_DMAROW(trow, sl) do { const size_t base_ = (size_t)(trow) * NIN0; LAS unsigned char* sl_ = lds + (sl) * AT_SLOT + ldsw; \
        __builtin_amdgcn_global_load_lds((const unsigned*)(ksrc + base_), (LAS unsigned*)(sl_), 16, 0, 0); \
        __builtin_amdgcn_global_load_lds((const unsigned*)(ksrc + base_ + 64), (LAS unsigned*)(sl_ + 8192), 16, 0, 0); \
        __builtin_amdgcn_global_load_lds((const unsigned*)(vsrc + base_), (LAS unsigned*)(sl_ + 16384), 16, 0, 0); \
        __builtin_amdgcn_global_load_lds((const unsigned*)(vsrc + base_ + 64), (LAS unsigned*)(sl_ + 24576), 16, 0, 0); } while (0)
#define AT_DMAQ(bb, rr, hh) do { const bf16_t* qp_ = QKV + (size_t)((bb) * SEQ + (rr) * 64 + 32 * qh + r32) * NIN0 + (hh) * 64 + 8 * hi; LAS unsigned char* ql_ = lds + AT_QST + w * 4096; \
        __builtin_amdgcn_global_load_lds((const unsigned*)(qp_), (LAS unsigned*)(ql_), 16, 0, 0); __builtin_amdgcn_global_load_lds((const unsigned*)(qp_ + 16), (LAS unsigned*)(ql_ + 1024), 16, 0, 0); \
        __builtin_amdgcn_global_load_lds((const unsigned*)(qp_ + 32), (LAS unsigned*)(ql_ + 2048), 16, 0, 0); __builtin_amdgcn_global_load_lds((const unsigned*)(qp_ + 48), (LAS unsigned*)(ql_ + 3072), 16, 0, 0); } while (0)
#define AT_LOADQ(bb, rr, hh) do { const bf16_t* qp_ = QKV + (size_t)((bb) * SEQ + (rr) * 64 + 32 * qh + r32) * NIN0 + (hh) * 64 + 8 * hi; \
        qr[0] = *(const bf16x8*)(qp_); qr[1] = *(const bf16x8*)(qp_ + 16); qr[2] = *(const bf16x8*)(qp_ + 32); qr[3] = *(const bf16x8*)(qp_ + 48); } while (0)
    bf16x8 qr[4];
    if (w >= 4) __builtin_amdgcn_s_setprio(1);
    int bias_hp = -1, gs0 = 0;
    bool primed = false;
#pragma unroll 1
    for (int task = blockIdx.x; task < AT_NTASK; task += F.G) {
    const int b = task >> 9, rp = (task >> 2) & 127, hp = task & 3;
    const int h = 2 * hp + hsel, r = 2 * rp + rsel;
    const int rs_r = min(max(r - 4, 0), 248);
    const int R_lo = min(max(2 * rp - 4, 0), 248), R_hi = min(max(2 * rp + 1 - 4, 0), 248) + 7, nsteps = 4 + (R_hi - R_lo + 1);
    const int tn = task + F.G, bn = tn >> 9, rpn = (tn >> 2) & 127;
    const bool cont = tn < AT_NTASK && (tn & 3) == hp;
    const int R_lo_n = min(max(2 * rpn - 4, 0), 248);
    const bf16_t* ksrc = QKV + (size_t)krow_ * NIN0 + 512 + (2 * hp) * 64 + 8 * kchunk_;
    const bf16_t* vsrc = QKV + (size_t)krow_ * NIN0 + 1024 + (2 * hp) * 64 + 8 * ((lane & 7) ^ (((krow_ >> 1) & 1) << 2));
    if (!primed) {
        if (bias_hp != hp) {
            for (int i = F.tid; i < 2 * 15 * 128; i += 512) { const int hh = i / 1920, dr = (i >> 7) % 15, dc = (i & 127) - 48;
                BIAS[i] = (dc >= 0 && dc <= 30) ? F.in[I_RPB][(size_t)(2 * hp + hh) * 465 + dr * 31 + dc] * LOG2E : 0.f; }
            bias_hp = hp;
        }
        AT_LOADQ(b, r, h);
        asm volatile("s_waitcnt vmcnt(0)" ::: "memory");
        AT_DMA(b, R_lo, 0, gs0); AT_DMA(b, R_lo, 1, gs0 == 2 ? 0 : gs0 + 1);
    } else {
        asm volatile("s_waitcnt vmcnt(0)" ::: "memory");
#pragma unroll
        for (int d0 = 0; d0 < 4; ++d0) qr[d0] = *(LAS const bf16x8*)(lds + AT_QST + w * 4096 + d0 * 1024 + lane * 16);
    }
    float mref = 0.f, lrun = 0.f; f32x16 o[2], c0, c1;
#pragma unroll
    for (int i = 0; i < 16; ++i) { o[0][i] = 0.f; o[1][i] = 0.f; c0[i] = 0.f; c1[i] = 0.f; }
    const int cbase2 = ML + b * NCTX + 128, wbase2 = b * SEQ + (R_lo - 2) * 64, nbase = ML + bn * NCTX;
    int slc = gs0, sl2 = gs0 == 0 ? 2 : gs0 - 1;
    auto step = [&](const int s, auto win_t, auto qh_t) __attribute__((always_inline)) {
        constexpr bool WIN = decltype(win_t)::value; constexpr int QHC = decltype(qh_t)::value;
        if (WIN ? !(s + 1 < nsteps || cont) : (s == 0 && primed)) asm volatile("s_waitcnt vmcnt(0)" ::: "memory"); else asm volatile("s_waitcnt vmcnt(4)" ::: "memory");
        asm volatile("s_waitcnt lgkmcnt(0)" ::: "memory"); __builtin_amdgcn_s_barrier(); asm volatile("" ::: "memory");
        if constexpr (!WIN) { AT_DMAROW((s < 2 ? cbase2 : wbase2) + 64 * s, sl2); }
        else { const bool own = s + 2 < nsteps;
               if (own || cont) AT_DMAROW(own ? wbase2 + 64 * s : nbase + 64 * (s + 2 - nsteps), sl2);
               if (s == nsteps - 1 && cont) AT_DMAQ(bn, 2 * rpn + rsel, h); }
        const int kr = R_lo + s - 4;
        const bool active = !WIN || (kr >= rs_r && kr <= rs_r + 7);
        if (active) {
            LAS const unsigned char* Kslot = lds + slc * AT_SLOT + hsel * 8192;
            const unsigned vbs = (unsigned)(uintptr_t)(lds + slc * AT_SLOT + 16384 + hsel * 8192);
            f32x16 p0, p1;
            constexpr bool win = WIN; const bool l0a = !WIN || qh == 0, l1b = !WIN || qh == 1;
            bf16x8 kb0[4], kb1[4];
#pragma unroll
            for (int d0 = 0; d0 < 4; ++d0) { kb0[d0] = *(LAS const bf16x8*)(Kslot + koff[d0]); kb1[d0] = *(LAS const bf16x8*)(Kslot + koff[d0] + 4096); }
            if (win) {
                f32x16 cc0, cc1;
                const int dr = kr - r + 7;
                LAS const float* T = BIAS + (hsel * 15 + dr) * 128 + (63 - qc);
                float tb0[16], tb1[16];
#pragma unroll
                for (int i = 0; i < 16; ++i) { tb0[i] = T[crow(i, hi)]; tb1[i] = T[crow(i, hi) + 32]; }
#pragma unroll
                for (int i = 0; i < 16; ++i) { cc0[i] = c0[i] + tb0[i]; cc1[i] = c1[i] + tb1[i]; }
                qkt(p0, p1, kb0, kb1, qr, cc0, cc1);
            } else qkt(p0, p1, kb0, kb1, qr, c0, c1);
            float ra = max3f(p0[12], p0[13], p1[0]), rb = max3f(p0[14], p0[15], p1[1]); ra = max3f(ra, p1[2], p1[3]);
            if (l0a) {
#pragma unroll
                for (int i = 0; i < 12; i += 4) { ra = max3f(ra, p0[i], p0[i + 1]); rb = max3f(rb, p0[i + 2], p0[i + 3]); }
            }
            if (l1b) {
#pragma unroll
                for (int i = 4; i < 16; i += 4) { ra = max3f(ra, p1[i], p1[i + 1]); rb = max3f(rb, p1[i + 2], p1[i + 3]); }
            }
            float rm = half_swap_max(max2f(ra, rb));
            if ((!WIN && s == 0) || __any(rm > AT_THR)) {
                const float dl = (!WIN && s == 0) ? rm : max2f(rm, 0.f);
                mref += dl;
#pragma unroll
                for (int i = 0; i < 16; ++i) { p0[i] -= dl; p1[i] -= dl; c0[i] -= dl; c1[i] -= dl; }
                const float f = (!WIN && s == 0) ? 1.f : fast_exp2(-dl);
                lrun *= f;
#pragma unroll
                for (int i = 0; i < 16; ++i) { o[0][i] *= f; o[1][i] *= f; }
            }
            float ls = 0.f;
            u32x4 pw0, pw1, pw2, pw3;
            if (l0a) {
#pragma unroll
                for (int i = 0; i < 12; ++i) { p0[i] = fast_exp2(p0[i]); ls += p0[i]; }
                pw0.x = pg8::cvt_pk_bf16(p0[0], p0[1]); pw0.y = pg8::cvt_pk_bf16(p0[2], p0[3]); pw0.z = pg8::cvt_pk_bf16(p0[4], p0[5]); pw0.w = pg8::cvt_pk_bf16(p0[6], p0[7]);
                pw1.x = pg8::cvt_pk_bf16(p0[8], p0[9]); pw1.y = pg8::cvt_pk_bf16(p0[10], p0[11]);
            } else { pw0 = (u32x4){0u, 0u, 0u, 0u}; pw1.x = 0u; pw1.y = 0u; }
#pragma unroll
            for (int i = 12; i < 16; ++i) { p0[i] = fast_exp2(p0[i]); ls += p0[i]; }
#pragma unroll
            for (int i = 0; i < 4; ++i) { p1[i] = fast_exp2(p1[i]); ls += p1[i]; }
            pw1.z = pg8::cvt_pk_bf16(p0[12], p0[13]); pw1.w = pg8::cvt_pk_bf16(p0[14], p0[15]);
            pw2.x = pg8::cvt_pk_bf16(p1[0], p1[1]); pw2.y = pg8::cvt_pk_bf16(p1[2], p1[3]);
            if (l1b) {
#pragma unroll
                for (int i = 4; i < 16; ++i) { p1[i] = fast_exp2(p1[i]); ls += p1[i]; }
                pw2.z = pg8::cvt_pk_bf16(p1[4], p1[5]); pw2.w = pg8::cvt_pk_bf16(p1[6], p1[7]);
                pw3.x = pg8::cvt_pk_bf16(p1[8], p1[9]); pw3.y = pg8::cvt_pk_bf16(p1[10], p1[11]); pw3.z = pg8::cvt_pk_bf16(p1[12], p1[13]); pw3.w = pg8::cvt_pk_bf16(p1[14], p1[15]);
            } else { pw2.z = 0u; pw2.w = 0u; pw3 = (u32x4){0u, 0u, 0u, 0u}; }
            lrun += ls;
            LDS_WAIT();
            pv(o, vbs + vboff0, vbs + vboff1, __builtin_bit_cast(bf16x8, pw0), __builtin_bit_cast(bf16x8, pw1), __builtin_bit_cast(bf16x8, pw2), __builtin_bit_cast(bf16x8, pw3), l0a, l1b);
        }
            slc = slc == 2 ? 0 : slc + 1; sl2 = sl2 == 2 ? 0 : sl2 + 1;
    };
    int s_ = 0;
#pragma unroll 1
    for (; s_ < 4; ++s_) step(s_, std::false_type{}, std::integral_constant<int, -1>{});
    {
#pragma unroll
        for (int i = 0; i < 16; ++i) { const int k0_ = crow(i, hi); c0[i] = ((unsigned)(k0_ - cs) < 16u) ? c0[i] : -INFINITY; c1[i] = ((unsigned)(k0_ + 32 - cs) < 16u) ? c1[i] : -INFINITY; }
    }
#pragma unroll 1
    for (; s_ < nsteps; ++s_) step(s_, std::true_type{}, std::integral_constant<int, -1>{});
    const float ri = fast_rcp(half_swap_sum(lrun));
    unsigned char* orow = (unsigned char*)(MIX + (size_t)(b * SEQ + r * 64 + 32 * qh + r32) * D + h * 64) + (hi ? 16 : 0);
#pragma unroll
    for (int db = 0; db < 2; ++db) {
        unsigned gx[4], gy[4];
#pragma unroll
        for (int g = 0; g < 4; ++g) { gx[g] = pk2(o[db][4 * g] * ri, o[db][4 * g + 1] * ri); gy[g] = pk2(o[db][4 * g + 2] * ri, o[db][4 * g + 3] * ri); }
#pragma unroll
        for (int k = 0; k < 4; k += 2) {
            const auto rx = __builtin_amdgcn_permlane32_swap(gx[k], gx[k + 1], false, false);
            const auto ry = __builtin_amdgcn_permlane32_swap(gy[k], gy[k + 1], false, false);
            *(u32x4*)(orow + db * 64 + 16 * k) = (u32x4){rx[0], ry[0], rx[1], ry[1]};
        }
    }
    asm volatile("s_waitcnt lgkmcnt(0)" ::: "memory");
    if (!cont) { asm volatile("s_waitcnt vmcnt(0)" ::: "memory"); __builtin_amdgcn_s_barrier(); asm volatile("" ::: "memory"); }
    gs0 = (gs0 + nsteps) % 3; primed = cont;
    }
    __builtin_amdgcn_s_setprio(0);
#undef AT_DMA
#undef AT_LOADQ
#undef AT_DMAQ
#undef AT_DMAROW
}

struct LruW { bf16x8 wr[4], wi[4]; f32x16 cr, ci; float cn; };
constexpr int LRU_LW = 0, LRU_LC = 32768, LRU_HF = 36864, LRU_AF = LRU_HF + 65536;
static_assert(LRU_AF + 8 * 4096 <= LDSCTL_OFF, "LRU LDS map");
__device__ __forceinline__ void lru_stage_w(Frame& F, int g) {
    const u32x4* src = WSP(u32x4, WS_LRUW);
    LAS u32x4* dst = (LAS u32x4*)(F.lds + LRU_LW);
#pragma unroll
    for (int i = 0; i < 4; ++i) { const int idx = F.tid + 512 * i;
        const int d = idx >> 10, rest = idx & 1023;
        dst[idx] = src[(size_t)((d * 8 + g) * 1024) + rest]; }
    if (F.tid < 128) { const int d = F.tid >> 6, ch = d * 512 + g * 64 + (F.tid & 63);
        LAS float* lc = (LAS float*)(F.lds + LRU_LC) + F.tid * 4;
        lc[0] = -LOG2E * F.in[I_LBR][ch]; lc[1] = -LOG2E * F.in[I_LBI][ch]; lc[2] = -8.f * LOG2E * log1pf(__expf(-F.in[I_LAM][ch])); }
    __syncthreads();
}
__device__ __forceinline__ void lru_load_w(Frame& F, LruW& W, int d, int half, int lane) {
    LAS const bf16x8* wf = (LAS const bf16x8*)(F.lds + LRU_LW) + d * 1024 + lane;
#pragma unroll
    for (int s = 0; s < 4; ++s) { W.wr[s] = wf[((0 * 2 + half) * 4 + s) * 64]; W.wi[s] = wf[((1 * 2 + half) * 4 + s) * 64]; }
    LAS const float* lc = (LAS const float*)(F.lds + LRU_LC) + (d * 64 + 32 * half + (lane & 31)) * 4;
    { const float br = lc[0], bi = lc[1];
#pragma unroll
      for (int i = 0; i < 16; ++i) { W.cr[i] = br; W.ci[i] = bi; } }
    W.cn = lc[2];
}
__device__ __forceinline__ void lru_dma_af(const bf16_t* XC, size_t t0, int g, int lane, LAS unsigned char* afb) {
    const int rr = lane >> 3, sl = lane & 7;
#pragma unroll
    for (int i = 0; i < 4; ++i) { const int row = 8 * i + rr;
        __builtin_amdgcn_global_load_lds((const unsigned*)(XC + (t0 + row) * 512 + 64 * g + 8 * (sl ^ ((row >> 1) & 7))), (LAS unsigned*)(afb + i * 1024), 16, 0, 0); }
}
__device__ __forceinline__ void lru_read_af(LAS const unsigned char* afb, int r32, int hi, bf16x8 (&af)[4]) {
#pragma unroll
    for (int s = 0; s < 4; ++s) af[s] = *(LAS const bf16x8*)(afb + r32 * 128 + (((2 * s + hi) ^ ((r32 >> 1) & 7)) << 4));
}
__device__ __forceinline__ void lru_gates(const bf16x8 (&af)[4], const LruW& W, int half, bf16x8 I0, bf16x8 I1, float (&a)[16], float (&b)[16]) {
    f32x16 R, I, X;
#pragma unroll
    for (int i = 0; i < 16; ++i) X[i] = 0.f;
    R = __builtin_amdgcn_mfma_f32_32x32x16_bf16(af[0], W.wr[0], W.cr, 0, 0, 0); I = __builtin_amdgcn_mfma_f32_32x32x16_bf16(af[0], W.wi[0], W.ci, 0, 0, 0);
#pragma unroll
    for (int s = 1; s < 4; ++s) { R = __builtin_amdgcn_mfma_f32_32x32x16_bf16(af[s], W.wr[s], R, 0, 0, 0); I = __builtin_amdgcn_mfma_f32_32x32x16_bf16(af[s], W.wi[s], I, 0, 0, 0); }
    const bf16x8 ax0 = half ? af[2] : af[0], ax1 = half ? af[3] : af[1];
    X = __builtin_amdgcn_mfma_f32_32x32x16_bf16(ax0, I0, X, 0, 0, 0);
    X = __builtin_amdgcn_mfma_f32_32x32x16_bf16(ax1, I1, X, 0, 0, 0);
    const float cn = W.cn;
#pragma unroll
    for (int i = 0; i < 16; ++i) {
        const float rr = fast_rcp(1.f + fast_exp2(R[i])), ii = fast_rcp(1.f + fast_exp2(I[i]));
        const float av = fast_exp2(rr * cn);
        a[i] = av; b[i] = __builtin_amdgcn_sqrtf(1.f - av * av) * ii * X[i]; }
}
__device__ __forceinline__ float partner32(float x, int hi) { auto rr = __builtin_amdgcn_permlane32_swap(__float_as_uint(x), __float_as_uint(x), false, false); return __uint_as_float(hi ? rr[0] : rr[1]); }
template <bool REV, bool WANT_H> __device__ __forceinline__ void lru_scan_tile(const float (&a)[16], const float (&b)[16], int hi, float& H, float (&h)[16], float& ap) {
    float SA[4], SB[4], EAv[4], OAv[4], EBv[4], OBv[4];
#pragma unroll
    for (int q = 0; q < 4; ++q) { const float a0 = a[4 * q], a1 = a[4 * q + 1], a2 = a[4 * q + 2], a3 = a[4 * q + 3], b0 = b[4 * q], b1 = b[4 * q + 1], b2 = b[4 * q + 2], b3 = b[4 * q + 3];
        SA[q] = (a0 * a1) * (a2 * a3);
        SB[q] = REV ? ((b3 * a2 + b2) * a1 + b1) * a0 + b0 : ((b0 * a1 + b1) * a2 + b2) * a3 + b3; }
#pragma unroll
    for (int q = 0; q < 4; ++q) { auto ra_ = __builtin_amdgcn_permlane32_swap(__float_as_uint(SA[q]), __float_as_uint(SA[q]), false, false); EAv[q] = __uint_as_float(ra_[0]); OAv[q] = __uint_as_float(ra_[1]);
        auto rb_ = __builtin_amdgcn_permlane32_swap(__float_as_uint(SB[q]), __float_as_uint(SB[q]), false, false); EBv[q] = __uint_as_float(rb_[0]); OBv[q] = __uint_as_float(rb_[1]); }
    float cin[4];
    if (!REV) {
#pragma unroll
        for (int q = 0; q < 4; ++q) { const float EA = EAv[q], EB = EBv[q], OA = OAv[q], OB = OBv[q];
            const float he = H; H = EA * H + EB; const float ho = H; H = OA * H + OB; cin[q] = hi ? ho : he; if (!WANT_H) ap *= EA * OA; }
    } else {
#pragma unroll
        for (int q = 3; q >= 0; --q) { const float EA = EAv[q], EB = EBv[q], OA = OAv[q], OB = OBv[q];
            const float ho = H; H = OA * H + OB; const float he = H; H = EA * H + EB; cin[q] = hi ? ho : he; if (!WANT_H) ap *= EA * OA; }
    }
    if (WANT_H) {
#pragma unroll
        for (int q = 0; q < 4; ++q) { float hh = cin[q];
            if (!REV) {
#pragma unroll
                for (int e = 0; e < 4; ++e) { hh = a[4 * q + e] * hh + b[4 * q + e]; h[4 * q + e] = hh; }
            } else {
#pragma unroll
                for (int e = 3; e >= 0; --e) { hh = a[4 * q + e] * hh + b[4 * q + e]; h[4 * q + e] = hh; }
            } }
    }
}
__device__ __forceinline__ void lru_ident(int r32, int hi, bf16x8& I0, bf16x8& I1) {
#pragma unroll
    for (int j = 0; j < 8; ++j) { I0[j] = (8 * hi + j == r32) ? (short)0x3F80 : (short)0; I1[j] = (16 + 8 * hi + j == r32) ? (short)0x3F80 : (short)0; }
}
template <bool REV, int MODE> __device__ __forceinline__ void lru_subpass(Frame& F, size_t row0, int ntile, int g, int half, float& H, float& ap, LAS unsigned* HFL, bf16x8 (&af)[4], bool have) {
    const bf16_t* XC = WSP(bf16_t, WS_XCONV);
    const int lane = F.lane, r32 = lane & 31, hi = lane >> 5;
    LAS unsigned char* afb = F.lds + LRU_AF + F.wave * 4096;
    bf16x8 I0, I1; lru_ident(r32, hi, I0, I1);
    LruW W; lru_load_w(F, W, REV ? 1 : 0, half, lane);
    if (!have) {
        lru_dma_af(XC, row0 + (REV ? 32 * (ntile - 1) : 0), g, lane, afb);
        asm volatile("s_waitcnt vmcnt(0)" ::: "memory");
        lru_read_af(afb, r32, hi, af);
        asm volatile("s_waitcnt lgkmcnt(0)" ::: "memory");
    }
#pragma unroll 1
    for (int tt = 0; tt < ntile; ++tt) {
        const int ti = REV ? ntile - 1 - tt : tt;
        const bool more = tt + 1 < ntile;
        if (more) lru_dma_af(XC, row0 + 32 * (REV ? ti - 1 : ti + 1), g, lane, afb);
        const size_t t0 = row0 + 32 * ti;
        bf16_t grw[16];
        if (MODE == 2) { const bf16_t* gp = WSP(bf16_t, WS_BIG) + t0 * NIN0 + 2048 + 64 * g + 32 * half;
            const unsigned lo_ = (unsigned)(4 * hi * NIN0 + r32);
#pragma unroll
            for (int i = 0; i < 16; ++i) grw[i] = gp[lo_ + (unsigned)(((i & 3) + 8 * (i >> 2)) * NIN0)]; }
        float a[16], bb[16], h[16];
        lru_gates(af, W, half, I0, I1, a, bb);
        lru_scan_tile<REV, MODE != 0>(a, bb, hi, H, h, ap);
        asm volatile("s_waitcnt vmcnt(0)" ::: "memory");
        if (more) lru_read_af(afb, r32, hi, af);
        if (MODE == 1) {
#pragma unroll
            for (int p = 0; p < 8; ++p) HFL[(ti * 8 + p) * 64 + lane] = pk2(h[2 * p], h[2 * p + 1]);
        }
        if (MODE == 2) {
            bf16_t* op = WSP(bf16_t, WS_A2) + t0 * D + 512 + 64 * g + 32 * half;
            const unsigned so_ = (unsigned)(4 * hi * D + r32);
#pragma unroll
            for (int p = 0; p < 8; ++p) { const unsigned hf = HFL[(ti * 8 + p) * 64 + lane];
                const unsigned pr_ = pk2((bflo(hf) + h[2 * p]) * gelu_tanh(bf1(grw[2 * p])), (bfhi(hf) + h[2 * p + 1]) * gelu_tanh(bf1(grw[2 * p + 1])));
                op[so_ + (unsigned)((((2 * p) & 3) + 8 * ((2 * p) >> 2)) * D)] = (bf16_t)(pr_ & 0xffffu);
                op[so_ + (unsigned)((((2 * p + 1) & 3) + 8 * ((2 * p + 1) >> 2)) * D)] = (bf16_t)(pr_ >> 16); }
        }
        asm volatile("s_waitcnt lgkmcnt(0)" ::: "memory");
    }
    asm volatile("" ::: "memory");
}
template <bool REV> __device__ __forceinline__ void lru_subpass0(Frame& F, size_t row0, int ntile, int g, int half, float& H, float& ap) {
    const bf16_t* XC = WSP(bf16_t, WS_XCONV);
    const int lane = F.lane, r32 = lane & 31, hi = lane >> 5;
    LAS unsigned char* buf0 = F.lds + LRU_AF + F.wave * 4096; LAS unsigned char* buf1 = F.lds + LRU_HF + 8192 + F.wave * 4096;
    bf16x8 I0, I1; lru_ident(r32, hi, I0, I1);
    LruW W; lru_load_w(F, W, REV ? 1 : 0, half, lane);
    bf16x8 af[4];
#define LRU0_ROW(tt) (row0 + 32 * (REV ? ntile - 1 - (tt) : (tt)))
    lru_dma_af(XC, LRU0_ROW(0), g, lane, buf0);
    if (ntile > 1) { lru_dma_af(XC, LRU0_ROW(1), g, lane, buf1); asm volatile("s_waitcnt vmcnt(4)" ::: "memory"); } else asm volatile("s_waitcnt vmcnt(0)" ::: "memory");
    lru_read_af(buf0, r32, hi, af);
    asm volatile("s_waitcnt lgkmcnt(0)" ::: "memory");
#pragma unroll 1
    for (int tt = 0; tt < ntile; ++tt) {
        LAS unsigned char* bcur = (tt & 1) ? buf1 : buf0; LAS unsigned char* bnxt = (tt & 1) ? buf0 : buf1;
        if (tt + 2 < ntile) lru_dma_af(XC, LRU0_ROW(tt + 2), g, lane, bcur);
        float a[16], bb[16], h[16];
        lru_gates(af, W, half, I0, I1, a, bb);
        lru_scan_tile<REV, false>(a, bb, hi, H, h, ap);
        if (tt + 1 < ntile) {
            if (tt + 2 < ntile) asm volatile("s_waitcnt vmcnt(4)" ::: "memory"); else asm volatile("s_waitcnt vmcnt(0)" ::: "memory");
            lru_read_af(bnxt, r32, hi, af);
            asm volatile("s_waitcnt lgkmcnt(0)" ::: "memory");
        }
    }
#undef LRU0_ROW
    asm volatile("" ::: "memory");
}
__device__ __forceinline__ void conv4_local(Frame& F, size_t r0, int ngrp, size_t sbeg, size_t send, int g) {
    const bf16_t* QKV = WSP(bf16_t, WS_BIG); bf16_t* XC = WSP(bf16_t, WS_XCONV);
    const int lane = F.lane, rgrp = lane >> 3, cl = lane & 7, ch = 64 * g + 8 * cl;
    if (rgrp < ngrp) {
        const size_t row0 = r0 + 16 * rgrp;
        u32x4 raw[19];
#pragma unroll
        for (int i = 0; i < 19; ++i) { const size_t r = row0 + i - 2; raw[i] = (r >= sbeg && r < send) ? *(const u32x4*)(QKV + r * NIN0 + 1536 + ch) : (u32x4){0u, 0u, 0u, 0u}; }
        float w[4][8], bs[8];
#pragma unroll
        for (int j = 0; j < 4; ++j) { const f32x4 a = *(const f32x4*)(F.in[I_ECW] + j * 512 + ch), b = *(const f32x4*)(F.in[I_ECW] + j * 512 + ch + 4);
            w[j][0] = a.x; w[j][1] = a.y; w[j][2] = a.z; w[j][3] = a.w; w[j][4] = b.x; w[j][5] = b.y; w[j][6] = b.z; w[j][7] = b.w; }
        { const f32x4 a = *(const f32x4*)(F.in[I_ECB] + ch), b = *(const f32x4*)(F.in[I_ECB] + ch + 4); bs[0] = a.x; bs[1] = a.y; bs[2] = a.z; bs[3] = a.w; bs[4] = b.x; bs[5] = b.y; bs[6] = b.z; bs[7] = b.w; }
#pragma unroll
        for (int t = 0; t < 16; ++t) {
            float o[8];
#pragma unroll
            for (int e = 0; e < 8; ++e) o[e] = bs[e];
#pragma unroll
            for (int j = 0; j < 4; ++j) { const u32x4 r = raw[t + j];
                o[0] += w[j][0] * bflo(r.x); o[1] += w[j][1] * bfhi(r.x); o[2] += w[j][2] * bflo(r.y); o[3] += w[j][3] * bfhi(r.y);
                o[4] += w[j][4] * bflo(r.z); o[5] += w[j][5] * bfhi(r.z); o[6] += w[j][6] * bflo(r.w); o[7] += w[j][7] * bfhi(r.w); }
            u32x4 pk; pk.x = pk2(o[0], o[1]); pk.y = pk2(o[2], o[3]); pk.z = pk2(o[4], o[5]); pk.w = pk2(o[6], o[7]);
            *(u32x4*)(XC + (row0 + t) * 512 + ch) = pk;
        }
    }
    asm volatile("s_waitcnt vmcnt(0)" ::: "memory");
}
template <bool REV> __device__ __forceinline__ void lru_subpass2(Frame& F, size_t row0, int ntile, int g, float (&H)[2], float (&ap)[2]) {
    const bf16_t* XC = WSP(bf16_t, WS_XCONV);
    const int lane = F.lane, r32 = lane & 31, hi = lane >> 5;
    LAS unsigned char* afb = F.lds + LRU_AF + F.wave * 4096;
    bf16x8 I0, I1; lru_ident(r32, hi, I0, I1);
    LruW W0, W1; lru_load_w(F, W0, REV ? 1 : 0, 0, lane); lru_load_w(F, W1, REV ? 1 : 0, 1, lane);
    bf16x8 af[4];
    lru_dma_af(XC, row0 + (REV ? 32 * (ntile - 1) : 0), g, lane, afb);
    asm volatile("s_waitcnt vmcnt(0)" ::: "memory");
    lru_read_af(afb, r32, hi, af);
    asm volatile("s_waitcnt lgkmcnt(0)" ::: "memory");
#pragma unroll 1
    for (int tt = 0; tt < ntile; ++tt) {
        const int ti = REV ? ntile - 1 - tt : tt;
        const bool more = tt + 1 < ntile;
        if (more) lru_dma_af(XC, row0 + 32 * (REV ? ti - 1 : ti + 1), g, lane, afb);
        float a0[16], b0[16], a1[16], b1[16], hd[16];
        lru_gates(af, W0, 0, I0, I1, a0, b0);
        lru_gates(af, W1, 1, I0, I1, a1, b1);
        lru_scan_tile<REV, false>(a0, b0, hi, H[0], hd, ap[0]);
        lru_scan_tile<REV, false>(a1, b1, hi, H[1], hd, ap[1]);
        asm volatile("s_waitcnt vmcnt(0)" ::: "memory");
        if (more) lru_read_af(afb, r32, hi, af);
        asm volatile("s_waitcnt lgkmcnt(0)" ::: "memory");
    }
    asm volatile("" ::: "memory");
}
__device__ __forceinline__ void lru_pass1_wg(Frame& F, int wg) {
    const int j = wg & 15, g = (wg >> 4) & 7, b = wg >> 7, w = F.wave, lane = F.lane, hi = lane >> 5;
    f32x2* TOT = WSP(f32x2, WS_TOT); f32x2* TOTG = WSP(f32x2, WS_TOTG); f32x2* TOTC = WSP(f32x2, WS_TOTC);
    LAS f32x2* CB = (LAS f32x2*)(F.lds + LRU_HF);
    lru_stage_w(F, g);
    const int c = 8 * j + w, sub = w - 2;
    const int njobs = (w == 2 || w == 4) ? 2 : 1;
    if (njobs == 2) __builtin_amdgcn_s_setprio(1);
#pragma unroll 1
    for (int job = 0; job < njobs; ++job) {
        const size_t r0 = job == 0 ? (size_t)b * SEQ + (size_t)c * CHUNK : (size_t)ML + (size_t)b * NCTX + 32 * (j & 7);
        const int nt = job == 0 ? 4 : 1;
        { const size_t sb_ = job == 0 ? (size_t)b * SEQ : (size_t)ML + (size_t)b * NCTX, se_ = job == 0 ? sb_ + SEQ : sb_ + NCTX;
          asm volatile("" ::: "memory"); __builtin_amdgcn_sched_barrier(0);
          conv4_local(F, r0, job == 0 ? 8 : 2, sb_, se_, g);
          asm volatile("" ::: "memory"); __builtin_amdgcn_sched_barrier(0); }
        f32x2 tot[2] = {(f32x2){1.f, 0.f}, (f32x2){1.f, 0.f}};
#pragma unroll 1
        for (int half = 0; half < 2; ++half) {
            if (job != 0 && half != (j >> 3)) continue;
            if (job == 0 || sub < 2) { float H = 0.f, ap = 1.f; lru_subpass0<false>(F, r0, nt, g, half, H, ap); if (hi == half) tot[0] = (f32x2){ap, H}; }
            if (job == 0 || sub >= 2) { float H = 0.f, ap = 1.f; lru_subpass0<true>(F, r0, nt, g, half, H, ap); if (hi == half) tot[1] = (f32x2){ap, H}; }
        }
        if (job == 0) {
#pragma unroll
            for (int d = 0; d < 2; ++d) { st8_wt(&TOT[(size_t)((b * 2 + d) * NCHUNK + c) * 512 + 64 * g + lane], tot[d]); CB[(d * 8 + w) * 64 + lane] = tot[d]; }
        } else {
            if (hi == (j >> 3)) st8_wt(&TOTC[(size_t)((b * 2 + (sub >> 1)) * 8 + (j & 7)) * 512 + 64 * g + lane], (sub >> 1) ? tot[1] : tot[0]);
        }
    }
    __builtin_amdgcn_s_setprio(0);
    __syncthreads();
    if (w < 2) { const int d = w; float A = 1.f, B = 0.f;
#pragma unroll
        for (int k = 0; k < 8; ++k) { const f32x2 t = CB[(d * 8 + (d == 0 ? k : 7 - k)) * 64 + lane]; B = t.x * B + t.y; A *= t.x; }
        st8_wt(&TOTG[(size_t)((b * 2 + d) * 16 + j) * 512 + 64 * g + lane], (f32x2){A, B}); }
    asm volatile("s_waitcnt vmcnt(0)" ::: "memory");
    __syncthreads();
    if (F.tid == 0) (void)__hip_atomic_fetch_add((unsigned*)(F.ws + WS_CTL) + CW_LRUG + 64 * (b * 8 + g), 1u, __ATOMIC_RELAXED, __HIP_MEMORY_SCOPE_AGENT);
}
__device__ __forceinline__ void lru_pass3_wg(Frame& F, int wg) {
    const int j = wg & 15, g = (wg >> 4) & 7, b = wg >> 7, w = F.wave, lane = F.lane, r32 = lane & 31;
    const f32x2* TOT = WSP(f32x2, WS_TOT); const f32x2* TOTG = WSP(f32x2, WS_TOTG); const f32x2* TOTC = WSP(f32x2, WS_TOTC);
    LAS unsigned* HFL = (LAS unsigned*)(F.lds + LRU_HF + w * 8192);
    if (F.tid == 0) { const unsigned* gc = (const unsigned*)(F.ws + WS_CTL) + CW_LRUG + 64 * (b * 8 + g); unsigned sp = 0;
        while (__hip_atomic_load(gc, __ATOMIC_RELAXED, __HIP_MEMORY_SCOPE_AGENT) < 16u) { __builtin_amdgcn_s_sleep(2); if (++sp > (1u << 22)) break; } }
    __syncthreads();
    const int c = 8 * j + w;
    const size_t row0 = (size_t)b * SEQ + (size_t)c * CHUNK;
    float Cf = 0.f, Cb = 0.f;
    {
        const f32x2 id = (f32x2){1.f, 0.f};
        const size_t chn = 64 * g + lane;
        f32x2 t[15];
#pragma unroll
        for (int k = 0; k < 8; ++k) t[k] = ld8_sc1(&TOTC[(size_t)((b * 2 + 0) * 8 + k) * 512 + chn]);
#pragma unroll
        for (int k = 0; k < 7; ++k) t[8 + k] = (k < w) ? ld8_sc1(&TOT[(size_t)((b * 2 + 0) * NCHUNK + 8 * j + k) * 512 + chn]) : id;
        f32x2 u[15];
#pragma unroll
        for (int k = 0; k < 15; ++k) u[k] = (k < j) ? ld8_sc1(&TOTG[(size_t)((b * 2 + 0) * 16 + k) * 512 + chn]) : id;
        f32x2 tb[15], ub[15];
#pragma unroll
        for (int k = 0; k < 8; ++k) tb[k] = ld8_sc1(&TOTC[(size_t)((b * 2 + 1) * 8 + (7 - k)) * 512 + chn]);
#pragma unroll
        for (int k = 0; k < 7; ++k) tb[8 + k] = (7 - k > w) ? ld8_sc1(&TOT[(size_t)((b * 2 + 1) * NCHUNK + 8 * j + (7 - k)) * 512 + chn]) : id;
#pragma unroll
        for (int k = 0; k < 15; ++k) ub[k] = (15 - k > j) ? ld8_sc1(&TOTG[(size_t)((b * 2 + 1) * 16 + (15 - k)) * 512 + chn]) : id;
        lru_stage_w(F, g);
#pragma unroll
        for (int k = 0; k < 8; ++k) Cf = t[k].x * Cf + t[k].y;
#pragma unroll
        for (int k = 0; k < 15; ++k) Cf = u[k].x * Cf + u[k].y;
#pragma unroll
        for (int k = 0; k < 7; ++k) Cf = t[8 + k].x * Cf + t[8 + k].y;
#pragma unroll
        for (int k = 0; k < 8; ++k) Cb = tb[k].x * Cb + tb[k].y;
#pragma unroll
        for (int k = 0; k < 15; ++k) Cb = ub[k].x * Cb + ub[k].y;
#pragma unroll
        for (int k = 0; k < 7; ++k) Cb = tb[8 + k].x * Cb + tb[8 + k].y;
        asm volatile("" ::: "memory");
    }
    float dummy = 1.f, H;
    bf16x8 af[4];
#pragma unroll 1
    for (int half = 0; half < 2; ++half) {
        H = __shfl(Cf, 32 * half + r32); lru_subpass<false, 1>(F, row0, 4, g, half, H, dummy, HFL, af, half != 0);
        H = __shfl(Cb, 32 * half + r32); lru_subpass<true, 2>(F, row0, 4, g, half, H, dummy, HFL, af, true);
    }
    LDS_WAIT();
    __syncthreads();
}

__device__ __forceinline__ void conv3_task(Frame& F, int task) {
    bf16_t* BG = WSP(bf16_t, WS_A1); const bf16_t* P = WSP(bf16_t, WS_A3);
    const int lane = F.lane, half = task & 1, row0 = (task >> 1) * 16, ch = half * 512 + 8 * lane;
    const int sbeg = (row0 / SEQ) * SEQ, send = sbeg + SEQ;
    u32x4 raw[18];
#pragma unroll
    for (int i = 0; i < 18; ++i) { const int r = row0 + i - 1; raw[i] = (r >= sbeg && r < send) ? *(const u32x4*)(P + (size_t)r * D + ch) : (u32x4){0u, 0u, 0u, 0u}; }
    u32x4 bgr[16];
#pragma unroll
    for (int t = 0; t < 16; ++t) bgr[t] = *(const u32x4*)(BG + (size_t)(row0 + t) * D + ch);
    float w[3][8];
#pragma unroll
    for (int j = 0; j < 3; ++j) { const f32x4 a = *(const f32x4*)(F.in[I_OCW] + j * D + ch), b = *(const f32x4*)(F.in[I_OCW] + j * D + ch + 4);
        w[j][0] = a.x; w[j][1] = a.y; w[j][2] = a.z; w[j][3] = a.w; w[j][4] = b.x; w[j][5] = b.y; w[j][6] = b.z; w[j][7] = b.w; }
#pragma unroll
    for (int t = 0; t < 16; ++t) {
        float o[8];
#pragma unroll
        for (int e = 0; e < 8; ++e) o[e] = 0.f;
#pragma unroll
        for (int j = 0; j < 3; ++j) { const u32x4 r = raw[t + j];
            o[0] += w[j][0] * bflo(r.x); o[1] += w[j][1] * bfhi(r.x); o[2] += w[j][2] * bflo(r.y); o[3] += w[j][3] * bfhi(r.y);
            o[4] += w[j][4] * bflo(r.z); o[5] += w[j][5] * bfhi(r.z); o[6] += w[j][6] * bflo(r.w); o[7] += w[j][7] * bfhi(r.w); }
        bf16_t* bp = BG + (size_t)(row0 + t) * D + ch;
        const u32x4 bgv = bgr[t];
        u32x4 pk; pk.x = pk2(o[0] * bflo(bgv.x), o[1] * bfhi(bgv.x)); pk.y = pk2(o[2] * bflo(bgv.y), o[3] * bfhi(bgv.y)); pk.z = pk2(o[4] * bflo(bgv.z), o[5] * bfhi(bgv.z)); pk.w = pk2(o[6] * bflo(bgv.w), o[7] * bfhi(bgv.w));
        st16_wt(bp, pk);
    }
}

__device__ __forceinline__ void final_row(Frame& F, int m) {
    f32x4* xr = (f32x4*)(F.out + (size_t)m * D) + F.lane;
    const float rs = fast_rsq(WSP(float, WS_SSQ)[3 * ML + m] * (1.f / D) + EPS);
    const f32x4* gp = (const f32x4*)F.in[I_FG] + F.lane;
#pragma unroll
    for (int j = 0; j < 4; ++j) { const f32x4 v = xr[64 * j], g = gp[64 * j]; xr[64 * j] = v * rs * g; }
}

__device__ __forceinline__ void ctx_proj_wg(Frame& F) {
    const int lane = F.lane, w = F.wave, r32 = lane & 31, hi = lane >> 5;
    const bf16_t* XB = WSP(bf16_t, WS_A1) + (size_t)ML * D;
    const bf16_t* W2 = WSP(bf16_t, WS_WIN0) + (size_t)2 * NIN0 * D;
    const float* ss = WSP(float, WS_SS0) + ML; const float* bias = WSP(float, WS_B_IN0) + (size_t)2 * NIN0;
    bf16_t* O = WSP(bf16_t, WS_BIG) + (size_t)ML * NIN0;
    LAS float* red = (LAS float*)F.lds;
    constexpr int NSTRIP = (NB * NCTX / 32) * (1536 / 96);
    for (int st = blockIdx.x; st < NSTRIP; st += (int)F.G) {
        const int rb = st >> 4, c0 = 512 + 96 * (st & 15);
        const bf16_t* ap = XB + (size_t)(32 * rb + r32) * D + 128 * w + 8 * hi;
        const bf16_t* bp = W2 + (size_t)(c0 + r32) * D + 128 * w + 8 * hi;
        bf16x8 a[8], b[3][8];
#pragma unroll
        for (int j = 0; j < 8; ++j) { a[j] = *(const bf16x8*)(ap + 16 * j);
#pragma unroll
            for (int t = 0; t < 3; ++t) b[t][j] = *(const bf16x8*)(bp + (size_t)(32 * t) * D + 16 * j); }
        f32x16 acc[3];
#pragma unroll
        for (int t = 0; t < 3; ++t) {
#pragma unroll
            for (int i = 0; i < 16; ++i) acc[t][i] = 0.f;
#pragma unroll
            for (int j = 0; j < 8; ++j) acc[t] = __builtin_amdgcn_mfma_f32_32x32x16_bf16(a[j], b[t][j], acc[t], 0, 0, 0);
#pragma unroll
            for (int i = 0; i < 16; ++i) red[((w * 3 + t) * 16 + i) * 64 + lane] = acc[t][i];
        }
        __syncthreads();
#pragma unroll
        for (int q = 0; q < 6; ++q) { const int p = w * 6 + q, t = p >> 4, i = p & 15, row = 32 * rb + crow(i, hi), col = c0 + 32 * t + r32;
            float v = 0.f;
#pragma unroll
            for (int k = 0; k < 8; ++k) v += red[((k * 3 + t) * 16 + i) * 64 + lane];
            v = v * fast_rsq(ss[row] * (1.f / D) + EPS) + bias[col];
            O[(size_t)row * NIN0 + col] = (bf16_t)f2bf(v); }
        __syncthreads();
    }
}

constexpr int PI_O = (D / 64) * (D / 32), PI_GU = (NGU / 32) * 16, PI_DN = (FF / 64) * (D / 32), PI_IN1 = (NIN1 / 32) * 16;
constexpr int PE0 = PI_O, PE1 = PE0 + PI_GU, PE2 = PE1 + PI_DN, PE3 = PE2 + PI_IN1, PE4 = PE3 + PI_O, PE5 = PE4 + PI_GU, L1_ITEMS = PE5 + PI_DN;
constexpr int PREP_SLICES = 9, PREP_PER = 1255;
__device__ __forceinline__ int prep_slice_begin(int k) { return PREP_PER * k; }
static_assert(2 * PREP_PER >= PE0 && 3 * PREP_PER >= PE1 && 4 * PREP_PER >= PE2 && 5 * PREP_PER >= PE3 && 7 * PREP_PER >= PE4 && 8 * PREP_PER >= PE5 && 9 * PREP_PER >= L1_ITEMS && PREP_PER <= 7 * 256, "prep deadlines");
__device__ __forceinline__ void prep_l1_item(Frame& F, int item) {
    LAS float* scr = (LAS float*)(F.lds + F.wave * 16384);
    const bool fold0 = item >= PE0 && item < PE1, fold_in1 = item >= PE2 && item < PE3, fold1 = item >= PE4 && item < PE5;
    if (fold0 || fold_in1 || fold1) {
        const bool gu = !fold_in1; const int l = fold0 ? 0 : 1;
        const int r = item - (fold0 ? PE0 : (fold_in1 ? PE2 : PE4)), ks = r & 15, n0 = (r >> 4) * 32;
        const int N = gu ? NGU : NIN1;
        fold_item<2>(gu ? F.in[I_WGU] + (size_t)l * D * NGU : F.in[I_OWIN], N, n0, gu ? gu_dst(n0) : in1_dst(n0), N, 64 * ks, 1.f, (gu ? F.in[I_N2G] : F.in[I_N1G]) + l * D, WSP(float, WS_MODS) + l * 3 * 6144,
                     gu ? 4096 : 1024, gu ? 3072 : 0, gu ? (l ? WSP(bf16_t, WS_WGU1) : WSP(bf16_t, WS_WGU0)) : WSP(bf16_t, WS_WIN1), gu ? (l ? WSP(float, WS_B_GU1) : WSP(float, WS_B_GU0)) : WSP(float, WS_B_IN1), scr, F.lane);
    } else {
        const int which = item < PE0 ? 0 : (item < PE2 ? 1 : (item < PE4 ? 2 : 3));
        const float* W = which == 0 ? F.in[I_EWOUT] : (which == 1 ? F.in[I_WDN] : (which == 2 ? F.in[I_OWOUT] : F.in[I_WDN] + (size_t)FF * D));
        bf16_t* WT = which == 0 ? WSP(bf16_t, WS_WOUT0) : (which == 1 ? WSP(bf16_t, WS_WDN0) : (which == 2 ? WSP(bf16_t, WS_WOUT1) : WSP(bf16_t, WS_WDN1)));
        p0_transpose_item(W, (which & 1) ? FF : D, D, WT, scr, which == 0 ? item : (which == 1 ? item - PE1 : (which == 2 ? item - PE3 : item - PE5)), F.lane);
    }
}
__device__ __forceinline__ void xcd_barrier_prep(const XcdBarrier& b, Frame& F, int slice) {
    asm volatile("s_waitcnt vmcnt(0)" ::: "memory");
    __syncthreads();
    if (F.wave == 0) {
        if (threadIdx.x == 0) {
            unsigned* bar = b.bar;
            __builtin_amdgcn_s_waitcnt(0);
            unsigned nloc = b.st[0], nx = b.st[1];
            if (nloc == 0u) { xcd_barrier_complete(bar, b.x, nloc, nx); b.st[0] = nloc; b.st[1] = nx; }
            const unsigned old = xb_add(&bar[XB_XSUB(b.x)], 1u);
            __builtin_amdgcn_fence(__ATOMIC_ACQUIRE, "agent");
            const unsigned gen = old / nloc;
            if (old + 1u == (gen + 1u) * nloc) {
                __builtin_amdgcn_fence(__ATOMIC_RELEASE, "agent");
                asm volatile("s_waitcnt vmcnt(0)" ::: "memory");
                const unsigned og = xb_add(&bar[XB_TOP], 1u);
                const unsigned tg = og / nx;
                if (og + 1u == (tg + 1u) * nx) {
#pragma unroll
                    for (unsigned j = 0; j < 16; ++j) xb_add(&bar[XB_XGEN(j)], 1u);
                } else XB_SPIN(xb_ld(&bar[XB_XGEN(b.x)]) == gen, bar);
                asm volatile("s_waitcnt vmcnt(0)" ::: "memory");
            } else {
                XB_SPIN(xb_ld(&bar[XB_XGEN(b.x)]) == gen, bar);
                asm volatile("s_waitcnt vmcnt(0)" ::: "memory");
            }
        }
    } else {
        const int w = (7 - F.wave) * (int)F.G + (int)blockIdx.x, item = prep_slice_begin(slice) + w;
        if (item < prep_slice_begin(slice + 1) && item < L1_ITEMS) prep_l1_item(F, item);
    }
    __syncthreads();
}

struct Args { const float* in[N_IN]; float* out; unsigned char* ws; int ph_lo, ph_hi; };
__global__ void __launch_bounds__(512, 2) dit_fwd(Args args) {
    extern __shared__ __attribute__((aligned(16))) unsigned char lds_raw[];
    Frame F;
    F.lds = (LAS unsigned char*)lds_raw;
    F.tid = threadIdx.x; F.lane = F.tid & 63; F.wave = __builtin_amdgcn_readfirstlane(F.tid >> 6);
    F.G = gridDim.x; F.gw = blockIdx.x * 8 + F.wave; F.NGW = F.G * 8;
#pragma unroll
    for (int i = 0; i < N_IN; ++i) F.in[i] = args.in[i];
    F.out = args.out; F.ws = args.ws;
    for (int u = F.tid; u < (LDS_BYTES - LDSCTL_OFF) / 4; u += 512) ((LAS unsigned*)(F.lds + LDSCTL_OFF))[u] = 0u;
    __syncthreads();
    volatile LAS unsigned* MISC = (volatile LAS unsigned*)(F.lds + MISC_OFF);
    XcdBarrier bar; bar.bar = (unsigned*)(F.ws + WS_CTL) + CW_BAR; bar.x = 0; bar.st = nullptr;
    const int lo = args.ph_lo, hi = args.ph_hi;
    if (hi - lo > 1) bar = xcd_barrier_post((unsigned*)(F.ws + WS_CTL) + CW_BAR, MISC + 8);
#ifdef ONLY_PHASE
#define IN(k) ((k) == ONLY_PHASE)
#else
#define IN(k) (lo <= (k) && (k) < hi)
#endif
#define SEAM(k) do { if (IN(k) && IN((k) + 1)) xcd_barrier(bar); } while (0)
#define SEAMP(k, sl) do { if (IN(k) && IN((k) + 1)) xcd_barrier_prep(bar, F, sl); } while (0)
    float* SSQ = WSP(float, WS_SSQ);
    const float* mods = WSP(float, WS_MODS);

    if (IN(0)) {
        unsigned* mt = (unsigned*)(F.ws + WS_CTL) + CW_MODS;
        for (int t = blockIdx.x; t < 192; t += F.G) {
            p0_mods_task(F, t);
            asm volatile("s_waitcnt vmcnt(0)" ::: "memory");
            __syncthreads();
            if (F.tid == 0) (void)__hip_atomic_fetch_add(mt, 1u, __ATOMIC_RELAXED, __HIP_MEMORY_SCOPE_AGENT);
        }
        phase_p0(F, 0, F.gw, F.NGW);
        if (F.tid == 0) { unsigned sp = 0; while (__hip_atomic_load(mt, __ATOMIC_RELAXED, __HIP_MEMORY_SCOPE_AGENT) < 192u) { __builtin_amdgcn_s_sleep(2); if (++sp > (1u << 22)) break; }
            __builtin_amdgcn_fence(__ATOMIC_ACQUIRE, "agent"); asm volatile("s_waitcnt vmcnt(0)" ::: "memory"); }
        __syncthreads();
        phase_p1(F, 0, F.wave * F.G + blockIdx.x, F.NGW);
    } SEAMP(0, 0);
    if (IN(2)) { for (int rep_ = 0; rep_ <= ((PROBE_REP_MASK >> 2) & 1); ++rep_) { if (rep_) xcd_barrier(bar);
        pg8::Gemm g{WSP(bf16_t, WS_A1), WSP(bf16_t, WS_WIN0), (long)NIN0 * D, (long)2 * NIN0 * D, D};
        pg8::Order S; S.init(ML / 256, NIN0 / 256, F.G, blockIdx.x);
        pg8::EpiInProj E{WSP(bf16_t, WS_BIG), WSP(float, WS_SS0), WSP(float, WS_B_IN0)};
        pg8::gemm_phase<pg8::EpiInProj, pg8::Order, true, true>(F.lds, g, S, E);
        __syncthreads();
        ctx_proj_wg(F);
    } } SEAMP(2, 1);
    if (IN(3)) { for (int rep_ = 0; rep_ <= ((PROBE_REP_MASK >> 3) & 1); ++rep_) { if (rep_) xcd_barrier(bar);
        for (int t = blockIdx.x; t < 256; t += F.G) lru_pass1_wg(F, t);
        __syncthreads();
        attn_phase(F);
        __syncthreads();
        for (int t = blockIdx.x; t < 256; t += F.G) lru_pass3_wg(F, t);
    } }
    SEAMP(5, 2);
    if (IN(6)) { for (int rep_ = 0; rep_ <= ((PROBE_REP_MASK >> 6) & 1); ++rep_) { if (rep_) xcd_barrier(bar);
        pg8::Gemm g{WSP(bf16_t, WS_A2), WSP(bf16_t, WS_WOUT0), 0l, 0l, D};
        pg8::Order S; S.init(ML / 256, D / 256, F.G, blockIdx.x);
        pg8::EpiRes<false, false> E{nullptr, WSP(bf16_t, WS_A1), WSP(bf16_t, WS_A3), nullptr, mods + 2048, SSQ, (unsigned)(uintptr_t)(F.lds + 132096)};
        pg8::gemm_phase<pg8::EpiRes<false, false>, pg8::Order, true, true>(F.lds, g, S, E);
    } } SEAMP(6, 3);
    if (IN(7)) { for (int rep_ = 0; rep_ <= ((PROBE_REP_MASK >> 7) & 1); ++rep_) { if (rep_) xcd_barrier(bar);
        pg8::Gemm g{WSP(bf16_t, WS_A3), WSP(bf16_t, WS_WGU0), (long)NGU * D, 0l, D};
        pg8::Order S; S.init(ML / 256, NGU / 256, F.G, blockIdx.x);
        pg8::EpiSwiGLU E{WSP(bf16_t, WS_BIG), SSQ, WSP(float, WS_B_GU0)};
        pg8::gemm_phase<pg8::EpiSwiGLU, pg8::Order, true, true>(F.lds, g, S, E);
    } } SEAMP(7, 4);
    if (IN(8)) { for (int rep_ = 0; rep_ <= ((PROBE_REP_MASK >> 8) & 1); ++rep_) { if (rep_) xcd_barrier(bar);
        pg8::Gemm g{WSP(bf16_t, WS_BIG), WSP(bf16_t, WS_WDN0), 0l, 0l, FF};
        pg8::Order S; S.init(ML / 256, D / 256, F.G, blockIdx.x);
        pg8::EpiRes<false, false> E{nullptr, WSP(bf16_t, WS_A3), WSP(bf16_t, WS_A2), nullptr, mods + 5120, SSQ + ML, (unsigned)(uintptr_t)(F.lds + 132096)};
        pg8::gemm_phase<pg8::EpiRes<false, false>, pg8::Order, true, true>(F.lds, g, S, E);
    } } SEAMP(8, 5);
    if (IN(9)) { for (int rep_ = 0; rep_ <= ((PROBE_REP_MASK >> 9) & 1); ++rep_) { if (rep_) xcd_barrier(bar);
        pg8::Gemm g{WSP(bf16_t, WS_A2), WSP(bf16_t, WS_WIN1), (long)NIN1 * D, 0l, D};
        pg8::Order S; S.init(ML / 256, 8, F.G, blockIdx.x); S.pn_off = 4;
        pg8::EpiScIn E{WSP(bf16_t, WS_A1), WSP(bf16_t, WS_A3), SSQ + ML, WSP(float, WS_B_IN1)};
        pg8::gemm_phase<pg8::EpiScIn, pg8::Order, true, true>(F.lds, g, S, E);
    } } SEAMP(9, 6);
    if (IN(10)) { for (int rep_ = 0; rep_ <= ((PROBE_REP_MASK >> 10) & 1); ++rep_) { if (rep_) xcd_barrier(bar);
        pg8::Gemm g{WSP(bf16_t, WS_A2), WSP(bf16_t, WS_WIN1), (long)NIN1 * D, 0l, D};
        pg8::Order S; S.init(ML / 256, 4, F.G, blockIdx.x);
        pg8::EpiScGate E{WSP(bf16_t, WS_A1), WSP(bf16_t, WS_A3), SSQ + ML, WSP(float, WS_B_IN1), F.in[I_OCW]};
        pg8::gemm_phase<pg8::EpiScGate, pg8::Order, true, true>(F.lds, g, S, E);
    } } SEAMP(10, 7);
    if (IN(11)) { for (int rep_ = 0; rep_ <= ((PROBE_REP_MASK >> 11) & 1); ++rep_) { if (rep_) xcd_barrier(bar);
        pg8::Gemm g{WSP(bf16_t, WS_A1), WSP(bf16_t, WS_WOUT1), 0l, 0l, D};
        pg8::Order S; S.init(ML / 256, D / 256, F.G, blockIdx.x);
        pg8::EpiRes<false, false> E{nullptr, WSP(bf16_t, WS_A2), WSP(bf16_t, WS_A3), nullptr, mods + 3 * 6144 + 2048, SSQ + 2 * ML, (unsigned)(uintptr_t)(F.lds + 132096)};
        pg8::gemm_phase<pg8::EpiRes<false, false>, pg8::Order, true, true>(F.lds, g, S, E);
    } } SEAMP(11, 8);
    if (IN(12)) { for (int rep_ = 0; rep_ <= ((PROBE_REP_MASK >> 12) & 1); ++rep_) { if (rep_) xcd_barrier(bar);
        pg8::Gemm g{WSP(bf16_t, WS_A3), WSP(bf16_t, WS_WGU1), (long)NGU * D, 0l, D};
        pg8::Order S; S.init(ML / 256, NGU / 256, F.G, blockIdx.x);
        pg8::EpiSwiGLU E{WSP(bf16_t, WS_BIG), SSQ + 2 * ML, WSP(float, WS_B_GU1)};
        pg8::gemm_phase<pg8::EpiSwiGLU, pg8::Order, true, true>(F.lds, g, S, E);
    } } SEAM(12);
    if (IN(13)) { for (int rep_ = 0; rep_ <= ((PROBE_REP_MASK >> 13) & 1); ++rep_) { if (rep_) xcd_barrier(bar);
        pg8::Gemm g{WSP(bf16_t, WS_BIG), WSP(bf16_t, WS_WDN1), 0l, 0l, FF};
        pg8::Order S; S.init(ML / 256, D / 256, F.G, blockIdx.x);
        pg8::EpiFinal E{WSP(bf16_t, WS_A3), F.out, mods + 3 * 6144 + 5120, SSQ + 3 * ML, (unsigned*)(F.ws + WS_CTL) + CW_PCNT, F.in[I_FG], (unsigned)(uintptr_t)(F.lds + 132096)};
        pg8::gemm_phase<pg8::EpiFinal, pg8::Order, true, true>(F.lds, g, S, E);
    } }
#undef IN
#undef SEAM
#undef SEAMP
}

extern "C" void kernel_launch(void* const* d_in, const int* in_sizes, int n_in, void* d_out, int out_size, void* d_ws, size_t ws_size, hipStream_t stream) {
    static int grid = 0;
    if (grid == 0) {
        if (n_in != N_IN || in_sizes[0] != ML * D || out_size != ML * D || ws_size < WS_END) { fprintf(stderr, "kernel_launch: unexpected shapes (n_in %d, in0 %d, out %d, ws %zu)\n", n_in, n_in > 0 ? in_sizes[0] : -1, out_size, ws_size); grid = -1; return; }
        int dev = 0, cus = 0;
        if (hipGetDevice(&dev) != hipSuccess || hipDeviceGetAttribute(&cus, hipDeviceAttributeMultiprocessorCount, dev) != hipSuccess) { grid = -1; return; }
        if (hipFuncSetAttribute((const void*)dit_fwd, hipFuncAttributeMaxDynamicSharedMemorySize, LDS_BYTES) != hipSuccess) { fprintf(stderr, "kernel_launch: hipFuncSetAttribute failed\n"); grid = -1; return; }
        int per_cu = 0;
        if (hipOccupancyMaxActiveBlocksPerMultiprocessor(&per_cu, (const void*)dit_fwd, 512, LDS_BYTES) != hipSuccess || per_cu < 1) fprintf(stderr, "kernel_launch: note: occupancy query reports %d\n", per_cu);
        (void)hipGetLastError();
        grid = cus;
    }
    if (grid < 0) return;
    if (hipMemsetAsync((char*)d_ws + WS_CTL, 0, CTL_ZERO_BYTES, stream) != hipSuccess) { fprintf(stderr, "kernel_launch: memset failed\n"); return; }
    Args a{};
    for (int i = 0; i < N_IN; ++i) a.in[i] = (const float*)d_in[i];
    a.out = (float*)d_out; a.ws = (unsigned char*)d_ws;
    constexpr int NPH = 14;
#if MK_PER_PHASE
    for (int p = 0; p < NPH; ++p) { a.ph_lo = p; a.ph_hi = p + 1; hipLaunchKernelGGL(dit_fwd, dim3(grid), dim3(512), LDS_BYTES, stream, a); }
#else
    a.ph_lo = 0; a.ph_hi = NPH;
    hipLaunchKernelGGL(dit_fwd, dim3(grid), dim3(512), LDS_BYTES, stream, a);
#endif
    const hipError_t le = hipPeekAtLastError();
    if (le != hipSuccess) fprintf(stderr, "kernel_launch: launch failed: %s\n", hipGetErrorName(le));
}
```

```cpp
#include <hip/hip_runtime.h>
#include <cstdio>
#include <cstdint>
#include <type_traits>

#ifndef PROBE_REP_MASK
#define PROBE_REP_MASK 0
#endif
#ifndef MK_PER_PHASE
#define MK_PER_PHASE 0
#endif

#define GAS __attribute__((address_space(1)))
#define LAS __attribute__((address_space(3)))
typedef unsigned short bf16_t;
typedef short bf16x8 __attribute__((ext_vector_type(8)));
typedef short s16x4 __attribute__((ext_vector_type(4)));
typedef float f32x4 __attribute__((ext_vector_type(4)));
typedef float f32x2 __attribute__((ext_vector_type(2)));
typedef float f32x16 __attribute__((ext_vector_type(16)));
typedef unsigned u32x4 __attribute__((ext_vector_type(4)));
typedef unsigned u32x2 __attribute__((ext_vector_type(2)));

constexpr int D = 1024, NB = 2, SEQ = 16384, ML = NB * SEQ, NCTX = 256, MC = NB * NCTX, MT = ML + MC;
constexpr int NIN0 = 2560, FF = 2816, NGU = 2 * FF, NIN1 = 3072;
constexpr int NCHUNK = 128, CHUNK = SEQ / NCHUNK  , NCI = NCHUNK + 2;
constexpr float EPS = 1e-6f;
constexpr float LOG2E = 1.4426950408889634f;
constexpr float QSCALE = 0.125f * LOG2E;
enum { I_X = 0, I_C, I_CTX, I_CCTX, I_MODW, I_MODB, I_N1G, I_N2G, I_WGU, I_WDN, I_EWIN, I_EWOUT, I_ECW, I_ECB, I_LWR, I_LBR, I_LWI, I_LBI, I_LAM, I_RPB, I_OWIN, I_OCW, I_OWOUT, I_FG, N_IN };

constexpr size_t MiB = 1u << 20;
constexpr size_t WS_CTL = 0, CTL_ZERO_BYTES = 1 * MiB + 160 * 1024;
constexpr size_t WS_SSQ = 256 * 1024;
constexpr size_t WS_B_IN0 = 768 * 1024;
constexpr size_t WS_B_GU0 = WS_B_IN0 + 3 * 2560 * 4;
constexpr size_t WS_B_IN1 = WS_B_GU0 + 2 * 5632 * 4;
constexpr size_t WS_B_GU1 = WS_B_IN1 + 2 * 3072 * 4;
static_assert(WS_B_GU1 + 2 * 5632 * 4 <= 1024 * 1024, "zeroed region");
constexpr size_t WS_MODS = 1 * MiB;
constexpr size_t WS_SS0 = WS_MODS + 160 * 1024;
constexpr size_t WS_BP_IN0 = WS_SS0 + 136 * 1024;
constexpr size_t WS_BP_GU0 = WS_BP_IN0 + 128 * 1024;
constexpr size_t WS_BP_IN1 = WS_BP_GU0 + 192 * 1024;
constexpr size_t WS_BP_GU1 = WS_BP_IN1 + 128 * 1024;
static_assert(WS_BP_GU1 + 192 * 1024 <= 4 * MiB, "small map");
constexpr size_t WS_TOT = 4 * MiB;
constexpr size_t WS_TOTG = 6 * MiB;
constexpr size_t WS_TOTC = 6 * MiB + 256 * 1024;
constexpr size_t WS_LRUW = 6 * MiB + 512 * 1024;
constexpr size_t WS_WIN0 = 8 * MiB;
constexpr size_t WS_WOUT0 = 23 * MiB;
constexpr size_t WS_WGU0 = 25 * MiB;
constexpr size_t WS_WDN0 = 47 * MiB;
constexpr size_t WS_WIN1 = 53 * MiB;
constexpr size_t WS_WOUT1 = 65 * MiB;
constexpr size_t WS_WGU1 = 67 * MiB;
constexpr size_t WS_WDN1 = 89 * MiB;
constexpr size_t WS_A1 = 96 * MiB;
constexpr size_t WS_A2 = 161 * MiB;
constexpr size_t WS_A3 = 225 * MiB;
constexpr size_t WS_BIG = 289 * MiB;
constexpr size_t WS_XCONV = 465 * MiB;
constexpr size_t WS_END = 498 * MiB;

constexpr int CW_BAR = 4096;
constexpr int CW_MODS = 3968;
constexpr int CW_LRUG = 16384 + 8192;
constexpr int CW_PCNT = 16384;

constexpr int RING_BYTES = 131072, LDS_BYTES = 163840, LDSCTL_OFF = LDS_BYTES - 1024, MISC_OFF = LDSCTL_OFF + 320;

#define LDS_WAIT() asm volatile("s_waitcnt lgkmcnt(0)" ::: "memory")
#define VM_WAIT() asm volatile("s_waitcnt vmcnt(0)" ::: "memory")
#define RLX_AGENT __ATOMIC_RELAXED, __HIP_MEMORY_SCOPE_AGENT
__device__ __forceinline__ unsigned pk2(float lo, float hi) { unsigned r; asm("v_cvt_pk_bf16_f32 %0, %1, %2" : "=v"(r) : "v"(lo), "v"(hi)); return r; }
__device__ __forceinline__ unsigned f2bf(float f) { return pk2(f, f) & 0xffffu; }
__device__ __forceinline__ float bflo(unsigned u) { return __builtin_bit_cast(float, u << 16); }
__device__ __forceinline__ float bfhi(unsigned u) { return __builtin_bit_cast(float, u & 0xffff0000u); }
__device__ __forceinline__ float bf1(bf16_t h) { return __builtin_bit_cast(float, (unsigned)h << 16); }
__device__ __forceinline__ float wave_sum(float v) {
#pragma unroll
    for (int o = 1; o < 64; o <<= 1) v += __shfl_xor(v, o);
    return v;
}
__device__ __forceinline__ float fast_rsq(float x) { return __builtin_amdgcn_rsqf(x); }
__device__ __forceinline__ float fast_exp2(float x) { return __builtin_amdgcn_exp2f(x); }
__device__ __forceinline__ float fast_rcp(float x) { return __builtin_amdgcn_rcpf(x); }
__device__ __forceinline__ float sigmoidf_(float x) { return fast_rcp(1.f + fast_exp2(-x * LOG2E)); }
__device__ __forceinline__ float siluf_(float x) { return x * sigmoidf_(x); }
__device__ __forceinline__ float gelu_tanh(float x) {
    constexpr float C1 = -2.f * 0.7978845608028654f * LOG2E, C2 = C1 * 0.044715f;
    const float t = x * (C1 + C2 * (x * x));
    return x * fast_rcp(1.f + fast_exp2(t));
}

__device__ __forceinline__ float sum_fq(float q) {
    const auto a = __builtin_amdgcn_permlane32_swap(__float_as_uint(q), __float_as_uint(q), false, false);
    const float s = __uint_as_float(a[0]) + __uint_as_float(a[1]);
    const auto b = __builtin_amdgcn_permlane16_swap(__float_as_uint(s), __float_as_uint(s), false, false);
    return __uint_as_float(b[0]) + __uint_as_float(b[1]);
}
__device__ __forceinline__ void st8_wt(void* p, f32x2 v) { asm volatile("global_store_dwordx2 %0, %1, off sc1\n\ts_nop 1" :: "v"(p), "v"(v) : "memory"); }
__device__ __forceinline__ f32x2 ld8_sc1(const f32x2* p) { const unsigned long long u = __hip_atomic_load((const unsigned long long*)p, __ATOMIC_RELAXED, __HIP_MEMORY_SCOPE_AGENT); return __builtin_bit_cast(f32x2, u); }
__device__ __forceinline__ void st16_wt(void* p, u32x4 v) { asm volatile("global_store_dwordx4 %0, %1, off sc1\n\ts_nop 1" :: "v"(p), "v"(v) : "memory"); }
namespace pg8 {
constexpr int BM = 256, BK = 64, HALF = 128, HTB = HALF * BK * 2, STAGE_BYTES = 8 * HTB, NXCD = 8, WGM = 8;
__host__ __device__ __forceinline__ int lds_byte(int r, int c) { const int st = (r >> 4) * 2 + (c >> 5), rr = r & 15, cc = c & 31, ob = rr * 64 + cc * 2; return st * 1024 + (ob ^ (((ob >> 9) & 1) << 5)); }
__host__ __device__ __forceinline__ void stage_rc(int b, int& R, int& C) { const int st = b / 1024, sb = b % 1024, swz = sb ^ (((sb >> 9) & 1) << 5); R = (st >> 1) * 16 + swz / 64; C = (st & 1) * 32 + (swz % 64) / 2; }
__host__ __device__ __forceinline__ int perm32(int rho) { const int n = rho >> 4, i = rho & 15; return 8 * (i >> 2) + 4 * n + (i & 3); }

struct Unit { int pm, pn; bool last; };
#define PG8_ST16(u_, ptr, w) do { if ((u_).last) st16_wt((ptr), (w)); else *(u32x4*)(ptr) = (w); } while (0)
struct Gemm { const bf16_t* A; const bf16_t* Bt; long boff1, boff2; int K; };
__device__ __forceinline__ const char* bsel(const bf16_t* Bt, long boff1, long boff2, const Unit& u) { const long o = u.pm < 64 ? 0l : (u.pm < 128 ? boff1 : boff2); return (const char*)(Bt + o); }

struct Order {
    int nM, nN, nwg, G, c, nextra, xpm0, xpn0, xnpn, pn_off = 0;
    __device__ void init(int nM_, int nN_, int G_, int c_, int nextra_ = 0, int xpm0_ = 0, int xpn0_ = 0, int xnpn_ = 1) { nM = nM_; nN = nN_; nwg = nM * nN; G = G_; c = c_; nextra = nextra_; xpm0 = xpm0_; xpn0 = xpn0_; xnpn = xnpn_; }
    __device__ bool next(int i, Unit& u) const {
        const long L = (long)i * G + c;
        if (L >= nwg) { const int e = (int)(L - nwg); if (e >= nextra) return false; u.pm = xpm0 + e / xnpn; u.pn = xpn0 + e % xnpn; return true; }
        int wgid = (int)L; { const int q = nwg / NXCD, r = nwg % NXCD, xcd = wgid % NXCD, off = wgid / NXCD; wgid = (xcd < r ? xcd * (q + 1) : r * (q + 1) + (xcd - r) * q) + off; }
        const int nig = WGM * nN, gid = wgid / nig, fm = gid * WGM, gsz = (nM - fm) < WGM ? (nM - fm) : WGM;
        u.pm = fm + ((wgid % nig) % gsz); u.pn = (wgid % nig) / gsz + pn_off; return true;
    }
};

__device__ __forceinline__ unsigned cvt_pk_bf16(float lo, float hi) { return pk2(lo, hi); }


struct EpiPre { f32x4 bv[2][2]; float ssr[2][4]; };
struct EpiInProj {
    static constexpr bool PERM = true; static constexpr bool IDEMP = true;
    typedef EpiPre Pre;
    bf16_t* O; const float* ss; const float* bias;
    __device__ __forceinline__ void prefetch(const Unit& u, int wr, int wc, int fr, int fq, Pre& p) const {
        const int row0 = u.pm * BM + wr * 64 + fr, col0 = u.pn * BM + wc * 32 + 8 * fq;
        const int v = u.pm < 64 ? 0 : (u.pm < 128 ? 1 : 2);
        const float* bp = bias + (size_t)v * NIN0 + col0;
#pragma unroll
        for (int bj = 0; bj < 2; ++bj)
#pragma unroll
            for (int n = 0; n < 2; ++n) p.bv[bj][n] = *(const f32x4*)(bp + bj * HALF + 4 * n);
#pragma unroll
        for (int ai = 0; ai < 2; ++ai)
#pragma unroll
            for (int m = 0; m < 4; ++m) p.ssr[ai][m] = ss[row0 + ai * HALF + m * 16];
    }
    __device__ __forceinline__ void operator()(const f32x4 (&acc)[2][2][4][2], const Unit& u, const Pre& p, int wr, int wc, int fr, int fq) const {
        const int row0 = u.pm * BM + wr * 64 + fr, col0 = u.pn * BM + wc * 32 + 8 * fq;
#pragma unroll
        for (int ai = 0; ai < 2; ++ai)
#pragma unroll
            for (int m = 0; m < 4; ++m) { const int row = row0 + ai * HALF + m * 16; const float rs = fast_rsq(p.ssr[ai][m] * (1.f / D) + EPS); bf16_t* rowp = O + (size_t)row * NIN0 + col0;
#pragma unroll
                for (int bj = 0; bj < 2; ++bj) { const f32x4 v0 = acc[ai][bj][m][0] * rs + p.bv[bj][0], v1 = acc[ai][bj][m][1] * rs + p.bv[bj][1];
                    u32x4 w; w.x = cvt_pk_bf16(v0[0], v0[1]); w.y = cvt_pk_bf16(v0[2], v0[3]); w.z = cvt_pk_bf16(v1[0], v1[1]); w.w = cvt_pk_bf16(v1[2], v1[3]);
                    PG8_ST16(u, rowp + bj * HALF, w); } }
    }
};

__device__ __forceinline__ void tile_row_ssq(const float (&qv)[2][4], unsigned Paddr, float* ssq_panel, int wr, int wc, int fr, int fq) {
    if (fq == 0) {
#pragma unroll
        for (int ai = 0; ai < 2; ++ai)
#pragma unroll
            for (int m = 0; m < 4; ++m) { const unsigned a_ = Paddr + (unsigned)(((ai * HALF + wr * 64 + m * 16 + fr) * 4 + wc) * 4); asm volatile("ds_write_b32 %0, %1" :: "v"(a_), "v"(qv[ai][m]) : "memory"); }
    }
    asm volatile("s_waitcnt lgkmcnt(0)" ::: "memory"); __builtin_amdgcn_s_barrier(); asm volatile("" ::: "memory");
    if (threadIdx.x < 256) { f32x4 v; const unsigned a_ = Paddr + threadIdx.x * 16u;
        asm volatile("ds_read_b128 %0, %1\n\ts_waitcnt lgkmcnt(0)" : "=v"(v) : "v"(a_) : "memory");
        unsafeAtomicAdd(ssq_panel + threadIdx.x, (v[0] + v[1]) + (v[2] + v[3])); }
}
struct EpiPreG { f32x4 gv[2][2]; };
template <bool RES_F32, bool OUT_F32> struct EpiRes {
    static constexpr bool PERM = true; static constexpr bool IDEMP = false;
    typedef EpiPreG Pre;
    const float* resf; const bf16_t* resb; bf16_t* Ob; float* Of; const float* gate; float* ssq; unsigned Paddr;
    __device__ __forceinline__ void prefetch(const Unit& u, int wr, int wc, int fr, int fq, Pre& p) const {
        const float* gp = gate + (size_t)(u.pm >> 6) * 6144 + u.pn * BM + wc * 32 + 8 * fq;
#pragma unroll
        for (int bj = 0; bj < 2; ++bj)
#pragma unroll
            for (int n = 0; n < 2; ++n) p.gv[bj][n] = *(const f32x4*)(gp + bj * HALF + 4 * n);
    }
    __device__ __forceinline__ void operator()(const f32x4 (&acc)[2][2][4][2], const Unit& u, const Pre& p, int wr, int wc, int fr, int fq) const {
        const int row0 = u.pm * BM + wr * 64 + fr, col0 = u.pn * BM + wc * 32 + 8 * fq;
        float qv[2][4];
#pragma unroll
        for (int ai = 0; ai < 2; ++ai) {
            f32x4 rf[RES_F32 ? 4 : 1][2][2]; u32x4 rb[1][RES_F32 ? 1 : 4][2];
#pragma unroll
            for (int m = 0; m < 4; ++m) { const size_t off = (size_t)(row0 + ai * HALF + m * 16) * D + col0;
#pragma unroll
                for (int bj = 0; bj < 2; ++bj) {
                    if constexpr (RES_F32) { rf[m][bj][0] = *(const f32x4*)(resf + off + bj * HALF); rf[m][bj][1] = *(const f32x4*)(resf + off + bj * HALF + 4); }
                    else rb[0][m][bj] = *(const u32x4*)(resb + off + bj * HALF); } }
#pragma unroll
            for (int m = 0; m < 4; ++m) { const int row = row0 + ai * HALF + m * 16; const size_t off = (size_t)row * D + col0; float q = 0.f;
#pragma unroll
                for (int bj = 0; bj < 2; ++bj) {
                    f32x4 r0, r1;
                    if constexpr (RES_F32) { r0 = rf[m][bj][0]; r1 = rf[m][bj][1]; }
                    else { const u32x4 t = rb[0][m][bj]; r0 = (f32x4){bflo(t.x), bfhi(t.x), bflo(t.y), bfhi(t.y)}; r1 = (f32x4){bflo(t.z), bfhi(t.z), bflo(t.w), bfhi(t.w)}; }
                    const f32x4 v0 = r0 + p.gv[bj][0] * acc[ai][bj][m][0], v1 = r1 + p.gv[bj][1] * acc[ai][bj][m][1];
                    q += (v0[0] * v0[0] + v0[1] * v0[1]) + (v0[2] * v0[2] + v0[3] * v0[3]) + (v1[0] * v1[0] + v1[1] * v1[1]) + (v1[2] * v1[2] + v1[3] * v1[3]);
                    if constexpr (OUT_F32) { *(f32x4*)(Of + off + bj * HALF) = v0; *(f32x4*)(Of + off + bj * HALF + 4) = v1; }
                    else { u32x4 w; w.x = cvt_pk_bf16(v0[0], v0[1]); w.y = cvt_pk_bf16(v0[2], v0[3]); w.z = cvt_pk_bf16(v1[0], v1[1]); w.w = cvt_pk_bf16(v1[2], v1[3]); PG8_ST16(u, Ob + off + bj * HALF, w); }
                }
                q = sum_fq(q);
                qv[ai][m] = q; }
        }
        tile_row_ssq(qv, Paddr, ssq + u.pm * BM, wr, wc, fr, fq);
    }
};

struct EpiFinal {
    static constexpr bool PERM = true; static constexpr bool IDEMP = false;
    typedef EpiPreG Pre;
    const bf16_t* resb; float* Of; const float* gate; float* ssq; unsigned* pcnt; const float* fg; unsigned Paddr;
    __device__ __forceinline__ void prefetch(const Unit& u, int wr, int wc, int fr, int fq, Pre& p) const {
        const float* gp = gate + (size_t)(u.pm >> 6) * 6144 + u.pn * BM + wc * 32 + 8 * fq;
#pragma unroll
        for (int bj = 0; bj < 2; ++bj)
#pragma unroll
            for (int n = 0; n < 2; ++n) p.gv[bj][n] = *(const f32x4*)(gp + bj * HALF + 4 * n);
    }
    __device__ __forceinline__ void operator()(f32x4 (&acc)[2][2][4][2], const Unit& u, const Pre& p, int wr, int wc, int fr, int fq) const {
        const int row0 = u.pm * BM + wr * 64 + fr, col0 = u.pn * BM + wc * 32 + 8 * fq;
        float qv[2][4];
#pragma unroll
        for (int ai = 0; ai < 2; ++ai) {
            u32x4 rb[4][2];
#pragma unroll
            for (int m = 0; m < 4; ++m) { const size_t off = (size_t)(row0 + ai * HALF + m * 16) * D + col0;
#pragma unroll
                for (int bj = 0; bj < 2; ++bj) rb[m][bj] = *(const u32x4*)(resb + off + bj * HALF); }
#pragma unroll
            for (int m = 0; m < 4; ++m) { const int row = row0 + ai * HALF + m * 16; float q = 0.f;
#pragma unroll
                for (int bj = 0; bj < 2; ++bj) {
                    const u32x4 t = rb[m][bj]; const f32x4 r0 = (f32x4){bflo(t.x), bfhi(t.x), bflo(t.y), bfhi(t.y)}, r1 = (f32x4){bflo(t.z), bfhi(t.z), bflo(t.w), bfhi(t.w)};
                    const f32x4 v0 = r0 + p.gv[bj][0] * acc[ai][bj][m][0], v1 = r1 + p.gv[bj][1] * acc[ai][bj][m][1];
                    q += (v0[0] * v0[0] + v0[1] * v0[1]) + (v0[2] * v0[2] + v0[3] * v0[3]) + (v1[0] * v1[0] + v1[1] * v1[1]) + (v1[2] * v1[2] + v1[3] * v1[3]);
                    acc[ai][bj][m][0] = v0; acc[ai][bj][m][1] = v1;
                }
                q = sum_fq(q);
                qv[ai][m] = q; }
        }
        tile_row_ssq(qv, Paddr, ssq + u.pm * BM, wr, wc, fr, fq);
        asm volatile("s_waitcnt vmcnt(0)" ::: "memory");
        __syncthreads();
        if (threadIdx.x == 0) {
            unsigned* pc = pcnt + 64 * u.pm;
            (void)__hip_atomic_fetch_add(pc, 1u, __ATOMIC_RELAXED, __HIP_MEMORY_SCOPE_AGENT);
            unsigned sp = 0;
            while (__hip_atomic_load(pc, __ATOMIC_RELAXED, __HIP_MEMORY_SCOPE_AGENT) < 4u) { __builtin_amdgcn_s_sleep(1); if (++sp > (1u << 22)) break; }
        }
        __syncthreads();
        f32x4 fv[2][2];
#pragma unroll
        for (int bj = 0; bj < 2; ++bj)
#pragma unroll
            for (int n = 0; n < 2; ++n) fv[bj][n] = *(const f32x4*)(fg + col0 + bj * HALF + 4 * n);
        float ssv[2][4];
#pragma unroll
        for (int ai = 0; ai < 2; ++ai)
#pragma unroll
            for (int m = 0; m < 4; ++m) ssv[ai][m] = __hip_atomic_load(ssq + row0 + ai * HALF + m * 16, __ATOMIC_RELAXED, __HIP_MEMORY_SCOPE_AGENT);
#pragma unroll
        for (int ai = 0; ai < 2; ++ai)
#pragma unroll
            for (int m = 0; m < 4; ++m) { const float rs = fast_rsq(ssv[ai][m] * (1.f / D) + EPS); const size_t off = (size_t)(row0 + ai * HALF + m * 16) * D + col0;
#pragma unroll
                for (int bj = 0; bj < 2; ++bj) { *(f32x4*)(Of + off + bj * HALF) = acc[ai][bj][m][0] * rs * fv[bj][0]; *(f32x4*)(Of + off + bj * HALF + 4) = acc[ai][bj][m][1] * rs * fv[bj][1]; } }
    }
};

struct EpiSwiGLU {
    static constexpr bool PERM = true; static constexpr bool IDEMP = true;
    typedef EpiPre Pre;
    bf16_t* O; const float* ss; const float* bias;
    __device__ __forceinline__ void prefetch(const Unit& u, int wr, int wc, int fr, int fq, Pre& p) const {
        const int row0 = u.pm * BM + wr * 64 + fr, colw = u.pn * BM + wc * 32 + 8 * fq;
        const float* bp = bias + (size_t)(u.pm >> 6) * NGU + colw;
#pragma unroll
        for (int bj = 0; bj < 2; ++bj)
#pragma unroll
            for (int n = 0; n < 2; ++n) p.bv[bj][n] = *(const f32x4*)(bp + bj * HALF + 4 * n);
#pragma unroll
        for (int ai = 0; ai < 2; ++ai)
#pragma unroll
            for (int m = 0; m < 4; ++m) p.ssr[ai][m] = ss[row0 + ai * HALF + m * 16];
    }
    __device__ __forceinline__ void operator()(const f32x4 (&acc)[2][2][4][2], const Unit& u, const Pre& p, int wr, int wc, int fr, int fq) const {
        const int row0 = u.pm * BM + wr * 64 + fr, colo = u.pn * HALF + wc * 32 + 8 * fq;
        f32x4 bg[2], bu[2];
#pragma unroll
        for (int n = 0; n < 2; ++n) { bg[n] = p.bv[0][n] * LOG2E; bu[n] = p.bv[1][n] * (1.f / LOG2E); }
#pragma unroll
        for (int ai = 0; ai < 2; ++ai)
#pragma unroll
            for (int m = 0; m < 4; ++m) { const int row = row0 + ai * HALF + m * 16; const float rs = fast_rsq(p.ssr[ai][m] * (1.f / D) + EPS), rsg = rs * LOG2E, rsu = rs * (1.f / LOG2E);
                f32x4 h[2];
#pragma unroll
                for (int n = 0; n < 2; ++n) {
                    const f32x4 G = acc[ai][0][m][n], U = acc[ai][1][m][n];
                    const f32x2 g0 = G.lo * rsg + bg[n].lo, g1 = G.hi * rsg + bg[n].hi, u0 = U.lo * rsu + bu[n].lo, u1 = U.hi * rsu + bu[n].hi;
                    f32x2 d0 = (f32x2){fast_exp2(-g0.x), fast_exp2(-g0.y)} + 1.f, d1 = (f32x2){fast_exp2(-g1.x), fast_exp2(-g1.y)} + 1.f;
                    const f32x2 r0 = (f32x2){fast_rcp(d0.x), fast_rcp(d0.y)}, r1 = (f32x2){fast_rcp(d1.x), fast_rcp(d1.y)};
                    const f32x2 h0 = (g0 * u0) * r0, h1 = (g1 * u1) * r1;
                    h[n] = (f32x4){h0.x, h0.y, h1.x, h1.y}; }
                u32x4 w; w.x = cvt_pk_bf16(h[0][0], h[0][1]); w.y = cvt_pk_bf16(h[0][2], h[0][3]); w.z = cvt_pk_bf16(h[1][0], h[1][1]); w.w = cvt_pk_bf16(h[1][2], h[1][3]);
                PG8_ST16(u, O + (size_t)row * FF + colo, w); }
    }
};

struct EpiScIn {
    static constexpr bool PERM = true; static constexpr bool IDEMP = true;
    typedef EpiPre Pre;
    bf16_t* BG; bf16_t* P; const float* ss; const float* bias;
    __device__ __forceinline__ void prefetch(const Unit& u, int wr, int wc, int fr, int fq, Pre& p) const {
        const int row0 = u.pm * BM + wr * 64 + fr, colw = u.pn * BM + wc * 32 + 8 * fq;
        const float* bp = bias + (size_t)(u.pm >> 6) * NIN1 + colw;
#pragma unroll
        for (int bj = 0; bj < 2; ++bj)
#pragma unroll
            for (int n = 0; n < 2; ++n) p.bv[bj][n] = *(const f32x4*)(bp + bj * HALF + 4 * n);
#pragma unroll
        for (int ai = 0; ai < 2; ++ai)
#pragma unroll
            for (int m = 0; m < 4; ++m) p.ssr[ai][m] = ss[row0 + ai * HALF + m * 16];
    }
    __device__ __forceinline__ void operator()(const f32x4 (&acc)[2][2][4][2], const Unit& u, const Pre& p, int wr, int wc, int fr, int fq) const {
        const int row0 = u.pm * BM + wr * 64 + fr, colw = u.pn * BM + wc * 32 + 8 * fq;
        if (u.pn < 4) {
#pragma unroll
            for (int ai = 0; ai < 2; ++ai)
#pragma unroll
                for (int m = 0; m < 4; ++m) { const int row = row0 + ai * HALF + m * 16; const float rs = fast_rsq(p.ssr[ai][m] * (1.f / D) + EPS); bf16_t* rowp = BG + (size_t)row * D + colw;
#pragma unroll
                    for (int bj = 0; bj < 2; ++bj) { const f32x4 v0 = acc[ai][bj][m][0] * rs + p.bv[bj][0], v1 = acc[ai][bj][m][1] * rs + p.bv[bj][1];
                        u32x4 w; w.x = cvt_pk_bf16(v0[0], v0[1]); w.y = cvt_pk_bf16(v0[2], v0[3]); w.z = cvt_pk_bf16(v1[0], v1[1]); w.w = cvt_pk_bf16(v1[2], v1[3]);
                        PG8_ST16(u, rowp + bj * HALF, w); } }
        } else {
            const int colo = (u.pn - 4) * HALF + wc * 32 + 8 * fq;
#pragma unroll
            for (int ai = 0; ai < 2; ++ai)
#pragma unroll
                for (int m = 0; m < 4; ++m) { const int row = row0 + ai * HALF + m * 16; const float rs = fast_rsq(p.ssr[ai][m] * (1.f / D) + EPS);
                    f32x4 h[2];
#pragma unroll
                    for (int n = 0; n < 2; ++n) { const f32x4 cgv = acc[ai][0][m][n] * rs + p.bv[0][n], xv = acc[ai][1][m][n] * rs + p.bv[1][n]; h[n] = cgv * xv; }
                    u32x4 w; w.x = cvt_pk_bf16(h[0][0], h[0][1]); w.y = cvt_pk_bf16(h[0][2], h[0][3]); w.z = cvt_pk_bf16(h[1][0], h[1][1]); w.w = cvt_pk_bf16(h[1][2], h[1][3]);
                    PG8_ST16(u, P + (size_t)row * D + colo, w); }
        }
    }
};
struct EpiScGate {
    static constexpr bool PERM = true; static constexpr bool IDEMP = true;
    typedef EpiPre Pre;
    bf16_t* Y; const bf16_t* P; const float* ss; const float* bias; const float* cw;
    __device__ __forceinline__ void prefetch(const Unit& u, int wr, int wc, int fr, int fq, Pre& p) const {
        const int row0 = u.pm * BM + wr * 64 + fr, colw = u.pn * BM + wc * 32 + 8 * fq;
        const float* bp = bias + (size_t)(u.pm >> 6) * NIN1 + colw;
#pragma unroll
        for (int bj = 0; bj < 2; ++bj)
#pragma unroll
            for (int n = 0; n < 2; ++n) p.bv[bj][n] = *(const f32x4*)(bp + bj * HALF + 4 * n);
#pragma unroll
        for (int ai = 0; ai < 2; ++ai)
#pragma unroll
            for (int m = 0; m < 4; ++m) p.ssr[ai][m] = ss[row0 + ai * HALF + m * 16];
    }
    template <int AI, int BJ, int M0, int MC>
    __device__ __forceinline__ void batch(const f32x4 (&acc)[2][2][4][2], const Unit& u, const Pre& p, const f32x4 (&w)[3][2], int row0, int col, int sbeg, int send) const {
        u32x4 raw[MC][3];
#pragma unroll
        for (int mm = 0; mm < MC; ++mm)
#pragma unroll
            for (int j = 0; j < 3; ++j) { const int rr = row0 + AI * HALF + (M0 + mm) * 16 + j - 1;
                raw[mm][j] = (rr >= sbeg && rr < send) ? *(const u32x4*)(P + (size_t)rr * D + col) : (u32x4){0u, 0u, 0u, 0u}; }
        asm volatile("" ::: "memory"); __builtin_amdgcn_sched_barrier(0);
#pragma unroll
        for (int mm = 0; mm < MC; ++mm) { constexpr int dummy = 0; (void)dummy; const int m = M0 + mm; const int row = row0 + AI * HALF + m * 16; const float rs = fast_rsq(p.ssr[AI][m] * (1.f / D) + EPS);
            const f32x4 v0 = acc[AI][BJ][m][0] * rs + p.bv[BJ][0], v1 = acc[AI][BJ][m][1] * rs + p.bv[BJ][1];
            f32x4 c0 = (f32x4){0.f, 0.f, 0.f, 0.f}, c1 = c0;
#pragma unroll
            for (int j = 0; j < 3; ++j) { const u32x4 r = raw[mm][j];
                c0 += w[j][0] * (f32x4){bflo(r.x), bfhi(r.x), bflo(r.y), bfhi(r.y)}; c1 += w[j][1] * (f32x4){bflo(r.z), bfhi(r.z), bflo(r.w), bfhi(r.w)}; }
            const f32x4 y0 = v0 * c0, y1 = v1 * c1;
            u32x4 o; o.x = cvt_pk_bf16(y0[0], y0[1]); o.y = cvt_pk_bf16(y0[2], y0[3]); o.z = cvt_pk_bf16(y1[0], y1[1]); o.w = cvt_pk_bf16(y1[2], y1[3]);
            PG8_ST16(u, Y + (size_t)row * D + col, o); }
        asm volatile("" ::: "memory"); __builtin_amdgcn_sched_barrier(0);
    }
    __device__ __forceinline__ void operator()(const f32x4 (&acc)[2][2][4][2], const Unit& u, const Pre& p, int wr, int wc, int fr, int fq) const {
        const int row0 = u.pm * BM + wr * 64 + fr, colw = u.pn * BM + wc * 32 + 8 * fq;
        const int sbeg = (u.pm * BM / SEQ) * SEQ, send = sbeg + SEQ;
        { const int col = colw; f32x4 w[3][2];
#pragma unroll
          for (int j = 0; j < 3; ++j) { w[j][0] = *(const f32x4*)(cw + j * D + col); w[j][1] = *(const f32x4*)(cw + j * D + col + 4); }
          batch<0, 0, 0, 2>(acc, u, p, w, row0, col, sbeg, send); batch<0, 0, 2, 2>(acc, u, p, w, row0, col, sbeg, send);
          batch<1, 0, 0, 2>(acc, u, p, w, row0, col, sbeg, send); batch<1, 0, 2, 2>(acc, u, p, w, row0, col, sbeg, send); }
        { const int col = colw + HALF; f32x4 w[3][2];
#pragma unroll
          for (int j = 0; j < 3; ++j) { w[j][0] = *(const f32x4*)(cw + j * D + col); w[j][1] = *(const f32x4*)(cw + j * D + col + 4); }
          batch<0, 1, 0, 4>(acc, u, p, w, row0, col, sbeg, send); batch<1, 1, 0, 4>(acc, u, p, w, row0, col, sbeg, send); }
    }
};

template <class Epi, class Sched, bool ALIGN_EPI = false, bool SP2 = false>
__device__ __forceinline__ void gemm_phase(LAS unsigned char* lds, const Gemm g, const Sched& S, const Epi& E) {
    const int tid = threadIdx.x, wid = __builtin_amdgcn_readfirstlane(tid >> 6), lane = tid & 63, wr = wid >> 2, wc = wid & 3, fr = lane & 15, fq = lane >> 4;
    const int K = g.K, nt = K / BK;
    unsigned voffA[2], voffB[2];
#pragma unroll
    for (int i = 0; i < 2; ++i) { const int b_ = tid * 16 + i * 8192; const int R = b_ >> 7, C = 8 * (((b_ >> 4) & 7) ^ ((R >> 1) & 7)); const int Rb = Epi::PERM ? ((R & ~31) + perm32(R & 31)) : R;
        voffA[i] = (unsigned)(R * K + C) * 2u; voffB[i] = (unsigned)(Rb * K + C) * 2u; }
    const size_t kstep = (size_t)(BK * 2);
    const size_t hstep = (size_t)HALF * K * 2;
    const size_t tstep = 2 * hstep;
    const unsigned ldsw = (unsigned)wid * 1024u;
    int aoffk[2], boffk[2];
#pragma unroll
    for (int k = 0; k < 2; ++k) { const int sw = ((4 * k + fq) ^ ((fr >> 1) & 7)) << 4; aoffk[k] = (wr * 64 + fr) * 128 + sw; boffk[k] = (wc * 32 + fr) * 128 + sw; }
#define PG8_SA(b, h) (((b) * 2 + (h)) * HTB)
#define PG8_SB(b, h) ((4 + (b) * 2 + (h)) * HTB)
#define PG8_STAGE(bufoff, gbase, voff) do { _Pragma("unroll") for (int _i = 0; _i < 2; ++_i) \
        __builtin_amdgcn_global_load_lds((const unsigned*)((const char*)(gbase) + (voff)[_i]), (LAS unsigned*)(lds + (bufoff) + ldsw + _i * 8192), 16, 0, 0); } while (0)
#define PG8_LDA(dst, b, h) do { _Pragma("unroll") for (int m = 0; m < 4; ++m) _Pragma("unroll") for (int k = 0; k < 2; ++k) dst[m][k] = *(const LAS bf16x8*)(lds + PG8_SA(b, h) + aoffk[k] + m * 2048); } while (0)
#define PG8_LDB(dst, b, h) do { _Pragma("unroll") for (int n = 0; n < 2; ++n) _Pragma("unroll") for (int k = 0; k < 2; ++k) dst[n][k] = *(const LAS bf16x8*)(lds + PG8_SB(b, h) + boffk[k] + n * 2048); } while (0)
#define PG8_MMA(ai, bj, At, Bt) do { __builtin_amdgcn_s_setprio(1); _Pragma("unroll") for (int m = 0; m < 4; ++m) _Pragma("unroll") for (int n = 0; n < 2; ++n) _Pragma("unroll") for (int k = 0; k < 2; ++k) \
        acc[ai][bj][m][n] = __builtin_amdgcn_mfma_f32_16x16x32_bf16(Bt[n][k], At[m][k], acc[ai][bj][m][n], 0, 0, 0); __builtin_amdgcn_s_setprio(0); } while (0)
#define PG8_WAIT_V(n) asm volatile("s_waitcnt vmcnt(" #n ")" ::: "memory")
#define PG8_WAIT_L(n) asm volatile("s_waitcnt lgkmcnt(" #n ")" ::: "memory")
#define PG8_BAR __builtin_amdgcn_s_barrier()
#define PG8_SCHED __builtin_amdgcn_sched_barrier(0)
    Unit cur, nxt; int ui = 0;
    if (!S.next(0, cur)) return;
    f32x4 acc[2][2][4][2];
#pragma unroll
    for (int a = 0; a < 2; ++a)
#pragma unroll
        for (int b = 0; b < 2; ++b)
#pragma unroll
            for (int m = 0; m < 4; ++m)
#pragma unroll
                for (int n = 0; n < 2; ++n) acc[a][b][m][n] = (f32x4){0.f, 0.f, 0.f, 0.f};
    bf16x8 At[4][2], B0[2][2], B1[2][2];
    typename Epi::Pre pre; E.prefetch(cur, wr, wc, fr, fq, pre);
    const char* cA = (const char*)g.A + (size_t)cur.pm * tstep; const bf16_t* gBt = g.Bt; const long gb1 = g.boff1, gb2 = g.boff2;
    const char* cB = bsel(gBt, gb1, gb2, cur) + (size_t)cur.pn * tstep;
    if constexpr (SP2) {
        PG8_STAGE(PG8_SB(0, 0), cB, voffB); PG8_STAGE(PG8_SB(0, 1), cB + hstep, voffB); PG8_STAGE(PG8_SA(0, 0), cA, voffA); PG8_STAGE(PG8_SA(0, 1), cA + hstep, voffA);
        if (wr == 1) PG8_BAR;
        PG8_WAIT_V(2); PG8_BAR;
        PG8_STAGE(PG8_SB(1, 0), cB + kstep, voffB); PG8_STAGE(PG8_SA(1, 0), cA + kstep, voffA); PG8_STAGE(PG8_SB(1, 1), cB + hstep + kstep, voffB);
        PG8_WAIT_V(6); PG8_BAR;
    } else {
        PG8_STAGE(PG8_SB(0, 0), cB, voffB); PG8_STAGE(PG8_SA(0, 0), cA, voffA); PG8_STAGE(PG8_SB(0, 1), cB + hstep, voffB); PG8_STAGE(PG8_SA(0, 1), cA + hstep, voffA);
        if (wr == 1) PG8_BAR;
        PG8_WAIT_V(4); PG8_BAR;
        PG8_STAGE(PG8_SB(1, 0), cB + kstep, voffB); PG8_STAGE(PG8_SA(1, 0), cA + kstep, voffA); PG8_STAGE(PG8_SB(1, 1), cB + hstep + kstep, voffB);
        PG8_WAIT_V(6); PG8_BAR;
    }
    for (;;) {
        const bool has_next = S.next(ui + 1, nxt);
        cur.last = !has_next;
        const char* nA = has_next ? (const char*)g.A + (size_t)nxt.pm * tstep : cA; const char* nB = has_next ? bsel(gBt, gb1, gb2, nxt) + (size_t)nxt.pn * tstep : cB;
        for (int t = 0; t < nt; t += 2) {
            const bool last = (t == nt - 2);
            const char* a1 = cA + (size_t)(t + 1) * kstep;
            const char* a2 = last ? nA : cA + (size_t)(t + 2) * kstep; const char* b2 = last ? nB : cB + (size_t)(t + 2) * kstep;
            const char* a3 = a2 + kstep; const char* b3 = b2 + kstep;
            if constexpr (SP2) {
            PG8_LDB(B0, 0, 0); PG8_LDB(B1, 0, 1); PG8_SCHED; PG8_LDA(At, 0, 0); PG8_STAGE(PG8_SA(1, 1), a1 + hstep, voffA);
            PG8_WAIT_V(8); PG8_WAIT_L(0); PG8_BAR; PG8_MMA(0, 0, At, B0); PG8_MMA(0, 1, At, B1); PG8_BAR; PG8_SCHED;
            PG8_LDA(At, 0, 1); PG8_STAGE(PG8_SB(0, 0), b2, voffB); PG8_STAGE(PG8_SB(0, 1), b2 + hstep, voffB); PG8_STAGE(PG8_SA(0, 0), a2, voffA);
            PG8_WAIT_V(8); PG8_WAIT_L(0); PG8_BAR; PG8_MMA(1, 0, At, B0); PG8_MMA(1, 1, At, B1); PG8_BAR; PG8_SCHED;
            PG8_LDB(B0, 1, 0); PG8_LDB(B1, 1, 1); PG8_SCHED; PG8_LDA(At, 1, 0); PG8_STAGE(PG8_SA(0, 1), a2 + hstep, voffA);
            PG8_WAIT_V(8); PG8_WAIT_L(0); PG8_BAR; PG8_MMA(0, 0, At, B0); PG8_MMA(0, 1, At, B1); PG8_BAR; PG8_SCHED;
            PG8_LDA(At, 1, 1); PG8_STAGE(PG8_SB(1, 0), b3, voffB); PG8_STAGE(PG8_SB(1, 1), b3 + hstep, voffB); PG8_STAGE(PG8_SA(1, 0), a3, voffA);
            PG8_WAIT_V(8); PG8_WAIT_L(0); PG8_BAR; PG8_MMA(1, 0, At, B0); PG8_MMA(1, 1, At, B1); PG8_BAR; PG8_SCHED;
            } else {
            PG8_LDB(B0, 0, 0); PG8_SCHED; PG8_LDA(At, 0, 0); PG8_STAGE(PG8_SA(1, 1), a1 + hstep, voffA);
            PG8_WAIT_L(8); PG8_BAR; PG8_WAIT_L(0); PG8_MMA(0, 0, At, B0); PG8_BAR; PG8_SCHED;
            PG8_LDB(B1, 0, 1); PG8_STAGE(PG8_SB(0, 0), b2, voffB);
            PG8_BAR; PG8_WAIT_L(0); PG8_MMA(0, 1, At, B1); PG8_BAR;
            PG8_LDA(At, 0, 1); PG8_STAGE(PG8_SA(0, 0), a2, voffA);
            PG8_BAR; PG8_WAIT_L(0); PG8_MMA(1, 0, At, B0); PG8_BAR; PG8_SCHED;
            PG8_STAGE(PG8_SB(0, 1), b2 + hstep, voffB);
            PG8_WAIT_V(6); PG8_BAR; PG8_MMA(1, 1, At, B1); PG8_BAR;
            PG8_LDB(B0, 1, 0); PG8_SCHED; PG8_LDA(At, 1, 0); PG8_STAGE(PG8_SA(0, 1), a2 + hstep, voffA);
            PG8_WAIT_L(8); PG8_BAR; PG8_WAIT_L(0); PG8_MMA(0, 0, At, B0); PG8_BAR; PG8_SCHED;
            PG8_LDB(B1, 1, 1); PG8_STAGE(PG8_SB(1, 0), b3, voffB);
            PG8_BAR; PG8_WAIT_L(0); PG8_MMA(0, 1, At, B1); PG8_BAR;
            PG8_LDA(At, 1, 1); PG8_STAGE(PG8_SA(1, 0), a3, voffA);
            PG8_BAR; PG8_WAIT_L(0); PG8_MMA(1, 0, At, B0); PG8_BAR; PG8_SCHED;
            PG8_STAGE(PG8_SB(1, 1), b3 + hstep, voffB);
            PG8_WAIT_V(6); PG8_BAR; PG8_MMA(1, 1, At, B1); PG8_BAR;
            }
        }
        if constexpr (ALIGN_EPI) { if (wr == 0) PG8_BAR; }
        E(acc, cur, pre, wr, wc, fr, fq);
#ifdef PROBE_EPI2
        if constexpr (Epi::IDEMP) { asm volatile("" ::: "memory"); E(acc, cur, pre, wr, wc, fr, fq); }
#endif
        if (!has_next) break;
        E.prefetch(nxt, wr, wc, fr, fq, pre);
        { bf16x8 zz;
#pragma unroll
          for (int j = 0; j < 8; ++j) zz[j] = 0;
          asm volatile("s_nop 3" : "+v"(zz));
#pragma unroll
          for (int b = 0; b < 2; ++b)
#pragma unroll
              for (int m = 0; m < 4; ++m)
#pragma unroll
                  for (int n = 0; n < 2; ++n) { asm volatile("v_mfma_f32_16x16x32_bf16 %0, %1, %1, 0" : "=&v"(acc[1][b][m][n]) : "v"(zz));
                      acc[0][b][m][n] = (f32x4){0.f, 0.f, 0.f, 0.f}; } }
        cur = nxt; cA = nA; cB = nB; ++ui;
        if constexpr (ALIGN_EPI) { if (wr == 1) PG8_BAR; }
    }
    PG8_WAIT_V(0);
    if constexpr (!ALIGN_EPI) { if (wr == 0) PG8_BAR; }
    PG8_BAR;
#undef PG8_SA
#undef PG8_SB
#undef PG8_STAGE
#undef PG8_LDA
#undef PG8_LDB
#undef PG8_MMA
#undef PG8_WAIT_V
#undef PG8_WAIT_L
#undef PG8_BAR
#undef PG8_SCHED
}
}

#define XB_TMO      128
#define XB_XCNT(j)  (256  + 64 * (j))
#define XB_XSUB(j)  (1280 + 64 * (j))
#define XB_XGEN(j)  (2304 + 64 * (j))
#define XB_TOP      3328
#define XB_TOPGEN   3392
#define XCD_BAR_WORDS 3456
#define XB_SPIN_CAP (1u << 18)
__device__ __forceinline__ unsigned xb_ld(unsigned* p)              { return __hip_atomic_load(p, __ATOMIC_RELAXED, __HIP_MEMORY_SCOPE_AGENT); }
__device__ __forceinline__ unsigned xb_add(unsigned* p, unsigned v) { return __hip_atomic_fetch_add(p, v, __ATOMIC_RELAXED, __HIP_MEMORY_SCOPE_AGENT); }
__device__ __forceinline__ unsigned xb_xcc_id() { return (unsigned)__builtin_amdgcn_s_getreg((3 << 11) | 20) & 0xFu; }
#define XB_SPIN(cond, bar) do { unsigned _sp = 0; while (cond) { __builtin_amdgcn_s_sleep(1); \
    if ((++_sp & 255u) == 0u) { if (xb_ld(&(bar)[XB_TMO])) break; if (_sp > XB_SPIN_CAP) { atomicAdd(&(bar)[XB_TMO], 1u); break; } } } } while (0)
struct XcdBarrier { unsigned* bar; unsigned x; volatile LAS unsigned* st; };
__device__ __forceinline__ XcdBarrier xcd_barrier_post(unsigned* bar, volatile LAS unsigned* st) {
    XcdBarrier b; b.bar = bar; b.x = xb_xcc_id(); b.st = st;
    if (threadIdx.x == 0) (void)xb_add(&bar[XB_XCNT(b.x)], 1u);
    return b;
}
__device__ __forceinline__ void xcd_barrier_complete(unsigned* bar, unsigned x, unsigned& nloc, unsigned& nx) {
    const unsigned G = gridDim.x * gridDim.y * gridDim.z;
    unsigned sum, cnt, mine, sp = 0u;
    for (;;) {
        sum = 0u; cnt = 0u; mine = 0u;
#pragma unroll
        for (unsigned j = 0; j < 16; ++j) { const unsigned c = xb_ld(&bar[XB_XCNT(j)]); sum += c; cnt += (c > 0u) ? 1u : 0u; mine = (j == x) ? c : mine; }
        if (sum == G) break;
        __builtin_amdgcn_s_sleep(1);
        if ((++sp & 255u) == 0u) { if (xb_ld(&bar[XB_TMO])) break; if (sp > XB_SPIN_CAP) { atomicAdd(&bar[XB_TMO], 1u); break; } }
    }
    nloc = mine > 0u ? mine : 1u; nx = cnt > 0u ? cnt : 1u;
}
__device__ __forceinline__ void xcd_barrier(const XcdBarrier& b) {
    asm volatile("s_waitcnt vmcnt(0)" ::: "memory");
    __syncthreads();
    if (threadIdx.x == 0) {
        unsigned* bar = b.bar;
        __builtin_amdgcn_s_waitcnt(0);
        unsigned nloc = b.st[0], nx = b.st[1];
        if (nloc == 0u) { xcd_barrier_complete(bar, b.x, nloc, nx); b.st[0] = nloc; b.st[1] = nx; }
        const unsigned old = xb_add(&bar[XB_XSUB(b.x)], 1u);
        __builtin_amdgcn_fence(__ATOMIC_ACQUIRE, "agent");
        const unsigned gen = old / nloc;
        if (old + 1u == (gen + 1u) * nloc) {
            __builtin_amdgcn_fence(__ATOMIC_RELEASE, "agent");
            asm volatile("s_waitcnt vmcnt(0)" ::: "memory");
            const unsigned og = xb_add(&bar[XB_TOP], 1u);
            const unsigned tg = og / nx;
            if (og + 1u == (tg + 1u) * nx) {
#pragma unroll
                for (unsigned j = 0; j < 16; ++j) xb_add(&bar[XB_XGEN(j)], 1u);
            } else XB_SPIN(xb_ld(&bar[XB_XGEN(b.x)]) == gen, bar);
            asm volatile("s_waitcnt vmcnt(0)" ::: "memory");
        } else {
            XB_SPIN(xb_ld(&bar[XB_XGEN(b.x)]) == gen, bar);
            asm volatile("s_waitcnt vmcnt(0)" ::: "memory");
        }
    }
    __syncthreads();
}

struct Frame {
    LAS unsigned char* lds;
    int tid, lane, wave, G, gw, NGW;
    const float* in[N_IN]; float* out; unsigned char* ws;
};
#define WSP(T, off) ((T*)(F.ws + (off)))

__device__ __forceinline__ void p0_transpose_item(const float* W, int K, int N, bf16_t* WT, LAS float* scr, int item, int lane) {
    const int nblk = N / 32, kb = item / nblk, nb = item % nblk, k0 = 64 * kb, n0 = 32 * nb;
    float val[32];
    { const float* wp = W + (size_t)(k0 + (lane >> 5)) * N + n0 + (lane & 31);
#pragma unroll
      for (int i = 0; i < 32; ++i) val[i] = wp[(size_t)(2 * i) * N]; }
#pragma unroll
    for (int i = 0; i < 32; ++i) scr[(2 * i + (lane >> 5)) * 33 + (lane & 31)] = val[i];
    LDS_WAIT(); asm volatile("" ::: "memory");
    const int c = lane & 7;
#pragma unroll
    for (int j = 0; j < 4; ++j) { const int n = (lane >> 3) + 8 * j; const LAS float* s = scr + (8 * c) * 33 + n;
        u32x4 o; o.x = pk2(s[0 * 33], s[1 * 33]); o.y = pk2(s[2 * 33], s[3 * 33]); o.z = pk2(s[4 * 33], s[5 * 33]); o.w = pk2(s[6 * 33], s[7 * 33]);
        st16_wt(WT + (size_t)(n0 + n) * K + k0 + 8 * c, o); }
    LDS_WAIT(); asm volatile("" ::: "memory");
}
__device__ __forceinline__ void row_to_bf16_ss(const float* xrow, bf16_t* orow, float* ssp, int lane) {
    const f32x4* xr = (const f32x4*)xrow + lane;
    f32x4 v[4]; float s = 0.f;
#pragma unroll
    for (int j = 0; j < 4; ++j) { v[j] = xr[64 * j]; s += (v[j].x * v[j].x + v[j].y * v[j].y) + (v[j].z * v[j].z + v[j].w * v[j].w); }
    s = wave_sum(s);
    u32x2* o8 = (u32x2*)orow + lane;
#pragma unroll
    for (int j = 0; j < 4; ++j) { u32x2 w; w.x = pk2(v[j].x, v[j].y); w.y = pk2(v[j].z, v[j].w); o8[64 * j] = w; }
    if (lane == 0) *ssp = s;
}
__device__ __forceinline__ void p0_mods_task(Frame& F, int task) {
    const int kh = task & 1, l = (task >> 1) / 48, n0 = ((task >> 1) % 48) * 128;
    LAS float* Sc = (LAS float*)F.lds;
    LAS float* R = (LAS float*)(F.lds + 16384);
    const float* c = F.in[I_C]; const float* cc = F.in[I_CCTX];
    for (int i = F.tid; i < 3 * 512; i += 512) { const int v = i >> 9, k = kh * 512 + (i & 511); const float cv = v == 0 ? c[k] : (v == 1 ? c[D + k] : cc[k]); Sc[i] = cv / (1.f + __expf(-cv)); }
    __syncthreads();
    float a[3][2] = {{0.f, 0.f}, {0.f, 0.f}, {0.f, 0.f}};
    const float* Wp = F.in[I_MODW] + (size_t)l * D * 6144 + (size_t)(kh * 512) * 6144 + n0 + 2 * F.lane;
    const int kb = F.wave * 64;
#pragma unroll 16
    for (int kk = 0; kk < 64; ++kk) { const int k = kb + kk; const f32x2 wv = *(const f32x2*)(Wp + (size_t)k * 6144);
#pragma unroll
        for (int v = 0; v < 3; ++v) { const float s = Sc[v * 512 + k]; a[v][0] += s * wv.x; a[v][1] += s * wv.y; } }
#pragma unroll
    for (int v = 0; v < 3; ++v) { R[(F.wave * 3 + v) * 128 + 2 * F.lane] = a[v][0]; R[(F.wave * 3 + v) * 128 + 2 * F.lane + 1] = a[v][1]; }
    __syncthreads();
    if (F.tid < 384) { const int v = F.tid >> 7, j = F.tid & 127; float s = kh == 0 ? F.in[I_MODB][l * 6144 + n0 + j] : 0.f;
#pragma unroll
        for (int w = 0; w < 8; ++w) s += R[(w * 3 + v) * 128 + j];
        unsafeAtomicAdd(WSP(float, WS_MODS) + (size_t)(l * 3 + v) * 6144 + n0 + j, s); }
    __syncthreads();
}
__device__ __forceinline__ void phase_p0(Frame& F, int part, int gw, int ngw) {
    LAS float* scr = (LAS float*)(F.lds + F.wave * 16384);
    if (part == 0) {
    bf16_t* XB = WSP(bf16_t, WS_A1); float* ss0 = WSP(float, WS_SS0);
    const int R1 = (F.G == 256) ? 3 * 64 * 8 : 0, R0 = MT - R1;
    for (int m = F.gw; m < R0; m += F.NGW) {
        const float* src = m < ML ? F.in[I_X] + (size_t)m * D : F.in[I_CTX] + (size_t)(m - ML) * D;
        row_to_bf16_ss(src, XB + (size_t)m * D, ss0 + m, F.lane);
    }
    if (R1 > 0 && blockIdx.x >= 192)
        for (int m = R0 + ((int)blockIdx.x - 192) * 8 + F.wave; m < MT; m += 64 * 8) {
            const float* src = m < ML ? F.in[I_X] + (size_t)m * D : F.in[I_CTX] + (size_t)(m - ML) * D;
            row_to_bf16_ss(src, XB + (size_t)m * D, ss0 + m, F.lane);
        }
    for (int idx = (int)((blockIdx.x + 64u) % (unsigned)F.G) * 512 + F.tid; idx < 2 * 8 * 2 * 2 * 4 * 64; idx += F.G * 512) {
        const int ln = idx & 63, s_ = (idx >> 6) & 3, half = (idx >> 8) & 1, gate = (idx >> 9) & 1, g_ = (idx >> 10) & 7, d_ = idx >> 13;
        const float* wsrc = (gate ? F.in[I_LWI] : F.in[I_LWR]) + (size_t)((d_ * 8 + g_) * 64 + 16 * s_ + 8 * (ln >> 5)) * 64 + 32 * half + (ln & 31);
        constexpr float NL = -LOG2E;
        u32x4 o; o.x = pk2(NL * wsrc[0], NL * wsrc[64]); o.y = pk2(NL * wsrc[128], NL * wsrc[192]); o.z = pk2(NL * wsrc[256], NL * wsrc[320]); o.w = pk2(NL * wsrc[384], NL * wsrc[448]);
        st16_wt(WSP(u32x4, WS_LRUW) + idx, o);
    }
    return; }
    constexpr int I_O = (D / 64) * (D / 32), I_DN = (FF / 64) * (D / 32);
    for (int it = gw; it < I_O; it += ngw) p0_transpose_item(F.in[I_EWOUT], D, D, WSP(bf16_t, WS_WOUT0), scr, it, F.lane);
}

template <int NV> __device__ __forceinline__ void fold_task(const float* W, int N, int n0, int dst0, int Nd, int kc, float cs, const float* gam, const float* mods_l, int sc_off, int sh_off,
                                                           bf16_t* WT, float* biasp, LAS float* scr, int lane) {
    LAS float* vec = scr + 2176;
    for (int i = lane; i < NV * 256; i += 64) { const int v = i >> 8, kk = i & 255, k = kc * 256 + kk;
        vec[i] = gam[k] * (1.f + mods_l[(size_t)v * 6144 + sc_off + k]) * cs; vec[768 + i] = mods_l[(size_t)v * 6144 + sh_off + k] * cs; }
    LDS_WAIT(); asm volatile("" ::: "memory");
    float bacc[NV];
#pragma unroll
    for (int v = 0; v < NV; ++v) bacc[v] = 0.f;
    for (int it = 0; it < 4; ++it) {
        const int k0 = kc * 256 + 64 * it;
        float val[32];
        { const float* wp = W + (size_t)(k0 + (lane >> 5)) * N + n0 + (lane & 31);
#pragma unroll
          for (int i = 0; i < 32; ++i) val[i] = wp[(size_t)(2 * i) * N]; }
#pragma unroll
        for (int i = 0; i < 32; ++i) { const int kk = 2 * i + (lane >> 5); scr[kk * 33 + (lane & 31)] = val[i];
#pragma unroll
            for (int v = 0; v < NV; ++v) bacc[v] += vec[768 + v * 256 + 64 * it + kk] * val[i]; }
        LDS_WAIT(); asm volatile("" ::: "memory");
        const int c = lane & 7;
#pragma unroll
        for (int j = 0; j < 4; ++j) { const int n = (lane >> 3) + 8 * j; const LAS float* s = scr + (8 * c) * 33 + n;
#pragma unroll
            for (int v = 0; v < NV; ++v) { const LAS float* sv = vec + v * 256 + 64 * it + 8 * c;
                u32x4 o; o.x = pk2(s[0 * 33] * sv[0], s[1 * 33] * sv[1]); o.y = pk2(s[2 * 33] * sv[2], s[3 * 33] * sv[3]); o.z = pk2(s[4 * 33] * sv[4], s[5 * 33] * sv[5]); o.w = pk2(s[6 * 33] * sv[6], s[7 * 33] * sv[7]);
                st16_wt(WT + (size_t)v * Nd * D + (size_t)(dst0 + n) * D + k0 + 8 * c, o); } }
        LDS_WAIT(); asm volatile("" ::: "memory");
    }
#pragma unroll
    for (int v = 0; v < NV; ++v) { float b = bacc[v]; b += __shfl_xor(b, 32); if (lane < 32) unsafeAtomicAdd(biasp + (size_t)v * Nd + dst0 + lane, b); }
}
template <int NV> __device__ __forceinline__ void fold_item(const float* W, int N, int n0, int dst0, int Nd, int k0, float cs, const float* gam, const float* mods_l, int sc_off, int sh_off,
                                                           bf16_t* WT, float* biasp, LAS float* scr, int lane) {
    LAS float* vec = scr + 2176;
    float val[32];
    { const float* wp = W + (size_t)(k0 + (lane >> 5)) * N + n0 + (lane & 31);
#pragma unroll
      for (int i = 0; i < 32; ++i) val[i] = wp[(size_t)(2 * i) * N]; }
    { const int k = k0 + lane; const float gk = gam[k] * cs;
#pragma unroll
      for (int v = 0; v < NV; ++v) { vec[v * 64 + lane] = gk * (1.f + mods_l[(size_t)v * 6144 + sc_off + k]); vec[192 + v * 64 + lane] = mods_l[(size_t)v * 6144 + sh_off + k] * cs; } }
#pragma unroll
    for (int i = 0; i < 32; ++i) scr[(2 * i + (lane >> 5)) * 33 + (lane & 31)] = val[i];
    LDS_WAIT(); asm volatile("" ::: "memory");
    float bacc[NV];
#pragma unroll
    for (int v = 0; v < NV; ++v) bacc[v] = 0.f;
#pragma unroll
    for (int i = 0; i < 32; ++i)
#pragma unroll
        for (int v = 0; v < NV; ++v) bacc[v] += vec[192 + v * 64 + 2 * i + (lane >> 5)] * val[i];
    const int c = lane & 7;
#pragma unroll
    for (int j = 0; j < 4; ++j) { const int n = (lane >> 3) + 8 * j; const LAS float* s = scr + (8 * c) * 33 + n;
#pragma unroll
        for (int v = 0; v < NV; ++v) { const LAS float* sv = vec + v * 64 + 8 * c;
            u32x4 o; o.x = pk2(s[0 * 33] * sv[0], s[1 * 33] * sv[1]); o.y = pk2(s[2 * 33] * sv[2], s[3 * 33] * sv[3]); o.z = pk2(s[4 * 33] * sv[4], s[5 * 33] * sv[5]); o.w = pk2(s[6 * 33] * sv[6], s[7 * 33] * sv[7]);
            st16_wt(WT + (size_t)v * Nd * D + (size_t)(dst0 + n) * D + k0 + 8 * c, o); } }
    LDS_WAIT(); asm volatile("" ::: "memory");
#pragma unroll
    for (int v = 0; v < NV; ++v) { float b = bacc[v]; b += __shfl_xor(b, 32); if (lane < 32) unsafeAtomicAdd(biasp + (size_t)v * Nd + dst0 + lane, b); }
}
__device__ __forceinline__ int gu_dst(int n) { return n < FF ? (n >> 7) * 256 + (n & 127) : ((n - FF) >> 7) * 256 + 128 + ((n - FF) & 127); }
__device__ __forceinline__ int in1_dst(int n) { if (n < 1024) return n; if (n < 2048) { const int q = n - 1024; return 1024 + (q >> 7) * 256 + (q & 127); } const int q = n - 2048; return 1024 + (q >> 7) * 256 + 128 + (q & 127); }
__device__ __forceinline__ void phase_p1(Frame& F, int part, int gw, int ngw) {
    LAS float* scr = (LAS float*)(F.lds + F.wave * 16384);
    const float* mods = WSP(float, WS_MODS);
    if (part == 0) {
        for (int it = gw; it < (NIN0 / 32) * 16; it += ngw) { const int ks = it & 15, n0 = (it >> 4) * 32;
            fold_item<3>(F.in[I_EWIN], NIN0, n0, n0, NIN0, 64 * ks, n0 < 512 ? QSCALE : 1.f, F.in[I_N1G], mods, 1024, 0, WSP(bf16_t, WS_WIN0), WSP(float, WS_B_IN0), scr, F.lane); }
    } else {
        for (int it = gw; it < (NGU / 32) * 16; it += ngw) { const int ks = it & 15, n0 = (it >> 4) * 32;
            fold_item<2>(F.in[I_WGU], NGU, n0, gu_dst(n0), NGU, 64 * ks, 1.f, F.in[I_N2G], mods, 4096, 3072, WSP(bf16_t, WS_WGU0), WSP(float, WS_B_GU0), scr, F.lane); }
    }
}

__device__ __forceinline__ void conv4_task(Frame& F, int task) {
    const bf16_t* QKV = WSP(bf16_t, WS_BIG); bf16_t* XC = WSP(bf16_t, WS_XCONV);
    const int row0 = task * 16, lane = F.lane;
    int sbeg, send;
    if (row0 < ML) { sbeg = (row0 / SEQ) * SEQ; send = sbeg + SEQ; } else { sbeg = ML + ((row0 - ML) / NCTX) * NCTX; send = sbeg + NCTX; }
    u32x4 raw[19];
#pragma unroll
    for (int i = 0; i < 19; ++i) { const int r = row0 + i - 2; raw[i] = (r >= sbeg && r < send) ? *(const u32x4*)(QKV + (size_t)r * NIN0 + 1536 + 8 * lane) : (u32x4){0u, 0u, 0u, 0u}; }
    float w[4][8], bs[8];
#pragma unroll
    for (int j = 0; j < 4; ++j) { const f32x4 a = *(const f32x4*)(F.in[I_ECW] + j * 512 + 8 * lane), b = *(const f32x4*)(F.in[I_ECW] + j * 512 + 8 * lane + 4);
        w[j][0] = a.x; w[j][1] = a.y; w[j][2] = a.z; w[j][3] = a.w; w[j][4] = b.x; w[j][5] = b.y; w[j][6] = b.z; w[j][7] = b.w; }
    { const f32x4 a = *(const f32x4*)(F.in[I_ECB] + 8 * lane), b = *(const f32x4*)(F.in[I_ECB] + 8 * lane + 4); bs[0] = a.x; bs[1] = a.y; bs[2] = a.z; bs[3] = a.w; bs[4] = b.x; bs[5] = b.y; bs[6] = b.z; bs[7] = b.w; }
#pragma unroll
    for (int t = 0; t < 16; ++t) {
        float o[8];
#pragma unroll
        for (int e = 0; e < 8; ++e) o[e] = bs[e];
#pragma unroll
        for (int j = 0; j < 4; ++j) { const u32x4 r = raw[t + j];
            o[0] += w[j][0] * bflo(r.x); o[1] += w[j][1] * bfhi(r.x); o[2] += w[j][2] * bflo(r.y); o[3] += w[j][3] * bfhi(r.y);
            o[4] += w[j][4] * bflo(r.z); o[5] += w[j][5] * bfhi(r.z); o[6] += w[j][6] * bflo(r.w); o[7] += w[j][7] * bfhi(r.w); }
        u32x4 pk; pk.x = pk2(o[0], o[1]); pk.y = pk2(o[2], o[3]); pk.z = pk2(o[4], o[5]); pk.w = pk2(o[6], o[7]);
        *(u32x4*)(XC + (size_t)(row0 + t) * 512 + 8 * lane) = pk;
    }
}

__device__ __forceinline__ int crow(int r, int hi) { return (r & 3) + 8 * (r >> 2) + 4 * hi; }
__device__ __forceinline__ void qkt(f32x16& p0, f32x16& p1, const bf16x8 (&b0)[4], const bf16x8 (&b1)[4], const bf16x8* qr, const f32x16& c0, const f32x16& c1) {
    p0 = __builtin_amdgcn_mfma_f32_32x32x16_bf16(b0[0], qr[0], c0, 0, 0, 0);
    p1 = __builtin_amdgcn_mfma_f32_32x32x16_bf16(b1[0], qr[0], c1, 0, 0, 0);
#pragma unroll
    for (int d0 = 1; d0 < 4; ++d0) {
        p0 = __builtin_amdgcn_mfma_f32_32x32x16_bf16(b0[d0], qr[d0], p0, 0, 0, 0);
        p1 = __builtin_amdgcn_mfma_f32_32x32x16_bf16(b1[d0], qr[d0], p1, 0, 0, 0);
    }
}
__device__ __forceinline__ void pv(f32x16* o, unsigned vb0, unsigned vb1, bf16x8 pa0, bf16x8 pa1, bf16x8 pa2, bf16x8 pa3, bool use0, bool use3) {
    s16x4 lo[2][4], hi[2][4];
#define PV_RD(ks) do { \
        lo[0][ks] = __builtin_amdgcn_ds_read_tr16_b64_v4i16((LAS s16x4*)(uintptr_t)(vb0 + (ks) * 2048)); \
        hi[0][ks] = __builtin_amdgcn_ds_read_tr16_b64_v4i16((LAS s16x4*)(uintptr_t)(vb0 + (ks) * 2048 + 1024)); \
        lo[1][ks] = __builtin_amdgcn_ds_read_tr16_b64_v4i16((LAS s16x4*)(uintptr_t)(vb1 + (ks) * 2048)); \
        hi[1][ks] = __builtin_amdgcn_ds_read_tr16_b64_v4i16((LAS s16x4*)(uintptr_t)(vb1 + (ks) * 2048 + 1024)); } while (0)
#define PK(d, k) (bf16x8){lo[d][k][0], lo[d][k][1], lo[d][k][2], lo[d][k][3], hi[d][k][0], hi[d][k][1], hi[d][k][2], hi[d][k][3]}
    PV_RD(1); PV_RD(2);
    if (use0) {
        PV_RD(0);
        asm volatile("s_waitcnt lgkmcnt(0)" ::: "memory");
        o[0] = __builtin_amdgcn_mfma_f32_32x32x16_bf16(PK(0, 0), pa0, o[0], 0, 0, 0);
        o[1] = __builtin_amdgcn_mfma_f32_32x32x16_bf16(PK(1, 0), pa0, o[1], 0, 0, 0);
    }
    if (use3) PV_RD(3);
    asm volatile("s_waitcnt lgkmcnt(0)" ::: "memory"); __builtin_amdgcn_sched_barrier(0);
    o[0] = __builtin_amdgcn_mfma_f32_32x32x16_bf16(PK(0, 1), pa1, o[0], 0, 0, 0);
    o[1] = __builtin_amdgcn_mfma_f32_32x32x16_bf16(PK(1, 1), pa1, o[1], 0, 0, 0);
    o[0] = __builtin_amdgcn_mfma_f32_32x32x16_bf16(PK(0, 2), pa2, o[0], 0, 0, 0);
    o[1] = __builtin_amdgcn_mfma_f32_32x32x16_bf16(PK(1, 2), pa2, o[1], 0, 0, 0);
    if (use3) {
        o[0] = __builtin_amdgcn_mfma_f32_32x32x16_bf16(PK(0, 3), pa3, o[0], 0, 0, 0);
        o[1] = __builtin_amdgcn_mfma_f32_32x32x16_bf16(PK(1, 3), pa3, o[1], 0, 0, 0);
    }
#undef PK
#undef PV_RD
}
__device__ __forceinline__ float max3f(float a, float b, float c) { float r; asm("v_max3_f32 %0, %1, %2, %3" : "=v"(r) : "v"(a), "v"(b), "v"(c)); return r; }
__device__ __forceinline__ float max2f(float a, float b) { float r; asm("v_max_f32 %0, %1, %2" : "=v"(r) : "v"(a), "v"(b)); return r; }
__device__ __forceinline__ float half_swap_max(float m) { auto rr = __builtin_amdgcn_permlane32_swap(__float_as_uint(m), __float_as_uint(m), false, false); return max2f(__uint_as_float(rr[0]), __uint_as_float(rr[1])); }
__device__ __forceinline__ float half_swap_sum(float m) { auto rr = __builtin_amdgcn_permlane32_swap(__float_as_uint(m), __float_as_uint(m), false, false); return __uint_as_float(rr[0]) + __uint_as_float(rr[1]); }

constexpr int AT_SLOT = 32768, AT_NSLOT = 3, AT_BIAS = AT_NSLOT * AT_SLOT, AT_WSF = AT_BIAS + 2 * 15 * 128 * 4, AT_QST = AT_WSF + 3072, AT_NTASK = NB * 128 * 4;
static_assert(AT_QST + 8 * 4096 <= LDSCTL_OFF, "attention LDS map");
constexpr float AT_THR = 8.f;
__device__ __forceinline__ void attn_phase(Frame& F) {
    const bf16_t* QKV = WSP(bf16_t, WS_BIG); bf16_t* MIX = WSP(bf16_t, WS_A2);
    const int lane = F.lane, w = F.wave, r32 = lane & 31, hi = lane >> 5;
    const int hsel = w >> 2, rsel = (w >> 1) & 1, qh = w & 1;
    LAS unsigned char* lds = F.lds;
    LAS float* BIAS = (LAS float*)(lds + AT_BIAS);
    LAS float* wsf = (LAS float*)(lds + AT_WSF) + w * 64;
    const int qc = 32 * qh + r32, cs = min(max(qc - 8, 0), 48);
    const int krow_ = 8 * w + (lane >> 3), kchunk_ = (lane & 7) ^ ((krow_ >> 1) & 7);
    int koff[4];
#pragma unroll
    for (int d0 = 0; d0 < 4; ++d0) koff[d0] = r32 * 128 + (((2 * d0 + hi) ^ ((r32 >> 1) & 7)) << 4);
    const unsigned ldsw = (unsigned)w * 1024u;
    unsigned vboff0, vboff1;
    { const int q_ = (lane & 15) >> 2, p_ = lane & 3, blk_ = (lane >> 4) & 1, fl_ = (q_ >> 1) << 2;
      vboff0 = (unsigned)((4 * hi + q_) * 128 + (((0 + 2 * blk_ + (p_ >> 1)) ^ fl_) << 4) + 8 * (p_ & 1));
      vboff1 = (unsigned)((4 * hi + q_) * 128 + (((4 + 2 * blk_ + (p_ >> 1)) ^ fl_) << 4) + 8 * (p_ & 1)); }
#define AT_DMA(bb, Rlo, s, sl) do { const int s_ = (s); const size_t base_ = (s_ < 4 ? (size_t)(ML + (bb) * NCTX + 64 * s_) : (size_t)((bb) * SEQ + ((Rlo) + s_ - 4) * 64)) * NIN0; \
        LAS unsigned char* sl_ = lds + (sl) * AT_SLOT + ldsw; \
        __builtin_amdgcn_global_load_lds((const unsigned*)(ksrc + base_), (LAS unsigned*)(sl_), 16, 0, 0); \
        __builtin_amdgcn_global_load_lds((const unsigned*)(ksrc + base_ + 64), (LAS unsigned*)(sl_ + 8192), 16, 0, 0); \
        __builtin_amdgcn_global_load_lds((const unsigned*)(vsrc + base_), (LAS unsigned*)(sl_ + 16384), 16, 0, 0); \
        __builtin_amdgcn_global_load_lds((const unsigned*)(vsrc + base_ + 64), (LAS unsigned*)(sl_ + 24576), 16, 0, 0); } while (0)
#define AT_DMAROW(trow, sl) do { const size_t base_ = (size_t)(trow) * NIN0; LAS unsigned char* sl_ = lds + (sl) * AT_SLOT + ldsw; \
        __builtin_amdgcn_global_load_lds((const unsigned*)(ksrc + base_), (LAS unsigned*)(sl_), 16, 0, 0); \
        __builtin_amdgcn_global_load_lds((const unsigned*)(ksrc + base_ + 64), (LAS unsigned*)(sl_ + 8192), 16, 0, 0); \
        __builtin_amdgcn_global_load_lds((const unsigned*)(vsrc + base_), (LAS unsigned*)(sl_ + 16384), 16, 0, 0); \
        __builtin_amdgcn_global_load_lds((const unsigned*)(vsrc + base_ + 64), (LAS unsigned*)(sl_ + 24576), 16, 0, 0); } while (0)
#define AT_DMAQ(bb, rr, hh) do { const bf16_t* qp_ = QKV + (size_t)((bb) * SEQ + (rr) * 64 + 32 * qh + r32) * NIN0 + (hh) * 64 + 8 * hi; LAS unsigned char* ql_ = lds + AT_QST + w * 4096; \
        __builtin_amdgcn_global_load_lds((const unsigned*)(qp_), (LAS unsigned*)(ql_), 16, 0, 0); __builtin_amdgcn_global_load_lds((const unsigned*)(qp_ + 16), (LAS unsigned*)(ql_ + 1024), 16, 0, 0); \
        __builtin_amdgcn_global_load_lds((const unsigned*)(qp_ + 32), (LAS unsigned*)(ql_ + 2048), 16, 0, 0); __builtin_amdgcn_global_load_lds((const unsigned*)(qp_ + 48), (LAS unsigned*)(ql_ + 3072), 16, 0, 0); } while (0)
#define AT_LOADQ(bb, rr, hh) do { const bf16_t* qp_ = QKV + (size_t)((bb) * SEQ + (rr) * 64 + 32 * qh + r32) * NIN0 + (hh) * 64 + 8 * hi; \
        qr[0] = *(const bf16x8*)(qp_); qr[1] = *(const bf16x8*)(qp_ + 16); qr[2] = *(const bf16x8*)(qp_ + 32); qr[3] = *(const bf16x8*)(qp_ + 48); } while (0)
    bf16x8 qr[4];
    if (w >= 4) __builtin_amdgcn_s_setprio(1);
    int bias_hp = -1, gs0 = 0;
    bool primed = false;
#pragma unroll 1
    for (int task = blockIdx.x; task < AT_NTASK; task += F.G) {
    const int b = task >> 9, rp = (task >> 2) & 127, hp = task & 3;
    const int h = 2 * hp + hsel, r = 2 * rp + rsel;
    const int rs_r = min(max(r - 4, 0), 248);
    const int R_lo = min(max(2 * rp - 4, 0), 248), R_hi = min(max(2 * rp + 1 - 4, 0), 248) + 7, nsteps = 4 + (R_hi - R_lo + 1);
    const int tn = task + F.G, bn = tn >> 9, rpn = (tn >> 2) & 127;
    const bool cont = tn < AT_NTASK && (tn & 3) == hp;
    const int R_lo_n = min(max(2 * rpn - 4, 0), 248);
    const bf16_t* ksrc = QKV + (size_t)krow_ * NIN0 + 512 + (2 * hp) * 64 + 8 * kchunk_;
    const bf16_t* vsrc = QKV + (size_t)krow_ * NIN0 + 1024 + (2 * hp) * 64 + 8 * ((lane & 7) ^ (((krow_ >> 1) & 1) << 2));
    if (!primed) {
        if (bias_hp != hp) {
            for (int i = F.tid; i < 2 * 15 * 128; i += 512) { const int hh = i / 1920, dr = (i >> 7) % 15, dc = (i & 127) - 48;
                BIAS[i] = (dc >= 0 && dc <= 30) ? F.in[I_RPB][(size_t)(2 * hp + hh) * 465 + dr * 31 + dc] * LOG2E : 0.f; }
            bias_hp = hp;
        }
        AT_LOADQ(b, r, h);
        asm volatile("s_waitcnt vmcnt(0)" ::: "memory");
        AT_DMA(b, R_lo, 0, gs0); AT_DMA(b, R_lo, 1, gs0 == 2 ? 0 : gs0 + 1);
    } else {
        asm volatile("s_waitcnt vmcnt(0)" ::: "memory");
#pragma unroll
        for (int d0 = 0; d0 < 4; ++d0) qr[d0] = *(LAS const bf16x8*)(lds + AT_QST + w * 4096 + d0 * 1024 + lane * 16);
    }
    float mref = 0.f, lrun = 0.f; f32x16 o[2], c0, c1;
#pragma unroll
    for (int i = 0; i < 16; ++i) { o[0][i] = 0.f; o[1][i] = 0.f; c0[i] = 0.f; c1[i] = 0.f; }
    const int cbase2 = ML + b * NCTX + 128, wbase2 = b * SEQ + (R_lo - 2) * 64, nbase = ML + bn * NCTX;
    int slc = gs0, sl2 = gs0 == 0 ? 2 : gs0 - 1;
    auto step = [&](const int s, auto win_t, auto qh_t) __attribute__((always_inline)) {
        constexpr bool WIN = decltype(win_t)::value; constexpr int QHC = decltype(qh_t)::value;
        if (WIN ? !(s + 1 < nsteps || cont) : (s == 0 && primed)) asm volatile("s_waitcnt vmcnt(0)" ::: "memory"); else asm volatile("s_waitcnt vmcnt(4)" ::: "memory");
        asm volatile("s_waitcnt lgkmcnt(0)" ::: "memory"); __builtin_amdgcn_s_barrier(); asm volatile("" ::: "memory");
        if constexpr (!WIN) { AT_DMAROW((s < 2 ? cbase2 : wbase2) + 64 * s, sl2); }
        else { const bool own = s + 2 < nsteps;
               if (own || cont) AT_DMAROW(own ? wbase2 + 64 * s : nbase + 64 * (s + 2 - nsteps), sl2);
               if (s == nsteps - 1 && cont) AT_DMAQ(bn, 2 * rpn + rsel, h); }
        const int kr = R_lo + s - 4;
        const bool active = !WIN || (kr >= rs_r && kr <= rs_r + 7);
        if (active) {
            LAS const unsigned char* Kslot = lds + slc * AT_SLOT + hsel * 8192;
            const unsigned vbs = (unsigned)(uintptr_t)(lds + slc * AT_SLOT + 16384 + hsel * 8192);
            f32x16 p0, p1;
            constexpr bool win = WIN; const bool l0a = !WIN || qh == 0, l1b = !WIN || qh == 1;
            bf16x8 kb0[4], kb1[4];
#pragma unroll
            for (int d0 = 0; d0 < 4; ++d0) { kb0[d0] = *(LAS const bf16x8*)(Kslot + koff[d0]); kb1[d0] = *(LAS const bf16x8*)(Kslot + koff[d0] + 4096); }
            if (win) {
                f32x16 cc0, cc1;
                const int dr = kr - r + 7;
                LAS const float* T = BIAS + (hsel * 15 + dr) * 128 + (63 - qc);
                float tb0[16], tb1[16];
#pragma unroll
                for (int i = 0; i < 16; ++i) { tb0[i] = T[crow(i, hi)]; tb1[i] = T[crow(i, hi) + 32]; }
#pragma unroll
                for (int i = 0; i < 16; ++i) { cc0[i] = c0[i] + tb0[i]; cc1[i] = c1[i] + tb1[i]; }
                qkt(p0, p1, kb0, kb1, qr, cc0, cc1);
            } else qkt(p0, p1, kb0, kb1, qr, c0, c1);
            float ra = max3f(p0[12], p0[13], p1[0]), rb = max3f(p0[14], p0[15], p1[1]); ra = max3f(ra, p1[2], p1[3]);
            if (l0a) {
#pragma unroll
                for (int i = 0; i < 12; i += 4) { ra = max3f(ra, p0[i], p0[i + 1]); rb = max3f(rb, p0[i + 2], p0[i + 3]); }
            }
            if (l1b) {
#pragma unroll
                for (int i = 4; i < 16; i += 4) { ra = max3f(ra, p1[i], p1[i + 1]); rb = max3f(rb, p1[i + 2], p1[i + 3]); }
            }
            float rm = half_swap_max(max2f(ra, rb));
            if ((!WIN && s == 0) || __any(rm > AT_THR)) {
                const float dl = (!WIN && s == 0) ? rm : max2f(rm, 0.f);
                mref += dl;
#pragma unroll
                for (int i = 0; i < 16; ++i) { p0[i] -= dl; p1[i] -= dl; c0[i] -= dl; c1[i] -= dl; }
                const float f = (!WIN && s == 0) ? 1.f : fast_exp2(-dl);
                lrun *= f;
#pragma unroll
                for (int i = 0; i < 16; ++i) { o[0][i] *= f; o[1][i] *= f; }
            }
            float ls = 0.f;
            u32x4 pw0, pw1, pw2, pw3;
            if (l0a) {
#pragma unroll
                for (int i = 0; i < 12; ++i) { p0[i] = fast_exp2(p0[i]); ls += p0[i]; }
                pw0.x = pg8::cvt_pk_bf16(p0[0], p0[1]); pw0.y = pg8::cvt_pk_bf16(p0[2], p0[3]); pw0.z = pg8::cvt_pk_bf16(p0[4], p0[5]); pw0.w = pg8::cvt_pk_bf16(p0[6], p0[7]);
                pw1.x = pg8::cvt_pk_bf16(p0[8], p0[9]); pw1.y = pg8::cvt_pk_bf16(p0[10], p0[11]);
            } else { pw0 = (u32x4){0u, 0u, 0u, 0u}; pw1.x = 0u; pw1.y = 0u; }
#pragma unroll
            for (int i = 12; i < 16; ++i) { p0[i] = fast_exp2(p0[i]); ls += p0[i]; }
#pragma unroll
            for (int i = 0; i < 4; ++i) { p1[i] = fast_exp2(p1[i]); ls += p1[i]; }
            pw1.z = pg8::cvt_pk_bf16(p0[12], p0[13]); pw1.w = pg8::cvt_pk_bf16(p0[14], p0[15]);
            pw2.x = pg8::cvt_pk_bf16(p1[0], p1[1]); pw2.y = pg8::cvt_pk_bf16(p1[2], p1[3]);
            if (l1b) {
#pragma unroll
                for (int i = 4; i < 16; ++i) { p1[i] = fast_exp2(p1[i]); ls += p1[i]; }
                pw2.z = pg8::cvt_pk_bf16(p1[4], p1[5]); pw2.w = pg8::cvt_pk_bf16(p1[6], p1[7]);
                pw3.x = pg8::cvt_pk_bf16(p1[8], p1[9]); pw3.y = pg8::cvt_pk_bf16(p1[10], p1[11]); pw3.z = pg8::cvt_pk_bf16(p1[12], p1[13]); pw3.w = pg8::cvt_pk_bf16(p1[14], p1[15]);
            } else { pw2.z = 0u; pw2.w = 0u; pw3 = (u32x4){0u, 0u, 0u, 0u}; }
            lrun += ls;
            LDS_WAIT();
            pv(o, vbs + vboff0, vbs + vboff1, __builtin_bit_cast(bf16x8, pw0), __builtin_bit_cast(bf16x8, pw1), __builtin_bit_cast(bf16x8, pw2), __builtin_bit_cast(bf16x8, pw3), l0a, l1b);
        }
            slc = slc == 2 ? 0 : slc + 1; sl2 = sl2 == 2 ? 0 : sl2 + 1;
    };
    int s_ = 0;
#pragma unroll 1
    for (; s_ < 4; ++s_) step(s_, std::false_type{}, std::integral_constant<int, -1>{});
    {
#pragma unroll
        for (int i = 0; i < 16; ++i) { const int k0_ = crow(i, hi); c0[i] = ((unsigned)(k0_ - cs) < 16u) ? c0[i] : -INFINITY; c1[i] = ((unsigned)(k0_ + 32 - cs) < 16u) ? c1[i] : -INFINITY; }
    }
#pragma unroll 1
    for (; s_ < nsteps; ++s_) step(s_, std::true_type{}, std::integral_constant<int, -1>{});
    const float ri = fast_rcp(half_swap_sum(lrun));
    unsigned char* orow = (unsigned char*)(MIX + (size_t)(b * SEQ + r * 64 + 32 * qh + r32) * D + h * 64) + (hi ? 16 : 0);
#pragma unroll
    for (int db = 0; db < 2; ++db) {
        unsigned gx[4], gy[4];
#pragma unroll
        for (int g = 0; g < 4; ++g) { gx[g] = pk2(o[db][4 * g] * ri, o[db][4 * g + 1] * ri); gy[g] = pk2(o[db][4 * g + 2] * ri, o[db][4 * g + 3] * ri); }
#pragma unroll
        for (int k = 0; k < 4; k += 2) {
            const auto rx = __builtin_amdgcn_permlane32_swap(gx[k], gx[k + 1], false, false);
            const auto ry = __builtin_amdgcn_permlane32_swap(gy[k], gy[k + 1], false, false);
            *(u32x4*)(orow + db * 64 + 16 * k) = (u32x4){rx[0], ry[0], rx[1], ry[1]};
        }
    }
    asm volatile("s_waitcnt lgkmcnt(0)" ::: "memory");
    if (!cont) { asm volatile("s_waitcnt vmcnt(0)" ::: "memory"); __builtin_amdgcn_s_barrier(); asm volatile("" ::: "memory"); }
    gs0 = (gs0 + nsteps) % 3; primed = cont;
    }
    __builtin_amdgcn_s_setprio(0);
#undef AT_DMA
#undef AT_LOADQ
#undef AT_DMAQ
#undef AT_DMAROW
}

struct LruW { bf16x8 wr[4], wi[4]; f32x16 cr, ci; float cn; };
constexpr int LRU_LW = 0, LRU_LC = 32768, LRU_HF = 36864, LRU_AF = LRU_HF + 65536;
static_assert(LRU_AF + 8 * 4096 <= LDSCTL_OFF, "LRU LDS map");
__device__ __forceinline__ void lru_stage_w(Frame& F, int g) {
    const u32x4* src = WSP(u32x4, WS_LRUW);
    LAS u32x4* dst = (LAS u32x4*)(F.lds + LRU_LW);
#pragma unroll
    for (int i = 0; i < 4; ++i) { const int idx = F.tid + 512 * i;
        const int d = idx >> 10, rest = idx & 1023;
        dst[idx] = src[(size_t)((d * 8 + g) * 1024) + rest]; }
    if (F.tid < 128) { const int d = F.tid >> 6, ch = d * 512 + g * 64 + (F.tid & 63);
        LAS float* lc = (LAS float*)(F.lds + LRU_LC) + F.tid * 4;
        lc[0] = -LOG2E * F.in[I_LBR][ch]; lc[1] = -LOG2E * F.in[I_LBI][ch]; lc[2] = -8.f * LOG2E * log1pf(__expf(-F.in[I_LAM][ch])); }
    __syncthreads();
}
__device__ __forceinline__ void lru_load_w(Frame& F, LruW& W, int d, int half, int lane) {
    LAS const bf16x8* wf = (LAS const bf16x8*)(F.lds + LRU_LW) + d * 1024 + lane;
#pragma unroll
    for (int s = 0; s < 4; ++s) { W.wr[s] = wf[((0 * 2 + half) * 4 + s) * 64]; W.wi[s] = wf[((1 * 2 + half) * 4 + s) * 64]; }
    LAS const float* lc = (LAS const float*)(F.lds + LRU_LC) + (d * 64 + 32 * half + (lane & 31)) * 4;
    { const float br = lc[0], bi = lc[1];
#pragma unroll
      for (int i = 0; i < 16; ++i) { W.cr[i] = br; W.ci[i] = bi; } }
    W.cn = lc[2];
}
__device__ __forceinline__ void lru_dma_af(const bf16_t* XC, size_t t0, int g, int lane, LAS unsigned char* afb) {
    const int rr = lane >> 3, sl = lane & 7;
#pragma unroll
    for (int i = 0; i < 4; ++i) { const int row = 8 * i + rr;
        __builtin_amdgcn_global_load_lds((const unsigned*)(XC + (t0 + row) * 512 + 64 * g + 8 * (sl ^ ((row >> 1) & 7))), (LAS unsigned*)(afb + i * 1024), 16, 0, 0); }
}
__device__ __forceinline__ void lru_read_af(LAS const unsigned char* afb, int r32, int hi, bf16x8 (&af)[4]) {
#pragma unroll
    for (int s = 0; s < 4; ++s) af[s] = *(LAS const bf16x8*)(afb + r32 * 128 + (((2 * s + hi) ^ ((r32 >> 1) & 7)) << 4));
}
__device__ __forceinline__ void lru_gates(const bf16x8 (&af)[4], const LruW& W, int half, bf16x8 I0, bf16x8 I1, float (&a)[16], float (&b)[16]) {
    f32x16 R, I, X;
#pragma unroll
    for (int i = 0; i < 16; ++i) X[i] = 0.f;
    R = __builtin_amdgcn_mfma_f32_32x32x16_bf16(af[0], W.wr[0], W.cr, 0, 0, 0); I = __builtin_amdgcn_mfma_f32_32x32x16_bf16(af[0], W.wi[0], W.ci, 0, 0, 0);
#pragma unroll
    for (int s = 1; s < 4; ++s) { R = __builtin_amdgcn_mfma_f32_32x32x16_bf16(af[s], W.wr[s], R, 0, 0, 0); I = __builtin_amdgcn_mfma_f32_32x32x16_bf16(af[s], W.wi[s], I, 0, 0, 0); }
    const bf16x8 ax0 = half ? af[2] : af[0], ax1 = half ? af[3] : af[1];
    X = __builtin_amdgcn_mfma_f32_32x32x16_bf16(ax0, I0, X, 0, 0, 0);
    X = __builtin_amdgcn_mfma_f32_32x32x16_bf16(ax1, I1, X, 0, 0, 0);
    const float cn = W.cn;
#pragma unroll
    for (int i = 0; i < 16; ++i) {
        const float rr = fast_rcp(1.f + fast_exp2(R[i])), ii = fast_rcp(1.f + fast_exp2(I[i]));
        const float av = fast_exp2(rr * cn);
        a[i] = av; b[i] = __builtin_amdgcn_sqrtf(1.f - av * av) * ii * X[i]; }
}
__device__ __forceinline__ float partner32(float x, int hi) { auto rr = __builtin_amdgcn_permlane32_swap(__float_as_uint(x), __float_as_uint(x), false, false); return __uint_as_float(hi ? rr[0] : rr[1]); }
template <bool REV, bool WANT_H> __device__ __forceinline__ void lru_scan_tile(const float (&a)[16], const float (&b)[16], int hi, float& H, float (&h)[16], float& ap) {
    float SA[4], SB[4], EAv[4], OAv[4], EBv[4], OBv[4];
#pragma unroll
    for (int q = 0; q < 4; ++q) { const float a0 = a[4 * q], a1 = a[4 * q + 1], a2 = a[4 * q + 2], a3 = a[4 * q + 3], b0 = b[4 * q], b1 = b[4 * q + 1], b2 = b[4 * q + 2], b3 = b[4 * q + 3];
        SA[q] = (a0 * a1) * (a2 * a3);
        SB[q] = REV ? ((b3 * a2 + b2) * a1 + b1) * a0 + b0 : ((b0 * a1 + b1) * a2 + b2) * a3 + b3; }
#pragma unroll
    for (int q = 0; q < 4; ++q) { auto ra_ = __builtin_amdgcn_permlane32_swap(__float_as_uint(SA[q]), __float_as_uint(SA[q]), false, false); EAv[q] = __uint_as_float(ra_[0]); OAv[q] = __uint_as_float(ra_[1]);
        auto rb_ = __builtin_amdgcn_permlane32_swap(__float_as_uint(SB[q]), __float_as_uint(SB[q]), false, false); EBv[q] = __uint_as_float(rb_[0]); OBv[q] = __uint_as_float(rb_[1]); }
    float cin[4];
    if (!REV) {
#pragma unroll
        for (int q = 0; q < 4; ++q) { const float EA = EAv[q], EB = EBv[q], OA = OAv[q], OB = OBv[q];
            const float he = H; H = EA * H + EB; const float ho = H; H = OA * H + OB; cin[q] = hi ? ho : he; if (!WANT_H) ap *= EA * OA; }
    } else {
#pragma unroll
        for (int q = 3; q >= 0; --q) { const float EA = EAv[q], EB = EBv[q], OA = OAv[q], OB = OBv[q];
            const float ho = H; H = OA * H + OB; const float he = H; H = EA * H + EB; cin[q] = hi ? ho : he; if (!WANT_H) ap *= EA * OA; }
    }
    if (WANT_H) {
#pragma unroll
        for (int q = 0; q < 4; ++q) { float hh = cin[q];
            if (!REV) {
#pragma unroll
                for (int e = 0; e < 4; ++e) { hh = a[4 * q + e] * hh + b[4 * q + e]; h[4 * q + e] = hh; }
            } else {
#pragma unroll
                for (int e = 3; e >= 0; --e) { hh = a[4 * q + e] * hh + b[4 * q + e]; h[4 * q + e] = hh; }
            } }
    }
}
__device__ __forceinline__ void lru_ident(int r32, int hi, bf16x8& I0, bf16x8& I1) {
#pragma unroll
    for (int j = 0; j < 8; ++j) { I0[j] = (8 * hi + j == r32) ? (short)0x3F80 : (short)0; I1[j] = (16 + 8 * hi + j == r32) ? (short)0x3F80 : (short)0; }
}
template <bool REV, int MODE> __device__ __forceinline__ void lru_subpass(Frame& F, size_t row0, int ntile, int g, int half, float& H, float& ap, LAS unsigned* HFL, bf16x8 (&af)[4], bool have) {
    const bf16_t* XC = WSP(bf16_t, WS_XCONV);
    const int lane = F.lane, r32 = lane & 31, hi = lane >> 5;
    LAS unsigned char* afb = F.lds + LRU_AF + F.wave * 4096;
    bf16x8 I0, I1; lru_ident(r32, hi, I0, I1);
    LruW W; lru_load_w(F, W, REV ? 1 : 0, half, lane);
    if (!have) {
        lru_dma_af(XC, row0 + (REV ? 32 * (ntile - 1) : 0), g, lane, afb);
        asm volatile("s_waitcnt vmcnt(0)" ::: "memory");
        lru_read_af(afb, r32, hi, af);
        asm volatile("s_waitcnt lgkmcnt(0)" ::: "memory");
    }
#pragma unroll 1
    for (int tt = 0; tt < ntile; ++tt) {
        const int ti = REV ? ntile - 1 - tt : tt;
        const bool more = tt + 1 < ntile;
        if (more) lru_dma_af(XC, row0 + 32 * (REV ? ti - 1 : ti + 1), g, lane, afb);
        const size_t t0 = row0 + 32 * ti;
        bf16_t grw[16];
        if (MODE == 2) { const bf16_t* gp = WSP(bf16_t, WS_BIG) + t0 * NIN0 + 2048 + 64 * g + 32 * half;
            const unsigned lo_ = (unsigned)(4 * hi * NIN0 + r32);
#pragma unroll
            for (int i = 0; i < 16; ++i) grw[i] = gp[lo_ + (unsigned)(((i & 3) + 8 * (i >> 2)) * NIN0)]; }
        float a[16], bb[16], h[16];
        lru_gates(af, W, half, I0, I1, a, bb);
        lru_scan_tile<REV, MODE != 0>(a, bb, hi, H, h, ap);
        asm volatile("s_waitcnt vmcnt(0)" ::: "memory");
        if (more) lru_read_af(afb, r32, hi, af);
        if (MODE == 1) {
#pragma unroll
            for (int p = 0; p < 8; ++p) HFL[(ti * 8 + p) * 64 + lane] = pk2(h[2 * p], h[2 * p + 1]);
        }
        if (MODE == 2) {
            bf16_t* op = WSP(bf16_t, WS_A2) + t0 * D + 512 + 64 * g + 32 * half;
            const unsigned so_ = (unsigned)(4 * hi * D + r32);
#pragma unroll
            for (int p = 0; p < 8; ++p) { const unsigned hf = HFL[(ti * 8 + p) * 64 + lane];
                const unsigned pr_ = pk2((bflo(hf) + h[2 * p]) * gelu_tanh(bf1(grw[2 * p])), (bfhi(hf) + h[2 * p + 1]) * gelu_tanh(bf1(grw[2 * p + 1])));
                op[so_ + (unsigned)((((2 * p) & 3) + 8 * ((2 * p) >> 2)) * D)] = (bf16_t)(pr_ & 0xffffu);
                op[so_ + (unsigned)((((2 * p + 1) & 3) + 8 * ((2 * p + 1) >> 2)) * D)] = (bf16_t)(pr_ >> 16); }
        }
        asm volatile("s_waitcnt lgkmcnt(0)" ::: "memory");
    }
    asm volatile("" ::: "memory");
}
template <bool REV> __device__ __forceinline__ void lru_subpass0(Frame& F, size_t row0, int ntile, int g, int half, float& H, float& ap) {
    const bf16_t* XC = WSP(bf16_t, WS_XCONV);
    const int lane = F.lane, r32 = lane & 31, hi = lane >> 5;
    LAS unsigned char* buf0 = F.lds + LRU_AF + F.wave * 4096; LAS unsigned char* buf1 = F.lds + LRU_HF + 8192 + F.wave * 4096;
    bf16x8 I0, I1; lru_ident(r32, hi, I0, I1);
    LruW W; lru_load_w(F, W, REV ? 1 : 0, half, lane);
    bf16x8 af[4];
#define LRU0_ROW(tt) (row0 + 32 * (REV ? ntile - 1 - (tt) : (tt)))
    lru_dma_af(XC, LRU0_ROW(0), g, lane, buf0);
    if (ntile > 1) { lru_dma_af(XC, LRU0_ROW(1), g, lane, buf1); asm volatile("s_waitcnt vmcnt(4)" ::: "memory"); } else asm volatile("s_waitcnt vmcnt(0)" ::: "memory");
    lru_read_af(buf0, r32, hi, af);
    asm volatile("s_waitcnt lgkmcnt(0)" ::: "memory");
#pragma unroll 1
    for (int tt = 0; tt < ntile; ++tt) {
        LAS unsigned char* bcur = (tt & 1) ? buf1 : buf0; LAS unsigned char* bnxt = (tt & 1) ? buf0 : buf1;
        if (tt + 2 < ntile) lru_dma_af(XC, LRU0_ROW(tt + 2), g, lane, bcur);
        float a[16], bb[16], h[16];
        lru_gates(af, W, half, I0, I1, a, bb);
        lru_scan_tile<REV, false>(a, bb, hi, H, h, ap);
        if (tt + 1 < ntile) {
            if (tt + 2 < ntile) asm volatile("s_waitcnt vmcnt(4)" ::: "memory"); else asm volatile("s_waitcnt vmcnt(0)" ::: "memory");
            lru_read_af(bnxt, r32, hi, af);
            asm volatile("s_waitcnt lgkmcnt(0)" ::: "memory");
        }
    }
#undef LRU0_ROW
    asm volatile("" ::: "memory");
}
__device__ __forceinline__ void conv4_local(Frame& F, size_t r0, int ngrp, size_t sbeg, size_t send, int g) {
    const bf16_t* QKV = WSP(bf16_t, WS_BIG); bf16_t* XC = WSP(bf16_t, WS_XCONV);
    const int lane = F.lane, rgrp = lane >> 3, cl = lane & 7, ch = 64 * g + 8 * cl;
    if (rgrp < ngrp) {
        const size_t row0 = r0 + 16 * rgrp;
        u32x4 raw[19];
#pragma unroll
        for (int i = 0; i < 19; ++i) { const size_t r = row0 + i - 2; raw[i] = (r >= sbeg && r < send) ? *(const u32x4*)(QKV + r * NIN0 + 1536 + ch) : (u32x4){0u, 0u, 0u, 0u}; }
        float w[4][8], bs[8];
#pragma unroll
        for (int j = 0; j < 4; ++j) { const f32x4 a = *(const f32x4*)(F.in[I_ECW] + j * 512 + ch), b = *(const f32x4*)(F.in[I_ECW] + j * 512 + ch + 4);
            w[j][0] = a.x; w[j][1] = a.y; w[j][2] = a.z; w[j][3] = a.w; w[j][4] = b.x; w[j][5] = b.y; w[j][6] = b.z; w[j][7] = b.w; }
        { const f32x4 a = *(const f32x4*)(F.in[I_ECB] + ch), b = *(const f32x4*)(F.in[I_ECB] + ch + 4); bs[0] = a.x; bs[1] = a.y; bs[2] = a.z; bs[3] = a.w; bs[4] = b.x; bs[5] = b.y; bs[6] = b.z; bs[7] = b.w; }
#pragma unroll
        for (int t = 0; t < 16; ++t) {
            float o[8];
#pragma unroll
            for (int e = 0; e < 8; ++e) o[e] = bs[e];
#pragma unroll
            for (int j = 0; j < 4; ++j) { const u32x4 r = raw[t + j];
                o[0] += w[j][0] * bflo(r.x); o[1] += w[j][1] * bfhi(r.x); o[2] += w[j][2] * bflo(r.y); o[3] += w[j][3] * bfhi(r.y);
                o[4] += w[j][4] * bflo(r.z); o[5] += w[j][5] * bfhi(r.z); o[6] += w[j][6] * bflo(r.w); o[7] += w[j][7] * bfhi(r.w); }
            u32x4 pk; pk.x = pk2(o[0], o[1]); pk.y = pk2(o[2], o[3]); pk.z = pk2(o[4], o[5]); pk.w = pk2(o[6], o[7]);
            *(u32x4*)(XC + (row0 + t) * 512 + ch) = pk;
        }
    }
    asm volatile("s_waitcnt vmcnt(0)" ::: "memory");
}
template <bool REV> __device__ __forceinline__ void lru_subpass2(Frame& F, size_t row0, int ntile, int g, float (&H)[2], float (&ap)[2]) {
    const bf16_t* XC = WSP(bf16_t, WS_XCONV);
    const int lane = F.lane, r32 = lane & 31, hi = lane >> 5;
    LAS unsigned char* afb = F.lds + LRU_AF + F.wave * 4096;
    bf16x8 I0, I1; lru_ident(r32, hi, I0, I1);
    LruW W0, W1; lru_load_w(F, W0, REV ? 1 : 0, 0, lane); lru_load_w(F, W1, REV ? 1 : 0, 1, lane);
    bf16x8 af[4];
    lru_dma_af(XC, row0 + (REV ? 32 * (ntile - 1) : 0), g, lane, afb);
    asm volatile("s_waitcnt vmcnt(0)" ::: "memory");
    lru_read_af(afb, r32, hi, af);
    asm volatile("s_waitcnt lgkmcnt(0)" ::: "memory");
#pragma unroll 1
    for (int tt = 0; tt < ntile; ++tt) {
        const int ti = REV ? ntile - 1 - tt : tt;
        const bool more = tt + 1 < ntile;
        if (more) lru_dma_af(XC, row0 + 32 * (REV ? ti - 1 : ti + 1), g, lane, afb);
        float a0[16], b0[16], a1[16], b1[16], hd[16];
        lru_gates(af, W0, 0, I0, I1, a0, b0);
        lru_gates(af, W1, 1, I0, I1, a1, b1);
        lru_scan_tile<REV, false>(a0, b0, hi, H[0], hd, ap[0]);
        lru_scan_tile<REV, false>(a1, b1, hi, H[1], hd, ap[1]);
        asm volatile("s_waitcnt vmcnt(0)" ::: "memory");
        if (more) lru_read_af(afb, r32, hi, af);
        asm volatile("s_waitcnt lgkmcnt(0)" ::: "memory");
    }
    asm volatile("" ::: "memory");
}
__device__ __forceinline__ void lru_pass1_wg(Frame& F, int wg) {
    const int j = wg & 15, g = (wg >> 4) & 7, b = wg >> 7, w = F.wave, lane = F.lane, hi = lane >> 5;
    f32x2* TOT = WSP(f32x2, WS_TOT); f32x2* TOTG = WSP(f32x2, WS_TOTG); f32x2* TOTC = WSP(f32x2, WS_TOTC);
    LAS f32x2* CB = (LAS f32x2*)(F.lds + LRU_HF);
    lru_stage_w(F, g);
    const int c = 8 * j + w, sub = w - 2;
    const int njobs = (w == 2 || w == 4) ? 2 : 1;
    if (njobs == 2) __builtin_amdgcn_s_setprio(1);
#pragma unroll 1
    for (int job = 0; job < njobs; ++job) {
        const size_t r0 = job == 0 ? (size_t)b * SEQ + (size_t)c * CHUNK : (size_t)ML + (size_t)b * NCTX + 32 * (j & 7);
        const int nt = job == 0 ? 4 : 1;
        { const size_t sb_ = job == 0 ? (size_t)b * SEQ : (size_t)ML + (size_t)b * NCTX, se_ = job == 0 ? sb_ + SEQ : sb_ + NCTX;
          asm volatile("" ::: "memory"); __builtin_amdgcn_sched_barrier(0);
          conv4_local(F, r0, job == 0 ? 8 : 2, sb_, se_, g);
          asm volatile("" ::: "memory"); __builtin_amdgcn_sched_barrier(0); }
        f32x2 tot[2] = {(f32x2){1.f, 0.f}, (f32x2){1.f, 0.f}};
#pragma unroll 1
        for (int half = 0; half < 2; ++half) {
            if (job != 0 && half != (j >> 3)) continue;
            if (job == 0 || sub < 2) { float H = 0.f, ap = 1.f; lru_subpass0<false>(F, r0, nt, g, half, H, ap); if (hi == half) tot[0] = (f32x2){ap, H}; }
            if (job == 0 || sub >= 2) { float H = 0.f, ap = 1.f; lru_subpass0<true>(F, r0, nt, g, half, H, ap); if (hi == half) tot[1] = (f32x2){ap, H}; }
        }
        if (job == 0) {
#pragma unroll
            for (int d = 0; d < 2; ++d) { st8_wt(&TOT[(size_t)((b * 2 + d) * NCHUNK + c) * 512 + 64 * g + lane], tot[d]); CB[(d * 8 + w) * 64 + lane] = tot[d]; }
        } else {
            if (hi == (j >> 3)) st8_wt(&TOTC[(size_t)((b * 2 + (sub >> 1)) * 8 + (j & 7)) * 512 + 64 * g + lane], (sub >> 1) ? tot[1] : tot[0]);
        }
    }
    __builtin_amdgcn_s_setprio(0);
    __syncthreads();
    if (w < 2) { const int d = w; float A = 1.f, B = 0.f;
#pragma unroll
        for (int k = 0; k < 8; ++k) { const f32x2 t = CB[(d * 8 + (d == 0 ? k : 7 - k)) * 64 + lane]; B = t.x * B + t.y; A *= t.x; }
        st8_wt(&TOTG[(size_t)((b * 2 + d) * 16 + j) * 512 + 64 * g + lane], (f32x2){A, B}); }
    asm volatile("s_waitcnt vmcnt(0)" ::: "memory");
    __syncthreads();
    if (F.tid == 0) (void)__hip_atomic_fetch_add((unsigned*)(F.ws + WS_CTL) + CW_LRUG + 64 * (b * 8 + g), 1u, __ATOMIC_RELAXED, __HIP_MEMORY_SCOPE_AGENT);
}
__device__ __forceinline__ void lru_pass3_wg(Frame& F, int wg, bool staged) {
    const int j = wg & 15, g = (wg >> 4) & 7, b = wg >> 7, w = F.wave, lane = F.lane, r32 = lane & 31;
    const f32x2* TOT = WSP(f32x2, WS_TOT); const f32x2* TOTG = WSP(f32x2, WS_TOTG); const f32x2* TOTC = WSP(f32x2, WS_TOTC);
    LAS unsigned* HFL = (LAS unsigned*)(F.lds + LRU_HF + w * 8192);
    if (F.tid == 0) { const unsigned* gc = (const unsigned*)(F.ws + WS_CTL) + CW_LRUG + 64 * (b * 8 + g); unsigned sp = 0;
        while (__hip_atomic_load(gc, __ATOMIC_RELAXED, __HIP_MEMORY_SCOPE_AGENT) < 16u) { __builtin_amdgcn_s_sleep(2); if (++sp > (1u << 22)) break; } }
    __syncthreads();
    const int c = 8 * j + w;
    const size_t row0 = (size_t)b * SEQ + (size_t)c * CHUNK;
    float Cf = 0.f, Cb = 0.f;
    {
        const f32x2 id = (f32x2){1.f, 0.f};
        const size_t chn = 64 * g + lane;
        f32x2 t[15];
#pragma unroll
        for (int k = 0; k < 8; ++k) t[k] = ld8_sc1(&TOTC[(size_t)((b * 2 + 0) * 8 + k) * 512 + chn]);
#pragma unroll
        for (int k = 0; k < 7; ++k) t[8 + k] = (k < w) ? ld8_sc1(&TOT[(size_t)((b * 2 + 0) * NCHUNK + 8 * j + k) * 512 + chn]) : id;
        f32x2 u[15];
#pragma unroll
        for (int k = 0; k < 15; ++k) u[k] = (k < j) ? ld8_sc1(&TOTG[(size_t)((b * 2 + 0) * 16 + k) * 512 + chn]) : id;
        f32x2 tb[15], ub[15];
#pragma unroll
        for (int k = 0; k < 8; ++k) tb[k] = ld8_sc1(&TOTC[(size_t)((b * 2 + 1) * 8 + (7 - k)) * 512 + chn]);
#pragma unroll
        for (int k = 0; k < 7; ++k) tb[8 + k] = (7 - k > w) ? ld8_sc1(&TOT[(size_t)((b * 2 + 1) * NCHUNK + 8 * j + (7 - k)) * 512 + chn]) : id;
#pragma unroll
        for (int k = 0; k < 15; ++k) ub[k] = (15 - k > j) ? ld8_sc1(&TOTG[(size_t)((b * 2 + 1) * 16 + (15 - k)) * 512 + chn]) : id;
        if (!staged) lru_stage_w(F, g);
#pragma unroll
        for (int k = 0; k < 8; ++k) Cf = t[k].x * Cf + t[k].y;
#pragma unroll
        for (int k = 0; k < 15; ++k) Cf = u[k].x * Cf + u[k].y;
#pragma unroll
        for (int k = 0; k < 7; ++k) Cf = t[8 + k].x * Cf + t[8 + k].y;
#pragma unroll
        for (int k = 0; k < 8; ++k) Cb = tb[k].x * Cb + tb[k].y;
#pragma unroll
        for (int k = 0; k < 15; ++k) Cb = ub[k].x * Cb + ub[k].y;
#pragma unroll
        for (int k = 0; k < 7; ++k) Cb = tb[8 + k].x * Cb + tb[8 + k].y;
        asm volatile("" ::: "memory");
    }
    float dummy = 1.f, H;
    bf16x8 af[4];
#pragma unroll 1
    for (int half = 0; half < 2; ++half) {
        H = __shfl(Cf, 32 * half + r32); lru_subpass<false, 1>(F, row0, 4, g, half, H, dummy, HFL, af, half != 0);
        H = __shfl(Cb, 32 * half + r32); lru_subpass<true, 2>(F, row0, 4, g, half, H, dummy, HFL, af, true);
    }
    LDS_WAIT();
    __syncthreads();
}

__device__ __forceinline__ void conv3_task(Frame& F, int task) {
    bf16_t* BG = WSP(bf16_t, WS_A1); const bf16_t* P = WSP(bf16_t, WS_A3);
    const int lane = F.lane, half = task & 1, row0 = (task >> 1) * 16, ch = half * 512 + 8 * lane;
    const int sbeg = (row0 / SEQ) * SEQ, send = sbeg + SEQ;
    u32x4 raw[18];
#pragma unroll
    for (int i = 0; i < 18; ++i) { const int r = row0 + i - 1; raw[i] = (r >= sbeg && r < send) ? *(const u32x4*)(P + (size_t)r * D + ch) : (u32x4){0u, 0u, 0u, 0u}; }
    u32x4 bgr[16];
#pragma unroll
    for (int t = 0; t < 16; ++t) bgr[t] = *(const u32x4*)(BG + (size_t)(row0 + t) * D + ch);
    float w[3][8];
#pragma unroll
    for (int j = 0; j < 3; ++j) { const f32x4 a = *(const f32x4*)(F.in[I_OCW] + j * D + ch), b = *(const f32x4*)(F.in[I_OCW] + j * D + ch + 4);
        w[j][0] = a.x; w[j][1] = a.y; w[j][2] = a.z; w[j][3] = a.w; w[j][4] = b.x; w[j][5] = b.y; w[j][6] = b.z; w[j][7] = b.w; }
#pragma unroll
    for (int t = 0; t < 16; ++t) {
        float o[8];
#pragma unroll
        for (int e = 0; e < 8; ++e) o[e] = 0.f;
#pragma unroll
        for (int j = 0; j < 3; ++j) { const u32x4 r = raw[t + j];
            o[0] += w[j][0] * bflo(r.x); o[1] += w[j][1] * bfhi(r.x); o[2] += w[j][2] * bflo(r.y); o[3] += w[j][3] * bfhi(r.y);
            o[4] += w[j][4] * bflo(r.z); o[5] += w[j][5] * bfhi(r.z); o[6] += w[j][6] * bflo(r.w); o[7] += w[j][7] * bfhi(r.w); }
        bf16_t* bp = BG + (size_t)(row0 + t) * D + ch;
        const u32x4 bgv = bgr[t];
        u32x4 pk; pk.x = pk2(o[0] * bflo(bgv.x), o[1] * bfhi(bgv.x)); pk.y = pk2(o[2] * bflo(bgv.y), o[3] * bfhi(bgv.y)); pk.z = pk2(o[4] * bflo(bgv.z), o[5] * bfhi(bgv.z)); pk.w = pk2(o[6] * bflo(bgv.w), o[7] * bfhi(bgv.w));
        st16_wt(bp, pk);
    }
}

__device__ __forceinline__ void final_row(Frame& F, int m) {
    f32x4* xr = (f32x4*)(F.out + (size_t)m * D) + F.lane;
    const float rs = fast_rsq(WSP(float, WS_SSQ)[3 * ML + m] * (1.f / D) + EPS);
    const f32x4* gp = (const f32x4*)F.in[I_FG] + F.lane;
#pragma unroll
    for (int j = 0; j < 4; ++j) { const f32x4 v = xr[64 * j], g = gp[64 * j]; xr[64 * j] = v * rs * g; }
}

__device__ __forceinline__ void ctx_proj_wg(Frame& F) {
    const int lane = F.lane, w = F.wave, r32 = lane & 31, hi = lane >> 5;
    const bf16_t* XB = WSP(bf16_t, WS_A1) + (size_t)ML * D;
    const bf16_t* W2 = WSP(bf16_t, WS_WIN0) + (size_t)2 * NIN0 * D;
    const float* ss = WSP(float, WS_SS0) + ML; const float* bias = WSP(float, WS_B_IN0) + (size_t)2 * NIN0;
    bf16_t* O = WSP(bf16_t, WS_BIG) + (size_t)ML * NIN0;
    LAS float* red = (LAS float*)F.lds;
    constexpr int NSTRIP = (NB * NCTX / 32) * (1536 / 96);
    for (int st = blockIdx.x; st < NSTRIP; st += (int)F.G) {
        const int rb = st >> 4, c0 = 512 + 96 * (st & 15);
        const bf16_t* ap = XB + (size_t)(32 * rb + r32) * D + 128 * w + 8 * hi;
        const bf16_t* bp = W2 + (size_t)(c0 + r32) * D + 128 * w + 8 * hi;
        bf16x8 a[8], b[3][8];
#pragma unroll
        for (int j = 0; j < 8; ++j) { a[j] = *(const bf16x8*)(ap + 16 * j);
#pragma unroll
            for (int t = 0; t < 3; ++t) b[t][j] = *(const bf16x8*)(bp + (size_t)(32 * t) * D + 16 * j); }
        f32x16 acc[3];
#pragma unroll
        for (int t = 0; t < 3; ++t) {
#pragma unroll
            for (int i = 0; i < 16; ++i) acc[t][i] = 0.f;
#pragma unroll
            for (int j = 0; j < 8; ++j) acc[t] = __builtin_amdgcn_mfma_f32_32x32x16_bf16(a[j], b[t][j], acc[t], 0, 0, 0);
#pragma unroll
            for (int i = 0; i < 16; ++i) red[((w * 3 + t) * 16 + i) * 64 + lane] = acc[t][i];
        }
        __syncthreads();
#pragma unroll
        for (int q = 0; q < 6; ++q) { const int p = w * 6 + q, t = p >> 4, i = p & 15, row = 32 * rb + crow(i, hi), col = c0 + 32 * t + r32;
            float v = 0.f;
#pragma unroll
            for (int k = 0; k < 8; ++k) v += red[((k * 3 + t) * 16 + i) * 64 + lane];
            v = v * fast_rsq(ss[row] * (1.f / D) + EPS) + bias[col];
            O[(size_t)row * NIN0 + col] = (bf16_t)f2bf(v); }
        __syncthreads();
    }
}

constexpr int PI_O = (D / 64) * (D / 32), PI_GU = (NGU / 32) * 16, PI_DN = (FF / 64) * (D / 32), PI_IN1 = (NIN1 / 32) * 16;
constexpr int PE0 = PI_O, PE1 = PE0 + PI_GU, PE2 = PE1 + PI_DN, PE3 = PE2 + PI_IN1, PE4 = PE3 + PI_O, PE5 = PE4 + PI_GU, L1_ITEMS = PE5 + PI_DN;
constexpr int PREP_SLICES = 9, PREP_PER = 1255;
__device__ __forceinline__ int prep_slice_begin(int k) { return PREP_PER * k; }
static_assert(2 * PREP_PER >= PE0 && 3 * PREP_PER >= PE1 && 4 * PREP_PER >= PE2 && 5 * PREP_PER >= PE3 && 7 * PREP_PER >= PE4 && 8 * PREP_PER >= PE5 && 9 * PREP_PER >= L1_ITEMS && PREP_PER <= 7 * 256, "prep deadlines");
__device__ __forceinline__ void prep_l1_item(Frame& F, int item) {
    LAS float* scr = (LAS float*)(F.lds + F.wave * 16384);
    const bool fold0 = item >= PE0 && item < PE1, fold_in1 = item >= PE2 && item < PE3, fold1 = item >= PE4 && item < PE5;
    if (fold0 || fold_in1 || fold1) {
        const bool gu = !fold_in1; const int l = fold0 ? 0 : 1;
        const int r = item - (fold0 ? PE0 : (fold_in1 ? PE2 : PE4)), ks = r & 15, n0 = (r >> 4) * 32;
        const int N = gu ? NGU : NIN1;
        fold_item<2>(gu ? F.in[I_WGU] + (size_t)l * D * NGU : F.in[I_OWIN], N, n0, gu ? gu_dst(n0) : in1_dst(n0), N, 64 * ks, 1.f, (gu ? F.in[I_N2G] : F.in[I_N1G]) + l * D, WSP(float, WS_MODS) + l * 3 * 6144,
                     gu ? 4096 : 1024, gu ? 3072 : 0, gu ? (l ? WSP(bf16_t, WS_WGU1) : WSP(bf16_t, WS_WGU0)) : WSP(bf16_t, WS_WIN1), gu ? (l ? WSP(float, WS_B_GU1) : WSP(float, WS_B_GU0)) : WSP(float, WS_B_IN1), scr, F.lane);
    } else {
        const int which = item < PE0 ? 0 : (item < PE2 ? 1 : (item < PE4 ? 2 : 3));
        const float* W = which == 0 ? F.in[I_EWOUT] : (which == 1 ? F.in[I_WDN] : (which == 2 ? F.in[I_OWOUT] : F.in[I_WDN] + (size_t)FF * D));
        bf16_t* WT = which == 0 ? WSP(bf16_t, WS_WOUT0) : (which == 1 ? WSP(bf16_t, WS_WDN0) : (which == 2 ? WSP(bf16_t, WS_WOUT1) : WSP(bf16_t, WS_WDN1)));
        p0_transpose_item(W, (which & 1) ? FF : D, D, WT, scr, which == 0 ? item : (which == 1 ? item - PE1 : (which == 2 ? item - PE3 : item - PE5)), F.lane);
    }
}
__device__ __forceinline__ void xcd_barrier_prep(const XcdBarrier& b, Frame& F, int slice) {
    asm volatile("s_waitcnt vmcnt(0)" ::: "memory");
    __syncthreads();
    if (F.wave == 0) {
        if (threadIdx.x == 0) {
            unsigned* bar = b.bar;
            __builtin_amdgcn_s_waitcnt(0);
            unsigned nloc = b.st[0], nx = b.st[1];
            if (nloc == 0u) { xcd_barrier_complete(bar, b.x, nloc, nx); b.st[0] = nloc; b.st[1] = nx; }
            const unsigned old = xb_add(&bar[XB_XSUB(b.x)], 1u);
            __builtin_amdgcn_fence(__ATOMIC_ACQUIRE, "agent");
            const unsigned gen = old / nloc;
            if (old + 1u == (gen + 1u) * nloc) {
                __builtin_amdgcn_fence(__ATOMIC_RELEASE, "agent");
                asm volatile("s_waitcnt vmcnt(0)" ::: "memory");
                const unsigned og = xb_add(&bar[XB_TOP], 1u);
                const unsigned tg = og / nx;
                if (og + 1u == (tg + 1u) * nx) {
#pragma unroll
                    for (unsigned j = 0; j < 16; ++j) xb_add(&bar[XB_XGEN(j)], 1u);
                } else XB_SPIN(xb_ld(&bar[XB_XGEN(b.x)]) == gen, bar);
                asm volatile("s_waitcnt vmcnt(0)" ::: "memory");
            } else {
                XB_SPIN(xb_ld(&bar[XB_XGEN(b.x)]) == gen, bar);
                asm volatile("s_waitcnt vmcnt(0)" ::: "memory");
            }
        }
    } else {
        const int w = (7 - F.wave) * (int)F.G + (int)blockIdx.x, item = prep_slice_begin(slice) + w;
        if (item < prep_slice_begin(slice + 1) && item < L1_ITEMS) prep_l1_item(F, item);
    }
    __syncthreads();
}

struct Args { const float* in[N_IN]; float* out; unsigned char* ws; int ph_lo, ph_hi; };
__global__ void __launch_bounds__(512, 2) dit_fwd(Args args) {
    extern __shared__ __attribute__((aligned(16))) unsigned char lds_raw[];
    Frame F;
    F.lds = (LAS unsigned char*)lds_raw;
    F.tid = threadIdx.x; F.lane = F.tid & 63; F.wave = __builtin_amdgcn_readfirstlane(F.tid >> 6);
    F.G = gridDim.x; F.gw = blockIdx.x * 8 + F.wave; F.NGW = F.G * 8;
#pragma unroll
    for (int i = 0; i < N_IN; ++i) F.in[i] = args.in[i];
    F.out = args.out; F.ws = args.ws;
    for (int u = F.tid; u < (LDS_BYTES - LDSCTL_OFF) / 4; u += 512) ((LAS unsigned*)(F.lds + LDSCTL_OFF))[u] = 0u;
    __syncthreads();
    volatile LAS unsigned* MISC = (volatile LAS unsigned*)(F.lds + MISC_OFF);
    XcdBarrier bar; bar.bar = (unsigned*)(F.ws + WS_CTL) + CW_BAR; bar.x = 0; bar.st = nullptr;
    const int lo = args.ph_lo, hi = args.ph_hi;
    if (hi - lo > 1) bar = xcd_barrier_post((unsigned*)(F.ws + WS_CTL) + CW_BAR, MISC + 8);
#ifdef ONLY_PHASE
#define IN(k) ((k) == ONLY_PHASE)
#else
#define IN(k) (lo <= (k) && (k) < hi)
#endif
#define SEAM(k) do { if (IN(k) && IN((k) + 1)) xcd_barrier(bar); } while (0)
#define SEAMP(k, sl) do { if (IN(k) && IN((k) + 1)) xcd_barrier_prep(bar, F, sl); } while (0)
    float* SSQ = WSP(float, WS_SSQ);
    const float* mods = WSP(float, WS_MODS);

    if (IN(0)) {
        unsigned* mt = (unsigned*)(F.ws + WS_CTL) + CW_MODS;
        for (int t = blockIdx.x; t < 192; t += F.G) {
            p0_mods_task(F, t);
            asm volatile("s_waitcnt vmcnt(0)" ::: "memory");
            __syncthreads();
            if (F.tid == 0) (void)__hip_atomic_fetch_add(mt, 1u, __ATOMIC_RELAXED, __HIP_MEMORY_SCOPE_AGENT);
        }
        phase_p0(F, 0, F.gw, F.NGW);
        if (F.tid == 0) { unsigned sp = 0; while (__hip_atomic_load(mt, __ATOMIC_RELAXED, __HIP_MEMORY_SCOPE_AGENT) < 192u) { __builtin_amdgcn_s_sleep(2); if (++sp > (1u << 22)) break; }
            __builtin_amdgcn_fence(__ATOMIC_ACQUIRE, "agent"); asm volatile("s_waitcnt vmcnt(0)" ::: "memory"); }
        __syncthreads();
        phase_p1(F, 0, F.wave * F.G + blockIdx.x, F.NGW);
    } SEAMP(0, 0);
    if (IN(2)) { for (int rep_ = 0; rep_ <= ((PROBE_REP_MASK >> 2) & 1); ++rep_) { if (rep_) xcd_barrier(bar);
        pg8::Gemm g{WSP(bf16_t, WS_A1), WSP(bf16_t, WS_WIN0), (long)NIN0 * D, (long)2 * NIN0 * D, D};
        pg8::Order S; S.init(ML / 256, NIN0 / 256, F.G, blockIdx.x);
        pg8::EpiInProj E{WSP(bf16_t, WS_BIG), WSP(float, WS_SS0), WSP(float, WS_B_IN0)};
        pg8::gemm_phase<pg8::EpiInProj, pg8::Order, true, true>(F.lds, g, S, E);
        __syncthreads();
        ctx_proj_wg(F);
    } } SEAMP(2, 1);
    if (IN(3)) { for (int rep_ = 0; rep_ <= ((PROBE_REP_MASK >> 3) & 1); ++rep_) { if (rep_) xcd_barrier(bar);
        attn_phase(F);
        __syncthreads();
        for (int t = blockIdx.x; t < 256; t += F.G) lru_pass1_wg(F, t);
        for (int t = blockIdx.x; t < 256; t += F.G) lru_pass3_wg(F, t, F.G >= 256);
    } }
    SEAMP(5, 2);
    if (IN(6)) { for (int rep_ = 0; rep_ <= ((PROBE_REP_MASK >> 6) & 1); ++rep_) { if (rep_) xcd_barrier(bar);
        pg8::Gemm g{WSP(bf16_t, WS_A2), WSP(bf16_t, WS_WOUT0), 0l, 0l, D};
        pg8::Order S; S.init(ML / 256, D / 256, F.G, blockIdx.x);
        pg8::EpiRes<false, false> E{nullptr, WSP(bf16_t, WS_A1), WSP(bf16_t, WS_A3), nullptr, mods + 2048, SSQ, (unsigned)(uintptr_t)(F.lds + 132096)};
        pg8::gemm_phase<pg8::EpiRes<false, false>, pg8::Order, true, true>(F.lds, g, S, E);
    } } SEAMP(6, 3);
    if (IN(7)) { for (int rep_ = 0; rep_ <= ((PROBE_REP_MASK >> 7) & 1); ++rep_) { if (rep_) xcd_barrier(bar);
        pg8::Gemm g{WSP(bf16_t, WS_A3), WSP(bf16_t, WS_WGU0), (long)NGU * D, 0l, D};
        pg8::Order S; S.init(ML / 256, NGU / 256, F.G, blockIdx.x);
        pg8::EpiSwiGLU E{WSP(bf16_t, WS_BIG), SSQ, WSP(float, WS_B_GU0)};
        pg8::gemm_phase<pg8::EpiSwiGLU, pg8::Order, true, true>(F.lds, g, S, E);
    } } SEAMP(7, 4);
    if (IN(8)) { for (int rep_ = 0; rep_ <= ((PROBE_REP_MASK >> 8) & 1); ++rep_) { if (rep_) xcd_barrier(bar);
        pg8::Gemm g{WSP(bf16_t, WS_BIG), WSP(bf16_t, WS_WDN0), 0l, 0l, FF};
        pg8::Order S; S.init(ML / 256, D / 256, F.G, blockIdx.x);
        pg8::EpiRes<false, false> E{nullptr, WSP(bf16_t, WS_A3), WSP(bf16_t, WS_A2), nullptr, mods + 5120, SSQ + ML, (unsigned)(uintptr_t)(F.lds + 132096)};
        pg8::gemm_phase<pg8::EpiRes<false, false>, pg8::Order, true, true>(F.lds, g, S, E);
    } } SEAMP(8, 5);
    if (IN(9)) { for (int rep_ = 0; rep_ <= ((PROBE_REP_MASK >> 9) & 1); ++rep_) { if (rep_) xcd_barrier(bar);
        pg8::Gemm g{WSP(bf16_t, WS_A2), WSP(bf16_t, WS_WIN1), (long)NIN1 * D, 0l, D};
        pg8::Order S; S.init(ML / 256, 8, F.G, blockIdx.x); S.pn_off = 4;
        pg8::EpiScIn E{WSP(bf16_t, WS_A1), WSP(bf16_t, WS_A3), SSQ + ML, WSP(float, WS_B_IN1)};
        pg8::gemm_phase<pg8::EpiScIn, pg8::Order, true, true>(F.lds, g, S, E);
    } } SEAMP(9, 6);
    if (IN(10)) { for (int rep_ = 0; rep_ <= ((PROBE_REP_MASK >> 10) & 1); ++rep_) { if (rep_) xcd_barrier(bar);
        pg8::Gemm g{WSP(bf16_t, WS_A2), WSP(bf16_t, WS_WIN1), (long)NIN1 * D, 0l, D};
        pg8::Order S; S.init(ML / 256, 4, F.G, blockIdx.x);
        pg8::EpiScGate E{WSP(bf16_t, WS_A1), WSP(bf16_t, WS_A3), SSQ + ML, WSP(float, WS_B_IN1), F.in[I_OCW]};
        pg8::gemm_phase<pg8::EpiScGate, pg8::Order, true, true>(F.lds, g, S, E);
    } } SEAMP(10, 7);
    if (IN(11)) { for (int rep_ = 0; rep_ <= ((PROBE_REP_MASK >> 11) & 1); ++rep_) { if (rep_) xcd_barrier(bar);
        pg8::Gemm g{WSP(bf16_t, WS_A1), WSP(bf16_t, WS_WOUT1), 0l, 0l, D};
        pg8::Order S; S.init(ML / 256, D / 256, F.G, blockIdx.x);
        pg8::EpiRes<false, false> E{nullptr, WSP(bf16_t, WS_A2), WSP(bf16_t, WS_A3), nullptr, mods + 3 * 6144 + 2048, SSQ + 2 * ML, (unsigned)(uintptr_t)(F.lds + 132096)};
        pg8::gemm_phase<pg8::EpiRes<false, false>, pg8::Order, true, true>(F.lds, g, S, E);
    } } SEAMP(11, 8);
    if (IN(12)) { for (int rep_ = 0; rep_ <= ((PROBE_REP_MASK >> 12) & 1); ++rep_) { if (rep_) xcd_barrier(bar);
        pg8::Gemm g{WSP(bf16_t, WS_A3), WSP(bf16_t, WS_WGU1), (long)NGU * D, 0l, D};
        pg8::Order S; S.init(ML / 256, NGU / 256, F.G, blockIdx.x);
        pg8::EpiSwiGLU E{WSP(bf16_t, WS_BIG), SSQ + 2 * ML, WSP(float, WS_B_GU1)};
        pg8::gemm_phase<pg8::EpiSwiGLU, pg8::Order, true, true>(F.lds, g, S, E);
    } } SEAM(12);
    if (IN(13)) { for (int rep_ = 0; rep_ <= ((PROBE_REP_MASK >> 13) & 1); ++rep_) { if (rep_) xcd_barrier(bar);
        pg8::Gemm g{WSP(bf16_t, WS_BIG), WSP(bf16_t, WS_WDN1), 0l, 0l, FF};
        pg8::Order S; S.init(ML / 256, D / 256, F.G, blockIdx.x);
        pg8::EpiFinal E{WSP(bf16_t, WS_A3), F.out, mods + 3 * 6144 + 5120, SSQ + 3 * ML, (unsigned*)(F.ws + WS_CTL) + CW_PCNT, F.in[I_FG], (unsigned)(uintptr_t)(F.lds + 132096)};
        pg8::gemm_phase<pg8::EpiFinal, pg8::Order, true, true>(F.lds, g, S, E);
    } }
#undef IN
#undef SEAM
#undef SEAMP
}

extern "C" void kernel_launch(void* const* d_in, const int* in_sizes, int n_in, void* d_out, int out_size, void* d_ws, size_t ws_size, hipStream_t stream) {
    static int grid = 0;
    if (grid == 0) {
        if (n_in != N_IN || in_sizes[0] != ML * D || out_size != ML * D || ws_size < WS_END) { fprintf(stderr, "kernel_launch: unexpected shapes (n_in %d, in0 %d, out %d, ws %zu)\n", n_in, n_in > 0 ? in_sizes[0] : -1, out_size, ws_size); grid = -1; return; }
        int dev = 0, cus = 0;
        if (hipGetDevice(&dev) != hipSuccess || hipDeviceGetAttribute(&cus, hipDeviceAttributeMultiprocessorCount, dev) != hipSuccess) { grid = -1; return; }
        if (hipFuncSetAttribute((const void*)dit_fwd, hipFuncAttributeMaxDynamicSharedMemorySize, LDS_BYTES) != hipSuccess) { fprintf(stderr, "kernel_launch: hipFuncSetAttribute failed\n"); grid = -1; return; }
        int per_cu = 0;
        if (hipOccupancyMaxActiveBlocksPerMultiprocessor(&per_cu, (const void*)dit_fwd, 512, LDS_BYTES) != hipSuccess || per_cu < 1) fprintf(stderr, "kernel_launch: note: occupancy query reports %d\n", per_cu);
        (void)hipGetLastError();
        grid = cus;
    }
    if (grid < 0) return;
    if (hipMemsetAsync((char*)d_ws + WS_CTL, 0, CTL_ZERO_BYTES, stream) != hipSuccess) { fprintf(stderr, "kernel_launch: memset failed\n"); return; }
    Args a{};
    for (int i = 0; i < N_IN; ++i) a.in[i] = (const float*)d_in[i];
    a.out = (float*)d_out; a.ws = (unsigned char*)d_ws;
    constexpr int NPH = 14;
#if MK_PER_PHASE
    for (int p = 0; p < NPH; ++p) { a.ph_lo = p; a.ph_hi = p + 1; hipLaunchKernelGGL(dit_fwd, dim3(grid), dim3(512), LDS_BYTES, stream, a); }
#else
    a.ph_lo = 0; a.ph_hi = NPH;
    hipLaunchKernelGGL(dit_fwd, dim3(grid), dim3(512), LDS_BYTES, stream, a);
#endif
    const hipError_t le = hipPeekAtLastError();
    if (le != hipSuccess) fprintf(stderr, "kernel_launch: launch failed: %s\n", hipGetErrorName(le));
}
```

```cpp
#include <hip/hip_runtime.h>
#include <cstdio>
#include <cstdint>
#include <type_traits>

#ifndef PROBE_REP_MASK
#define PROBE_REP_MASK 0
#endif
#ifndef MK_PER_PHASE
#define MK_PER_PHASE 0
#endif

#define GAS __attribute__((address_space(1)))
#define LAS __attribute__((address_space(3)))
typedef unsigned short bf16_t;
typedef short bf16x8 __attribute__((ext_vector_type(8)));
typedef short s16x4 __attribute__((ext_vector_type(4)));
typedef float f32x4 __attribute__((ext_vector_type(4)));
typedef float f32x2 __attribute__((ext_vector_type(2)));
typedef float f32x16 __attribute__((ext_vector_type(16)));
typedef unsigned u32x4 __attribute__((ext_vector_type(4)));
typedef unsigned u32x2 __attribute__((ext_vector_type(2)));

constexpr int D = 1024, NB = 2, SEQ = 16384, ML = NB * SEQ, NCTX = 256, MC = NB * NCTX, MT = ML + MC;
constexpr int NIN0 = 2560, FF = 2816, NGU = 2 * FF, NIN1 = 3072;
constexpr int NCHUNK = 128, CHUNK = SEQ / NCHUNK  , NCI = NCHUNK + 2;
constexpr float EPS = 1e-6f;
constexpr float LOG2E = 1.4426950408889634f;
constexpr float QSCALE = 0.125f * LOG2E;
enum { I_X = 0, I_C, I_CTX, I_CCTX, I_MODW, I_MODB, I_N1G, I_N2G, I_WGU, I_WDN, I_EWIN, I_EWOUT, I_ECW, I_ECB, I_LWR, I_LBR, I_LWI, I_LBI, I_LAM, I_RPB, I_OWIN, I_OCW, I_OWOUT, I_FG, N_IN };

constexpr size_t MiB = 1u << 20;
constexpr size_t WS_CTL = 0, CTL_ZERO_BYTES = 1 * MiB + 160 * 1024;
constexpr size_t WS_SSQ = 256 * 1024;
constexpr size_t WS_B_IN0 = 768 * 1024;
constexpr size_t WS_B_GU0 = WS_B_IN0 + 3 * 2560 * 4;
constexpr size_t WS_B_IN1 = WS_B_GU0 + 2 * 5632 * 4;
constexpr size_t WS_B_GU1 = WS_B_IN1 + 2 * 3072 * 4;
static_assert(WS_B_GU1 + 2 * 5632 * 4 <= 1024 * 1024, "zeroed region");
constexpr size_t WS_MODS = 1 * MiB;
constexpr size_t WS_SS0 = WS_MODS + 160 * 1024;
constexpr size_t WS_BP_IN0 = WS_SS0 + 136 * 1024;
constexpr size_t WS_BP_GU0 = WS_BP_IN0 + 128 * 1024;
constexpr size_t WS_BP_IN1 = WS_BP_GU0 + 192 * 1024;
constexpr size_t WS_BP_GU1 = WS_BP_IN1 + 128 * 1024;
static_assert(WS_BP_GU1 + 192 * 1024 <= 4 * MiB, "small map");
constexpr size_t WS_TOT = 4 * MiB;
constexpr size_t WS_TOTG = 6 * MiB;
constexpr size_t WS_TOTC = 6 * MiB + 256 * 1024;
constexpr size_t WS_LRUW = 6 * MiB + 512 * 1024;
constexpr size_t WS_WIN0 = 8 * MiB;
constexpr size_t WS_WOUT0 = 23 * MiB;
constexpr size_t WS_WGU0 = 25 * MiB;
constexpr size_t WS_WDN0 = 47 * MiB;
constexpr size_t WS_WIN1 = 53 * MiB;
constexpr size_t WS_WOUT1 = 65 * MiB;
constexpr size_t WS_WGU1 = 67 * MiB;
constexpr size_t WS_WDN1 = 89 * MiB;
constexpr size_t WS_A1 = 96 * MiB;
constexpr size_t WS_A2 = 161 * MiB;
constexpr size_t WS_A3 = 225 * MiB;
constexpr size_t WS_BIG = 289 * MiB;
constexpr size_t WS_XCONV = 465 * MiB;
constexpr size_t WS_END = 498 * MiB;

constexpr int CW_BAR = 4096;
constexpr int CW_MODS = 3968;
constexpr int CW_LRUG = 16384 + 8192;
constexpr int CW_PCNT = 16384;

constexpr int RING_BYTES = 131072, LDS_BYTES = 163840, LDSCTL_OFF = LDS_BYTES - 1024, MISC_OFF = LDSCTL_OFF + 320;

#define LDS_WAIT() asm volatile("s_waitcnt lgkmcnt(0)" ::: "memory")
#define VM_WAIT() asm volatile("s_waitcnt vmcnt(0)" ::: "memory")
#define RLX_AGENT __ATOMIC_RELAXED, __HIP_MEMORY_SCOPE_AGENT
__device__ __forceinline__ unsigned pk2(float lo, float hi) { unsigned r; asm("v_cvt_pk_bf16_f32 %0, %1, %2" : "=v"(r) : "v"(lo), "v"(hi)); return r; }
__device__ __forceinline__ unsigned f2bf(float f) { return pk2(f, f) & 0xffffu; }
__device__ __forceinline__ float bflo(unsigned u) { return __builtin_bit_cast(float, u << 16); }
__device__ __forceinline__ float bfhi(unsigned u) { return __builtin_bit_cast(float, u & 0xffff0000u); }
__device__ __forceinline__ float bf1(bf16_t h) { return __builtin_bit_cast(float, (unsigned)h << 16); }
__device__ __forceinline__ float wave_sum(float v) {
#pragma unroll
    for (int o = 1; o < 64; o <<= 1) v += __shfl_xor(v, o);
    return v;
}
__device__ __forceinline__ float fast_rsq(float x) { return __builtin_amdgcn_rsqf(x); }
__device__ __forceinline__ float fast_exp2(float x) { return __builtin_amdgcn_exp2f(x); }
__device__ __forceinline__ float fast_rcp(float x) { return __builtin_amdgcn_rcpf(x); }
__device__ __forceinline__ float sigmoidf_(float x) { return fast_rcp(1.f + fast_exp2(-x * LOG2E)); }
__device__ __forceinline__ float siluf_(float x) { return x * sigmoidf_(x); }
__device__ __forceinline__ float gelu_tanh(float x) {
    constexpr float C1 = -2.f * 0.7978845608028654f * LOG2E, C2 = C1 * 0.044715f;
    const float t = x * (C1 + C2 * (x * x));
    return x * fast_rcp(1.f + fast_exp2(t));
}

__device__ __forceinline__ float sum_fq(float q) {
    const auto a = __builtin_amdgcn_permlane32_swap(__float_as_uint(q), __float_as_uint(q), false, false);
    const float s = __uint_as_float(a[0]) + __uint_as_float(a[1]);
    const auto b = __builtin_amdgcn_permlane16_swap(__float_as_uint(s), __float_as_uint(s), false, false);
    return __uint_as_float(b[0]) + __uint_as_float(b[1]);
}
__device__ __forceinline__ void st8_wt(void* p, f32x2 v) { asm volatile("global_store_dwordx2 %0, %1, off sc1\n\ts_nop 1" :: "v"(p), "v"(v) : "memory"); }
__device__ __forceinline__ f32x2 ld8_sc1(const f32x2* p) { const unsigned long long u = __hip_atomic_load((const unsigned long long*)p, __ATOMIC_RELAXED, __HIP_MEMORY_SCOPE_AGENT); return __builtin_bit_cast(f32x2, u); }
__device__ __forceinline__ void st16_wt(void* p, u32x4 v) { asm volatile("global_store_dwordx4 %0, %1, off sc1\n\ts_nop 1" :: "v"(p), "v"(v) : "memory"); }
namespace pg8 {
constexpr int BM = 256, BK = 64, HALF = 128, HTB = HALF * BK * 2, STAGE_BYTES = 8 * HTB, NXCD = 8, WGM = 8;
__host__ __device__ __forceinline__ int lds_byte(int r, int c) { const int st = (r >> 4) * 2 + (c >> 5), rr = r & 15, cc = c & 31, ob = rr * 64 + cc * 2; return st * 1024 + (ob ^ (((ob >> 9) & 1) << 5)); }
__host__ __device__ __forceinline__ void stage_rc(int b, int& R, int& C) { const int st = b / 1024, sb = b % 1024, swz = sb ^ (((sb >> 9) & 1) << 5); R = (st >> 1) * 16 + swz / 64; C = (st & 1) * 32 + (swz % 64) / 2; }
__host__ __device__ __forceinline__ int perm32(int rho) { const int n = rho >> 4, i = rho & 15; return 8 * (i >> 2) + 4 * n + (i & 3); }

struct Unit { int pm, pn; bool last; };
#define PG8_ST16(u_, ptr, w) do { if ((u_).last) st16_wt((ptr), (w)); else *(u32x4*)(ptr) = (w); } while (0)
struct Gemm { const bf16_t* A; const bf16_t* Bt; long boff1, boff2; int K; };
__device__ __forceinline__ const char* bsel(const bf16_t* Bt, long boff1, long boff2, const Unit& u) { const long o = u.pm < 64 ? 0l : (u.pm < 128 ? boff1 : boff2); return (const char*)(Bt + o); }

struct Order {
    int nM, nN, nwg, G, c, nextra, xpm0, xpn0, xnpn, pn_off = 0;
    __device__ void init(int nM_, int nN_, int G_, int c_, int nextra_ = 0, int xpm0_ = 0, int xpn0_ = 0, int xnpn_ = 1) { nM = nM_; nN = nN_; nwg = nM * nN; G = G_; c = c_; nextra = nextra_; xpm0 = xpm0_; xpn0 = xpn0_; xnpn = xnpn_; }
    __device__ bool next(int i, Unit& u) const {
        const long L = (long)i * G + c;
        if (L >= nwg) { const int e = (int)(L - nwg); if (e >= nextra) return false; u.pm = xpm0 + e / xnpn; u.pn = xpn0 + e % xnpn; return true; }
        int wgid = (int)L; { const int q = nwg / NXCD, r = nwg % NXCD, xcd = wgid % NXCD, off = wgid / NXCD; wgid = (xcd < r ? xcd * (q + 1) : r * (q + 1) + (xcd - r) * q) + off; }
        const int nig = WGM * nN, gid = wgid / nig, fm = gid * WGM, gsz = (nM - fm) < WGM ? (nM - fm) : WGM;
        u.pm = fm + ((wgid % nig) % gsz); u.pn = (wgid % nig) / gsz + pn_off; return true;
    }
};

__device__ __forceinline__ unsigned cvt_pk_bf16(float lo, float hi) { return pk2(lo, hi); }


struct EpiPre { f32x4 bv[2][2]; float ssr[2][4]; };
struct EpiInProj {
    static constexpr bool PERM = true; static constexpr bool IDEMP = true;
    typedef EpiPre Pre;
    bf16_t* O; const float* ss; const float* bias;
    __device__ __forceinline__ void prefetch(const Unit& u, int wr, int wc, int fr, int fq, Pre& p) const {
        const int row0 = u.pm * BM + wr * 64 + fr, col0 = u.pn * BM + wc * 32 + 8 * fq;
        const int v = u.pm < 64 ? 0 : (u.pm < 128 ? 1 : 2);
        const float* bp = bias + (size_t)v * NIN0 + col0;
#pragma unroll
        for (int bj = 0; bj < 2; ++bj)
#pragma unroll
            for (int n = 0; n < 2; ++n) p.bv[bj][n] = *(const f32x4*)(bp + bj * HALF + 4 * n);
#pragma unroll
        for (int ai = 0; ai < 2; ++ai)
#pragma unroll
            for (int m = 0; m < 4; ++m) p.ssr[ai][m] = ss[row0 + ai * HALF + m * 16];
    }
    __device__ __forceinline__ void operator()(const f32x4 (&acc)[2][2][4][2], const Unit& u, const Pre& p, int wr, int wc, int fr, int fq) const {
        const int row0 = u.pm * BM + wr * 64 + fr, col0 = u.pn * BM + wc * 32 + 8 * fq;
#pragma unroll
        for (int ai = 0; ai < 2; ++ai)
#pragma unroll
            for (int m = 0; m < 4; ++m) { const int row = row0 + ai * HALF + m * 16; const float rs = fast_rsq(p.ssr[ai][m] * (1.f / D) + EPS); bf16_t* rowp = O + (size_t)row * NIN0 + col0;
#pragma unroll
                for (int bj = 0; bj < 2; ++bj) { const f32x4 v0 = acc[ai][bj][m][0] * rs + p.bv[bj][0], v1 = acc[ai][bj][m][1] * rs + p.bv[bj][1];
                    u32x4 w; w.x = cvt_pk_bf16(v0[0], v0[1]); w.y = cvt_pk_bf16(v0[2], v0[3]); w.z = cvt_pk_bf16(v1[0], v1[1]); w.w = cvt_pk_bf16(v1[2], v1[3]);
                    PG8_ST16(u, rowp + bj * HALF, w); } }
    }
};

__device__ __forceinline__ void tile_row_ssq(const float (&qv)[2][4], unsigned Paddr, float* ssq_panel, int wr, int wc, int fr, int fq) {
    if (fq == 0) {
#pragma unroll
        for (int ai = 0; ai < 2; ++ai)
#pragma unroll
            for (int m = 0; m < 4; ++m) { const unsigned a_ = Paddr + (unsigned)(((ai * HALF + wr * 64 + m * 16 + fr) * 4 + wc) * 4); asm volatile("ds_write_b32 %0, %1" :: "v"(a_), "v"(qv[ai][m]) : "memory"); }
    }
    asm volatile("s_waitcnt lgkmcnt(0)" ::: "memory"); __builtin_amdgcn_s_barrier(); asm volatile("" ::: "memory");
    if (threadIdx.x < 256) { f32x4 v; const unsigned a_ = Paddr + threadIdx.x * 16u;
        asm volatile("ds_read_b128 %0, %1\n\ts_waitcnt lgkmcnt(0)" : "=v"(v) : "v"(a_) : "memory");
        unsafeAtomicAdd(ssq_panel + threadIdx.x, (v[0] + v[1]) + (v[2] + v[3])); }
}
struct EpiPreG { f32x4 gv[2][2]; };
template <bool RES_F32, bool OUT_F32> struct EpiRes {
    static constexpr bool PERM = true; static constexpr bool IDEMP = false;
    typedef EpiPreG Pre;
    const float* resf; const bf16_t* resb; bf16_t* Ob; float* Of; const float* gate; float* ssq; unsigned Paddr;
    __device__ __forceinline__ void prefetch(const Unit& u, int wr, int wc, int fr, int fq, Pre& p) const {
        const float* gp = gate + (size_t)(u.pm >> 6) * 6144 + u.pn * BM + wc * 32 + 8 * fq;
#pragma unroll
        for (int bj = 0; bj < 2; ++bj)
#pragma unroll
            for (int n = 0; n < 2; ++n) p.gv[bj][n] = *(const f32x4*)(gp + bj * HALF + 4 * n);
    }
    __device__ __forceinline__ void operator()(const f32x4 (&acc)[2][2][4][2], const Unit& u, const Pre& p, int wr, int wc, int fr, int fq) const {
        const int row0 = u.pm * BM + wr * 64 + fr, col0 = u.pn * BM + wc * 32 + 8 * fq;
        float qv[2][4];
#pragma unroll
        for (int ai = 0; ai < 2; ++ai) {
            f32x4 rf[RES_F32 ? 4 : 1][2][2]; u32x4 rb[1][RES_F32 ? 1 : 4][2];
#pragma unroll
            for (int m = 0; m < 4; ++m) { const size_t off = (size_t)(row0 + ai * HALF + m * 16) * D + col0;
#pragma unroll
                for (int bj = 0; bj < 2; ++bj) {
                    if constexpr (RES_F32) { rf[m][bj][0] = *(const f32x4*)(resf + off + bj * HALF); rf[m][bj][1] = *(const f32x4*)(resf + off + bj * HALF + 4); }
                    else rb[0][m][bj] = *(const u32x4*)(resb + off + bj * HALF); } }
#pragma unroll
            for (int m = 0; m < 4; ++m) { const int row = row0 + ai * HALF + m * 16; const size_t off = (size_t)row * D + col0; float q = 0.f;
#pragma unroll
                for (int bj = 0; bj < 2; ++bj) {
                    f32x4 r0, r1;
                    if constexpr (RES_F32) { r0 = rf[m][bj][0]; r1 = rf[m][bj][1]; }
                    else { const u32x4 t = rb[0][m][bj]; r0 = (f32x4){bflo(t.x), bfhi(t.x), bflo(t.y), bfhi(t.y)}; r1 = (f32x4){bflo(t.z), bfhi(t.z), bflo(t.w), bfhi(t.w)}; }
                    const f32x4 v0 = r0 + p.gv[bj][0] * acc[ai][bj][m][0], v1 = r1 + p.gv[bj][1] * acc[ai][bj][m][1];
                    q += (v0[0] * v0[0] + v0[1] * v0[1]) + (v0[2] * v0[2] + v0[3] * v0[3]) + (v1[0] * v1[0] + v1[1] * v1[1]) + (v1[2] * v1[2] + v1[3] * v1[3]);
                    if constexpr (OUT_F32) { *(f32x4*)(Of + off + bj * HALF) = v0; *(f32x4*)(Of + off + bj * HALF + 4) = v1; }
                    else { u32x4 w; w.x = cvt_pk_bf16(v0[0], v0[1]); w.y = cvt_pk_bf16(v0[2], v0[3]); w.z = cvt_pk_bf16(v1[0], v1[1]); w.w = cvt_pk_bf16(v1[2], v1[3]); PG8_ST16(u, Ob + off + bj * HALF, w); }
                }
                q = sum_fq(q);
                qv[ai][m] = q; }
        }
        tile_row_ssq(qv, Paddr, ssq + u.pm * BM, wr, wc, fr, fq);
    }
};

struct EpiFinal {
    static constexpr bool PERM = true; static constexpr bool IDEMP = false;
    typedef EpiPreG Pre;
    const bf16_t* resb; float* Of; const float* gate; float* ssq; unsigned* pcnt; const float* fg; unsigned Paddr;
    __device__ __forceinline__ void prefetch(const Unit& u, int wr, int wc, int fr, int fq, Pre& p) const {
        const float* gp = gate + (size_t)(u.pm >> 6) * 6144 + u.pn * BM + wc * 32 + 8 * fq;
#pragma unroll
        for (int bj = 0; bj < 2; ++bj)
#pragma unroll
            for (int n = 0; n < 2; ++n) p.gv[bj][n] = *(const f32x4*)(gp + bj * HALF + 4 * n);
    }
    __device__ __forceinline__ void operator()(f32x4 (&acc)[2][2][4][2], const Unit& u, const Pre& p, int wr, int wc, int fr, int fq) const {
        const int row0 = u.pm * BM + wr * 64 + fr, col0 = u.pn * BM + wc * 32 + 8 * fq;
        float qv[2][4];
#pragma unroll
        for (int ai = 0; ai < 2; ++ai) {
            u32x4 rb[4][2];
#pragma unroll
            for (int m = 0; m < 4; ++m) { const size_t off = (size_t)(row0 + ai * HALF + m * 16) * D + col0;
#pragma unroll
                for (int bj = 0; bj < 2; ++bj) rb[m][bj] = *(const u32x4*)(resb + off + bj * HALF); }
#pragma unroll
            for (int m = 0; m < 4; ++m) { const int row = row0 + ai * HALF + m * 16; float q = 0.f;
#pragma unroll
                for (int bj = 0; bj < 2; ++bj) {
                    const u32x4 t = rb[m][bj]; const f32x4 r0 = (f32x4){bflo(t.x), bfhi(t.x), bflo(t.y), bfhi(t.y)}, r1 = (f32x4){bflo(t.z), bfhi(t.z), bflo(t.w), bfhi(t.w)};
                    const f32x4 v0 = r0 + p.gv[bj][0] * acc[ai][bj][m][0], v1 = r1 + p.gv[bj][1] * acc[ai][bj][m][1];
                    q += (v0[0] * v0[0] + v0[1] * v0[1]) + (v0[2] * v0[2] + v0[3] * v0[3]) + (v1[0] * v1[0] + v1[1] * v1[1]) + (v1[2] * v1[2] + v1[3] * v1[3]);
                    acc[ai][bj][m][0] = v0; acc[ai][bj][m][1] = v1;
                }
                q = sum_fq(q);
                qv[ai][m] = q; }
        }
        tile_row_ssq(qv, Paddr, ssq + u.pm * BM, wr, wc, fr, fq);
        asm volatile("s_waitcnt vmcnt(0)" ::: "memory");
        __syncthreads();
        if (threadIdx.x == 0) {
            unsigned* pc = pcnt + 64 * u.pm;
            (void)__hip_atomic_fetch_add(pc, 1u, __ATOMIC_RELAXED, __HIP_MEMORY_SCOPE_AGENT);
            unsigned sp = 0;
            while (__hip_atomic_load(pc, __ATOMIC_RELAXED, __HIP_MEMORY_SCOPE_AGENT) < 4u) { __builtin_amdgcn_s_sleep(1); if (++sp > (1u << 22)) break; }
        }
        __syncthreads();
        f32x4 fv[2][2];
#pragma unroll
        for (int bj = 0; bj < 2; ++bj)
#pragma unroll
            for (int n = 0; n < 2; ++n) fv[bj][n] = *(const f32x4*)(fg + col0 + bj * HALF + 4 * n);
        float ssv[2][4];
#pragma unroll
        for (int ai = 0; ai < 2; ++ai)
#pragma unroll
            for (int m = 0; m < 4; ++m) ssv[ai][m] = __hip_atomic_load(ssq + row0 + ai * HALF + m * 16, __ATOMIC_RELAXED, __HIP_MEMORY_SCOPE_AGENT);
#pragma unroll
        for (int ai = 0; ai < 2; ++ai)
#pragma unroll
            for (int m = 0; m < 4; ++m) { const float rs = fast_rsq(ssv[ai][m] * (1.f / D) + EPS); const size_t off = (size_t)(row0 + ai * HALF + m * 16) * D + col0;
#pragma unroll
                for (int bj = 0; bj < 2; ++bj) { *(f32x4*)(Of + off + bj * HALF) = acc[ai][bj][m][0] * rs * fv[bj][0]; *(f32x4*)(Of + off + bj * HALF + 4) = acc[ai][bj][m][1] * rs * fv[bj][1]; } }
    }
};

struct EpiSwiGLU {
    static constexpr bool PERM = true; static constexpr bool IDEMP = true;
    typedef EpiPre Pre;
    bf16_t* O; const float* ss; const float* bias;
    __device__ __forceinline__ void prefetch(const Unit& u, int wr, int wc, int fr, int fq, Pre& p) const {
        const int row0 = u.pm * BM + wr * 64 + fr, colw = u.pn * BM + wc * 32 + 8 * fq;
        const float* bp = bias + (size_t)(u.pm >> 6) * NGU + colw;
#pragma unroll
        for (int bj = 0; bj < 2; ++bj)
#pragma unroll
            for (int n = 0; n < 2; ++n) p.bv[bj][n] = *(const f32x4*)(bp + bj * HALF + 4 * n);
#pragma unroll
        for (int ai = 0; ai < 2; ++ai)
#pragma unroll
            for (int m = 0; m < 4; ++m) p.ssr[ai][m] = ss[row0 + ai * HALF + m * 16];
    }
    __device__ __forceinline__ void operator()(const f32x4 (&acc)[2][2][4][2], const Unit& u, const Pre& p, int wr, int wc, int fr, int fq) const {
        const int row0 = u.pm * BM + wr * 64 + fr, colo = u.pn * HALF + wc * 32 + 8 * fq;
        f32x4 bg[2], bu[2];
#pragma unroll
        for (int n = 0; n < 2; ++n) { bg[n] = p.bv[0][n] * LOG2E; bu[n] = p.bv[1][n] * (1.f / LOG2E); }
#pragma unroll
        for (int ai = 0; ai < 2; ++ai)
#pragma unroll
            for (int m = 0; m < 4; ++m) { const int row = row0 + ai * HALF + m * 16; const float rs = fast_rsq(p.ssr[ai][m] * (1.f / D) + EPS), rsg = rs * LOG2E, rsu = rs * (1.f / LOG2E);
                f32x4 h[2];
#pragma unroll
                for (int n = 0; n < 2; ++n) {
                    const f32x4 G = acc[ai][0][m][n], U = acc[ai][1][m][n];
                    const f32x2 g0 = G.lo * rsg + bg[n].lo, g1 = G.hi * rsg + bg[n].hi, u0 = U.lo * rsu + bu[n].lo, u1 = U.hi * rsu + bu[n].hi;
                    f32x2 d0 = (f32x2){fast_exp2(-g0.x), fast_exp2(-g0.y)} + 1.f, d1 = (f32x2){fast_exp2(-g1.x), fast_exp2(-g1.y)} + 1.f;
                    const f32x2 r0 = (f32x2){fast_rcp(d0.x), fast_rcp(d0.y)}, r1 = (f32x2){fast_rcp(d1.x), fast_rcp(d1.y)};
                    const f32x2 h0 = (g0 * u0) * r0, h1 = (g1 * u1) * r1;
                    h[n] = (f32x4){h0.x, h0.y, h1.x, h1.y}; }
                u32x4 w; w.x = cvt_pk_bf16(h[0][0], h[0][1]); w.y = cvt_pk_bf16(h[0][2], h[0][3]); w.z = cvt_pk_bf16(h[1][0], h[1][1]); w.w = cvt_pk_bf16(h[1][2], h[1][3]);
                PG8_ST16(u, O + (size_t)row * FF + colo, w); }
    }
};

struct EpiScIn {
    static constexpr bool PERM = true; static constexpr bool IDEMP = true;
    typedef EpiPre Pre;
    bf16_t* BG; bf16_t* P; const float* ss; const float* bias;
    __device__ __forceinline__ void prefetch(const Unit& u, int wr, int wc, int fr, int fq, Pre& p) const {
        const int row0 = u.pm * BM + wr * 64 + fr, colw = u.pn * BM + wc * 32 + 8 * fq;
        const float* bp = bias + (size_t)(u.pm >> 6) * NIN1 + colw;
#pragma unroll
        for (int bj = 0; bj < 2; ++bj)
#pragma unroll
            for (int n = 0; n < 2; ++n) p.bv[bj][n] = *(const f32x4*)(bp + bj * HALF + 4 * n);
#pragma unroll
        for (int ai = 0; ai < 2; ++ai)
#pragma unroll
            for (int m = 0; m < 4; ++m) p.ssr[ai][m] = ss[row0 + ai * HALF + m * 16];
    }
    __device__ __forceinline__ void operator()(const f32x4 (&acc)[2][2][4][2], const Unit& u, const Pre& p, int wr, int wc, int fr, int fq) const {
        const int row0 = u.pm * BM + wr * 64 + fr, colw = u.pn * BM + wc * 32 + 8 * fq;
        if (u.pn < 4) {
#pragma unroll
            for (int ai = 0; ai < 2; ++ai)
#pragma unroll
                for (int m = 0; m < 4; ++m) { const int row = row0 + ai * HALF + m * 16; const float rs = fast_rsq(p.ssr[ai][m] * (1.f / D) + EPS); bf16_t* rowp = BG + (size_t)row * D + colw;
#pragma unroll
                    for (int bj = 0; bj < 2; ++bj) { const f32x4 v0 = acc[ai][bj][m][0] * rs + p.bv[bj][0], v1 = acc[ai][bj][m][1] * rs + p.bv[bj][1];
                        u32x4 w; w.x = cvt_pk_bf16(v0[0], v0[1]); w.y = cvt_pk_bf16(v0[2], v0[3]); w.z = cvt_pk_bf16(v1[0], v1[1]); w.w = cvt_pk_bf16(v1[2], v1[3]);
                        PG8_ST16(u, rowp + bj * HALF, w); } }
        } else {
            const int colo = (u.pn - 4) * HALF + wc * 32 + 8 * fq;
#pragma unroll
            for (int ai = 0; ai < 2; ++ai)
#pragma unroll
                for (int m = 0; m < 4; ++m) { const int row = row0 + ai * HALF + m * 16; const float rs = fast_rsq(p.ssr[ai][m] * (1.f / D) + EPS);
                    f32x4 h[2];
#pragma unroll
                    for (int n = 0; n < 2; ++n) { const f32x4 cgv = acc[ai][0][m][n] * rs + p.bv[0][n], xv = acc[ai][1][m][n] * rs + p.bv[1][n]; h[n] = cgv * xv; }
                    u32x4 w; w.x = cvt_pk_bf16(h[0][0], h[0][1]); w.y = cvt_pk_bf16(h[0][2], h[0][3]); w.z = cvt_pk_bf16(h[1][0], h[1][1]); w.w = cvt_pk_bf16(h[1][2], h[1][3]);
                    PG8_ST16(u, P + (size_t)row * D + colo, w); }
        }
    }
};
struct EpiScGate {
    static constexpr bool PERM = true; static constexpr bool IDEMP = true;
    typedef EpiPre Pre;
    bf16_t* Y; const bf16_t* P; const float* ss; const float* bias; const float* cw;
    __device__ __forceinline__ void prefetch(const Unit& u, int wr, int wc, int fr, int fq, Pre& p) const {
        const int row0 = u.pm * BM + wr * 64 + fr, colw = u.pn * BM + wc * 32 + 8 * fq;
        const float* bp = bias + (size_t)(u.pm >> 6) * NIN1 + colw;
#pragma unroll
        for (int bj = 0; bj < 2; ++bj)
#pragma unroll
            for (int n = 0; n < 2; ++n) p.bv[bj][n] = *(const f32x4*)(bp + bj * HALF + 4 * n);
#pragma unroll
        for (int ai = 0; ai < 2; ++ai)
#pragma unroll
            for (int m = 0; m < 4; ++m) p.ssr[ai][m] = ss[row0 + ai * HALF + m * 16];
    }
    template <int AI, int BJ, int M0, int MC>
    __device__ __forceinline__ void batch(const f32x4 (&acc)[2][2][4][2], const Unit& u, const Pre& p, const f32x4 (&w)[3][2], int row0, int col, int sbeg, int send) const {
        u32x4 raw[MC][3];
#pragma unroll
        for (int mm = 0; mm < MC; ++mm)
#pragma unroll
            for (int j = 0; j < 3; ++j) { const int rr = row0 + AI * HALF + (M0 + mm) * 16 + j - 1;
                raw[mm][j] = (rr >= sbeg && rr < send) ? *(const u32x4*)(P + (size_t)rr * D + col) : (u32x4){0u, 0u, 0u, 0u}; }
        asm volatile("" ::: "memory"); __builtin_amdgcn_sched_barrier(0);
#pragma unroll
        for (int mm = 0; mm < MC; ++mm) { constexpr int dummy = 0; (void)dummy; const int m = M0 + mm; const int row = row0 + AI * HALF + m * 16; const float rs = fast_rsq(p.ssr[AI][m] * (1.f / D) + EPS);
            const f32x4 v0 = acc[AI][BJ][m][0] * rs + p.bv[BJ][0], v1 = acc[AI][BJ][m][1] * rs + p.bv[BJ][1];
            f32x4 c0 = (f32x4){0.f, 0.f, 0.f, 0.f}, c1 = c0;
#pragma unroll
            for (int j = 0; j < 3; ++j) { const u32x4 r = raw[mm][j];
                c0 += w[j][0] * (f32x4){bflo(r.x), bfhi(r.x), bflo(r.y), bfhi(r.y)}; c1 += w[j][1] * (f32x4){bflo(r.z), bfhi(r.z), bflo(r.w), bfhi(r.w)}; }
            const f32x4 y0 = v0 * c0, y1 = v1 * c1;
            u32x4 o; o.x = cvt_pk_bf16(y0[0], y0[1]); o.y = cvt_pk_bf16(y0[2], y0[3]); o.z = cvt_pk_bf16(y1[0], y1[1]); o.w = cvt_pk_bf16(y1[2], y1[3]);
            PG8_ST16(u, Y + (size_t)row * D + col, o); }
        asm volatile("" ::: "memory"); __builtin_amdgcn_sched_barrier(0);
    }
    __device__ __forceinline__ void operator()(const f32x4 (&acc)[2][2][4][2], const Unit& u, const Pre& p, int wr, int wc, int fr, int fq) const {
        const int row0 = u.pm * BM + wr * 64 + fr, colw = u.pn * BM + wc * 32 + 8 * fq;
        const int sbeg = (u.pm * BM / SEQ) * SEQ, send = sbeg + SEQ;
        { const int col = colw; f32x4 w[3][2];
#pragma unroll
          for (int j = 0; j < 3; ++j) { w[j][0] = *(const f32x4*)(cw + j * D + col); w[j][1] = *(const f32x4*)(cw + j * D + col + 4); }
          batch<0, 0, 0, 2>(acc, u, p, w, row0, col, sbeg, send); batch<0, 0, 2, 2>(acc, u, p, w, row0, col, sbeg, send);
          batch<1, 0, 0, 2>(acc, u, p, w, row0, col, sbeg, send); batch<1, 0, 2, 2>(acc, u, p, w, row0, col, sbeg, send); }
        { const int col = colw + HALF; f32x4 w[3][2];
#pragma unroll
          for (int j = 0; j < 3; ++j) { w[j][0] = *(const f32x4*)(cw + j * D + col); w[j][1] = *(const f32x4*)(cw + j * D + col + 4); }
          batch<0, 1, 0, 4>(acc, u, p, w, row0, col, sbeg, send); batch<1, 1, 0, 4>(acc, u, p, w, row0, col, sbeg, send); }
    }
};

template <class Epi, class Sched, bool ALIGN_EPI = false, bool SP2 = false>
__device__ __forceinline__ void gemm_phase(LAS unsigned char* lds, const Gemm g, const Sched& S, const Epi& E) {
    const int tid = threadIdx.x, wid = __builtin_amdgcn_readfirstlane(tid >> 6), lane = tid & 63, wr = wid >> 2, wc = wid & 3, fr = lane & 15, fq = lane >> 4;
    const int K = g.K, nt = K / BK;
    unsigned voffA[2], voffB[2];
#pragma unroll
    for (int i = 0; i < 2; ++i) { const int b_ = tid * 16 + i * 8192; const int R = b_ >> 7, C = 8 * (((b_ >> 4) & 7) ^ ((R >> 1) & 7)); const int Rb = Epi::PERM ? ((R & ~31) + perm32(R & 31)) : R;
        voffA[i] = (unsigned)(R * K + C) * 2u; voffB[i] = (unsigned)(Rb * K + C) * 2u; }
    const size_t kstep = (size_t)(BK * 2);
    const size_t hstep = (size_t)HALF * K * 2;
    const size_t tstep = 2 * hstep;
    const unsigned ldsw = (unsigned)wid * 1024u;
    int aoffk[2], boffk[2];
#pragma unroll
    for (int k = 0; k < 2; ++k) { const int sw = ((4 * k + fq) ^ ((fr >> 1) & 7)) << 4; aoffk[k] = (wr * 64 + fr) * 128 + sw; boffk[k] = (wc * 32 + fr) * 128 + sw; }
#define PG8_SA(b, h) (((b) * 2 + (h)) * HTB)
#define PG8_SB(b, h) ((4 + (b) * 2 + (h)) * HTB)
#define PG8_STAGE(bufoff, gbase, voff) do { _Pragma("unroll") for (int _i = 0; _i < 2; ++_i) \
        __builtin_amdgcn_global_load_lds((const unsigned*)((const char*)(gbase) + (voff)[_i]), (LAS unsigned*)(lds + (bufoff) + ldsw + _i * 8192), 16, 0, 0); } while (0)
#define PG8_LDA(dst, b, h) do { _Pragma("unroll") for (int m = 0; m < 4; ++m) _Pragma("unroll") for (int k = 0; k < 2; ++k) dst[m][k] = *(const LAS bf16x8*)(lds + PG8_SA(b, h) + aoffk[k] + m * 2048); } while (0)
#define PG8_LDB(dst, b, h) do { _Pragma("unroll") for (int n = 0; n < 2; ++n) _Pragma("unroll") for (int k = 0; k < 2; ++k) dst[n][k] = *(const LAS bf16x8*)(lds + PG8_SB(b, h) + boffk[k] + n * 2048); } while (0)
#define PG8_MMA(ai, bj, At, Bt) do { __builtin_amdgcn_s_setprio(1); _Pragma("unroll") for (int m = 0; m < 4; ++m) _Pragma("unroll") for (int n = 0; n < 2; ++n) _Pragma("unroll") for (int k = 0; k < 2; ++k) \
        acc[ai][bj][m][n] = __builtin_amdgcn_mfma_f32_16x16x32_bf16(Bt[n][k], At[m][k], acc[ai][bj][m][n], 0, 0, 0); __builtin_amdgcn_s_setprio(0); } while (0)
#define PG8_WAIT_V(n) asm volatile("s_waitcnt vmcnt(" #n ")" ::: "memory")
#define PG8_WAIT_L(n) asm volatile("s_waitcnt lgkmcnt(" #n ")" ::: "memory")
#define PG8_BAR __builtin_amdgcn_s_barrier()
#define PG8_SCHED __builtin_amdgcn_sched_barrier(0)
    Unit cur, nxt; int ui = 0;
    if (!S.next(0, cur)) return;
    f32x4 acc[2][2][4][2];
#pragma unroll
    for (int a = 0; a < 2; ++a)
#pragma unroll
        for (int b = 0; b < 2; ++b)
#pragma unroll
            for (int m = 0; m < 4; ++m)
#pragma unroll
                for (int n = 0; n < 2; ++n) acc[a][b][m][n] = (f32x4){0.f, 0.f, 0.f, 0.f};
    bf16x8 At[4][2], B0[2][2], B1[2][2];
    typename Epi::Pre pre; E.prefetch(cur, wr, wc, fr, fq, pre);
    const char* cA = (const char*)g.A + (size_t)cur.pm * tstep; const bf16_t* gBt = g.Bt; const long gb1 = g.boff1, gb2 = g.boff2;
    const char* cB = bsel(gBt, gb1, gb2, cur) + (size_t)cur.pn * tstep;
    if constexpr (SP2) {
        PG8_STAGE(PG8_SB(0, 0), cB, voffB); PG8_STAGE(PG8_SB(0, 1), cB + hstep, voffB); PG8_STAGE(PG8_SA(0, 0), cA, voffA); PG8_STAGE(PG8_SA(0, 1), cA + hstep, voffA);
        if (wr == 1) PG8_BAR;
        PG8_WAIT_V(2); PG8_BAR;
        PG8_STAGE(PG8_SB(1, 0), cB + kstep, voffB); PG8_STAGE(PG8_SA(1, 0), cA + kstep, voffA); PG8_STAGE(PG8_SB(1, 1), cB + hstep + kstep, voffB);
        PG8_WAIT_V(6); PG8_BAR;
    } else {
        PG8_STAGE(PG8_SB(0, 0), cB, voffB); PG8_STAGE(PG8_SA(0, 0), cA, voffA); PG8_STAGE(PG8_SB(0, 1), cB + hstep, voffB); PG8_STAGE(PG8_SA(0, 1), cA + hstep, voffA);
        if (wr == 1) PG8_BAR;
        PG8_WAIT_V(4); PG8_BAR;
        PG8_STAGE(PG8_SB(1, 0), cB + kstep, voffB); PG8_STAGE(PG8_SA(1, 0), cA + kstep, voffA); PG8_STAGE(PG8_SB(1, 1), cB + hstep + kstep, voffB);
        PG8_WAIT_V(6); PG8_BAR;
    }
    for (;;) {
        const bool has_next = S.next(ui + 1, nxt);
        cur.last = !has_next;
        const char* nA = has_next ? (const char*)g.A + (size_t)nxt.pm * tstep : cA; const char* nB = has_next ? bsel(gBt, gb1, gb2, nxt) + (size_t)nxt.pn * tstep : cB;
        for (int t = 0; t < nt; t += 2) {
            const bool last = (t == nt - 2);
            const char* a1 = cA + (size_t)(t + 1) * kstep;
            const char* a2 = last ? nA : cA + (size_t)(t + 2) * kstep; const char* b2 = last ? nB : cB + (size_t)(t + 2) * kstep;
            const char* a3 = a2 + kstep; const char* b3 = b2 + kstep;
            if constexpr (SP2) {
            PG8_LDB(B0, 0, 0); PG8_LDB(B1, 0, 1); PG8_SCHED; PG8_LDA(At, 0, 0); PG8_STAGE(PG8_SA(1, 1), a1 + hstep, voffA);
            PG8_WAIT_V(8); PG8_WAIT_L(0); PG8_BAR; PG8_MMA(0, 0, At, B0); PG8_MMA(0, 1, At, B1); PG8_BAR; PG8_SCHED;
            PG8_LDA(At, 0, 1); PG8_STAGE(PG8_SB(0, 0), b2, voffB); PG8_STAGE(PG8_SB(0, 1), b2 + hstep, voffB); PG8_STAGE(PG8_SA(0, 0), a2, voffA);
            PG8_WAIT_V(8); PG8_WAIT_L(0); PG8_BAR; PG8_MMA(1, 0, At, B0); PG8_MMA(1, 1, At, B1); PG8_BAR; PG8_SCHED;
            PG8_LDB(B0, 1, 0); PG8_LDB(B1, 1, 1); PG8_SCHED; PG8_LDA(At, 1, 0); PG8_STAGE(PG8_SA(0, 1), a2 + hstep, voffA);
            PG8_WAIT_V(8); PG8_WAIT_L(0); PG8_BAR; PG8_MMA(0, 0, At, B0); PG8_MMA(0, 1, At, B1); PG8_BAR; PG8_SCHED;
            PG8_LDA(At, 1, 1); PG8_STAGE(PG8_SB(1, 0), b3, voffB); PG8_STAGE(PG8_SB(1, 1), b3 + hstep, voffB); PG8_STAGE(PG8_SA(1, 0), a3, voffA);
            PG8_WAIT_V(8); PG8_WAIT_L(0); PG8_BAR; PG8_MMA(1, 0, At, B0); PG8_MMA(1, 1, At, B1); PG8_BAR; PG8_SCHED;
            } else {
            PG8_LDB(B0, 0, 0); PG8_SCHED; PG8_LDA(At, 0, 0); PG8_STAGE(PG8_SA(1, 1), a1 + hstep, voffA);
            PG8_WAIT_L(8); PG8_BAR; PG8_WAIT_L(0); PG8_MMA(0, 0, At, B0); PG8_BAR; PG8_SCHED;
            PG8_LDB(B1, 0, 1); PG8_STAGE(PG8_SB(0, 0), b2, voffB);
            PG8_BAR; PG8_WAIT_L(0); PG8_MMA(0, 1, At, B1); PG8_BAR;
            PG8_LDA(At, 0, 1); PG8_STAGE(PG8_SA(0, 0), a2, voffA);
            PG8_BAR; PG8_WAIT_L(0); PG8_MMA(1, 0, At, B0); PG8_BAR; PG8_SCHED;
            PG8_STAGE(PG8_SB(0, 1), b2 + hstep, voffB);
            PG8_WAIT_V(6); PG8_BAR; PG8_MMA(1, 1, At, B1); PG8_BAR;
            PG8_LDB(B0, 1, 0); PG8_SCHED; PG8_LDA(At, 1, 0); PG8_STAGE(PG8_SA(0, 1), a2 + hstep, voffA);
            PG8_WAIT_L(8); PG8_BAR; PG8_WAIT_L(0); PG8_MMA(0, 0, At, B0); PG8_BAR; PG8_SCHED;
            PG8_LDB(B1, 1, 1); PG8_STAGE(PG8_SB(1, 0), b3, voffB);
            PG8_BAR; PG8_WAIT_L(0); PG8_MMA(0, 1, At, B1); PG8_BAR;
            PG8_LDA(At, 1, 1); PG8_STAGE(PG8_SA(1, 0), a3, voffA);
            PG8_BAR; PG8_WAIT_L(0); PG8_MMA(1, 0, At, B0); PG8_BAR; PG8_SCHED;
            PG8_STAGE(PG8_SB(1, 1), b3 + hstep, voffB);
            PG8_WAIT_V(6); PG8_BAR; PG8_MMA(1, 1, At, B1); PG8_BAR;
            }
        }
        if constexpr (ALIGN_EPI) { if (wr == 0) PG8_BAR; }
        E(acc, cur, pre, wr, wc, fr, fq);
#ifdef PROBE_EPI2
        if constexpr (Epi::IDEMP) { asm volatile("" ::: "memory"); E(acc, cur, pre, wr, wc, fr, fq); }
#endif
        if (!has_next) break;
        E.prefetch(nxt, wr, wc, fr, fq, pre);
        { bf16x8 zz;
#pragma unroll
          for (int j = 0; j < 8; ++j) zz[j] = 0;
          asm volatile("s_nop 3" : "+v"(zz));
#pragma unroll
          for (int b = 0; b < 2; ++b)
#pragma unroll
              for (int m = 0; m < 4; ++m)
#pragma unroll
                  for (int n = 0; n < 2; ++n) { asm volatile("v_mfma_f32_16x16x32_bf16 %0, %1, %1, 0" : "=&v"(acc[1][b][m][n]) : "v"(zz));
                      acc[0][b][m][n] = (f32x4){0.f, 0.f, 0.f, 0.f}; } }
        cur = nxt; cA = nA; cB = nB; ++ui;
        if constexpr (ALIGN_EPI) { if (wr == 1) PG8_BAR; }
    }
    PG8_WAIT_V(0);
    if constexpr (!ALIGN_EPI) { if (wr == 0) PG8_BAR; }
    PG8_BAR;
#undef PG8_SA
#undef PG8_SB
#undef PG8_STAGE
#undef PG8_LDA
#undef PG8_LDB
#undef PG8_MMA
#undef PG8_WAIT_V
#undef PG8_WAIT_L
#undef PG8_BAR
#undef PG8_SCHED
}
}

#define XB_TMO      128
#define XB_XCNT(j)  (256  + 64 * (j))
#define XB_XSUB(j)  (1280 + 64 * (j))
#define XB_XGEN(j)  (2304 + 64 * (j))
#define XB_TOP      3328
#define XB_TOPGEN   3392
#define XCD_BAR_WORDS 3456
#define XB_SPIN_CAP (1u << 18)
__device__ __forceinline__ unsigned xb_ld(unsigned* p)              { return __hip_atomic_load(p, __ATOMIC_RELAXED, __HIP_MEMORY_SCOPE_AGENT); }
__device__ __forceinline__ unsigned xb_add(unsigned* p, unsigned v) { return __hip_atomic_fetch_add(p, v, __ATOMIC_RELAXED, __HIP_MEMORY_SCOPE_AGENT); }
__device__ __forceinline__ unsigned xb_xcc_id() { return (unsigned)__builtin_amdgcn_s_getreg((3 << 11) | 20) & 0xFu; }
#define XB_SPIN(cond, bar) do { unsigned _sp = 0; while (cond) { __builtin_amdgcn_s_sleep(1); \
    if ((++_sp & 255u) == 0u) { if (xb_ld(&(bar)[XB_TMO])) break; if (_sp > XB_SPIN_CAP) { atomicAdd(&(bar)[XB_TMO], 1u); break; } } } } while (0)
struct XcdBarrier { unsigned* bar; unsigned x; volatile LAS unsigned* st; };
__device__ __forceinline__ XcdBarrier xcd_barrier_post(unsigned* bar, volatile LAS unsigned* st) {
    XcdBarrier b; b.bar = bar; b.x = xb_xcc_id(); b.st = st;
    if (threadIdx.x == 0) (void)xb_add(&bar[XB_XCNT(b.x)], 1u);
    return b;
}
__device__ __forceinline__ void xcd_barrier_complete(unsigned* bar, unsigned x, unsigned& nloc, unsigned& nx) {
    const unsigned G = gridDim.x * gridDim.y * gridDim.z;
    unsigned sum, cnt, mine, sp = 0u;
    for (;;) {
        sum = 0u; cnt = 0u; mine = 0u;
#pragma unroll
        for (unsigned j = 0; j < 16; ++j) { const unsigned c = xb_ld(&bar[XB_XCNT(j)]); sum += c; cnt += (c > 0u) ? 1u : 0u; mine = (j == x) ? c : mine; }
        if (sum == G) break;
        __builtin_amdgcn_s_sleep(1);
        if ((++sp & 255u) == 0u) { if (xb_ld(&bar[XB_TMO])) break; if (sp > XB_SPIN_CAP) { atomicAdd(&bar[XB_TMO], 1u); break; } }
    }
    nloc = mine > 0u ? mine : 1u; nx = cnt > 0u ? cnt : 1u;
}
__device__ __forceinline__ void xcd_barrier(const XcdBarrier& b) {
    asm volatile("s_waitcnt vmcnt(0)" ::: "memory");
    __syncthreads();
    if (threadIdx.x == 0) {
        unsigned* bar = b.bar;
        __builtin_amdgcn_s_waitcnt(0);
        unsigned nloc = b.st[0], nx = b.st[1];
        if (nloc == 0u) { xcd_barrier_complete(bar, b.x, nloc, nx); b.st[0] = nloc; b.st[1] = nx; }
        const unsigned old = xb_add(&bar[XB_XSUB(b.x)], 1u);
        __builtin_amdgcn_fence(__ATOMIC_ACQUIRE, "agent");
        const unsigned gen = old / nloc;
        if (old + 1u == (gen + 1u) * nloc) {
            __builtin_amdgcn_fence(__ATOMIC_RELEASE, "agent");
            asm volatile("s_waitcnt vmcnt(0)" ::: "memory");
            const unsigned og = xb_add(&bar[XB_TOP], 1u);
            const unsigned tg = og / nx;
            if (og + 1u == (tg + 1u) * nx) {
#pragma unroll
                for (unsigned j = 0; j < 16; ++j) xb_add(&bar[XB_XGEN(j)], 1u);
            } else XB_SPIN(xb_ld(&bar[XB_XGEN(b.x)]) == gen, bar);
            asm volatile("s_waitcnt vmcnt(0)" ::: "memory");
        } else {
            XB_SPIN(xb_ld(&bar[XB_XGEN(b.x)]) == gen, bar);
            asm volatile("s_waitcnt vmcnt(0)" ::: "memory");
        }
    }
    __syncthreads();
}

struct Frame {
    LAS unsigned char* lds;
    int tid, lane, wave, G, gw, NGW;
    const float* in[N_IN]; float* out; unsigned char* ws;
};
#define WSP(T, off) ((T*)(F.ws + (off)))

__device__ __forceinline__ void p0_transpose_item(const float* W, int K, int N, bf16_t* WT, LAS float* scr, int item, int lane) {
    const int nblk = N / 32, kb = item / nblk, nb = item % nblk, k0 = 64 * kb, n0 = 32 * nb;
    float val[32];
    { const float* wp = W + (size_t)(k0 + (lane >> 5)) * N + n0 + (lane & 31);
#pragma unroll
      for (int i = 0; i < 32; ++i) val[i] = wp[(size_t)(2 * i) * N]; }
#pragma unroll
    for (int i = 0; i < 32; ++i) scr[(2 * i + (lane >> 5)) * 33 + (lane & 31)] = val[i];
    LDS_WAIT(); asm volatile("" ::: "memory");
    const int c = lane & 7;
#pragma unroll
    for (int j = 0; j < 4; ++j) { const int n = (lane >> 3) + 8 * j; const LAS float* s = scr + (8 * c) * 33 + n;
        u32x4 o; o.x = pk2(s[0 * 33], s[1 * 33]); o.y = pk2(s[2 * 33], s[3 * 33]); o.z = pk2(s[4 * 33], s[5 * 33]); o.w = pk2(s[6 * 33], s[7 * 33]);
        st16_wt(WT + (size_t)(n0 + n) * K + k0 + 8 * c, o); }
    LDS_WAIT(); asm volatile("" ::: "memory");
}
__device__ __forceinline__ void row_to_bf16_ss(const float* xrow, bf16_t* orow, float* ssp, int lane) {
    const f32x4* xr = (const f32x4*)xrow + lane;
    f32x4 v[4]; float s = 0.f;
#pragma unroll
    for (int j = 0; j < 4; ++j) { v[j] = __builtin_nontemporal_load(&xr[64 * j]);
        s += (v[j].x * v[j].x + v[j].y * v[j].y) + (v[j].z * v[j].z + v[j].w * v[j].w); }
    s = wave_sum(s);
    u32x2* o8 = (u32x2*)orow + lane;
#pragma unroll
    for (int j = 0; j < 4; ++j) { u32x2 w; w.x = pk2(v[j].x, v[j].y); w.y = pk2(v[j].z, v[j].w); o8[64 * j] = w; }
    if (lane == 0) *ssp = s;
}
__device__ __forceinline__ void p0_mods_task(Frame& F, int task) {
    const int kh = task & 1, l = (task >> 1) / 48, n0 = ((task >> 1) % 48) * 128;
    LAS float* Sc = (LAS float*)F.lds;
    LAS float* R = (LAS float*)(F.lds + 16384);
    const float* c = F.in[I_C]; const float* cc = F.in[I_CCTX];
    for (int i = F.tid; i < 3 * 512; i += 512) { const int v = i >> 9, k = kh * 512 + (i & 511); const float cv = v == 0 ? c[k] : (v == 1 ? c[D + k] : cc[k]); Sc[i] = cv / (1.f + __expf(-cv)); }
    __syncthreads();
    float a[3][2] = {{0.f, 0.f}, {0.f, 0.f}, {0.f, 0.f}};
    const float* Wp = F.in[I_MODW] + (size_t)l * D * 6144 + (size_t)(kh * 512) * 6144 + n0 + 2 * F.lane;
    const int kb = F.wave * 64;
#pragma unroll 16
    for (int kk = 0; kk < 64; ++kk) { const int k = kb + kk; const f32x2 wv = *(const f32x2*)(Wp + (size_t)k * 6144);
#pragma unroll
        for (int v = 0; v < 3; ++v) { const float s = Sc[v * 512 + k]; a[v][0] += s * wv.x; a[v][1] += s * wv.y; } }
#pragma unroll
    for (int v = 0; v < 3; ++v) { R[(F.wave * 3 + v) * 128 + 2 * F.lane] = a[v][0]; R[(F.wave * 3 + v) * 128 + 2 * F.lane + 1] = a[v][1]; }
    __syncthreads();
    if (F.tid < 384) { const int v = F.tid >> 7, j = F.tid & 127; float s = kh == 0 ? F.in[I_MODB][l * 6144 + n0 + j] : 0.f;
#pragma unroll
        for (int w = 0; w < 8; ++w) s += R[(w * 3 + v) * 128 + j];
        unsafeAtomicAdd(WSP(float, WS_MODS) + (size_t)(l * 3 + v) * 6144 + n0 + j, s); }
    __syncthreads();
}
__device__ __forceinline__ void phase_p0(Frame& F, int part, int gw, int ngw) {
    LAS float* scr = (LAS float*)(F.lds + F.wave * 16384);
    if (part == 0) {
    bf16_t* XB = WSP(bf16_t, WS_A1); float* ss0 = WSP(float, WS_SS0);
    const int R1 = (F.G == 256) ? 3 * 64 * 8 : 0, R0 = MT - R1;
    for (int m = F.gw; m < R0; m += F.NGW) {
        const float* src = m < ML ? F.in[I_X] + (size_t)m * D : F.in[I_CTX] + (size_t)(m - ML) * D;
        row_to_bf16_ss(src, XB + (size_t)m * D, ss0 + m, F.lane);
    }
    if (R1 > 0 && blockIdx.x >= 192)
        for (int m = R0 + ((int)blockIdx.x - 192) * 8 + F.wave; m < MT; m += 64 * 8) {
            const float* src = m < ML ? F.in[I_X] + (size_t)m * D : F.in[I_CTX] + (size_t)(m - ML) * D;
            row_to_bf16_ss(src, XB + (size_t)m * D, ss0 + m, F.lane);
        }
    for (int idx = (int)((blockIdx.x + 64u) % (unsigned)F.G) * 512 + F.tid; idx < 2 * 8 * 2 * 2 * 4 * 64; idx += F.G * 512) {
        const int ln = idx & 63, s_ = (idx >> 6) & 3, half = (idx >> 8) & 1, gate = (idx >> 9) & 1, g_ = (idx >> 10) & 7, d_ = idx >> 13;
        const float* wsrc = (gate ? F.in[I_LWI] : F.in[I_LWR]) + (size_t)((d_ * 8 + g_) * 64 + 16 * s_ + 8 * (ln >> 5)) * 64 + 32 * half + (ln & 31);
        constexpr float NL = -LOG2E;
        u32x4 o; o.x = pk2(NL * wsrc[0], NL * wsrc[64]); o.y = pk2(NL * wsrc[128], NL * wsrc[192]); o.z = pk2(NL * wsrc[256], NL * wsrc[320]); o.w = pk2(NL * wsrc[384], NL * wsrc[448]);
        st16_wt(WSP(u32x4, WS_LRUW) + idx, o);
    }
    return; }
    constexpr int I_O = (D / 64) * (D / 32), I_DN = (FF / 64) * (D / 32);
    for (int it = gw; it < I_O; it += ngw) p0_transpose_item(F.in[I_EWOUT], D, D, WSP(bf16_t, WS_WOUT0), scr, it, F.lane);
}

template <int NV> __device__ __forceinline__ void fold_task(const float* W, int N, int n0, int dst0, int Nd, int kc, float cs, const float* gam, const float* mods_l, int sc_off, int sh_off,
                                                           bf16_t* WT, float* biasp, LAS float* scr, int lane) {
    LAS float* vec = scr + 2176;
    for (int i = lane; i < NV * 256; i += 64) { const int v = i >> 8, kk = i & 255, k = kc * 256 + kk;
        vec[i] = gam[k] * (1.f + mods_l[(size_t)v * 6144 + sc_off + k]) * cs; vec[768 + i] = mods_l[(size_t)v * 6144 + sh_off + k] * cs; }
    LDS_WAIT(); asm volatile("" ::: "memory");
    float bacc[NV];
#pragma unroll
    for (int v = 0; v < NV; ++v) bacc[v] = 0.f;
    for (int it = 0; it < 4; ++it) {
        const int k0 = kc * 256 + 64 * it;
        float val[32];
        { const float* wp = W + (size_t)(k0 + (lane >> 5)) * N + n0 + (lane & 31);
#pragma unroll
          for (int i = 0; i < 32; ++i) val[i] = wp[(size_t)(2 * i) * N]; }
#pragma unroll
        for (int i = 0; i < 32; ++i) { const int kk = 2 * i + (lane >> 5); scr[kk * 33 + (lane & 31)] = val[i];
#pragma unroll
            for (int v = 0; v < NV; ++v) bacc[v] += vec[768 + v * 256 + 64 * it + kk] * val[i]; }
        LDS_WAIT(); asm volatile("" ::: "memory");
        const int c = lane & 7;
#pragma unroll
        for (int j = 0; j < 4; ++j) { const int n = (lane >> 3) + 8 * j; const LAS float* s = scr + (8 * c) * 33 + n;
#pragma unroll
            for (int v = 0; v < NV; ++v) { const LAS float* sv = vec + v * 256 + 64 * it + 8 * c;
                u32x4 o; o.x = pk2(s[0 * 33] * sv[0], s[1 * 33] * sv[1]); o.y = pk2(s[2 * 33] * sv[2], s[3 * 33] * sv[3]); o.z = pk2(s[4 * 33] * sv[4], s[5 * 33] * sv[5]); o.w = pk2(s[6 * 33] * sv[6], s[7 * 33] * sv[7]);
                st16_wt(WT + (size_t)v * Nd * D + (size_t)(dst0 + n) * D + k0 + 8 * c, o); } }
        LDS_WAIT(); asm volatile("" ::: "memory");
    }
#pragma unroll
    for (int v = 0; v < NV; ++v) { float b = bacc[v]; b += __shfl_xor(b, 32); if (lane < 32) unsafeAtomicAdd(biasp + (size_t)v * Nd + dst0 + lane, b); }
}
template <int NV> __device__ __forceinline__ void fold_item(const float* W, int N, int n0, int dst0, int Nd, int k0, float cs, const float* gam, const float* mods_l, int sc_off, int sh_off,
                                                           bf16_t* WT, float* biasp, LAS float* scr, int lane) {
    LAS float* vec = scr + 2176;
    float val[32];
    { const float* wp = W + (size_t)(k0 + (lane >> 5)) * N + n0 + (lane & 31);
#pragma unroll
      for (int i = 0; i < 32; ++i) val[i] = wp[(size_t)(2 * i) * N]; }
    { const int k = k0 + lane; const float gk = gam[k] * cs;
#pragma unroll
      for (int v = 0; v < NV; ++v) { vec[v * 64 + lane] = gk * (1.f + mods_l[(size_t)v * 6144 + sc_off + k]); vec[192 + v * 64 + lane] = mods_l[(size_t)v * 6144 + sh_off + k] * cs; } }
#pragma unroll
    for (int i = 0; i < 32; ++i) scr[(2 * i + (lane >> 5)) * 33 + (lane & 31)] = val[i];
    LDS_WAIT(); asm volatile("" ::: "memory");
    float bacc[NV];
#pragma unroll
    for (int v = 0; v < NV; ++v) bacc[v] = 0.f;
#pragma unroll
    for (int i = 0; i < 32; ++i)
#pragma unroll
        for (int v = 0; v < NV; ++v) bacc[v] += vec[192 + v * 64 + 2 * i + (lane >> 5)] * val[i];
    const int c = lane & 7;
#pragma unroll
    for (int j = 0; j < 4; ++j) { const int n = (lane >> 3) + 8 * j; const LAS float* s = scr + (8 * c) * 33 + n;
#pragma unroll
        for (int v = 0; v < NV; ++v) { const LAS float* sv = vec + v * 64 + 8 * c;
            u32x4 o; o.x = pk2(s[0 * 33] * sv[0], s[1 * 33] * sv[1]); o.y = pk2(s[2 * 33] * sv[2], s[3 * 33] * sv[3]); o.z = pk2(s[4 * 33] * sv[4], s[5 * 33] * sv[5]); o.w = pk2(s[6 * 33] * sv[6], s[7 * 33] * sv[7]);
            st16_wt(WT + (size_t)v * Nd * D + (size_t)(dst0 + n) * D + k0 + 8 * c, o); } }
    LDS_WAIT(); asm volatile("" ::: "memory");
#pragma unroll
    for (int v = 0; v < NV; ++v) { float b = bacc[v]; b += __shfl_xor(b, 32); if (lane < 32) unsafeAtomicAdd(biasp + (size_t)v * Nd + dst0 + lane, b); }
}
__device__ __forceinline__ int gu_dst(int n) { return n < FF ? (n >> 7) * 256 + (n & 127) : ((n - FF) >> 7) * 256 + 128 + ((n - FF) & 127); }
__device__ __forceinline__ int in1_dst(int n) { if (n < 1024) return n; if (n < 2048) { const int q = n - 1024; return 1024 + (q >> 7) * 256 + (q & 127); } const int q = n - 2048; return 1024 + (q >> 7) * 256 + 128 + (q & 127); }
__device__ __forceinline__ void phase_p1(Frame& F, int part, int gw, int ngw) {
    LAS float* scr = (LAS float*)(F.lds + F.wave * 16384);
    const float* mods = WSP(float, WS_MODS);
    if (part == 0) {
        for (int it = gw; it < (NIN0 / 32) * 16; it += ngw) { const int ks = it & 15, n0 = (it >> 4) * 32;
            fold_item<3>(F.in[I_EWIN], NIN0, n0, n0, NIN0, 64 * ks, n0 < 512 ? QSCALE : 1.f, F.in[I_N1G], mods, 1024, 0, WSP(bf16_t, WS_WIN0), WSP(float, WS_B_IN0), scr, F.lane); }
    } else {
        for (int it = gw; it < (NGU / 32) * 16; it += ngw) { const int ks = it & 15, n0 = (it >> 4) * 32;
            fold_item<2>(F.in[I_WGU], NGU, n0, gu_dst(n0), NGU, 64 * ks, 1.f, F.in[I_N2G], mods, 4096, 3072, WSP(bf16_t, WS_WGU0), WSP(float, WS_B_GU0), scr, F.lane); }
    }
}

__device__ __forceinline__ void conv4_task(Frame& F, int task) {
    const bf16_t* QKV = WSP(bf16_t, WS_BIG); bf16_t* XC = WSP(bf16_t, WS_XCONV);
    const int row0 = task * 16, lane = F.lane;
    int sbeg, send;
    if (row0 < ML) { sbeg = (row0 / SEQ) * SEQ; send = sbeg + SEQ; } else { sbeg = ML + ((row0 - ML) / NCTX) * NCTX; send = sbeg + NCTX; }
    u32x4 raw[19];
#pragma unroll
    for (int i = 0; i < 19; ++i) { const int r = row0 + i - 2; raw[i] = (r >= sbeg && r < send) ? *(const u32x4*)(QKV + (size_t)r * NIN0 + 1536 + 8 * lane) : (u32x4){0u, 0u, 0u, 0u}; }
    float w[4][8], bs[8];
#pragma unroll
    for (int j = 0; j < 4; ++j) { const f32x4 a = *(const f32x4*)(F.in[I_ECW] + j * 512 + 8 * lane), b = *(const f32x4*)(F.in[I_ECW] + j * 512 + 8 * lane + 4);
        w[j][0] = a.x; w[j][1] = a.y; w[j][2] = a.z; w[j][3] = a.w; w[j][4] = b.x; w[j][5] = b.y; w[j][6] = b.z; w[j][7] = b.w; }
    { const f32x4 a = *(const f32x4*)(F.in[I_ECB] + 8 * lane), b = *(const f32x4*)(F.in[I_ECB] + 8 * lane + 4); bs[0] = a.x; bs[1] = a.y; bs[2] = a.z; bs[3] = a.w; bs[4] = b.x; bs[5] = b.y; bs[6] = b.z; bs[7] = b.w; }
#pragma unroll
    for (int t = 0; t < 16; ++t) {
        float o[8];
#pragma unroll
        for (int e = 0; e < 8; ++e) o[e] = bs[e];
#pragma unroll
        for (int j = 0; j < 4; ++j) { const u32x4 r = raw[t + j];
            o[0] += w[j][0] * bflo(r.x); o[1] += w[j][1] * bfhi(r.x); o[2] += w[j][2] * bflo(r.y); o[3] += w[j][3] * bfhi(r.y);
            o[4] += w[j][4] * bflo(r.z); o[5] += w[j][5] * bfhi(r.z); o[6] += w[j][6] * bflo(r.w); o[7] += w[j][7] * bfhi(r.w); }
        u32x4 pk; pk.x = pk2(o[0], o[1]); pk.y = pk2(o[2], o[3]); pk.z = pk2(o[4], o[5]); pk.w = pk2(o[6], o[7]);
        *(u32x4*)(XC + (size_t)(row0 + t) * 512 + 8 * lane) = pk;
    }
}

__device__ __forceinline__ int crow(int r, int hi) { return (r & 3) + 8 * (r >> 2) + 4 * hi; }
__device__ __forceinline__ void qkt(f32x16& p0, f32x16& p1, const bf16x8 (&b0)[4], const bf16x8 (&b1)[4], const bf16x8* qr, const f32x16& c0, const f32x16& c1) {
    p0 = __builtin_amdgcn_mfma_f32_32x32x16_bf16(b0[0], qr[0], c0, 0, 0, 0);
    p1 = __builtin_amdgcn_mfma_f32_32x32x16_bf16(b1[0], qr[0], c1, 0, 0, 0);
#pragma unroll
    for (int d0 = 1; d0 < 4; ++d0) {
        p0 = __builtin_amdgcn_mfma_f32_32x32x16_bf16(b0[d0], qr[d0], p0, 0, 0, 0);
        p1 = __builtin_amdgcn_mfma_f32_32x32x16_bf16(b1[d0], qr[d0], p1, 0, 0, 0);
    }
}
__device__ __forceinline__ void pv(f32x16* o, unsigned vb0, unsigned vb1, bf16x8 pa0, bf16x8 pa1, bf16x8 pa2, bf16x8 pa3, bool use0, bool use3) {
    s16x4 lo[2][4], hi[2][4];
#define PV_RD(ks) do { \
        lo[0][ks] = __builtin_amdgcn_ds_read_tr16_b64_v4i16((LAS s16x4*)(uintptr_t)(vb0 + (ks) * 2048)); \
        hi[0][ks] = __builtin_amdgcn_ds_read_tr16_b64_v4i16((LAS s16x4*)(uintptr_t)(vb0 + (ks) * 2048 + 1024)); \
        lo[1][ks] = __builtin_amdgcn_ds_read_tr16_b64_v4i16((LAS s16x4*)(uintptr_t)(vb1 + (ks) * 2048)); \
        hi[1][ks] = __builtin_amdgcn_ds_read_tr16_b64_v4i16((LAS s16x4*)(uintptr_t)(vb1 + (ks) * 2048 + 1024)); } while (0)
#define PK(d, k) (bf16x8){lo[d][k][0], lo[d][k][1], lo[d][k][2], lo[d][k][3], hi[d][k][0], hi[d][k][1], hi[d][k][2], hi[d][k][3]}
    PV_RD(1); PV_RD(2);
    if (use0) {
        PV_RD(0);
        asm volatile("s_waitcnt lgkmcnt(0)" ::: "memory");
        o[0] = __builtin_amdgcn_mfma_f32_32x32x16_bf16(PK(0, 0), pa0, o[0], 0, 0, 0);
        o[1] = __builtin_amdgcn_mfma_f32_32x32x16_bf16(PK(1, 0), pa0, o[1], 0, 0, 0);
    }
    if (use3) PV_RD(3);
    asm volatile("s_waitcnt lgkmcnt(0)" ::: "memory"); __builtin_amdgcn_sched_barrier(0);
    o[0] = __builtin_amdgcn_mfma_f32_32x32x16_bf16(PK(0, 1), pa1, o[0], 0, 0, 0);
    o[1] = __builtin_amdgcn_mfma_f32_32x32x16_bf16(PK(1, 1), pa1, o[1], 0, 0, 0);
    o[0] = __builtin_amdgcn_mfma_f32_32x32x16_bf16(PK(0, 2), pa2, o[0], 0, 0, 0);
    o[1] = __builtin_amdgcn_mfma_f32_32x32x16_bf16(PK(1, 2), pa2, o[1], 0, 0, 0);
    if (use3) {
        o[0] = __builtin_amdgcn_mfma_f32_32x32x16_bf16(PK(0, 3), pa3, o[0], 0, 0, 0);
        o[1] = __builtin_amdgcn_mfma_f32_32x32x16_bf16(PK(1, 3), pa3, o[1], 0, 0, 0);
    }
#undef PK
#undef PV_RD
}
__device__ __forceinline__ float max3f(float a, float b, float c) { float r; asm("v_max3_f32 %0, %1, %2, %3" : "=v"(r) : "v"(a), "v"(b), "v"(c)); return r; }
__device__ __forceinline__ float max2f(float a, float b) { float r; asm("v_max_f32 %0, %1, %2" : "=v"(r) : "v"(a), "v"(b)); return r; }
__device__ __forceinline__ float half_swap_max(float m) { auto rr = __builtin_amdgcn_permlane32_swap(__float_as_uint(m), __float_as_uint(m), false, false); return max2f(__uint_as_float(rr[0]), __uint_as_float(rr[1])); }
__device__ __forceinline__ float half_swap_sum(float m) { auto rr = __builtin_amdgcn_permlane32_swap(__float_as_uint(m), __float_as_uint(m), false, false); return __uint_as_float(rr[0]) + __uint_as_float(rr[1]); }

constexpr int AT_SLOT = 32768, AT_NSLOT = 3, AT_BIAS = AT_NSLOT * AT_SLOT, AT_WSF = AT_BIAS + 2 * 15 * 128 * 4, AT_QST = AT_WSF + 3072, AT_NTASK = NB * 128 * 4;
static_assert(AT_QST + 8 * 4096 <= LDSCTL_OFF, "attention LDS map");
constexpr float AT_THR = 8.f;
__device__ __forceinline__ void attn_phase(Frame& F) {
    const bf16_t* QKV = WSP(bf16_t, WS_BIG); bf16_t* MIX = WSP(bf16_t, WS_A2);
    const int lane = F.lane, w = F.wave, r32 = lane & 31, hi = lane >> 5;
    const int hsel = w >> 2, rsel = (w >> 1) & 1, qh = w & 1;
    LAS unsigned char* lds = F.lds;
    LAS float* BIAS = (LAS float*)(lds + AT_BIAS);
    LAS float* wsf = (LAS float*)(lds + AT_WSF) + w * 64;
    const int qc = 32 * qh + r32, cs = min(max(qc - 8, 0), 48);
    const int krow_ = 8 * w + (lane >> 3), kchunk_ = (lane & 7) ^ ((krow_ >> 1) & 7);
    int koff[4];
#pragma unroll
    for (int d0 = 0; d0 < 4; ++d0) koff[d0] = r32 * 128 + (((2 * d0 + hi) ^ ((r32 >> 1) & 7)) << 4);
    const unsigned ldsw = (unsigned)w * 1024u;
    unsigned vboff0, vboff1;
    { const int q_ = (lane & 15) >> 2, p_ = lane & 3, blk_ = (lane >> 4) & 1, fl_ = (q_ >> 1) << 2;
      vboff0 = (unsigned)((4 * hi + q_) * 128 + (((0 + 2 * blk_ + (p_ >> 1)) ^ fl_) << 4) + 8 * (p_ & 1));
      vboff1 = (unsigned)((4 * hi + q_) * 128 + (((4 + 2 * blk_ + (p_ >> 1)) ^ fl_) << 4) + 8 * (p_ & 1)); }
#define AT_DMA(bb, Rlo, s, sl) do { const int s_ = (s); const size_t base_ = (s_ < 4 ? (size_t)(ML + (bb) * NCTX + 64 * s_) : (size_t)((bb) * SEQ + ((Rlo) + s_ - 4) * 64)) * NIN0; \
        LAS unsigned char* sl_ = lds + (sl) * AT_SLOT + ldsw; \
        __builtin_amdgcn_global_load_lds((const unsigned*)(ksrc + base_), (LAS unsigned*)(sl_), 16, 0, 0); \
        __builtin_amdgcn_global_load_lds((const unsigned*)(ksrc + base_ + 64), (LAS unsigned*)(sl_ + 8192), 16, 0, 0); \
        __builtin_amdgcn_global_load_lds((const unsigned*)(vsrc + base_), (LAS unsigned*)(sl_ + 16384), 16, 0, 0); \
        __builtin_amdgcn_global_load_lds((const unsigned*)(vsrc + base_ + 64), (LAS unsigned*)(sl_ + 24576), 16, 0, 0); } while (0)
#define AT_DMAROW(trow, sl) do { const size_t base_ = (size_t)(trow) * NIN0; LAS unsigned char* sl_ = lds + (sl) * AT_SLOT + ldsw; \
        __builtin_amdgcn_global_load_lds((const unsigned*)(ksrc + base_), (LAS unsigned*)(sl_), 16, 0, 0); \
        __builtin_amdgcn_global_load_lds((const unsigned*)(ksrc + base_ + 64), (LAS unsigned*)(sl_ + 8192), 16, 0, 0); \
        __builtin_amdgcn_global_load_lds((const unsigned*)(vsrc + base_), (LAS unsigned*)(sl_ + 16384), 16, 0, 0); \
        __builtin_amdgcn_global_load_lds((const unsigned*)(vsrc + base_ + 64), (LAS unsigned*)(sl_ + 24576), 16, 0, 0); } while (0)
#define AT_DMAQ(bb, rr, hh) do { const bf16_t* qp_ = QKV + (size_t)((bb) * SEQ + (rr) * 64 + 32 * qh + r32) * NIN0 + (hh) * 64 + 8 * hi; LAS unsigned char* ql_ = lds + AT_QST + w * 4096; \
        __builtin_amdgcn_global_load_lds((const unsigned*)(qp_), (LAS unsigned*)(ql_), 16, 0, 0); __builtin_amdgcn_global_load_lds((const unsigned*)(qp_ + 16), (LAS unsigned*)(ql_ + 1024), 16, 0, 0); \
        __builtin_amdgcn_global_load_lds((const unsigned*)(qp_ + 32), (LAS unsigned*)(ql_ + 2048), 16, 0, 0); __builtin_amdgcn_global_load_lds((const unsigned*)(qp_ + 48), (LAS unsigned*)(ql_ + 3072), 16, 0, 0); } while (0)
#define AT_LOADQ(bb, rr, hh) do { const bf16_t* qp_ = QKV + (size_t)((bb) * SEQ + (rr) * 64 + 32 * qh + r32) * NIN0 + (hh) * 64 + 8 * hi; \
        qr[0] = *(const bf16x8*)(qp_); qr[1] = *(const bf16x8*)(qp_ + 16); qr[2] = *(const bf16x8*)(qp_ + 32); qr[3] = *(const bf16x8*)(qp_ + 48); } while (0)
    bf16x8 qr[4];
    if (w >= 4) __builtin_amdgcn_s_setprio(1);
    int bias_hp = -1, gs0 = 0;
    bool primed = false;
#pragma unroll 1
    for (int task = blockIdx.x; task < AT_NTASK; task += F.G) {
    const int b = task >> 9, rp = (task >> 2) & 127, hp = task & 3;
    const int h = 2 * hp + hsel, r = 2 * rp + rsel;
    const int rs_r = min(max(r - 4, 0), 248);
    const int R_lo = min(max(2 * rp - 4, 0), 248), R_hi = min(max(2 * rp + 1 - 4, 0), 248) + 7, nsteps = 4 + (R_hi - R_lo + 1);
    const int tn = task + F.G, bn = tn >> 9, rpn = (tn >> 2) & 127;
    const bool cont = tn < AT_NTASK && (tn & 3) == hp;
    const int R_lo_n = min(max(2 * rpn - 4, 0), 248);
    const bf16_t* ksrc = QKV + (size_t)krow_ * NIN0 + 512 + (2 * hp) * 64 + 8 * kchunk_;
    const bf16_t* vsrc = QKV + (size_t)krow_ * NIN0 + 1024 + (2 * hp) * 64 + 8 * ((lane & 7) ^ (((krow_ >> 1) & 1) << 2));
    if (!primed) {
        if (bias_hp != hp) {
            for (int i = F.tid; i < 2 * 15 * 128; i += 512) { const int hh = i / 1920, dr = (i >> 7) % 15, dc = (i & 127) - 48;
                BIAS[i] = (dc >= 0 && dc <= 30) ? F.in[I_RPB][(size_t)(2 * hp + hh) * 465 + dr * 31 + dc] * LOG2E : 0.f; }
            bias_hp = hp;
        }
        AT_LOADQ(b, r, h);
        asm volatile("s_waitcnt vmcnt(0)" ::: "memory");
        AT_DMA(b, R_lo, 0, gs0); AT_DMA(b, R_lo, 1, gs0 == 2 ? 0 : gs0 + 1);
    } else {
        asm volatile("s_waitcnt vmcnt(0)" ::: "memory");
#pragma unroll
        for (int d0 = 0; d0 < 4; ++d0) qr[d0] = *(LAS const bf16x8*)(lds + AT_QST + w * 4096 + d0 * 1024 + lane * 16);
    }
    float mref = 0.f, lrun = 0.f; f32x16 o[2], c0, c1;
#pragma unroll
    for (int i = 0; i < 16; ++i) { o[0][i] = 0.f; o[1][i] = 0.f; c0[i] = 0.f; c1[i] = 0.f; }
    const int cbase2 = ML + b * NCTX + 128, wbase2 = b * SEQ + (R_lo - 2) * 64, nbase = ML + bn * NCTX;
    int slc = gs0, sl2 = gs0 == 0 ? 2 : gs0 - 1;
    auto step = [&](const int s, auto win_t, auto qh_t) __attribute__((always_inline)) {
        constexpr bool WIN = decltype(win_t)::value; constexpr int QHC = decltype(qh_t)::value;
        if (WIN ? !(s + 1 < nsteps || cont) : (s == 0 && primed)) asm volatile("s_waitcnt vmcnt(0)" ::: "memory"); else asm volatile("s_waitcnt vmcnt(4)" ::: "memory");
        asm volatile("s_waitcnt lgkmcnt(0)" ::: "memory"); __builtin_amdgcn_s_barrier(); asm volatile("" ::: "memory");
        if constexpr (!WIN) { AT_DMAROW((s < 2 ? cbase2 : wbase2) + 64 * s, sl2); }
        else { const bool own = s + 2 < nsteps;
               if (own || cont) AT_DMAROW(own ? wbase2 + 64 * s : nbase + 64 * (s + 2 - nsteps), sl2);
               if (s == nsteps - 1 && cont) AT_DMAQ(bn, 2 * rpn + rsel, h); }
        const int kr = R_lo + s - 4;
        const bool active = !WIN || (kr >= rs_r && kr <= rs_r + 7);
        if (active) {
            LAS const unsigned char* Kslot = lds + slc * AT_SLOT + hsel * 8192;
            const unsigned vbs = (unsigned)(uintptr_t)(lds + slc * AT_SLOT + 16384 + hsel * 8192);
            f32x16 p0, p1;
            constexpr bool win = WIN; const bool l0a = !WIN || qh == 0, l1b = !WIN || qh == 1;
            bf16x8 kb0[4], kb1[4];
#pragma unroll
            for (int d0 = 0; d0 < 4; ++d0) { kb0[d0] = *(LAS const bf16x8*)(Kslot + koff[d0]); kb1[d0] = *(LAS const bf16x8*)(Kslot + koff[d0] + 4096); }
            if (win) {
                f32x16 cc0, cc1;
                const int dr = kr - r + 7;
                LAS const float* T = BIAS + (hsel * 15 + dr) * 128 + (63 - qc);
                float tb0[16], tb1[16];
#pragma unroll
                for (int i = 0; i < 16; ++i) { tb0[i] = T[crow(i, hi)]; tb1[i] = T[crow(i, hi) + 32]; }
#pragma unroll
                for (int i = 0; i < 16; ++i) { cc0[i] = c0[i] + tb0[i]; cc1[i] = c1[i] + tb1[i]; }
                qkt(p0, p1, kb0, kb1, qr, cc0, cc1);
            } else qkt(p0, p1, kb0, kb1, qr, c0, c1);
            float ra = max3f(p0[12], p0[13], p1[0]), rb = max3f(p0[14], p0[15], p1[1]); ra = max3f(ra, p1[2], p1[3]);
            if (l0a) {
#pragma unroll
                for (int i = 0; i < 12; i += 4) { ra = max3f(ra, p0[i], p0[i + 1]); rb = max3f(rb, p0[i + 2], p0[i + 3]); }
            }
            if (l1b) {
#pragma unroll
                for (int i = 4; i < 16; i += 4) { ra = max3f(ra, p1[i], p1[i + 1]); rb = max3f(rb, p1[i + 2], p1[i + 3]); }
            }
            float rm = half_swap_max(max2f(ra, rb));
            if ((!WIN && s == 0) || __any(rm > AT_THR)) {
                const float dl = (!WIN && s == 0) ? rm : max2f(rm, 0.f);
                mref += dl;
#pragma unroll
                for (int i = 0; i < 16; ++i) { p0[i] -= dl; p1[i] -= dl; c0[i] -= dl; c1[i] -= dl; }
                const float f = (!WIN && s == 0) ? 1.f : fast_exp2(-dl);
                lrun *= f;
#pragma unroll
                for (int i = 0; i < 16; ++i) { o[0][i] *= f; o[1][i] *= f; }
            }
            float ls = 0.f;
            u32x4 pw0, pw1, pw2, pw3;
            if (l0a) {
#pragma unroll
                for (int i = 0; i < 12; ++i) { p0[i] = fast_exp2(p0[i]); ls += p0[i]; }
                pw0.x = pg8::cvt_pk_bf16(p0[0], p0[1]); pw0.y = pg8::cvt_pk_bf16(p0[2], p0[3]); pw0.z = pg8::cvt_pk_bf16(p0[4], p0[5]); pw0.w = pg8::cvt_pk_bf16(p0[6], p0[7]);
                pw1.x = pg8::cvt_pk_bf16(p0[8], p0[9]); pw1.y = pg8::cvt_pk_bf16(p0[10], p0[11]);
            } else { pw0 = (u32x4){0u, 0u, 0u, 0u}; pw1.x = 0u; pw1.y = 0u; }
#pragma unroll
            for (int i = 12; i < 16; ++i) { p0[i] = fast_exp2(p0[i]); ls += p0[i]; }
#pragma unroll
            for (int i = 0; i < 4; ++i) { p1[i] = fast_exp2(p1[i]); ls += p1[i]; }
            pw1.z = pg8::cvt_pk_bf16(p0[12], p0[13]); pw1.w = pg8::cvt_pk_bf16(p0[14], p0[15]);
            pw2.x = pg8::cvt_pk_bf16(p1[0], p1[1]); pw2.y = pg8::cvt_pk_bf16(p1[2], p1[3]);
            if (l1b) {
#pragma unroll
                for (int i = 4; i < 16; ++i) { p1[i] = fast_exp2(p1[i]); ls += p1[i]; }
                pw2.z = pg8::cvt_pk_bf16(p1[4], p1[5]); pw2.w = pg8::cvt_pk_bf16(p1[6], p1[7]);
                pw3.x = pg8::cvt_pk_bf16(p1[8], p1[9]); pw3.y = pg8::cvt_pk_bf16(p1[10], p1[11]); pw3.z = pg8::cvt_pk_bf16(p1[12], p1[13]); pw3.w = pg8::cvt_pk_bf16(p1[14], p1[15]);
            } else { pw2.z = 0u; pw2.w = 0u; pw3 = (u32x4){0u, 0u, 0u, 0u}; }
            lrun += ls;
            LDS_WAIT();
            pv(o, vbs + vboff0, vbs + vboff1, __builtin_bit_cast(bf16x8, pw0), __builtin_bit_cast(bf16x8, pw1), __builtin_bit_cast(bf16x8, pw2), __builtin_bit_cast(bf16x8, pw3), l0a, l1b);
        }
            slc = slc == 2 ? 0 : slc + 1; sl2 = sl2 == 2 ? 0 : sl2 + 1;
    };
    int s_ = 0;
#pragma unroll 1
    for (; s_ < 4; ++s_) step(s_, std::false_type{}, std::integral_constant<int, -1>{});
    {
#pragma unroll
        for (int i = 0; i < 16; ++i) { const int k0_ = crow(i, hi); c0[i] = ((unsigned)(k0_ - cs) < 16u) ? c0[i] : -INFINITY; c1[i] = ((unsigned)(k0_ + 32 - cs) < 16u) ? c1[i] : -INFINITY; }
    }
#pragma unroll 1
    for (; s_ < nsteps; ++s_) step(s_, std::true_type{}, std::integral_constant<int, -1>{});
    const float ri = fast_rcp(half_swap_sum(lrun));
    unsigned char* orow = (unsigned char*)(MIX + (size_t)(b * SEQ + r * 64 + 32 * qh + r32) * D + h * 64) + (hi ? 16 : 0);
#pragma unroll
    for (int db = 0; db < 2; ++db) {
        unsigned gx[4], gy[4];
#pragma unroll
        for (int g = 0; g < 4; ++g) { gx[g] = pk2(o[db][4 * g] * ri, o[db][4 * g + 1] * ri); gy[g] = pk2(o[db][4 * g + 2] * ri, o[db][4 * g + 3] * ri); }
#pragma unroll
        for (int k = 0; k < 4; k += 2) {
            const auto rx = __builtin_amdgcn_permlane32_swap(gx[k], gx[k + 1], false, false);
            const auto ry = __builtin_amdgcn_permlane32_swap(gy[k], gy[k + 1], false, false);
            *(u32x4*)(orow + db * 64 + 16 * k) = (u32x4){rx[0], ry[0], rx[1], ry[1]};
        }
    }
    asm volatile("s_waitcnt lgkmcnt(0)" ::: "memory");
    if (!cont) { asm volatile("s_waitcnt vmcnt(0)" ::: "memory"); __builtin_amdgcn_s_barrier(); asm volatile("" ::: "memory"); }
    gs0 = (gs0 + nsteps) % 3; primed = cont;
    }
    __builtin_amdgcn_s_setprio(0);
#undef AT_DMA
#undef AT_LOADQ
#undef AT_DMAQ
#undef AT_DMAROW
}

struct LruW { bf16x8 wr[4], wi[4]; f32x16 cr, ci; float cn; };
constexpr int LRU_LW = 0, LRU_LC = 32768, LRU_HF = 36864, LRU_AF = LRU_HF + 65536;
static_assert(LRU_AF + 8 * 4096 <= LDSCTL_OFF, "LRU LDS map");
__device__ __forceinline__ void lru_stage_w(Frame& F, int g) {
    const u32x4* src = WSP(u32x4, WS_LRUW);
    LAS u32x4* dst = (LAS u32x4*)(F.lds + LRU_LW);
#pragma unroll
    for (int i = 0; i < 4; ++i) { const int idx = F.tid + 512 * i;
        const int d = idx >> 10, rest = idx & 1023;
        dst[idx] = src[(size_t)((d * 8 + g) * 1024) + rest]; }
    if (F.tid < 128) { const int d = F.tid >> 6, ch = d * 512 + g * 64 + (F.tid & 63);
        LAS float* lc = (LAS float*)(F.lds + LRU_LC) + F.tid * 4;
        lc[0] = -LOG2E * F.in[I_LBR][ch]; lc[1] = -LOG2E * F.in[I_LBI][ch]; lc[2] = -8.f * LOG2E * log1pf(__expf(-F.in[I_LAM][ch])); }
    __syncthreads();
}
__device__ __forceinline__ void lru_load_w(Frame& F, LruW& W, int d, int half, int lane) {
    LAS const bf16x8* wf = (LAS const bf16x8*)(F.lds + LRU_LW) + d * 1024 + lane;
#pragma unroll
    for (int s = 0; s < 4; ++s) { W.wr[s] = wf[((0 * 2 + half) * 4 + s) * 64]; W.wi[s] = wf[((1 * 2 + half) * 4 + s) * 64]; }
    LAS const float* lc = (LAS const float*)(F.lds + LRU_LC) + (d * 64 + 32 * half + (lane & 31)) * 4;
    { const float br = lc[0], bi = lc[1];
#pragma unroll
      for (int i = 0; i < 16; ++i) { W.cr[i] = br; W.ci[i] = bi; } }
    W.cn = lc[2];
}
__device__ __forceinline__ void lru_dma_af(const bf16_t* XC, size_t t0, int g, int lane, LAS unsigned char* afb) {
    const int rr = lane >> 3, sl = lane & 7;
#pragma unroll
    for (int i = 0; i < 4; ++i) { const int row = 8 * i + rr;
        __builtin_amdgcn_global_load_lds((const unsigned*)(XC + (t0 + row) * 512 + 64 * g + 8 * (sl ^ ((row >> 1) & 7))), (LAS unsigned*)(afb + i * 1024), 16, 0, 0); }
}
__device__ __forceinline__ void lru_read_af(LAS const unsigned char* afb, int r32, int hi, bf16x8 (&af)[4]) {
#pragma unroll
    for (int s = 0; s < 4; ++s) af[s] = *(LAS const bf16x8*)(afb + r32 * 128 + (((2 * s + hi) ^ ((r32 >> 1) & 7)) << 4));
}
__device__ __forceinline__ void lru_gates(const bf16x8 (&af)[4], const LruW& W, int half, bf16x8 I0, bf16x8 I1, float (&a)[16], float (&b)[16]) {
    f32x16 R, I, X;
#pragma unroll
    for (int i = 0; i < 16; ++i) X[i] = 0.f;
    R = __builtin_amdgcn_mfma_f32_32x32x16_bf16(af[0], W.wr[0], W.cr, 0, 0, 0); I = __builtin_amdgcn_mfma_f32_32x32x16_bf16(af[0], W.wi[0], W.ci, 0, 0, 0);
#pragma unroll
    for (int s = 1; s < 4; ++s) { R = __builtin_amdgcn_mfma_f32_32x32x16_bf16(af[s], W.wr[s], R, 0, 0, 0); I = __builtin_amdgcn_mfma_f32_32x32x16_bf16(af[s], W.wi[s], I, 0, 0, 0); }
    const bf16x8 ax0 = half ? af[2] : af[0], ax1 = half ? af[3] : af[1];
    X = __builtin_amdgcn_mfma_f32_32x32x16_bf16(ax0, I0, X, 0, 0, 0);
    X = __builtin_amdgcn_mfma_f32_32x32x16_bf16(ax1, I1, X, 0, 0, 0);
    const float cn = W.cn;
#pragma unroll
    for (int i = 0; i < 16; ++i) {
        const float rr = fast_rcp(1.f + fast_exp2(R[i])), ii = fast_rcp(1.f + fast_exp2(I[i]));
        const float av = fast_exp2(rr * cn);
        a[i] = av; b[i] = __builtin_amdgcn_sqrtf(1.f - av * av) * ii * X[i]; }
}
__device__ __forceinline__ float partner32(float x, int hi) { auto rr = __builtin_amdgcn_permlane32_swap(__float_as_uint(x), __float_as_uint(x), false, false); return __uint_as_float(hi ? rr[0] : rr[1]); }
template <bool REV, bool WANT_H> __device__ __forceinline__ void lru_scan_tile(const float (&a)[16], const float (&b)[16], int hi, float& H, float (&h)[16], float& ap) {
    float SA[4], SB[4], EAv[4], OAv[4], EBv[4], OBv[4];
#pragma unroll
    for (int q = 0; q < 4; ++q) { const float a0 = a[4 * q], a1 = a[4 * q + 1], a2 = a[4 * q + 2], a3 = a[4 * q + 3], b0 = b[4 * q], b1 = b[4 * q + 1], b2 = b[4 * q + 2], b3 = b[4 * q + 3];
        SA[q] = (a0 * a1) * (a2 * a3);
        SB[q] = REV ? ((b3 * a2 + b2) * a1 + b1) * a0 + b0 : ((b0 * a1 + b1) * a2 + b2) * a3 + b3; }
#pragma unroll
    for (int q = 0; q < 4; ++q) { auto ra_ = __builtin_amdgcn_permlane32_swap(__float_as_uint(SA[q]), __float_as_uint(SA[q]), false, false); EAv[q] = __uint_as_float(ra_[0]); OAv[q] = __uint_as_float(ra_[1]);
        auto rb_ = __builtin_amdgcn_permlane32_swap(__float_as_uint(SB[q]), __float_as_uint(SB[q]), false, false); EBv[q] = __uint_as_float(rb_[0]); OBv[q] = __uint_as_float(rb_[1]); }
    float cin[4];
    if (!REV) {
#pragma unroll
        for (int q = 0; q < 4; ++q) { const float EA = EAv[q], EB = EBv[q], OA = OAv[q], OB = OBv[q];
            const float he = H; H = EA * H + EB; const float ho = H; H = OA * H + OB; cin[q] = hi ? ho : he; if (!WANT_H) ap *= EA * OA; }
    } else {
#pragma unroll
        for (int q = 3; q >= 0; --q) { const float EA = EAv[q], EB = EBv[q], OA = OAv[q], OB = OBv[q];
            const float ho = H; H = OA * H + OB; const float he = H; H = EA * H + EB; cin[q] = hi ? ho : he; if (!WANT_H) ap *= EA * OA; }
    }
    if (WANT_H) {
#pragma unroll
        for (int q = 0; q < 4; ++q) { float hh = cin[q];
            if (!REV) {
#pragma unroll
                for (int e = 0; e < 4; ++e) { hh = a[4 * q + e] * hh + b[4 * q + e]; h[4 * q + e] = hh; }
            } else {
#pragma unroll
                for (int e = 3; e >= 0; --e) { hh = a[4 * q + e] * hh + b[4 * q + e]; h[4 * q + e] = hh; }
            } }
    }
}
__device__ __forceinline__ void lru_ident(int r32, int hi, bf16x8& I0, bf16x8& I1) {
#pragma unroll
    for (int j = 0; j < 8; ++j) { I0[j] = (8 * hi + j == r32) ? (short)0x3F80 : (short)0; I1[j] = (16 + 8 * hi + j == r32) ? (short)0x3F80 : (short)0; }
}
template <bool REV, int MODE> __device__ __forceinline__ void lru_subpass(Frame& F, size_t row0, int ntile, int g, int half, float& H, float& ap, LAS unsigned* HFL, bf16x8 (&af)[4], bool have) {
    const bf16_t* XC = WSP(bf16_t, WS_XCONV);
    const int lane = F.lane, r32 = lane & 31, hi = lane >> 5;
    LAS unsigned char* afb = F.lds + LRU_AF + F.wave * 4096;
    bf16x8 I0, I1; lru_ident(r32, hi, I0, I1);
    LruW W; lru_load_w(F, W, REV ? 1 : 0, half, lane);
    if (!have) {
        lru_dma_af(XC, row0 + (REV ? 32 * (ntile - 1) : 0), g, lane, afb);
        asm volatile("s_waitcnt vmcnt(0)" ::: "memory");
        lru_read_af(afb, r32, hi, af);
        asm volatile("s_waitcnt lgkmcnt(0)" ::: "memory");
    }
#pragma unroll 1
    for (int tt = 0; tt < ntile; ++tt) {
        const int ti = REV ? ntile - 1 - tt : tt;
        const bool more = tt + 1 < ntile;
        if (more) lru_dma_af(XC, row0 + 32 * (REV ? ti - 1 : ti + 1), g, lane, afb);
        const size_t t0 = row0 + 32 * ti;
        bf16_t grw[16];
        if (MODE == 2) { const bf16_t* gp = WSP(bf16_t, WS_BIG) + t0 * NIN0 + 2048 + 64 * g + 32 * half;
            const unsigned lo_ = (unsigned)(4 * hi * NIN0 + r32);
#pragma unroll
            for (int i = 0; i < 16; ++i) grw[i] = gp[lo_ + (unsigned)(((i & 3) + 8 * (i >> 2)) * NIN0)]; }
        float a[16], bb[16], h[16];
        lru_gates(af, W, half, I0, I1, a, bb);
        lru_scan_tile<REV, MODE != 0>(a, bb, hi, H, h, ap);
        asm volatile("s_waitcnt vmcnt(0)" ::: "memory");
        if (more) lru_read_af(afb, r32, hi, af);
        if (MODE == 1) {
#pragma unroll
            for (int p = 0; p < 8; ++p) HFL[(ti * 8 + p) * 64 + lane] = pk2(h[2 * p], h[2 * p + 1]);
        }
        if (MODE == 2) {
            bf16_t* op = WSP(bf16_t, WS_A2) + t0 * D + 512 + 64 * g + 32 * half;
            const unsigned so_ = (unsigned)(4 * hi * D + r32);
#pragma unroll
            for (int p = 0; p < 8; ++p) { const unsigned hf = HFL[(ti * 8 + p) * 64 + lane];
                const unsigned pr_ = pk2((bflo(hf) + h[2 * p]) * gelu_tanh(bf1(grw[2 * p])), (bfhi(hf) + h[2 * p + 1]) * gelu_tanh(bf1(grw[2 * p + 1])));
                op[so_ + (unsigned)((((2 * p) & 3) + 8 * ((2 * p) >> 2)) * D)] = (bf16_t)(pr_ & 0xffffu);
                op[so_ + (unsigned)((((2 * p + 1) & 3) + 8 * ((2 * p + 1) >> 2)) * D)] = (bf16_t)(pr_ >> 16); }
        }
        asm volatile("s_waitcnt lgkmcnt(0)" ::: "memory");
    }
    asm volatile("" ::: "memory");
}
template <bool REV> __device__ __forceinline__ void lru_subpass0(Frame& F, size_t row0, int ntile, int g, int half, float& H, float& ap) {
    const bf16_t* XC = WSP(bf16_t, WS_XCONV);
    const int lane = F.lane, r32 = lane & 31, hi = lane >> 5;
    LAS unsigned char* buf0 = F.lds + LRU_AF + F.wave * 4096; LAS unsigned char* buf1 = F.lds + LRU_HF + 8192 + F.wave * 4096;
    bf16x8 I0, I1; lru_ident(r32, hi, I0, I1);
    LruW W; lru_load_w(F, W, REV ? 1 : 0, half, lane);
    bf16x8 af[4];
#define LRU0_ROW(tt) (row0 + 32 * (REV ? ntile - 1 - (tt) : (tt)))
    lru_dma_af(XC, LRU0_ROW(0), g, lane, buf0);
    if (ntile > 1) { lru_dma_af(XC, LRU0_ROW(1), g, lane, buf1); asm volatile("s_waitcnt vmcnt(4)" ::: "memory"); } else asm volatile("s_waitcnt vmcnt(0)" ::: "memory");
    lru_read_af(buf0, r32, hi, af);
    asm volatile("s_waitcnt lgkmcnt(0)" ::: "memory");
#pragma unroll 1
    for (int tt = 0; tt < ntile; ++tt) {
        LAS unsigned char* bcur = (tt & 1) ? buf1 : buf0; LAS unsigned char* bnxt = (tt & 1) ? buf0 : buf1;
        if (tt + 2 < ntile) lru_dma_af(XC, LRU0_ROW(tt + 2), g, lane, bcur);
        float a[16], bb[16], h[16];
        lru_gates(af, W, half, I0, I1, a, bb);
        lru_scan_tile<REV, false>(a, bb, hi, H, h, ap);
        if (tt + 1 < ntile) {
            if (tt + 2 < ntile) asm volatile("s_waitcnt vmcnt(4)" ::: "memory"); else asm volatile("s_waitcnt vmcnt(0)" ::: "memory");
            lru_read_af(bnxt, r32, hi, af);
            asm volatile("s_waitcnt lgkmcnt(0)" ::: "memory");
        }
    }
#undef LRU0_ROW
    asm volatile("" ::: "memory");
}
__device__ __forceinline__ void conv4_local(Frame& F, size_t r0, int ngrp, size_t sbeg, size_t send, int g) {
    const bf16_t* QKV = WSP(bf16_t, WS_BIG); bf16_t* XC = WSP(bf16_t, WS_XCONV);
    const int lane = F.lane, rgrp = lane >> 3, cl = lane & 7, ch = 64 * g + 8 * cl;
    if (rgrp < ngrp) {
        const size_t row0 = r0 + 16 * rgrp;
        u32x4 raw[19];
#pragma unroll
        for (int i = 0; i < 19; ++i) { const size_t r = row0 + i - 2; raw[i] = (r >= sbeg && r < send) ? *(const u32x4*)(QKV + r * NIN0 + 1536 + ch) : (u32x4){0u, 0u, 0u, 0u}; }
        float w[4][8], bs[8];
#pragma unroll
        for (int j = 0; j < 4; ++j) { const f32x4 a = *(const f32x4*)(F.in[I_ECW] + j * 512 + ch), b = *(const f32x4*)(F.in[I_ECW] + j * 512 + ch + 4);
            w[j][0] = a.x; w[j][1] = a.y; w[j][2] = a.z; w[j][3] = a.w; w[j][4] = b.x; w[j][5] = b.y; w[j][6] = b.z; w[j][7] = b.w; }
        { const f32x4 a = *(const f32x4*)(F.in[I_ECB] + ch), b = *(const f32x4*)(F.in[I_ECB] + ch + 4); bs[0] = a.x; bs[1] = a.y; bs[2] = a.z; bs[3] = a.w; bs[4] = b.x; bs[5] = b.y; bs[6] = b.z; bs[7] = b.w; }
#pragma unroll
        for (int t = 0; t < 16; ++t) {
            float o[8];
#pragma unroll
            for (int e = 0; e < 8; ++e) o[e] = bs[e];
#pragma unroll
            for (int j = 0; j < 4; ++j) { const u32x4 r = raw[t + j];
                o[0] += w[j][0] * bflo(r.x); o[1] += w[j][1] * bfhi(r.x); o[2] += w[j][2] * bflo(r.y); o[3] += w[j][3] * bfhi(r.y);
                o[4] += w[j][4] * bflo(r.z); o[5] += w[j][5] * bfhi(r.z); o[6] += w[j][6] * bflo(r.w); o[7] += w[j][7] * bfhi(r.w); }
            u32x4 pk; pk.x = pk2(o[0], o[1]); pk.y = pk2(o[2], o[3]); pk.z = pk2(o[4], o[5]); pk.w = pk2(o[6], o[7]);
            *(u32x4*)(XC + (row0 + t) * 512 + ch) = pk;
        }
    }
    asm volatile("s_waitcnt vmcnt(0)" ::: "memory");
}
template <bool REV> __device__ __forceinline__ void lru_subpass2(Frame& F, size_t row0, int ntile, int g, float (&H)[2], float (&ap)[2]) {
    const bf16_t* XC = WSP(bf16_t, WS_XCONV);
    const int lane = F.lane, r32 = lane & 31, hi = lane >> 5;
    LAS unsigned char* afb = F.lds + LRU_AF + F.wave * 4096;
    bf16x8 I0, I1; lru_ident(r32, hi, I0, I1);
    LruW W0, W1; lru_load_w(F, W0, REV ? 1 : 0, 0, lane); lru_load_w(F, W1, REV ? 1 : 0, 1, lane);
    bf16x8 af[4];
    lru_dma_af(XC, row0 + (REV ? 32 * (ntile - 1) : 0), g, lane, afb);
    asm volatile("s_waitcnt vmcnt(0)" ::: "memory");
    lru_read_af(afb, r32, hi, af);
    asm volatile("s_waitcnt lgkmcnt(0)" ::: "memory");
#pragma unroll 1
    for (int tt = 0; tt < ntile; ++tt) {
        const int ti = REV ? ntile - 1 - tt : tt;
        const bool more = tt + 1 < ntile;
        if (more) lru_dma_af(XC, row0 + 32 * (REV ? ti - 1 : ti + 1), g, lane, afb);
        float a0[16], b0[16], a1[16], b1[16], hd[16];
        lru_gates(af, W0, 0, I0, I1, a0, b0);
        lru_gates(af, W1, 1, I0, I1, a1, b1);
        lru_scan_tile<REV, false>(a0, b0, hi, H[0], hd, ap[0]);
        lru_scan_tile<REV, false>(a1, b1, hi, H[1], hd, ap[1]);
        asm volatile("s_waitcnt vmcnt(0)" ::: "memory");
        if (more) lru_read_af(afb, r32, hi, af);
        asm volatile("s_waitcnt lgkmcnt(0)" ::: "memory");
    }
    asm volatile("" ::: "memory");
}
__device__ __forceinline__ void lru_pass1_wg(Frame& F, int wg) {
    const int j = wg & 15, g = (wg >> 4) & 7, b = wg >> 7, w = F.wave, lane = F.lane, hi = lane >> 5;
    f32x2* TOT = WSP(f32x2, WS_TOT); f32x2* TOTG = WSP(f32x2, WS_TOTG); f32x2* TOTC = WSP(f32x2, WS_TOTC);
    LAS f32x2* CB = (LAS f32x2*)(F.lds + LRU_HF);
    lru_stage_w(F, g);
    const int c = 8 * j + w, sub = w - 2;
    const int njobs = (w == 2 || w == 4) ? 2 : 1;
    if (njobs == 2) __builtin_amdgcn_s_setprio(1);
#pragma unroll 1
    for (int job = 0; job < njobs; ++job) {
        const size_t r0 = job == 0 ? (size_t)b * SEQ + (size_t)c * CHUNK : (size_t)ML + (size_t)b * NCTX + 32 * (j & 7);
        const int nt = job == 0 ? 4 : 1;
        { const size_t sb_ = job == 0 ? (size_t)b * SEQ : (size_t)ML + (size_t)b * NCTX, se_ = job == 0 ? sb_ + SEQ : sb_ + NCTX;
          asm volatile("" ::: "memory"); __builtin_amdgcn_sched_barrier(0);
          conv4_local(F, r0, job == 0 ? 8 : 2, sb_, se_, g);
          asm volatile("" ::: "memory"); __builtin_amdgcn_sched_barrier(0); }
        f32x2 tot[2] = {(f32x2){1.f, 0.f}, (f32x2){1.f, 0.f}};
#pragma unroll 1
        for (int half = 0; half < 2; ++half) {
            if (job != 0 && half != (j >> 3)) continue;
            if (job == 0 || sub < 2) { float H = 0.f, ap = 1.f; lru_subpass0<false>(F, r0, nt, g, half, H, ap); if (hi == half) tot[0] = (f32x2){ap, H}; }
            if (job == 0 || sub >= 2) { float H = 0.f, ap = 1.f; lru_subpass0<true>(F, r0, nt, g, half, H, ap); if (hi == half) tot[1] = (f32x2){ap, H}; }
        }
        if (job == 0) {
#pragma unroll
            for (int d = 0; d < 2; ++d) { st8_wt(&TOT[(size_t)((b * 2 + d) * NCHUNK + c) * 512 + 64 * g + lane], tot[d]); CB[(d * 8 + w) * 64 + lane] = tot[d]; }
        } else {
            if (hi == (j >> 3)) st8_wt(&TOTC[(size_t)((b * 2 + (sub >> 1)) * 8 + (j & 7)) * 512 + 64 * g + lane], (sub >> 1) ? tot[1] : tot[0]);
        }
    }
    __builtin_amdgcn_s_setprio(0);
    __syncthreads();
    if (w < 2) { const int d = w; float A = 1.f, B = 0.f;
#pragma unroll
        for (int k = 0; k < 8; ++k) { const f32x2 t = CB[(d * 8 + (d == 0 ? k : 7 - k)) * 64 + lane]; B = t.x * B + t.y; A *= t.x; }
        st8_wt(&TOTG[(size_t)((b * 2 + d) * 16 + j) * 512 + 64 * g + lane], (f32x2){A, B}); }
    asm volatile("s_waitcnt vmcnt(0)" ::: "memory");
    __syncthreads();
    if (F.tid == 0) (void)__hip_atomic_fetch_add((unsigned*)(F.ws + WS_CTL) + CW_LRUG + 64 * (b * 8 + g), 1u, __ATOMIC_RELAXED, __HIP_MEMORY_SCOPE_AGENT);
}
__device__ __forceinline__ void lru_pass3_wg(Frame& F, int wg, bool staged) {
    const int j = wg & 15, g = (wg >> 4) & 7, b = wg >> 7, w = F.wave, lane = F.lane, r32 = lane & 31;
    const f32x2* TOT = WSP(f32x2, WS_TOT); const f32x2* TOTG = WSP(f32x2, WS_TOTG); const f32x2* TOTC = WSP(f32x2, WS_TOTC);
    LAS unsigned* HFL = (LAS unsigned*)(F.lds + LRU_HF + w * 8192);
    if (F.tid == 0) { const unsigned* gc = (const unsigned*)(F.ws + WS_CTL) + CW_LRUG + 64 * (b * 8 + g); unsigned sp = 0;
        while (__hip_atomic_load(gc, __ATOMIC_RELAXED, __HIP_MEMORY_SCOPE_AGENT) < 16u) { __builtin_amdgcn_s_sleep(2); if (++sp > (1u << 22)) break; } }
    __syncthreads();
    const int c = 8 * j + w;
    const size_t row0 = (size_t)b * SEQ + (size_t)c * CHUNK;
    float Cf = 0.f, Cb = 0.f;
    {
        const f32x2 id = (f32x2){1.f, 0.f};
        const size_t chn = 64 * g + lane;
        f32x2 t[15];
#pragma unroll
        for (int k = 0; k < 8; ++k) t[k] = ld8_sc1(&TOTC[(size_t)((b * 2 + 0) * 8 + k) * 512 + chn]);
#pragma unroll
        for (int k = 0; k < 7; ++k) t[8 + k] = (k < w) ? ld8_sc1(&TOT[(size_t)((b * 2 + 0) * NCHUNK + 8 * j + k) * 512 + chn]) : id;
        f32x2 u[15];
#pragma unroll
        for (int k = 0; k < 15; ++k) u[k] = (k < j) ? ld8_sc1(&TOTG[(size_t)((b * 2 + 0) * 16 + k) * 512 + chn]) : id;
        f32x2 tb[15], ub[15];
#pragma unroll
        for (int k = 0; k < 8; ++k) tb[k] = ld8_sc1(&TOTC[(size_t)((b * 2 + 1) * 8 + (7 - k)) * 512 + chn]);
#pragma unroll
        for (int k = 0; k < 7; ++k) tb[8 + k] = (7 - k > w) ? ld8_sc1(&TOT[(size_t)((b * 2 + 1) * NCHUNK + 8 * j + (7 - k)) * 512 + chn]) : id;
#pragma unroll
        for (int k = 0; k < 15; ++k) ub[k] = (15 - k > j) ? ld8_sc1(&TOTG[(size_t)((b * 2 + 1) * 16 + (15 - k)) * 512 + chn]) : id;
        if (!staged) lru_stage_w(F, g);
#pragma unroll
        for (int k = 0; k < 8; ++k) Cf = t[k].x * Cf + t[k].y;
#pragma unroll
        for (int k = 0; k < 15; ++k) Cf = u[k].x * Cf + u[k].y;
#pragma unroll
        for (int k = 0; k < 7; ++k) Cf = t[8 + k].x * Cf + t[8 + k].y;
#pragma unroll
        for (int k = 0; k < 8; ++k) Cb = tb[k].x * Cb + tb[k].y;
#pragma unroll
        for (int k = 0; k < 15; ++k) Cb = ub[k].x * Cb + ub[k].y;
#pragma unroll
        for (int k = 0; k < 7; ++k) Cb = tb[8 + k].x * Cb + tb[8 + k].y;
        asm volatile("" ::: "memory");
    }
    float dummy = 1.f, H;
    bf16x8 af[4];
#pragma unroll 1
    for (int half = 0; half < 2; ++half) {
        H = __shfl(Cf, 32 * half + r32); lru_subpass<false, 1>(F, row0, 4, g, half, H, dummy, HFL, af, half != 0);
        H = __shfl(Cb, 32 * half + r32); lru_subpass<true, 2>(F, row0, 4, g, half, H, dummy, HFL, af, true);
    }
    LDS_WAIT();
    __syncthreads();
}

__device__ __forceinline__ void conv3_task(Frame& F, int task) {
    bf16_t* BG = WSP(bf16_t, WS_A1); const bf16_t* P = WSP(bf16_t, WS_A3);
    const int lane = F.lane, half = task & 1, row0 = (task >> 1) * 16, ch = half * 512 + 8 * lane;
    const int sbeg = (row0 / SEQ) * SEQ, send = sbeg + SEQ;
    u32x4 raw[18];
#pragma unroll
    for (int i = 0; i < 18; ++i) { const int r = row0 + i - 1; raw[i] = (r >= sbeg && r < send) ? *(const u32x4*)(P + (size_t)r * D + ch) : (u32x4){0u, 0u, 0u, 0u}; }
    u32x4 bgr[16];
#pragma unroll
    for (int t = 0; t < 16; ++t) bgr[t] = *(const u32x4*)(BG + (size_t)(row0 + t) * D + ch);
    float w[3][8];
#pragma unroll
    for (int j = 0; j < 3; ++j) { const f32x4 a = *(const f32x4*)(F.in[I_OCW] + j * D + ch), b = *(const f32x4*)(F.in[I_OCW] + j * D + ch + 4);
        w[j][0] = a.x; w[j][1] = a.y; w[j][2] = a.z; w[j][3] = a.w; w[j][4] = b.x; w[j][5] = b.y; w[j][6] = b.z; w[j][7] = b.w; }
#pragma unroll
    for (int t = 0; t < 16; ++t) {
        float o[8];
#pragma unroll
        for (int e = 0; e < 8; ++e) o[e] = 0.f;
#pragma unroll
        for (int j = 0; j < 3; ++j) { const u32x4 r = raw[t + j];
            o[0] += w[j][0] * bflo(r.x); o[1] += w[j][1] * bfhi(r.x); o[2] += w[j][2] * bflo(r.y); o[3] += w[j][3] * bfhi(r.y);
            o[4] += w[j][4] * bflo(r.z); o[5] += w[j][5] * bfhi(r.z); o[6] += w[j][6] * bflo(r.w); o[7] += w[j][7] * bfhi(r.w); }
        bf16_t* bp = BG + (size_t)(row0 + t) * D + ch;
        const u32x4 bgv = bgr[t];
        u32x4 pk; pk.x = pk2(o[0] * bflo(bgv.x), o[1] * bfhi(bgv.x)); pk.y = pk2(o[2] * bflo(bgv.y), o[3] * bfhi(bgv.y)); pk.z = pk2(o[4] * bflo(bgv.z), o[5] * bfhi(bgv.z)); pk.w = pk2(o[6] * bflo(bgv.w), o[7] * bfhi(bgv.w));
        st16_wt(bp, pk);
    }
}

__device__ __forceinline__ void final_row(Frame& F, int m) {
    f32x4* xr = (f32x4*)(F.out + (size_t)m * D) + F.lane;
    const float rs = fast_rsq(WSP(float, WS_SSQ)[3 * ML + m] * (1.f / D) + EPS);
    const f32x4* gp = (const f32x4*)F.in[I_FG] + F.lane;
#pragma unroll
    for (int j = 0; j < 4; ++j) { const f32x4 v = xr[64 * j], g = gp[64 * j]; xr[64 * j] = v * rs * g; }
}

__device__ __forceinline__ void ctx_proj_wg(Frame& F) {
    const int lane = F.lane, w = F.wave, r32 = lane & 31, hi = lane >> 5;
    const bf16_t* XB = WSP(bf16_t, WS_A1) + (size_t)ML * D;
    const bf16_t* W2 = WSP(bf16_t, WS_WIN0) + (size_t)2 * NIN0 * D;
    const float* ss = WSP(float, WS_SS0) + ML; const float* bias = WSP(float, WS_B_IN0) + (size_t)2 * NIN0;
    bf16_t* O = WSP(bf16_t, WS_BIG) + (size_t)ML * NIN0;
    LAS float* red = (LAS float*)F.lds;
    constexpr int NSTRIP = (NB * NCTX / 32) * (1536 / 96);
    for (int st = blockIdx.x; st < NSTRIP; st += (int)F.G) {
        const int rb = st >> 4, c0 = 512 + 96 * (st & 15);
        const bf16_t* ap = XB + (size_t)(32 * rb + r32) * D + 128 * w + 8 * hi;
        const bf16_t* bp = W2 + (size_t)(c0 + r32) * D + 128 * w + 8 * hi;
        bf16x8 a[8], b[3][8];
#pragma unroll
        for (int j = 0; j < 8; ++j) { a[j] = *(const bf16x8*)(ap + 16 * j);
#pragma unroll
            for (int t = 0; t < 3; ++t) b[t][j] = *(const bf16x8*)(bp + (size_t)(32 * t) * D + 16 * j); }
        f32x16 acc[3];
#pragma unroll
        for (int t = 0; t < 3; ++t) {
#pragma unroll
            for (int i = 0; i < 16; ++i) acc[t][i] = 0.f;
#pragma unroll
            for (int j = 0; j < 8; ++j) acc[t] = __builtin_amdgcn_mfma_f32_32x32x16_bf16(a[j], b[t][j], acc[t], 0, 0, 0);
#pragma unroll
            for (int i = 0; i < 16; ++i) red[((w * 3 + t) * 16 + i) * 64 + lane] = acc[t][i];
        }
        __syncthreads();
#pragma unroll
        for (int q = 0; q < 6; ++q) { const int p = w * 6 + q, t = p >> 4, i = p & 15, row = 32 * rb + crow(i, hi), col = c0 + 32 * t + r32;
            float v = 0.f;
#pragma unroll
            for (int k = 0; k < 8; ++k) v += red[((k * 3 + t) * 16 + i) * 64 + lane];
            v = v * fast_rsq(ss[row] * (1.f / D) + EPS) + bias[col];
            O[(size_t)row * NIN0 + col] = (bf16_t)f2bf(v); }
        __syncthreads();
    }
}

constexpr int PI_O = (D / 64) * (D / 32), PI_GU = (NGU / 32) * 16, PI_DN = (FF / 64) * (D / 32), PI_IN1 = (NIN1 / 32) * 16;
constexpr int PE0 = PI_O, PE1 = PE0 + PI_GU, PE2 = PE1 + PI_DN, PE3 = PE2 + PI_IN1, PE4 = PE3 + PI_O, PE5 = PE4 + PI_GU, L1_ITEMS = PE5 + PI_DN;
constexpr int PREP_SLICES = 9, PREP_PER = 1255;
__device__ __forceinline__ int prep_slice_begin(int k) { return PREP_PER * k; }
static_assert(2 * PREP_PER >= PE0 && 3 * PREP_PER >= PE1 && 4 * PREP_PER >= PE2 && 5 * PREP_PER >= PE3 && 7 * PREP_PER >= PE4 && 8 * PREP_PER >= PE5 && 9 * PREP_PER >= L1_ITEMS && PREP_PER <= 7 * 256, "prep deadlines");
__device__ __forceinline__ void prep_l1_item(Frame& F, int item) {
    LAS float* scr = (LAS float*)(F.lds + F.wave * 16384);
    const bool fold0 = item >= PE0 && item < PE1, fold_in1 = item >= PE2 && item < PE3, fold1 = item >= PE4 && item < PE5;
    if (fold0 || fold_in1 || fold1) {
        const bool gu = !fold_in1; const int l = fold0 ? 0 : 1;
        const int r = item - (fold0 ? PE0 : (fold_in1 ? PE2 : PE4)), ks = r & 15, n0 = (r >> 4) * 32;
        const int N = gu ? NGU : NIN1;
        fold_item<2>(gu ? F.in[I_WGU] + (size_t)l * D * NGU : F.in[I_OWIN], N, n0, gu ? gu_dst(n0) : in1_dst(n0), N, 64 * ks, 1.f, (gu ? F.in[I_N2G] : F.in[I_N1G]) + l * D, WSP(float, WS_MODS) + l * 3 * 6144,
                     gu ? 4096 : 1024, gu ? 3072 : 0, gu ? (l ? WSP(bf16_t, WS_WGU1) : WSP(bf16_t, WS_WGU0)) : WSP(bf16_t, WS_WIN1), gu ? (l ? WSP(float, WS_B_GU1) : WSP(float, WS_B_GU0)) : WSP(float, WS_B_IN1), scr, F.lane);
    } else {
        const int which = item < PE0 ? 0 : (item < PE2 ? 1 : (item < PE4 ? 2 : 3));
        const float* W = which == 0 ? F.in[I_EWOUT] : (which == 1 ? F.in[I_WDN] : (which == 2 ? F.in[I_OWOUT] : F.in[I_WDN] + (size_t)FF * D));
        bf16_t* WT = which == 0 ? WSP(bf16_t, WS_WOUT0) : (which == 1 ? WSP(bf16_t, WS_WDN0) : (which == 2 ? WSP(bf16_t, WS_WOUT1) : WSP(bf16_t, WS_WDN1)));
        p0_transpose_item(W, (which & 1) ? FF : D, D, WT, scr, which == 0 ? item : (which == 1 ? item - PE1 : (which == 2 ? item - PE3 : item - PE5)), F.lane);
    }
}
__device__ __forceinline__ void xcd_barrier_prep(const XcdBarrier& b, Frame& F, int slice) {
    asm volatile("s_waitcnt vmcnt(0)" ::: "memory");
    __syncthreads();
    if (F.wave == 0) {
        if (threadIdx.x == 0) {
            unsigned* bar = b.bar;
            __builtin_amdgcn_s_waitcnt(0);
            unsigned nloc = b.st[0], nx = b.st[1];
            if (nloc == 0u) { xcd_barrier_complete(bar, b.x, nloc, nx); b.st[0] = nloc; b.st[1] = nx; }
            const unsigned old = xb_add(&bar[XB_XSUB(b.x)], 1u);
            __builtin_amdgcn_fence(__ATOMIC_ACQUIRE, "agent");
            const unsigned gen = old / nloc;
            if (old + 1u == (gen + 1u) * nloc) {
                __builtin_amdgcn_fence(__ATOMIC_RELEASE, "agent");
                asm volatile("s_waitcnt vmcnt(0)" ::: "memory");
                const unsigned og = xb_add(&bar[XB_TOP], 1u);
                const unsigned tg = og / nx;
                if (og + 1u == (tg + 1u) * nx) {
#pragma unroll
                    for (unsigned j = 0; j < 16; ++j) xb_add(&bar[XB_XGEN(j)], 1u);
                } else XB_SPIN(xb_ld(&bar[XB_XGEN(b.x)]) == gen, bar);
                asm volatile("s_waitcnt vmcnt(0)" ::: "memory");
            } else {
                XB_SPIN(xb_ld(&bar[XB_XGEN(b.x)]) == gen, bar);
                asm volatile("s_waitcnt vmcnt(0)" ::: "memory");
            }
        }
    } else {
        const int w = (7 - F.wave) * (int)F.G + (int)blockIdx.x, item = prep_slice_begin(slice) + w;
        if (item < prep_slice_begin(slice + 1) && item < L1_ITEMS) prep_l1_item(F, item);
    }
    __syncthreads();
}

struct Args { const float* in[N_IN]; float* out; unsigned char* ws; int ph_lo, ph_hi; };
__global__ void __launch_bounds__(512, 2) dit_fwd(Args args) {
    extern __shared__ __attribute__((aligned(16))) unsigned char lds_raw[];
    Frame F;
    F.lds = (LAS unsigned char*)lds_raw;
    F.tid = threadIdx.x; F.lane = F.tid & 63; F.wave = __builtin_amdgcn_readfirstlane(F.tid >> 6);
    F.G = gridDim.x; F.gw = blockIdx.x * 8 + F.wave; F.NGW = F.G * 8;
#pragma unroll
    for (int i = 0; i < N_IN; ++i) F.in[i] = args.in[i];
    F.out = args.out; F.ws = args.ws;
    for (int u = F.tid; u < (LDS_BYTES - LDSCTL_OFF) / 4; u += 512) ((LAS unsigned*)(F.lds + LDSCTL_OFF))[u] = 0u;
    __syncthreads();
    volatile LAS unsigned* MISC = (volatile LAS unsigned*)(F.lds + MISC_OFF);
    XcdBarrier bar; bar.bar = (unsigned*)(F.ws + WS_CTL) + CW_BAR; bar.x = 0; bar.st = nullptr;
    const int lo = args.ph_lo, hi = args.ph_hi;
    if (hi - lo > 1) bar = xcd_barrier_post((unsigned*)(F.ws + WS_CTL) + CW_BAR, MISC + 8);
#ifdef ONLY_PHASE
#define IN(k) ((k) == ONLY_PHASE)
#else
#define IN(k) (lo <= (k) && (k) < hi)
#endif
#define SEAM(k) do { if (IN(k) && IN((k) + 1)) xcd_barrier(bar); } while (0)
#define SEAMP(k, sl) do { if (IN(k) && IN((k) + 1)) xcd_barrier_prep(bar, F, sl); } while (0)
    float* SSQ = WSP(float, WS_SSQ);
    const float* mods = WSP(float, WS_MODS);

    if (IN(0)) {
        unsigned* mt = (unsigned*)(F.ws + WS_CTL) + CW_MODS;
        for (int t = blockIdx.x; t < 192; t += F.G) {
            p0_mods_task(F, t);
            asm volatile("s_waitcnt vmcnt(0)" ::: "memory");
            __syncthreads();
            if (F.tid == 0) (void)__hip_atomic_fetch_add(mt, 1u, __ATOMIC_RELAXED, __HIP_MEMORY_SCOPE_AGENT);
        }
        phase_p0(F, 0, F.gw, F.NGW);
        if (F.tid == 0) { unsigned sp = 0; while (__hip_atomic_load(mt, __ATOMIC_RELAXED, __HIP_MEMORY_SCOPE_AGENT) < 192u) { __builtin_amdgcn_s_sleep(2); if (++sp > (1u << 22)) break; }
            __builtin_amdgcn_fence(__ATOMIC_ACQUIRE, "agent"); asm volatile("s_waitcnt vmcnt(0)" ::: "memory"); }
        __syncthreads();
        phase_p1(F, 0, F.wave * F.G + blockIdx.x, F.NGW);
    } SEAMP(0, 0);
    if (IN(2)) { for (int rep_ = 0; rep_ <= ((PROBE_REP_MASK >> 2) & 1); ++rep_) { if (rep_) xcd_barrier(bar);
        pg8::Gemm g{WSP(bf16_t, WS_A1), WSP(bf16_t, WS_WIN0), (long)NIN0 * D, (long)2 * NIN0 * D, D};
        pg8::Order S; S.init(ML / 256, NIN0 / 256, F.G, blockIdx.x);
        pg8::EpiInProj E{WSP(bf16_t, WS_BIG), WSP(float, WS_SS0), WSP(float, WS_B_IN0)};
        pg8::gemm_phase<pg8::EpiInProj, pg8::Order, true, true>(F.lds, g, S, E);
        __syncthreads();
        ctx_proj_wg(F);
    } } SEAMP(2, 1);
    if (IN(3)) { for (int rep_ = 0; rep_ <= ((PROBE_REP_MASK >> 3) & 1); ++rep_) { if (rep_) xcd_barrier(bar);
        attn_phase(F);
        __syncthreads();
        for (int t = blockIdx.x; t < 256; t += F.G) lru_pass1_wg(F, t);
        for (int t = blockIdx.x; t < 256; t += F.G) lru_pass3_wg(F, t, F.G >= 256);
    } }
    SEAMP(5, 2);
    if (IN(6)) { for (int rep_ = 0; rep_ <= ((PROBE_REP_MASK >> 6) & 1); ++rep_) { if (rep_) xcd_barrier(bar);
        pg8::Gemm g{WSP(bf16_t, WS_A2), WSP(bf16_t, WS_WOUT0), 0l, 0l, D};
        pg8::Order S; S.init(ML / 256, D / 256, F.G, blockIdx.x);
        pg8::EpiRes<false, false> E{nullptr, WSP(bf16_t, WS_A1), WSP(bf16_t, WS_A3), nullptr, mods + 2048, SSQ, (unsigned)(uintptr_t)(F.lds + 132096)};
        pg8::gemm_phase<pg8::EpiRes<false, false>, pg8::Order, true, true>(F.lds, g, S, E);
    } } SEAMP(6, 3);
    if (IN(7)) { for (int rep_ = 0; rep_ <= ((PROBE_REP_MASK >> 7) & 1); ++rep_) { if (rep_) xcd_barrier(bar);
        pg8::Gemm g{WSP(bf16_t, WS_A3), WSP(bf16_t, WS_WGU0), (long)NGU * D, 0l, D};
        pg8::Order S; S.init(ML / 256, NGU / 256, F.G, blockIdx.x);
        pg8::EpiSwiGLU E{WSP(bf16_t, WS_BIG), SSQ, WSP(float, WS_B_GU0)};
        pg8::gemm_phase<pg8::EpiSwiGLU, pg8::Order, true, true>(F.lds, g, S, E);
    } } SEAMP(7, 4);
    if (IN(8)) { for (int rep_ = 0; rep_ <= ((PROBE_REP_MASK >> 8) & 1); ++rep_) { if (rep_) xcd_barrier(bar);
        pg8::Gemm g{WSP(bf16_t, WS_BIG), WSP(bf16_t, WS_WDN0), 0l, 0l, FF};
        pg8::Order S; S.init(ML / 256, D / 256, F.G, blockIdx.x);
        pg8::EpiRes<false, false> E{nullptr, WSP(bf16_t, WS_A3), WSP(bf16_t, WS_A2), nullptr, mods + 5120, SSQ + ML, (unsigned)(uintptr_t)(F.lds + 132096)};
        pg8::gemm_phase<pg8::EpiRes<false, false>, pg8::Order, true, true>(F.lds, g, S, E);
    } } SEAMP(8, 5);
    if (IN(9)) { for (int rep_ = 0; rep_ <= ((PROBE_REP_MASK >> 9) & 1); ++rep_) { if (rep_) xcd_barrier(bar);
        pg8::Gemm g{WSP(bf16_t, WS_A2), WSP(bf16_t, WS_WIN1), (long)NIN1 * D, 0l, D};
        pg8::Order S; S.init(ML / 256, 8, F.G, blockIdx.x); S.pn_off = 4;
        pg8::EpiScIn E{WSP(bf16_t, WS_A1), WSP(bf16_t, WS_A3), SSQ + ML, WSP(float, WS_B_IN1)};
        pg8::gemm_phase<pg8::EpiScIn, pg8::Order, true, true>(F.lds, g, S, E);
    } } SEAMP(9, 6);
    if (IN(10)) { for (int rep_ = 0; rep_ <= ((PROBE_REP_MASK >> 10) & 1); ++rep_) { if (rep_) xcd_barrier(bar);
        pg8::Gemm g{WSP(bf16_t, WS_A2), WSP(bf16_t, WS_WIN1), (long)NIN1 * D, 0l, D};
        pg8::Order S; S.init(ML / 256, 4, F.G, blockIdx.x);
        pg8::EpiScGate E{WSP(bf16_t, WS_A1), WSP(bf16_t, WS_A3), SSQ + ML, WSP(float, WS_B_IN1), F.in[I_OCW]};
        pg8::gemm_phase<pg8::EpiScGate, pg8::Order, true, true>(F.lds, g, S, E);
    } } SEAMP(10, 7);
    if (IN(11)) { for (int rep_ = 0; rep_ <= ((PROBE_REP_MASK >> 11) & 1); ++rep_) { if (rep_) xcd_barrier(bar);
        pg8::Gemm g{WSP(bf16_t, WS_A1), WSP(bf16_t, WS_WOUT1), 0l, 0l, D};
        pg8::Order S; S.init(ML / 256, D / 256, F.G, blockIdx.x);
        pg8::EpiRes<false, false> E{nullptr, WSP(bf16_t, WS_A2), WSP(bf16_t, WS_A3), nullptr, mods + 3 * 6144 + 2048, SSQ + 2 * ML, (unsigned)(uintptr_t)(F.lds + 132096)};
        pg8::gemm_phase<pg8::EpiRes<false, false>, pg8::Order, true, true>(F.lds, g, S, E);
    } } SEAMP(11, 8);
    if (IN(12)) { for (int rep_ = 0; rep_ <= ((PROBE_REP_MASK >> 12) & 1); ++rep_) { if (rep_) xcd_barrier(bar);
        pg8::Gemm g{WSP(bf16_t, WS_A3), WSP(bf16_t, WS_WGU1), (long)NGU * D, 0l, D};
        pg8::Order S; S.init(ML / 256, NGU / 256, F.G, blockIdx.x);
        pg8::EpiSwiGLU E{WSP(bf16_t, WS_BIG), SSQ + 2 * ML, WSP(float, WS_B_GU1)};
        pg8::gemm_phase<pg8::EpiSwiGLU, pg8::Order, true, true>(F.lds, g, S, E);
    } } SEAM(12);
    if (IN(13)) { for (int rep_ = 0; rep_ <= ((PROBE_REP_MASK >> 13) & 1); ++rep_) { if (rep_) xcd_barrier(bar);
        pg8::Gemm g{WSP(bf16_t, WS_BIG), WSP(bf16_t, WS_WDN1), 0l, 0l, FF};
        pg8::Order S; S.init(ML / 256, D / 256, F.G, blockIdx.x);
        pg8::EpiFinal E{WSP(bf16_t, WS_A3), F.out, mods + 3 * 6144 + 5120, SSQ + 3 * ML, (unsigned*)(F.ws + WS_CTL) + CW_PCNT, F.in[I_FG], (unsigned)(uintptr_t)(F.lds + 132096)};
        pg8::gemm_phase<pg8::EpiFinal, pg8::Order, true, true>(F.lds, g, S, E);
    } }
#undef IN
#undef SEAM
#undef SEAMP
}

extern "C" void kernel_launch(void* const* d_in, const int* in_sizes, int n_in, void* d_out, int out_size, void* d_ws, size_t ws_size, hipStream_t stream) {
    static int grid = 0;
    if (grid == 0) {
        if (n_in != N_IN || in_sizes[0] != ML * D || out_size != ML * D || ws_size < WS_END) { fprintf(stderr, "kernel_launch: unexpected shapes (n_in %d, in0 %d, out %d, ws %zu)\n", n_in, n_in > 0 ? in_sizes[0] : -1, out_size, ws_size); grid = -1; return; }
        int dev = 0, cus = 0;
        if (hipGetDevice(&dev) != hipSuccess || hipDeviceGetAttribute(&cus, hipDeviceAttributeMultiprocessorCount, dev) != hipSuccess) { grid = -1; return; }
        if (hipFuncSetAttribute((const void*)dit_fwd, hipFuncAttributeMaxDynamicSharedMemorySize, LDS_BYTES) != hipSuccess) { fprintf(stderr, "kernel_launch: hipFuncSetAttribute failed\n"); grid = -1; return; }
        int per_cu = 0;
        if (hipOccupancyMaxActiveBlocksPerMultiprocessor(&per_cu, (const void*)dit_fwd, 512, LDS_BYTES) != hipSuccess || per_cu < 1) fprintf(stderr, "kernel_launch: note: occupancy query reports %d\n", per_cu);
        (void)hipGetLastError();
        grid = cus;
    }
    if (grid < 0) return;
    if (hipMemsetAsync((char*)d_ws + WS_CTL, 0, CTL_ZERO_BYTES, stream) != hipSuccess) { fprintf(stderr, "kernel_launch: memset failed\n"); return; }
    Args a{};
    for (int i = 0; i < N_IN; ++i) a.in[i] = (const float*)d_in[i];
    a.out = (float*)d_out; a.ws = (unsigned char*)d_ws;
    constexpr int NPH = 14;
#if MK_PER_PHASE
    for (int p = 0; p < NPH; ++p) { a.ph_lo = p; a.ph_hi = p + 1; hipLaunchKernelGGL(dit_fwd, dim3(grid), dim3(512), LDS_BYTES, stream, a); }
#else
    a.ph_lo = 0; a.ph_hi = NPH;
    hipLaunchKernelGGL(dit_fwd, dim3(grid), dim3(512), LDS_BYTES, stream, a);
#endif
    const hipError_t le = hipPeekAtLastError();
    if (le != hipSuccess) fprintf(stderr, "kernel_launch: launch failed: %s\n", hipGetErrorName(le));
}
```

```cpp
#include <hip/hip_runtime.h>
#include <cstdio>
#include <cstdint>
#include <type_traits>

#ifndef PROBE_REP_MASK
#define PROBE_REP_MASK 0
#endif
#ifndef MK_PER_PHASE
#define MK_PER_PHASE 0
#endif

#define GAS __attribute__((address_space(1)))
#define LAS __attribute__((address_space(3)))
typedef unsigned short bf16_t;
typedef short bf16x8 __attribute__((ext_vector_type(8)));
typedef short s16x4 __attribute__((ext_vector_type(4)));
typedef float f32x4 __attribute__((ext_vector_type(4)));
typedef float f32x2 __attribute__((ext_vector_type(2)));
typedef float f32x16 __attribute__((ext_vector_type(16)));
typedef unsigned u32x4 __attribute__((ext_vector_type(4)));
typedef unsigned u32x2 __attribute__((ext_vector_type(2)));

constexpr int D = 1024, NB = 2, SEQ = 16384, ML = NB * SEQ, NCTX = 256, MC = NB * NCTX, MT = ML + MC;
constexpr int NIN0 = 2560, FF = 2816, NGU = 2 * FF, NIN1 = 3072;
constexpr int NCHUNK = 128, CHUNK = SEQ / NCHUNK  , NCI = NCHUNK + 2;
constexpr float EPS = 1e-6f;
constexpr float LOG2E = 1.4426950408889634f;
constexpr float QSCALE = 0.125f * LOG2E;
enum { I_X = 0, I_C, I_CTX, I_CCTX, I_MODW, I_MODB, I_N1G, I_N2G, I_WGU, I_WDN, I_EWIN, I_EWOUT, I_ECW, I_ECB, I_LWR, I_LBR, I_LWI, I_LBI, I_LAM, I_RPB, I_OWIN, I_OCW, I_OWOUT, I_FG, N_IN };

constexpr size_t MiB = 1u << 20;
constexpr size_t WS_CTL = 0, CTL_ZERO_BYTES = 1 * MiB + 160 * 1024;
constexpr size_t WS_SSQ = 256 * 1024;
constexpr size_t WS_B_IN0 = 768 * 1024;
constexpr size_t WS_B_GU0 = WS_B_IN0 + 3 * 2560 * 4;
constexpr size_t WS_B_IN1 = WS_B_GU0 + 2 * 5632 * 4;
constexpr size_t WS_B_GU1 = WS_B_IN1 + 2 * 3072 * 4;
static_assert(WS_B_GU1 + 2 * 5632 * 4 <= 1024 * 1024, "zeroed region");
constexpr size_t WS_MODS = 1 * MiB;
constexpr size_t WS_SS0 = WS_MODS + 160 * 1024;
constexpr size_t WS_BP_IN0 = WS_SS0 + 136 * 1024;
constexpr size_t WS_BP_GU0 = WS_BP_IN0 + 128 * 1024;
constexpr size_t WS_BP_IN1 = WS_BP_GU0 + 192 * 1024;
constexpr size_t WS_BP_GU1 = WS_BP_IN1 + 128 * 1024;
static_assert(WS_BP_GU1 + 192 * 1024 <= 4 * MiB, "small map");
constexpr size_t WS_TOT = 4 * MiB;
constexpr size_t WS_TOTG = 6 * MiB;
constexpr size_t WS_TOTC = 6 * MiB + 256 * 1024;
constexpr size_t WS_LRUW = 6 * MiB + 512 * 1024;
constexpr size_t WS_WIN0 = 8 * MiB;
constexpr size_t WS_WOUT0 = 23 * MiB;
constexpr size_t WS_WGU0 = 25 * MiB;
constexpr size_t WS_WDN0 = 47 * MiB;
constexpr size_t WS_WIN1 = 53 * MiB;
constexpr size_t WS_WOUT1 = 65 * MiB;
constexpr size_t WS_WGU1 = 67 * MiB;
constexpr size_t WS_WDN1 = 89 * MiB;
constexpr size_t WS_A1 = 96 * MiB;
constexpr size_t WS_A2 = 161 * MiB;
constexpr size_t WS_A3 = 225 * MiB;
constexpr size_t WS_BIG = 289 * MiB;
constexpr size_t WS_XCONV = 465 * MiB;
constexpr size_t WS_END = 498 * MiB;

constexpr int CW_BAR = 4096;
constexpr int CW_MODS = 3968;
constexpr int CW_LRUG = 16384 + 8192;
constexpr int CW_PCNT = 16384;

constexpr int RING_BYTES = 131072, LDS_BYTES = 163840, LDSCTL_OFF = LDS_BYTES - 1024, MISC_OFF = LDSCTL_OFF + 320;

#define LDS_WAIT() asm volatile("s_waitcnt lgkmcnt(0)" ::: "memory")
#define VM_WAIT() asm volatile("s_waitcnt vmcnt(0)" ::: "memory")
#define RLX_AGENT __ATOMIC_RELAXED, __HIP_MEMORY_SCOPE_AGENT
__device__ __forceinline__ unsigned pk2(float lo, float hi) { unsigned r; asm("v_cvt_pk_bf16_f32 %0, %1, %2" : "=v"(r) : "v"(lo), "v"(hi)); return r; }
__device__ __forceinline__ unsigned f2bf(float f) { return pk2(f, f) & 0xffffu; }
__device__ __forceinline__ float bflo(unsigned u) { return __builtin_bit_cast(float, u << 16); }
__device__ __forceinline__ float bfhi(unsigned u) { return __builtin_bit_cast(float, u & 0xffff0000u); }
__device__ __forceinline__ float bf1(bf16_t h) { return __builtin_bit_cast(float, (unsigned)h << 16); }
__device__ __forceinline__ float wave_sum(float v) {
#pragma unroll
    for (int o = 1; o < 64; o <<= 1) v += __shfl_xor(v, o);
    return v;
}
__device__ __forceinline__ float fast_rsq(float x) { return __builtin_amdgcn_rsqf(x); }
__device__ __forceinline__ float fast_exp2(float x) { return __builtin_amdgcn_exp2f(x); }
__device__ __forceinline__ float fast_rcp(float x) { return __builtin_amdgcn_rcpf(x); }
__device__ __forceinline__ float sigmoidf_(float x) { return fast_rcp(1.f + fast_exp2(-x * LOG2E)); }
__device__ __forceinline__ float siluf_(float x) { return x * sigmoidf_(x); }
__device__ __forceinline__ float gelu_tanh(float x) {
    constexpr float C1 = -2.f * 0.7978845608028654f * LOG2E, C2 = C1 * 0.044715f;
    const float t = x * (C1 + C2 * (x * x));
    return x * fast_rcp(1.f + fast_exp2(t));
}

__device__ __forceinline__ float sum_fq(float q) {
    const auto a = __builtin_amdgcn_permlane32_swap(__float_as_uint(q), __float_as_uint(q), false, false);
    const float s = __uint_as_float(a[0]) + __uint_as_float(a[1]);
    const auto b = __builtin_amdgcn_permlane16_swap(__float_as_uint(s), __float_as_uint(s), false, false);
    return __uint_as_float(b[0]) + __uint_as_float(b[1]);
}
__device__ __forceinline__ void st8_wt(void* p, f32x2 v) { asm volatile("global_store_dwordx2 %0, %1, off sc1\n\ts_nop 1" :: "v"(p), "v"(v) : "memory"); }
__device__ __forceinline__ f32x2 ld8_sc1(const f32x2* p) { const unsigned long long u = __hip_atomic_load((const unsigned long long*)p, __ATOMIC_RELAXED, __HIP_MEMORY_SCOPE_AGENT); return __builtin_bit_cast(f32x2, u); }
__device__ __forceinline__ void st16_wt(void* p, u32x4 v) { asm volatile("global_store_dwordx4 %0, %1, off sc1\n\ts_nop 1" :: "v"(p), "v"(v) : "memory"); }
namespace pg8 {
constexpr int BM = 256, BK = 64, HALF = 128, HTB = HALF * BK * 2, STAGE_BYTES = 8 * HTB, NXCD = 8, WGM = 8;
__host__ __device__ __forceinline__ int lds_byte(int r, int c) { const int st = (r >> 4) * 2 + (c >> 5), rr = r & 15, cc = c & 31, ob = rr * 64 + cc * 2; return st * 1024 + (ob ^ (((ob >> 9) & 1) << 5)); }
__host__ __device__ __forceinline__ void stage_rc(int b, int& R, int& C) { const int st = b / 1024, sb = b % 1024, swz = sb ^ (((sb >> 9) & 1) << 5); R = (st >> 1) * 16 + swz / 64; C = (st & 1) * 32 + (swz % 64) / 2; }
__host__ __device__ __forceinline__ int perm32(int rho) { const int n = rho >> 4, i = rho & 15; return 8 * (i >> 2) + 4 * n + (i & 3); }

struct Unit { int pm, pn; bool last; };
#define PG8_ST16(u_, ptr, w) do { if ((u_).last) st16_wt((ptr), (w)); else *(u32x4*)(ptr) = (w); } while (0)
struct Gemm { const bf16_t* A; const bf16_t* Bt; long boff1, boff2; int K; };
__device__ __forceinline__ const char* bsel(const bf16_t* Bt, long boff1, long boff2, const Unit& u) { const long o = u.pm < 64 ? 0l : (u.pm < 128 ? boff1 : boff2); return (const char*)(Bt + o); }

struct Order {
    int nM, nN, nwg, G, c, nextra, xpm0, xpn0, xnpn, pn_off = 0;
    __device__ void init(int nM_, int nN_, int G_, int c_, int nextra_ = 0, int xpm0_ = 0, int xpn0_ = 0, int xnpn_ = 1) { nM = nM_; nN = nN_; nwg = nM * nN; G = G_; c = c_; nextra = nextra_; xpm0 = xpm0_; xpn0 = xpn0_; xnpn = xnpn_; }
    __device__ bool next(int i, Unit& u) const {
        const long L = (long)i * G + c;
        if (L >= nwg) { const int e = (int)(L - nwg); if (e >= nextra) return false; u.pm = xpm0 + e / xnpn; u.pn = xpn0 + e % xnpn; return true; }
        int wgid = (int)L; { const int q = nwg / NXCD, r = nwg % NXCD, xcd = wgid % NXCD, off = wgid / NXCD; wgid = (xcd < r ? xcd * (q + 1) : r * (q + 1) + (xcd - r) * q) + off; }
        const int nig = WGM * nN, gid = wgid / nig, fm = gid * WGM, gsz = (nM - fm) < WGM ? (nM - fm) : WGM;
        u.pm = fm + ((wgid % nig) % gsz); u.pn = (wgid % nig) / gsz + pn_off; return true;
    }
};

__device__ __forceinline__ unsigned cvt_pk_bf16(float lo, float hi) { return pk2(lo, hi); }


struct EpiPre { f32x4 bv[2][2]; float ssr[2][4]; };
struct EpiInProj {
    static constexpr bool PERM = true; static constexpr bool IDEMP = true;
    typedef EpiPre Pre;
    bf16_t* O; const float* ss; const float* bias;
    __device__ __forceinline__ void prefetch(const Unit& u, int wr, int wc, int fr, int fq, Pre& p) const {
        const int row0 = u.pm * BM + wr * 64 + fr, col0 = u.pn * BM + wc * 32 + 8 * fq;
        const int v = u.pm < 64 ? 0 : (u.pm < 128 ? 1 : 2);
        const float* bp = bias + (size_t)v * NIN0 + col0;
#pragma unroll
        for (int bj = 0; bj < 2; ++bj)
#pragma unroll
            for (int n = 0; n < 2; ++n) p.bv[bj][n] = *(const f32x4*)(bp + bj * HALF + 4 * n);
#pragma unroll
        for (int ai = 0; ai < 2; ++ai)
#pragma unroll
            for (int m = 0; m < 4; ++m) p.ssr[ai][m] = ss[row0 + ai * HALF + m * 16];
    }
    __device__ __forceinline__ void operator()(const f32x4 (&acc)[2][2][4][2], const Unit& u, const Pre& p, int wr, int wc, int fr, int fq) const {
        const int row0 = u.pm * BM + wr * 64 + fr, col0 = u.pn * BM + wc * 32 + 8 * fq;
#pragma unroll
        for (int ai = 0; ai < 2; ++ai)
#pragma unroll
            for (int m = 0; m < 4; ++m) { const int row = row0 + ai * HALF + m * 16; const float rs = fast_rsq(p.ssr[ai][m] * (1.f / D) + EPS); bf16_t* rowp = O + (size_t)row * NIN0 + col0;
#pragma unroll
                for (int bj = 0; bj < 2; ++bj) { const f32x4 v0 = acc[ai][bj][m][0] * rs + p.bv[bj][0], v1 = acc[ai][bj][m][1] * rs + p.bv[bj][1];
                    u32x4 w; w.x = cvt_pk_bf16(v0[0], v0[1]); w.y = cvt_pk_bf16(v0[2], v0[3]); w.z = cvt_pk_bf16(v1[0], v1[1]); w.w = cvt_pk_bf16(v1[2], v1[3]);
                    PG8_ST16(u, rowp + bj * HALF, w); } }
    }
};

__device__ __forceinline__ void tile_row_ssq(const float (&qv)[2][4], unsigned Paddr, float* ssq_panel, int wr, int wc, int fr, int fq) {
    if (fq == 0) {
#pragma unroll
        for (int ai = 0; ai < 2; ++ai)
#pragma unroll
            for (int m = 0; m < 4; ++m) { const unsigned a_ = Paddr + (unsigned)(((ai * HALF + wr * 64 + m * 16 + fr) * 4 + wc) * 4); asm volatile("ds_write_b32 %0, %1" :: "v"(a_), "v"(qv[ai][m]) : "memory"); }
    }
    asm volatile("s_waitcnt lgkmcnt(0)" ::: "memory"); __builtin_amdgcn_s_barrier(); asm volatile("" ::: "memory");
    if (threadIdx.x < 256) { f32x4 v; const unsigned a_ = Paddr + threadIdx.x * 16u;
        asm volatile("ds_read_b128 %0, %1\n\ts_waitcnt lgkmcnt(0)" : "=v"(v) : "v"(a_) : "memory");
        unsafeAtomicAdd(ssq_panel + threadIdx.x, (v[0] + v[1]) + (v[2] + v[3])); }
}
struct EpiPreG { f32x4 gv[2][2]; };
template <bool RES_F32, bool OUT_F32> struct EpiRes {
    static constexpr bool PERM = true; static constexpr bool IDEMP = false;
    typedef EpiPreG Pre;
    const float* resf; const bf16_t* resb; bf16_t* Ob; float* Of; const float* gate; float* ssq; unsigned Paddr;
    __device__ __forceinline__ void prefetch(const Unit& u, int wr, int wc, int fr, int fq, Pre& p) const {
        const float* gp = gate + (size_t)(u.pm >> 6) * 6144 + u.pn * BM + wc * 32 + 8 * fq;
#pragma unroll
        for (int bj = 0; bj < 2; ++bj)
#pragma unroll
            for (int n = 0; n < 2; ++n) p.gv[bj][n] = *(const f32x4*)(gp + bj * HALF + 4 * n);
    }
    __device__ __forceinline__ void operator()(const f32x4 (&acc)[2][2][4][2], const Unit& u, const Pre& p, int wr, int wc, int fr, int fq) const {
        const int row0 = u.pm * BM + wr * 64 + fr, col0 = u.pn * BM + wc * 32 + 8 * fq;
        float qv[2][4];
#pragma unroll
        for (int ai = 0; ai < 2; ++ai) {
            f32x4 rf[RES_F32 ? 4 : 1][2][2]; u32x4 rb[1][RES_F32 ? 1 : 4][2];
#pragma unroll
            for (int m = 0; m < 4; ++m) { const size_t off = (size_t)(row0 + ai * HALF + m * 16) * D + col0;
#pragma unroll
                for (int bj = 0; bj < 2; ++bj) {
                    if constexpr (RES_F32) { rf[m][bj][0] = *(const f32x4*)(resf + off + bj * HALF); rf[m][bj][1] = *(const f32x4*)(resf + off + bj * HALF + 4); }
                    else rb[0][m][bj] = *(const u32x4*)(resb + off + bj * HALF); } }
#pragma unroll
            for (int m = 0; m < 4; ++m) { const int row = row0 + ai * HALF + m * 16; const size_t off = (size_t)row * D + col0; float q = 0.f;
#pragma unroll
                for (int bj = 0; bj < 2; ++bj) {
                    f32x4 r0, r1;
                    if constexpr (RES_F32) { r0 = rf[m][bj][0]; r1 = rf[m][bj][1]; }
                    else { const u32x4 t = rb[0][m][bj]; r0 = (f32x4){bflo(t.x), bfhi(t.x), bflo(t.y), bfhi(t.y)}; r1 = (f32x4){bflo(t.z), bfhi(t.z), bflo(t.w), bfhi(t.w)}; }
                    const f32x4 v0 = r0 + p.gv[bj][0] * acc[ai][bj][m][0], v1 = r1 + p.gv[bj][1] * acc[ai][bj][m][1];
                    q += (v0[0] * v0[0] + v0[1] * v0[1]) + (v0[2] * v0[2] + v0[3] * v0[3]) + (v1[0] * v1[0] + v1[1] * v1[1]) + (v1[2] * v1[2] + v1[3] * v1[3]);
                    if constexpr (OUT_F32) { *(f32x4*)(Of + off + bj * HALF) = v0; *(f32x4*)(Of + off + bj * HALF + 4) = v1; }
                    else { u32x4 w; w.x = cvt_pk_bf16(v0[0], v0[1]); w.y = cvt_pk_bf16(v0[2], v0[3]); w.z = cvt_pk_bf16(v1[0], v1[1]); w.w = cvt_pk_bf16(v1[2], v1[3]); PG8_ST16(u, Ob + off + bj * HALF, w); }
                }
                q = sum_fq(q);
                qv[ai][m] = q; }
        }
        tile_row_ssq(qv, Paddr, ssq + u.pm * BM, wr, wc, fr, fq);
    }
};

struct EpiFinal {
    static constexpr bool PERM = true; static constexpr bool IDEMP = false;
    typedef EpiPreG Pre;
    const bf16_t* resb; float* Of; const float* gate; float* ssq; unsigned* pcnt; const float* fg; unsigned Paddr;
    __device__ __forceinline__ void prefetch(const Unit& u, int wr, int wc, int fr, int fq, Pre& p) const {
        const float* gp = gate + (size_t)(u.pm >> 6) * 6144 + u.pn * BM + wc * 32 + 8 * fq;
#pragma unroll
        for (int bj = 0; bj < 2; ++bj)
#pragma unroll
            for (int n = 0; n < 2; ++n) p.gv[bj][n] = *(const f32x4*)(gp + bj * HALF + 4 * n);
    }
    __device__ __forceinline__ void operator()(f32x4 (&acc)[2][2][4][2], const Unit& u, const Pre& p, int wr, int wc, int fr, int fq) const {
        const int row0 = u.pm * BM + wr * 64 + fr, col0 = u.pn * BM + wc * 32 + 8 * fq;
        float qv[2][4];
#pragma unroll
        for (int ai = 0; ai < 2; ++ai) {
            u32x4 rb[4][2];
#pragma unroll
            for (int m = 0; m < 4; ++m) { const size_t off = (size_t)(row0 + ai * HALF + m * 16) * D + col0;
#pragma unroll
                for (int bj = 0; bj < 2; ++bj) rb[m][bj] = *(const u32x4*)(resb + off + bj * HALF); }
#pragma unroll
            for (int m = 0; m < 4; ++m) { const int row = row0 + ai * HALF + m * 16; float q = 0.f;
#pragma unroll
                for (int bj = 0; bj < 2; ++bj) {
                    const u32x4 t = rb[m][bj]; const f32x4 r0 = (f32x4){bflo(t.x), bfhi(t.x), bflo(t.y), bfhi(t.y)}, r1 = (f32x4){bflo(t.z), bfhi(t.z), bflo(t.w), bfhi(t.w)};
                    const f32x4 v0 = r0 + p.gv[bj][0] * acc[ai][bj][m][0], v1 = r1 + p.gv[bj][1] * acc[ai][bj][m][1];
                    q += (v0[0] * v0[0] + v0[1] * v0[1]) + (v0[2] * v0[2] + v0[3] * v0[3]) + (v1[0] * v1[0] + v1[1] * v1[1]) + (v1[2] * v1[2] + v1[3] * v1[3]);
                    acc[ai][bj][m][0] = v0; acc[ai][bj][m][1] = v1;
                }
                q = sum_fq(q);
                qv[ai][m] = q; }
        }
        tile_row_ssq(qv, Paddr, ssq + u.pm * BM, wr, wc, fr, fq);
        asm volatile("s_waitcnt vmcnt(0)" ::: "memory");
        __syncthreads();
        if (threadIdx.x == 0) {
            unsigned* pc = pcnt + 64 * u.pm;
            (void)__hip_atomic_fetch_add(pc, 1u, __ATOMIC_RELAXED, __HIP_MEMORY_SCOPE_AGENT);
            unsigned sp = 0;
            while (__hip_atomic_load(pc, __ATOMIC_RELAXED, __HIP_MEMORY_SCOPE_AGENT) < 4u) { __builtin_amdgcn_s_sleep(1); if (++sp > (1u << 22)) break; }
        }
        __syncthreads();
        f32x4 fv[2][2];
#pragma unroll
        for (int bj = 0; bj < 2; ++bj)
#pragma unroll
            for (int n = 0; n < 2; ++n) fv[bj][n] = *(const f32x4*)(fg + col0 + bj * HALF + 4 * n);
        float ssv[2][4];
#pragma unroll
        for (int ai = 0; ai < 2; ++ai)
#pragma unroll
            for (int m = 0; m < 4; ++m) ssv[ai][m] = __hip_atomic_load(ssq + row0 + ai * HALF + m * 16, __ATOMIC_RELAXED, __HIP_MEMORY_SCOPE_AGENT);
#pragma unroll
        for (int ai = 0; ai < 2; ++ai)
#pragma unroll
            for (int m = 0; m < 4; ++m) { const float rs = fast_rsq(ssv[ai][m] * (1.f / D) + EPS); const size_t off = (size_t)(row0 + ai * HALF + m * 16) * D + col0;
#pragma unroll
                for (int bj = 0; bj < 2; ++bj) { *(f32x4*)(Of + off + bj * HALF) = acc[ai][bj][m][0] * rs * fv[bj][0]; *(f32x4*)(Of + off + bj * HALF + 4) = acc[ai][bj][m][1] * rs * fv[bj][1]; } }
    }
};

struct EpiSwiGLU {
    static constexpr bool PERM = true; static constexpr bool IDEMP = true;
    typedef EpiPre Pre;
    bf16_t* O; const float* ss; const float* bias;
    __device__ __forceinline__ void prefetch(const Unit& u, int wr, int wc, int fr, int fq, Pre& p) const {
        const int row0 = u.pm * BM + wr * 64 + fr, colw = u.pn * BM + wc * 32 + 8 * fq;
        const float* bp = bias + (size_t)(u.pm >> 6) * NGU + colw;
#pragma unroll
        for (int bj = 0; bj < 2; ++bj)
#pragma unroll
            for (int n = 0; n < 2; ++n) p.bv[bj][n] = *(const f32x4*)(bp + bj * HALF + 4 * n);
#pragma unroll
        for (int ai = 0; ai < 2; ++ai)
#pragma unroll
            for (int m = 0; m < 4; ++m) p.ssr[ai][m] = ss[row0 + ai * HALF + m * 16];
    }
    __device__ __forceinline__ void operator()(const f32x4 (&acc)[2][2][4][2], const Unit& u, const Pre& p, int wr, int wc, int fr, int fq) const {
        const int row0 = u.pm * BM + wr * 64 + fr, colo = u.pn * HALF + wc * 32 + 8 * fq;
        f32x4 bg[2], bu[2];
#pragma unroll
        for (int n = 0; n < 2; ++n) { bg[n] = p.bv[0][n] * LOG2E; bu[n] = p.bv[1][n] * (1.f / LOG2E); }
#pragma unroll
        for (int ai = 0; ai < 2; ++ai)
#pragma unroll
            for (int m = 0; m < 4; ++m) { const int row = row0 + ai * HALF + m * 16; const float rs = fast_rsq(p.ssr[ai][m] * (1.f / D) + EPS), rsg = rs * LOG2E, rsu = rs * (1.f / LOG2E);
                f32x4 h[2];
#pragma unroll
                for (int n = 0; n < 2; ++n) {
                    const f32x4 G = acc[ai][0][m][n], U = acc[ai][1][m][n];
                    const f32x2 g0 = G.lo * rsg + bg[n].lo, g1 = G.hi * rsg + bg[n].hi, u0 = U.lo * rsu + bu[n].lo, u1 = U.hi * rsu + bu[n].hi;
                    f32x2 d0 = (f32x2){fast_exp2(-g0.x), fast_exp2(-g0.y)} + 1.f, d1 = (f32x2){fast_exp2(-g1.x), fast_exp2(-g1.y)} + 1.f;
                    const f32x2 r0 = (f32x2){fast_rcp(d0.x), fast_rcp(d0.y)}, r1 = (f32x2){fast_rcp(d1.x), fast_rcp(d1.y)};
                    const f32x2 h0 = (g0 * u0) * r0, h1 = (g1 * u1) * r1;
                    h[n] = (f32x4){h0.x, h0.y, h1.x, h1.y}; }
                u32x4 w; w.x = cvt_pk_bf16(h[0][0], h[0][1]); w.y = cvt_pk_bf16(h[0][2], h[0][3]); w.z = cvt_pk_bf16(h[1][0], h[1][1]); w.w = cvt_pk_bf16(h[1][2], h[1][3]);
                PG8_ST16(u, O + (size_t)row * FF + colo, w); }
    }
};

struct EpiScIn {
    static constexpr bool PERM = true; static constexpr bool IDEMP = true;
    typedef EpiPre Pre;
    bf16_t* BG; bf16_t* P; const float* ss; const float* bias;
    __device__ __forceinline__ void prefetch(const Unit& u, int wr, int wc, int fr, int fq, Pre& p) const {
        const int row0 = u.pm * BM + wr * 64 + fr, colw = u.pn * BM + wc * 32 + 8 * fq;
        const float* bp = bias + (size_t)(u.pm >> 6) * NIN1 + colw;
#pragma unroll
        for (int bj = 0; bj < 2; ++bj)
#pragma unroll
            for (int n = 0; n < 2; ++n) p.bv[bj][n] = *(const f32x4*)(bp + bj * HALF + 4 * n);
#pragma unroll
        for (int ai = 0; ai < 2; ++ai)
#pragma unroll
            for (int m = 0; m < 4; ++m) p.ssr[ai][m] = ss[row0 + ai * HALF + m * 16];
    }
    __device__ __forceinline__ void operator()(const f32x4 (&acc)[2][2][4][2], const Unit& u, const Pre& p, int wr, int wc, int fr, int fq) const {
        const int row0 = u.pm * BM + wr * 64 + fr, colw = u.pn * BM + wc * 32 + 8 * fq;
        if (u.pn < 4) {
#pragma unroll
            for (int ai = 0; ai < 2; ++ai)
#pragma unroll
                for (int m = 0; m < 4; ++m) { const int row = row0 + ai * HALF + m * 16; const float rs = fast_rsq(p.ssr[ai][m] * (1.f / D) + EPS); bf16_t* rowp = BG + (size_t)row * D + colw;
#pragma unroll
                    for (int bj = 0; bj < 2; ++bj) { const f32x4 v0 = acc[ai][bj][m][0] * rs + p.bv[bj][0], v1 = acc[ai][bj][m][1] * rs + p.bv[bj][1];
                        u32x4 w; w.x = cvt_pk_bf16(v0[0], v0[1]); w.y = cvt_pk_bf16(v0[2], v0[3]); w.z = cvt_pk_bf16(v1[0], v1[1]); w.w = cvt_pk_bf16(v1[2], v1[3]);
                        PG8_ST16(u, rowp + bj * HALF, w); } }
        } else {
            const int colo = (u.pn - 4) * HALF + wc * 32 + 8 * fq;
#pragma unroll
            for (int ai = 0; ai < 2; ++ai)
#pragma unroll
                for (int m = 0; m < 4; ++m) { const int row = row0 + ai * HALF + m * 16; const float rs = fast_rsq(p.ssr[ai][m] * (1.f / D) + EPS);
                    f32x4 h[2];
#pragma unroll
                    for (int n = 0; n < 2; ++n) { const f32x4 cgv = acc[ai][0][m][n] * rs + p.bv[0][n], xv = acc[ai][1][m][n] * rs + p.bv[1][n]; h[n] = cgv * xv; }
                    u32x4 w; w.x = cvt_pk_bf16(h[0][0], h[0][1]); w.y = cvt_pk_bf16(h[0][2], h[0][3]); w.z = cvt_pk_bf16(h[1][0], h[1][1]); w.w = cvt_pk_bf16(h[1][2], h[1][3]);
                    PG8_ST16(u, P + (size_t)row * D + colo, w); }
        }
    }
};
struct EpiScGate {
    static constexpr bool PERM = true; static constexpr bool IDEMP = true;
    typedef EpiPre Pre;
    bf16_t* Y; const bf16_t* P; const float* ss; const float* bias; const float* cw;
    __device__ __forceinline__ void prefetch(const Unit& u, int wr, int wc, int fr, int fq, Pre& p) const {
        const int row0 = u.pm * BM + wr * 64 + fr, colw = u.pn * BM + wc * 32 + 8 * fq;
        const float* bp = bias + (size_t)(u.pm >> 6) * NIN1 + colw;
#pragma unroll
        for (int bj = 0; bj < 2; ++bj)
#pragma unroll
            for (int n = 0; n < 2; ++n) p.bv[bj][n] = *(const f32x4*)(bp + bj * HALF + 4 * n);
#pragma unroll
        for (int ai = 0; ai < 2; ++ai)
#pragma unroll
            for (int m = 0; m < 4; ++m) p.ssr[ai][m] = ss[row0 + ai * HALF + m * 16];
    }
    template <int AI, int BJ, int M0, int MC>
    __device__ __forceinline__ void batch(const f32x4 (&acc)[2][2][4][2], const Unit& u, const Pre& p, const f32x4 (&w)[3][2], int row0, int col, int sbeg, int send) const {
        u32x4 raw[MC][3];
#pragma unroll
        for (int mm = 0; mm < MC; ++mm)
#pragma unroll
            for (int j = 0; j < 3; ++j) { const int rr = row0 + AI * HALF + (M0 + mm) * 16 + j - 1;
                raw[mm][j] = (rr >= sbeg && rr < send) ? *(const u32x4*)(P + (size_t)rr * D + col) : (u32x4){0u, 0u, 0u, 0u}; }
        asm volatile("" ::: "memory"); __builtin_amdgcn_sched_barrier(0);
#pragma unroll
        for (int mm = 0; mm < MC; ++mm) { constexpr int dummy = 0; (void)dummy; const int m = M0 + mm; const int row = row0 + AI * HALF + m * 16; const float rs = fast_rsq(p.ssr[AI][m] * (1.f / D) + EPS);
            const f32x4 v0 = acc[AI][BJ][m][0] * rs + p.bv[BJ][0], v1 = acc[AI][BJ][m][1] * rs + p.bv[BJ][1];
            f32x4 c0 = (f32x4){0.f, 0.f, 0.f, 0.f}, c1 = c0;
#pragma unroll
            for (int j = 0; j < 3; ++j) { const u32x4 r = raw[mm][j];
                c0 += w[j][0] * (f32x4){bflo(r.x), bfhi(r.x), bflo(r.y), bfhi(r.y)}; c1 += w[j][1] * (f32x4){bflo(r.z), bfhi(r.z), bflo(r.w), bfhi(r.w)}; }
            const f32x4 y0 = v0 * c0, y1 = v1 * c1;
            u32x4 o; o.x = cvt_pk_bf16(y0[0], y0[1]); o.y = cvt_pk_bf16(y0[2], y0[3]); o.z = cvt_pk_bf16(y1[0], y1[1]); o.w = cvt_pk_bf16(y1[2], y1[3]);
            PG8_ST16(u, Y + (size_t)row * D + col, o); }
        asm volatile("" ::: "memory"); __builtin_amdgcn_sched_barrier(0);
    }
    __device__ __forceinline__ void operator()(const f32x4 (&acc)[2][2][4][2], const Unit& u, const Pre& p, int wr, int wc, int fr, int fq) const {
        const int row0 = u.pm * BM + wr * 64 + fr, colw = u.pn * BM + wc * 32 + 8 * fq;
        const int sbeg = (u.pm * BM / SEQ) * SEQ, send = sbeg + SEQ;
        { const int col = colw; f32x4 w[3][2];
#pragma unroll
          for (int j = 0; j < 3; ++j) { w[j][0] = *(const f32x4*)(cw + j * D + col); w[j][1] = *(const f32x4*)(cw + j * D + col + 4); }
          batch<0, 0, 0, 2>(acc, u, p, w, row0, col, sbeg, send); batch<0, 0, 2, 2>(acc, u, p, w, row0, col, sbeg, send);
          batch<1, 0, 0, 2>(acc, u, p, w, row0, col, sbeg, send); batch<1, 0, 2, 2>(acc, u, p, w, row0, col, sbeg, send); }
        { const int col = colw + HALF; f32x4 w[3][2];
#pragma unroll
          for (int j = 0; j < 3; ++j) { w[j][0] = *(const f32x4*)(cw + j * D + col); w[j][1] = *(const f32x4*)(cw + j * D + col + 4); }
          batch<0, 1, 0, 4>(acc, u, p, w, row0, col, sbeg, send); batch<1, 1, 0, 4>(acc, u, p, w, row0, col, sbeg, send); }
    }
};

template <class Epi, class Sched, bool ALIGN_EPI = false, bool SP2 = false>
__device__ __forceinline__ void gemm_phase(LAS unsigned char* lds, const Gemm g, const Sched& S, const Epi& E) {
    const int tid = threadIdx.x, wid = __builtin_amdgcn_readfirstlane(tid >> 6), lane = tid & 63, wr = wid >> 2, wc = wid & 3, fr = lane & 15, fq = lane >> 4;
    const int K = g.K, nt = K / BK;
    unsigned voffA[2], voffB[2];
#pragma unroll
    for (int i = 0; i < 2; ++i) { const int b_ = tid * 16 + i * 8192; const int R = b_ >> 7, C = 8 * (((b_ >> 4) & 7) ^ ((R >> 1) & 7)); const int Rb = Epi::PERM ? ((R & ~31) + perm32(R & 31)) : R;
        voffA[i] = (unsigned)(R * K + C) * 2u; voffB[i] = (unsigned)(Rb * K + C) * 2u; }
    const size_t kstep = (size_t)(BK * 2);
    const size_t hstep = (size_t)HALF * K * 2;
    const size_t tstep = 2 * hstep;
    const unsigned ldsw = (unsigned)wid * 1024u;
    int aoffk[2], boffk[2];
#pragma unroll
    for (int k = 0; k < 2; ++k) { const int sw = ((4 * k + fq) ^ ((fr >> 1) & 7)) << 4; aoffk[k] = (wr * 64 + fr) * 128 + sw; boffk[k] = (wc * 32 + fr) * 128 + sw; }
#define PG8_SA(b, h) (((b) * 2 + (h)) * HTB)
#define PG8_SB(b, h) ((4 + (b) * 2 + (h)) * HTB)
#define PG8_STAGE(bufoff, gbase, voff) do { _Pragma("unroll") for (int _i = 0; _i < 2; ++_i) \
        __builtin_amdgcn_global_load_lds((const unsigned*)((const char*)(gbase) + (voff)[_i]), (LAS unsigned*)(lds + (bufoff) + ldsw + _i * 8192), 16, 0, 0); } while (0)
#define PG8_LDA(dst, b, h) do { _Pragma("unroll") for (int m = 0; m < 4; ++m) _Pragma("unroll") for (int k = 0; k < 2; ++k) dst[m][k] = *(const LAS bf16x8*)(lds + PG8_SA(b, h) + aoffk[k] + m * 2048); } while (0)
#define PG8_LDB(dst, b, h) do { _Pragma("unroll") for (int n = 0; n < 2; ++n) _Pragma("unroll") for (int k = 0; k < 2; ++k) dst[n][k] = *(const LAS bf16x8*)(lds + PG8_SB(b, h) + boffk[k] + n * 2048); } while (0)
#define PG8_MMA(ai, bj, At, Bt) do { __builtin_amdgcn_s_setprio(1); _Pragma("unroll") for (int m = 0; m < 4; ++m) _Pragma("unroll") for (int n = 0; n < 2; ++n) _Pragma("unroll") for (int k = 0; k < 2; ++k) \
        acc[ai][bj][m][n] = __builtin_amdgcn_mfma_f32_16x16x32_bf16(Bt[n][k], At[m][k], acc[ai][bj][m][n], 0, 0, 0); __builtin_amdgcn_s_setprio(0); } while (0)
#define PG8_WAIT_V(n) asm volatile("s_waitcnt vmcnt(" #n ")" ::: "memory")
#define PG8_WAIT_L(n) asm volatile("s_waitcnt lgkmcnt(" #n ")" ::: "memory")
#define PG8_BAR __builtin_amdgcn_s_barrier()
#define PG8_SCHED __builtin_amdgcn_sched_barrier(0)
    Unit cur, nxt; int ui = 0;
    if (!S.next(0, cur)) return;
    f32x4 acc[2][2][4][2];
#pragma unroll
    for (int a = 0; a < 2; ++a)
#pragma unroll
        for (int b = 0; b < 2; ++b)
#pragma unroll
            for (int m = 0; m < 4; ++m)
#pragma unroll
                for (int n = 0; n < 2; ++n) acc[a][b][m][n] = (f32x4){0.f, 0.f, 0.f, 0.f};
    bf16x8 At[4][2], B0[2][2], B1[2][2];
    typename Epi::Pre pre; E.prefetch(cur, wr, wc, fr, fq, pre);
    const char* cA = (const char*)g.A + (size_t)cur.pm * tstep; const bf16_t* gBt = g.Bt; const long gb1 = g.boff1, gb2 = g.boff2;
    const char* cB = bsel(gBt, gb1, gb2, cur) + (size_t)cur.pn * tstep;
    if constexpr (SP2) {
        PG8_STAGE(PG8_SB(0, 0), cB, voffB); PG8_STAGE(PG8_SB(0, 1), cB + hstep, voffB); PG8_STAGE(PG8_SA(0, 0), cA, voffA); PG8_STAGE(PG8_SA(0, 1), cA + hstep, voffA);
        if (wr == 1) PG8_BAR;
        PG8_WAIT_V(2); PG8_BAR;
        PG8_STAGE(PG8_SB(1, 0), cB + kstep, voffB); PG8_STAGE(PG8_SA(1, 0), cA + kstep, voffA); PG8_STAGE(PG8_SB(1, 1), cB + hstep + kstep, voffB);
        PG8_WAIT_V(6); PG8_BAR;
    } else {
        PG8_STAGE(PG8_SB(0, 0), cB, voffB); PG8_STAGE(PG8_SA(0, 0), cA, voffA); PG8_STAGE(PG8_SB(0, 1), cB + hstep, voffB); PG8_STAGE(PG8_SA(0, 1), cA + hstep, voffA);
        if (wr == 1) PG8_BAR;
        PG8_WAIT_V(4); PG8_BAR;
        PG8_STAGE(PG8_SB(1, 0), cB + kstep, voffB); PG8_STAGE(PG8_SA(1, 0), cA + kstep, voffA); PG8_STAGE(PG8_SB(1, 1), cB + hstep + kstep, voffB);
        PG8_WAIT_V(6); PG8_BAR;
    }
    for (;;) {
        const bool has_next = S.next(ui + 1, nxt);
        cur.last = !has_next;
        const char* nA = has_next ? (const char*)g.A + (size_t)nxt.pm * tstep : cA; const char* nB = has_next ? bsel(gBt, gb1, gb2, nxt) + (size_t)nxt.pn * tstep : cB;
        for (int t = 0; t < nt; t += 2) {
            const bool last = (t == nt - 2);
            const char* a1 = cA + (size_t)(t + 1) * kstep;
            const char* a2 = last ? nA : cA + (size_t)(t + 2) * kstep; const char* b2 = last ? nB : cB + (size_t)(t + 2) * kstep;
            const char* a3 = a2 + kstep; const char* b3 = b2 + kstep;
            if constexpr (SP2) {
            PG8_LDB(B0, 0, 0); PG8_LDB(B1, 0, 1); PG8_SCHED; PG8_LDA(At, 0, 0); PG8_STAGE(PG8_SA(1, 1), a1 + hstep, voffA);
            PG8_WAIT_V(8); PG8_WAIT_L(0); PG8_BAR; PG8_MMA(0, 0, At, B0); PG8_MMA(0, 1, At, B1); PG8_BAR; PG8_SCHED;
            PG8_LDA(At, 0, 1); PG8_STAGE(PG8_SB(0, 0), b2, voffB); PG8_STAGE(PG8_SB(0, 1), b2 + hstep, voffB); PG8_STAGE(PG8_SA(0, 0), a2, voffA);
            PG8_WAIT_V(8); PG8_WAIT_L(0); PG8_BAR; PG8_MMA(1, 0, At, B0); PG8_MMA(1, 1, At, B1); PG8_BAR; PG8_SCHED;
            PG8_LDB(B0, 1, 0); PG8_LDB(B1, 1, 1); PG8_SCHED; PG8_LDA(At, 1, 0); PG8_STAGE(PG8_SA(0, 1), a2 + hstep, voffA);
            PG8_WAIT_V(8); PG8_WAIT_L(0); PG8_BAR; PG8_MMA(0, 0, At, B0); PG8_MMA(0, 1, At, B1); PG8_BAR; PG8_SCHED;
            PG8_LDA(At, 1, 1); PG8_STAGE(PG8_SB(1, 0), b3, voffB); PG8_STAGE(PG8_SB(1, 1), b3 + hstep, voffB); PG8_STAGE(PG8_SA(1, 0), a3, voffA);
            PG8_WAIT_V(8); PG8_WAIT_L(0); PG8_BAR; PG8_MMA(1, 0, At, B0); PG8_MMA(1, 1, At, B1); PG8_BAR; PG8_SCHED;
            } else {
            PG8_LDB(B0, 0, 0); PG8_SCHED; PG8_LDA(At, 0, 0); PG8_STAGE(PG8_SA(1, 1), a1 + hstep, voffA);
            PG8_WAIT_L(8); PG8_BAR; PG8_WAIT_L(0); PG8_MMA(0, 0, At, B0); PG8_BAR; PG8_SCHED;
            PG8_LDB(B1, 0, 1); PG8_STAGE(PG8_SB(0, 0), b2, voffB);
            PG8_BAR; PG8_WAIT_L(0); PG8_MMA(0, 1, At, B1); PG8_BAR;
            PG8_LDA(At, 0, 1); PG8_STAGE(PG8_SA(0, 0), a2, voffA);
            PG8_BAR; PG8_WAIT_L(0); PG8_MMA(1, 0, At, B0); PG8_BAR; PG8_SCHED;
            PG8_STAGE(PG8_SB(0, 1), b2 + hstep, voffB);
            PG8_WAIT_V(6); PG8_BAR; PG8_MMA(1, 1, At, B1); PG8_BAR;
            PG8_LDB(B0, 1, 0); PG8_SCHED; PG8_LDA(At, 1, 0); PG8_STAGE(PG8_SA(0, 1), a2 + hstep, voffA);
            PG8_WAIT_L(8); PG8_BAR; PG8_WAIT_L(0); PG8_MMA(0, 0, At, B0); PG8_BAR; PG8_SCHED;
            PG8_LDB(B1, 1, 1); PG8_STAGE(PG8_SB(1, 0), b3, voffB);
            PG8_BAR; PG8_WAIT_L(0); PG8_MMA(0, 1, At, B1); PG8_BAR;
            PG8_LDA(At, 1, 1); PG8_STAGE(PG8_SA(1, 0), a3, voffA);
            PG8_BAR; PG8_WAIT_L(0); PG8_MMA(1, 0, At, B0); PG8_BAR; PG8_SCHED;
            PG8_STAGE(PG8_SB(1, 1), b3 + hstep, voffB);
            PG8_WAIT_V(6); PG8_BAR; PG8_MMA(1, 1, At, B1); PG8_BAR;
            }
        }
        if constexpr (ALIGN_EPI) { if (wr == 0) PG8_BAR; }
        E(acc, cur, pre, wr, wc, fr, fq);
#ifdef PROBE_EPI2
        if constexpr (Epi::IDEMP) { asm volatile("" ::: "memory"); E(acc, cur, pre, wr, wc, fr, fq); }
#endif
        if (!has_next) break;
        E.prefetch(nxt, wr, wc, fr, fq, pre);
        { bf16x8 zz;
#pragma unroll
          for (int j = 0; j < 8; ++j) zz[j] = 0;
          asm volatile("s_nop 3" : "+v"(zz));
#pragma unroll
          for (int b = 0; b < 2; ++b)
#pragma unroll
              for (int m = 0; m < 4; ++m)
#pragma unroll
                  for (int n = 0; n < 2; ++n) { asm volatile("v_mfma_f32_16x16x32_bf16 %0, %1, %1, 0" : "=&v"(acc[1][b][m][n]) : "v"(zz));
                      acc[0][b][m][n] = (f32x4){0.f, 0.f, 0.f, 0.f}; } }
        cur = nxt; cA = nA; cB = nB; ++ui;
        if constexpr (ALIGN_EPI) { if (wr == 1) PG8_BAR; }
    }
    PG8_WAIT_V(0);
    if constexpr (!ALIGN_EPI) { if (wr == 0) PG8_BAR; }
    PG8_BAR;
#undef PG8_SA
#undef PG8_SB
#undef PG8_STAGE
#undef PG8_LDA
#undef PG8_LDB
#undef PG8_MMA
#undef PG8_WAIT_V
#undef PG8_WAIT_L
#undef PG8_BAR
#undef PG8_SCHED
}
}

#define XB_TMO      128
#define XB_XCNT(j)  (256  + 64 * (j))
#define XB_XSUB(j)  (1280 + 64 * (j))
#define XB_XGEN(j)  (2304 + 64 * (j))
#define XB_TOP      3328
#define XB_TOPGEN   3392
#define XCD_BAR_WORDS 3456
#define XB_SPIN_CAP (1u << 18)
__device__ __forceinline__ unsigned xb_ld(unsigned* p)              { return __hip_atomic_load(p, __ATOMIC_RELAXED, __HIP_MEMORY_SCOPE_AGENT); }
__device__ __forceinline__ unsigned xb_add(unsigned* p, unsigned v) { return __hip_atomic_fetch_add(p, v, __ATOMIC_RELAXED, __HIP_MEMORY_SCOPE_AGENT); }
__device__ __forceinline__ unsigned xb_xcc_id() { return (unsigned)__builtin_amdgcn_s_getreg((3 << 11) | 20) & 0xFu; }
#define XB_SPIN(cond, bar) do { unsigned _sp = 0; while (cond) { __builtin_amdgcn_s_sleep(1); \
    if ((++_sp & 255u) == 0u) { if (xb_ld(&(bar)[XB_TMO])) break; if (_sp > XB_SPIN_CAP) { atomicAdd(&(bar)[XB_TMO], 1u); break; } } } } while (0)
struct XcdBarrier { unsigned* bar; unsigned x; volatile LAS unsigned* st; };
__device__ __forceinline__ XcdBarrier xcd_barrier_post(unsigned* bar, volatile LAS unsigned* st) {
    XcdBarrier b; b.bar = bar; b.x = xb_xcc_id(); b.st = st;
    if (threadIdx.x == 0) (void)xb_add(&bar[XB_XCNT(b.x)], 1u);
    return b;
}
__device__ __forceinline__ void xcd_barrier_complete(unsigned* bar, unsigned x, unsigned& nloc, unsigned& nx) {
    const unsigned G = gridDim.x * gridDim.y * gridDim.z;
    unsigned sum, cnt, mine, sp = 0u;
    for (;;) {
        sum = 0u; cnt = 0u; mine = 0u;
#pragma unroll
        for (unsigned j = 0; j < 16; ++j) { const unsigned c = xb_ld(&bar[XB_XCNT(j)]); sum += c; cnt += (c > 0u) ? 1u : 0u; mine = (j == x) ? c : mine; }
        if (sum == G) break;
        __builtin_amdgcn_s_sleep(1);
        if ((++sp & 255u) == 0u) { if (xb_ld(&bar[XB_TMO])) break; if (sp > XB_SPIN_CAP) { atomicAdd(&bar[XB_TMO], 1u); break; } }
    }
    nloc = mine > 0u ? mine : 1u; nx = cnt > 0u ? cnt : 1u;
}
__device__ __forceinline__ void xcd_barrier(const XcdBarrier& b) {
    asm volatile("s_waitcnt vmcnt(0)" ::: "memory");
    __syncthreads();
    if (threadIdx.x == 0) {
        unsigned* bar = b.bar;
        __builtin_amdgcn_s_waitcnt(0);
        unsigned nloc = b.st[0], nx = b.st[1];
        if (nloc == 0u) { xcd_barrier_complete(bar, b.x, nloc, nx); b.st[0] = nloc; b.st[1] = nx; }
        const unsigned old = xb_add(&bar[XB_XSUB(b.x)], 1u);
        __builtin_amdgcn_fence(__ATOMIC_ACQUIRE, "agent");
        const unsigned gen = old / nloc;
        if (old + 1u == (gen + 1u) * nloc) {
            __builtin_amdgcn_fence(__ATOMIC_RELEASE, "agent");
            asm volatile("s_waitcnt vmcnt(0)" ::: "memory");
            const unsigned og = xb_add(&bar[XB_TOP], 1u);
            const unsigned tg = og / nx;
            if (og + 1u == (tg + 1u) * nx) {
#pragma unroll
                for (unsigned j = 0; j < 16; ++j) xb_add(&bar[XB_XGEN(j)], 1u);
            } else XB_SPIN(xb_ld(&bar[XB_XGEN(b.x)]) == gen, bar);
            asm volatile("s_waitcnt vmcnt(0)" ::: "memory");
        } else {
            XB_SPIN(xb_ld(&bar[XB_XGEN(b.x)]) == gen, bar);
            asm volatile("s_waitcnt vmcnt(0)" ::: "memory");
        }
    }
    __syncthreads();
}

struct Frame {
    LAS unsigned char* lds;
    int tid, lane, wave, G, gw, NGW;
    const float* in[N_IN]; float* out; unsigned char* ws;
};
#define WSP(T, off) ((T*)(F.ws + (off)))

__device__ __forceinline__ void p0_transpose_item(const float* W, int K, int N, bf16_t* WT, LAS float* scr, int item, int lane) {
    const int nblk = N / 32, kb = item / nblk, nb = item % nblk, k0 = 64 * kb, n0 = 32 * nb;
    float val[32];
    { const float* wp = W + (size_t)(k0 + (lane >> 5)) * N + n0 + (lane & 31);
#pragma unroll
      for (int i = 0; i < 32; ++i) val[i] = __builtin_nontemporal_load(&wp[(size_t)(2 * i) * N]); }
#pragma unroll
    for (int i = 0; i < 32; ++i) scr[(2 * i + (lane >> 5)) * 33 + (lane & 31)] = val[i];
    LDS_WAIT(); asm volatile("" ::: "memory");
    const int c = lane & 7;
#pragma unroll
    for (int j = 0; j < 4; ++j) { const int n = (lane >> 3) + 8 * j; const LAS float* s = scr + (8 * c) * 33 + n;
        u32x4 o; o.x = pk2(s[0 * 33], s[1 * 33]); o.y = pk2(s[2 * 33], s[3 * 33]); o.z = pk2(s[4 * 33], s[5 * 33]); o.w = pk2(s[6 * 33], s[7 * 33]);
        st16_wt(WT + (size_t)(n0 + n) * K + k0 + 8 * c, o); }
    LDS_WAIT(); asm volatile("" ::: "memory");
}
__device__ __forceinline__ void row_to_bf16_ss(const float* xrow, bf16_t* orow, float* ssp, int lane) {
    const f32x4* xr = (const f32x4*)xrow + lane;
    f32x4 v[4]; float s = 0.f;
#pragma unroll
    for (int j = 0; j < 4; ++j) { v[j] = __builtin_nontemporal_load(&xr[64 * j]);
        s += (v[j].x * v[j].x + v[j].y * v[j].y) + (v[j].z * v[j].z + v[j].w * v[j].w); }
    s = wave_sum(s);
    u32x2* o8 = (u32x2*)orow + lane;
#pragma unroll
    for (int j = 0; j < 4; ++j) { u32x2 w; w.x = pk2(v[j].x, v[j].y); w.y = pk2(v[j].z, v[j].w); o8[64 * j] = w; }
    if (lane == 0) *ssp = s;
}
__device__ __forceinline__ void p0_mods_task(Frame& F, int task) {
    const int kh = task & 1, l = (task >> 1) / 48, n0 = ((task >> 1) % 48) * 128;
    LAS float* Sc = (LAS float*)F.lds;
    LAS float* R = (LAS float*)(F.lds + 16384);
    const float* c = F.in[I_C]; const float* cc = F.in[I_CCTX];
    for (int i = F.tid; i < 3 * 512; i += 512) { const int v = i >> 9, k = kh * 512 + (i & 511); const float cv = v == 0 ? c[k] : (v == 1 ? c[D + k] : cc[k]); Sc[i] = cv / (1.f + __expf(-cv)); }
    __syncthreads();
    float a[3][2] = {{0.f, 0.f}, {0.f, 0.f}, {0.f, 0.f}};
    const float* Wp = F.in[I_MODW] + (size_t)l * D * 6144 + (size_t)(kh * 512) * 6144 + n0 + 2 * F.lane;
    const int kb = F.wave * 64;
#pragma unroll 16
    for (int kk = 0; kk < 64; ++kk) { const int k = kb + kk; const f32x2 wv = __builtin_nontemporal_load((const f32x2*)(Wp + (size_t)k * 6144));
#pragma unroll
        for (int v = 0; v < 3; ++v) { const float s = Sc[v * 512 + k]; a[v][0] += s * wv.x; a[v][1] += s * wv.y; } }
#pragma unroll
    for (int v = 0; v < 3; ++v) { R[(F.wave * 3 + v) * 128 + 2 * F.lane] = a[v][0]; R[(F.wave * 3 + v) * 128 + 2 * F.lane + 1] = a[v][1]; }
    __syncthreads();
    if (F.tid < 384) { const int v = F.tid >> 7, j = F.tid & 127; float s = kh == 0 ? F.in[I_MODB][l * 6144 + n0 + j] : 0.f;
#pragma unroll
        for (int w = 0; w < 8; ++w) s += R[(w * 3 + v) * 128 + j];
        unsafeAtomicAdd(WSP(float, WS_MODS) + (size_t)(l * 3 + v) * 6144 + n0 + j, s); }
    __syncthreads();
}
__device__ __forceinline__ void phase_p0(Frame& F, int part, int gw, int ngw) {
    LAS float* scr = (LAS float*)(F.lds + F.wave * 16384);
    if (part == 0) {
    bf16_t* XB = WSP(bf16_t, WS_A1); float* ss0 = WSP(float, WS_SS0);
    const int R1 = (F.G == 256) ? 3 * 64 * 8 : 0, R0 = MT - R1;
    for (int m = F.gw; m < R0; m += F.NGW) {
        const float* src = m < ML ? F.in[I_X] + (size_t)m * D : F.in[I_CTX] + (size_t)(m - ML) * D;
        row_to_bf16_ss(src, XB + (size_t)m * D, ss0 + m, F.lane);
    }
    if (R1 > 0 && blockIdx.x >= 192)
        for (int m = R0 + ((int)blockIdx.x - 192) * 8 + F.wave; m < MT; m += 64 * 8) {
            const float* src = m < ML ? F.in[I_X] + (size_t)m * D : F.in[I_CTX] + (size_t)(m - ML) * D;
            row_to_bf16_ss(src, XB + (size_t)m * D, ss0 + m, F.lane);
        }
    for (int idx = (int)((blockIdx.x + 64u) % (unsigned)F.G) * 512 + F.tid; idx < 2 * 8 * 2 * 2 * 4 * 64; idx += F.G * 512) {
        const int ln = idx & 63, s_ = (idx >> 6) & 3, half = (idx >> 8) & 1, gate = (idx >> 9) & 1, g_ = (idx >> 10) & 7, d_ = idx >> 13;
        const float* wsrc = (gate ? F.in[I_LWI] : F.in[I_LWR]) + (size_t)((d_ * 8 + g_) * 64 + 16 * s_ + 8 * (ln >> 5)) * 64 + 32 * half + (ln & 31);
        constexpr float NL = -LOG2E;
        u32x4 o; o.x = pk2(NL * wsrc[0], NL * wsrc[64]); o.y = pk2(NL * wsrc[128], NL * wsrc[192]); o.z = pk2(NL * wsrc[256], NL * wsrc[320]); o.w = pk2(NL * wsrc[384], NL * wsrc[448]);
        st16_wt(WSP(u32x4, WS_LRUW) + idx, o);
    }
    return; }
    constexpr int I_O = (D / 64) * (D / 32), I_DN = (FF / 64) * (D / 32);
    for (int it = gw; it < I_O; it += ngw) p0_transpose_item(F.in[I_EWOUT], D, D, WSP(bf16_t, WS_WOUT0), scr, it, F.lane);
}

template <int NV> __device__ __forceinline__ void fold_task(const float* W, int N, int n0, int dst0, int Nd, int kc, float cs, const float* gam, const float* mods_l, int sc_off, int sh_off,
                                                           bf16_t* WT, float* biasp, LAS float* scr, int lane) {
    LAS float* vec = scr + 2176;
    for (int i = lane; i < NV * 256; i += 64) { const int v = i >> 8, kk = i & 255, k = kc * 256 + kk;
        vec[i] = gam[k] * (1.f + mods_l[(size_t)v * 6144 + sc_off + k]) * cs; vec[768 + i] = mods_l[(size_t)v * 6144 + sh_off + k] * cs; }
    LDS_WAIT(); asm volatile("" ::: "memory");
    float bacc[NV];
#pragma unroll
    for (int v = 0; v < NV; ++v) bacc[v] = 0.f;
    for (int it = 0; it < 4; ++it) {
        const int k0 = kc * 256 + 64 * it;
        float val[32];
        { const float* wp = W + (size_t)(k0 + (lane >> 5)) * N + n0 + (lane & 31);
#pragma unroll
          for (int i = 0; i < 32; ++i) val[i] = __builtin_nontemporal_load(&wp[(size_t)(2 * i) * N]); }
#pragma unroll
        for (int i = 0; i < 32; ++i) { const int kk = 2 * i + (lane >> 5); scr[kk * 33 + (lane & 31)] = val[i];
#pragma unroll
            for (int v = 0; v < NV; ++v) bacc[v] += vec[768 + v * 256 + 64 * it + kk] * val[i]; }
        LDS_WAIT(); asm volatile("" ::: "memory");
        const int c = lane & 7;
#pragma unroll
        for (int j = 0; j < 4; ++j) { const int n = (lane >> 3) + 8 * j; const LAS float* s = scr + (8 * c) * 33 + n;
#pragma unroll
            for (int v = 0; v < NV; ++v) { const LAS float* sv = vec + v * 256 + 64 * it + 8 * c;
                u32x4 o; o.x = pk2(s[0 * 33] * sv[0], s[1 * 33] * sv[1]); o.y = pk2(s[2 * 33] * sv[2], s[3 * 33] * sv[3]); o.z = pk2(s[4 * 33] * sv[4], s[5 * 33] * sv[5]); o.w = pk2(s[6 * 33] * sv[6], s[7 * 33] * sv[7]);
                st16_wt(WT + (size_t)v * Nd * D + (size_t)(dst0 + n) * D + k0 + 8 * c, o); } }
        LDS_WAIT(); asm volatile("" ::: "memory");
    }
#pragma unroll
    for (int v = 0; v < NV; ++v) { float b = bacc[v]; b += __shfl_xor(b, 32); if (lane < 32) unsafeAtomicAdd(biasp + (size_t)v * Nd + dst0 + lane, b); }
}
template <int NV> __device__ __forceinline__ void fold_item(const float* W, int N, int n0, int dst0, int Nd, int k0, float cs, const float* gam, const float* mods_l, int sc_off, int sh_off,
                                                           bf16_t* WT, float* biasp, LAS float* scr, int lane) {
    LAS float* vec = scr + 2176;
    float val[32];
    { const float* wp = W + (size_t)(k0 + (lane >> 5)) * N + n0 + (lane & 31);
#pragma unroll
      for (int i = 0; i < 32; ++i) val[i] = __builtin_nontemporal_load(&wp[(size_t)(2 * i) * N]); }
    { const int k = k0 + lane; const float gk = gam[k] * cs;
#pragma unroll
      for (int v = 0; v < NV; ++v) { vec[v * 64 + lane] = gk * (1.f + mods_l[(size_t)v * 6144 + sc_off + k]); vec[192 + v * 64 + lane] = mods_l[(size_t)v * 6144 + sh_off + k] * cs; } }
#pragma unroll
    for (int i = 0; i < 32; ++i) scr[(2 * i + (lane >> 5)) * 33 + (lane & 31)] = val[i];
    LDS_WAIT(); asm volatile("" ::: "memory");
    float bacc[NV];
#pragma unroll
    for (int v = 0; v < NV; ++v) bacc[v] = 0.f;
#pragma unroll
    for (int i = 0; i < 32; ++i)
#pragma unroll
        for (int v = 0; v < NV; ++v) bacc[v] += vec[192 + v * 64 + 2 * i + (lane >> 5)] * val[i];
    const int c = lane & 7;
#pragma unroll
    for (int j = 0; j < 4; ++j) { const int n = (lane >> 3) + 8 * j; const LAS float* s = scr + (8 * c) * 33 + n;
#pragma unroll
        for (int v = 0; v < NV; ++v) { const LAS float* sv = vec + v * 64 + 8 * c;
            u32x4 o; o.x = pk2(s[0 * 33] * sv[0], s[1 * 33] * sv[1]); o.y = pk2(s[2 * 33] * sv[2], s[3 * 33] * sv[3]); o.z = pk2(s[4 * 33] * sv[4], s[5 * 33] * sv[5]); o.w = pk2(s[6 * 33] * sv[6], s[7 * 33] * sv[7]);
            st16_wt(WT + (size_t)v * Nd * D + (size_t)(dst0 + n) * D + k0 + 8 * c, o); } }
    LDS_WAIT(); asm volatile("" ::: "memory");
#pragma unroll
    for (int v = 0; v < NV; ++v) { float b = bacc[v]; b += __shfl_xor(b, 32); if (lane < 32) unsafeAtomicAdd(biasp + (size_t)v * Nd + dst0 + lane, b); }
}
__device__ __forceinline__ int gu_dst(int n) { return n < FF ? (n >> 7) * 256 + (n & 127) : ((n - FF) >> 7) * 256 + 128 + ((n - FF) & 127); }
__device__ __forceinline__ int in1_dst(int n) { if (n < 1024) return n; if (n < 2048) { const int q = n - 1024; return 1024 + (q >> 7) * 256 + (q & 127); } const int q = n - 2048; return 1024 + (q >> 7) * 256 + 128 + (q & 127); }
__device__ __forceinline__ void phase_p1(Frame& F, int part, int gw, int ngw) {
    LAS float* scr = (LAS float*)(F.lds + F.wave * 16384);
    const float* mods = WSP(float, WS_MODS);
    if (part == 0) {
        for (int it = gw; it < (NIN0 / 32) * 16; it += ngw) { const int ks = it & 15, n0 = (it >> 4) * 32;
            fold_item<3>(F.in[I_EWIN], NIN0, n0, n0, NIN0, 64 * ks, n0 < 512 ? QSCALE : 1.f, F.in[I_N1G], mods, 1024, 0, WSP(bf16_t, WS_WIN0), WSP(float, WS_B_IN0), scr, F.lane); }
    } else {
        for (int it = gw; it < (NGU / 32) * 16; it += ngw) { const int ks = it & 15, n0 = (it >> 4) * 32;
            fold_item<2>(F.in[I_WGU], NGU, n0, gu_dst(n0), NGU, 64 * ks, 1.f, F.in[I_N2G], mods, 4096, 3072, WSP(bf16_t, WS_WGU0), WSP(float, WS_B_GU0), scr, F.lane); }
    }
}

__device__ __forceinline__ void conv4_task(Frame& F, int task) {
    const bf16_t* QKV = WSP(bf16_t, WS_BIG); bf16_t* XC = WSP(bf16_t, WS_XCONV);
    const int row0 = task * 16, lane = F.lane;
    int sbeg, send;
    if (row0 < ML) { sbeg = (row0 / SEQ) * SEQ; send = sbeg + SEQ; } else { sbeg = ML + ((row0 - ML) / NCTX) * NCTX; send = sbeg + NCTX; }
    u32x4 raw[19];
#pragma unroll
    for (int i = 0; i < 19; ++i) { const int r = row0 + i - 2; raw[i] = (r >= sbeg && r < send) ? *(const u32x4*)(QKV + (size_t)r * NIN0 + 1536 + 8 * lane) : (u32x4){0u, 0u, 0u, 0u}; }
    float w[4][8], bs[8];
#pragma unroll
    for (int j = 0; j < 4; ++j) { const f32x4 a = *(const f32x4*)(F.in[I_ECW] + j * 512 + 8 * lane), b = *(const f32x4*)(F.in[I_ECW] + j * 512 + 8 * lane + 4);
        w[j][0] = a.x; w[j][1] = a.y; w[j][2] = a.z; w[j][3] = a.w; w[j][4] = b.x; w[j][5] = b.y; w[j][6] = b.z; w[j][7] = b.w; }
    { const f32x4 a = *(const f32x4*)(F.in[I_ECB] + 8 * lane), b = *(const f32x4*)(F.in[I_ECB] + 8 * lane + 4); bs[0] = a.x; bs[1] = a.y; bs[2] = a.z; bs[3] = a.w; bs[4] = b.x; bs[5] = b.y; bs[6] = b.z; bs[7] = b.w; }
#pragma unroll
    for (int t = 0; t < 16; ++t) {
        float o[8];
#pragma unroll
        for (int e = 0; e < 8; ++e) o[e] = bs[e];
#pragma unroll
        for (int j = 0; j < 4; ++j) { const u32x4 r = raw[t + j];
            o[0] += w[j][0] * bflo(r.x); o[1] += w[j][1] * bfhi(r.x); o[2] += w[j][2] * bflo(r.y); o[3] += w[j][3] * bfhi(r.y);
            o[4] += w[j][4] * bflo(r.z); o[5] += w[j][5] * bfhi(r.z); o[6] += w[j][6] * bflo(r.w); o[7] += w[j][7] * bfhi(r.w); }
        u32x4 pk; pk.x = pk2(o[0], o[1]); pk.y = pk2(o[2], o[3]); pk.z = pk2(o[4], o[5]); pk.w = pk2(o[6], o[7]);
        *(u32x4*)(XC + (size_t)(row0 + t) * 512 + 8 * lane) = pk;
    }
}

__device__ __forceinline__ int crow(int r, int hi) { return (r & 3) + 8 * (r >> 2) + 4 * hi; }
__device__ __forceinline__ void qkt(f32x16& p0, f32x16& p1, const bf16x8 (&b0)[4], const bf16x8 (&b1)[4], const bf16x8* qr, const f32x16& c0, const f32x16& c1) {
    p0 = __builtin_amdgcn_mfma_f32_32x32x16_bf16(b0[0], qr[0], c0, 0, 0, 0);
    p1 = __builtin_amdgcn_mfma_f32_32x32x16_bf16(b1[0], qr[0], c1, 0, 0, 0);
#pragma unroll
    for (int d0 = 1; d0 < 4; ++d0) {
        p0 = __builtin_amdgcn_mfma_f32_32x32x16_bf16(b0[d0], qr[d0], p0, 0, 0, 0);
        p1 = __builtin_amdgcn_mfma_f32_32x32x16_bf16(b1[d0], qr[d0], p1, 0, 0, 0);
    }
}
__device__ __forceinline__ void pv(f32x16* o, unsigned vb0, unsigned vb1, bf16x8 pa0, bf16x8 pa1, bf16x8 pa2, bf16x8 pa3, bool use0, bool use3) {
    s16x4 lo[2][4], hi[2][4];
#define PV_RD(ks) do { \
        lo[0][ks] = __builtin_amdgcn_ds_read_tr16_b64_v4i16((LAS s16x4*)(uintptr_t)(vb0 + (ks) * 2048)); \
        hi[0][ks] = __builtin_amdgcn_ds_read_tr16_b64_v4i16((LAS s16x4*)(uintptr_t)(vb0 + (ks) * 2048 + 1024)); \
        lo[1][ks] = __builtin_amdgcn_ds_read_tr16_b64_v4i16((LAS s16x4*)(uintptr_t)(vb1 + (ks) * 2048)); \
        hi[1][ks] = __builtin_amdgcn_ds_read_tr16_b64_v4i16((LAS s16x4*)(uintptr_t)(vb1 + (ks) * 2048 + 1024)); } while (0)
#define PK(d, k) (bf16x8){lo[d][k][0], lo[d][k][1], lo[d][k][2], lo[d][k][3], hi[d][k][0], hi[d][k][1], hi[d][k][2], hi[d][k][3]}
    PV_RD(1); PV_RD(2);
    if (use0) {
        PV_RD(0);
        asm volatile("s_waitcnt lgkmcnt(0)" ::: "memory");
        o[0] = __builtin_amdgcn_mfma_f32_32x32x16_bf16(PK(0, 0), pa0, o[0], 0, 0, 0);
        o[1] = __builtin_amdgcn_mfma_f32_32x32x16_bf16(PK(1, 0), pa0, o[1], 0, 0, 0);
    }
    if (use3) PV_RD(3);
    asm volatile("s_waitcnt lgkmcnt(0)" ::: "memory"); __builtin_amdgcn_sched_barrier(0);
    o[0] = __builtin_amdgcn_mfma_f32_32x32x16_bf16(PK(0, 1), pa1, o[0], 0, 0, 0);
    o[1] = __builtin_amdgcn_mfma_f32_32x32x16_bf16(PK(1, 1), pa1, o[1], 0, 0, 0);
    o[0] = __builtin_amdgcn_mfma_f32_32x32x16_bf16(PK(0, 2), pa2, o[0], 0, 0, 0);
    o[1] = __builtin_amdgcn_mfma_f32_32x32x16_bf16(PK(1, 2), pa2, o[1], 0, 0, 0);
    if (use3) {
        o[0] = __builtin_amdgcn_mfma_f32_32x32x16_bf16(PK(0, 3), pa3, o[0], 0, 0, 0);
        o[1] = __builtin_amdgcn_mfma_f32_32x32x16_bf16(PK(1, 3), pa3, o[1], 0, 0, 0);
    }
#undef PK
#undef PV_RD
}
__device__ __forceinline__ float max3f(float a, float b, float c) { float r; asm("v_max3_f32 %0, %1, %2, %3" : "=v"(r) : "v"(a), "v"(b), "v"(c)); return r; }
__device__ __forceinline__ float max2f(float a, float b) { float r; asm("v_max_f32 %0, %1, %2" : "=v"(r) : "v"(a), "v"(b)); return r; }
__device__ __forceinline__ float half_swap_max(float m) { auto rr = __builtin_amdgcn_permlane32_swap(__float_as_uint(m), __float_as_uint(m), false, false); return max2f(__uint_as_float(rr[0]), __uint_as_float(rr[1])); }
__device__ __forceinline__ float half_swap_sum(float m) { auto rr = __builtin_amdgcn_permlane32_swap(__float_as_uint(m), __float_as_uint(m), false, false); return __uint_as_float(rr[0]) + __uint_as_float(rr[1]); }

constexpr int AT_SLOT = 32768, AT_NSLOT = 3, AT_BIAS = AT_NSLOT * AT_SLOT, AT_WSF = AT_BIAS + 2 * 15 * 128 * 4, AT_QST = AT_WSF + 3072, AT_NTASK = NB * 128 * 4;
static_assert(AT_QST + 8 * 4096 <= LDSCTL_OFF, "attention LDS map");
constexpr float AT_THR = 8.f;
__device__ __forceinline__ void attn_phase(Frame& F) {
    const bf16_t* QKV = WSP(bf16_t, WS_BIG); bf16_t* MIX = WSP(bf16_t, WS_A2);
    const int lane = F.lane, w = F.wave, r32 = lane & 31, hi = lane >> 5;
    const int hsel = w >> 2, rsel = (w >> 1) & 1, qh = w & 1;
    LAS unsigned char* lds = F.lds;
    LAS float* BIAS = (LAS float*)(lds + AT_BIAS);
    LAS float* wsf = (LAS float*)(lds + AT_WSF) + w * 64;
    const int qc = 32 * qh + r32, cs = min(max(qc - 8, 0), 48);
    const int krow_ = 8 * w + (lane >> 3), kchunk_ = (lane & 7) ^ ((krow_ >> 1) & 7);
    int koff[4];
#pragma unroll
    for (int d0 = 0; d0 < 4; ++d0) koff[d0] = r32 * 128 + (((2 * d0 + hi) ^ ((r32 >> 1) & 7)) << 4);
    const unsigned ldsw = (unsigned)w * 1024u;
    unsigned vboff0, vboff1;
    { const int q_ = (lane & 15) >> 2, p_ = lane & 3, blk_ = (lane >> 4) & 1, fl_ = (q_ >> 1) << 2;
      vboff0 = (unsigned)((4 * hi + q_) * 128 + (((0 + 2 * blk_ + (p_ >> 1)) ^ fl_) << 4) + 8 * (p_ & 1));
      vboff1 = (unsigned)((4 * hi + q_) * 128 + (((4 + 2 * blk_ + (p_ >> 1)) ^ fl_) << 4) + 8 * (p_ & 1)); }
#define AT_DMA(bb, Rlo, s, sl) do { const int s_ = (s); const size_t base_ = (s_ < 4 ? (size_t)(ML + (bb) * NCTX + 64 * s_) : (size_t)((bb) * SEQ + ((Rlo) + s_ - 4) * 64)) * NIN0; \
        LAS unsigned char* sl_ = lds + (sl) * AT_SLOT + ldsw; \
        __builtin_amdgcn_global_load_lds((const unsigned*)(ksrc + base_), (LAS unsigned*)(sl_), 16, 0, 0); \
        __builtin_amdgcn_global_load_lds((const unsigned*)(ksrc + base_ + 64), (LAS unsigned*)(sl_ + 8192), 16, 0, 0); \
        __builtin_amdgcn_global_load_lds((const unsigned*)(vsrc + base_), (LAS unsigned*)(sl_ + 16384), 16, 0, 0); \
        __builtin_amdgcn_global_load_lds((const unsigned*)(vsrc + base_ + 64), (LAS unsigned*)(sl_ + 24576), 16, 0, 0); } while (0)
#define AT_DMAROW(trow, sl) do { const size_t base_ = (size_t)(trow) * NIN0; LAS unsigned char* sl_ = lds + (sl) * AT_SLOT + ldsw; \
        __builtin_amdgcn_global_load_lds((const unsigned*)(ksrc + base_), (LAS unsigned*)(sl_), 16, 0, 0); \
        __builtin_amdgcn_global_load_lds((const unsigned*)(ksrc + base_ + 64), (LAS unsigned*)(sl_ + 8192), 16, 0, 0); \
        __builtin_amdgcn_global_load_lds((const unsigned*)(vsrc + base_), (LAS unsigned*)(sl_ + 16384), 16, 0, 0); \
        __builtin_amdgcn_global_load_lds((const unsigned*)(vsrc + base_ + 64), (LAS unsigned*)(sl_ + 24576), 16, 0, 0); } while (0)
#define AT_DMAQ(bb, rr, hh) do { const bf16_t* qp_ = QKV + (size_t)((bb) * SEQ + (rr) * 64 + 32 * qh + r32) * NIN0 + (hh) * 64 + 8 * hi; LAS unsigned char* ql_ = lds + AT_QST + w * 4096; \
        __builtin_amdgcn_global_load_lds((const unsigned*)(qp_), (LAS unsigned*)(ql_), 16, 0, 0); __builtin_amdgcn_global_load_lds((const unsigned*)(qp_ + 16), (LAS unsigned*)(ql_ + 1024), 16, 0, 0); \
        __builtin_amdgcn_global_load_lds((const unsigned*)(qp_ + 32), (LAS unsigned*)(ql_ + 2048), 16, 0, 0); __builtin_amdgcn_global_load_lds((const unsigned*)(qp_ + 48), (LAS unsigned*)(ql_ + 3072), 16, 0, 0); } while (0)
#define AT_LOADQ(bb, rr, hh) do { const bf16_t* qp_ = QKV + (size_t)((bb) * SEQ + (rr) * 64 + 32 * qh + r32) * NIN0 + (hh) * 64 + 8 * hi; \
        qr[0] = *(const bf16x8*)(qp_); qr[1] = *(const bf16x8*)(qp_ + 16); qr[2] = *(const bf16x8*)(qp_ + 32); qr[3] = *(const bf16x8*)(qp_ + 48); } while (0)
    bf16x8 qr[4];
    if (w >= 4) __builtin_amdgcn_s_setprio(1);
    int bias_hp = -1, gs0 = 0;
    bool primed = false;
#pragma unroll 1
    for (int task = blockIdx.x; task < AT_NTASK; task += F.G) {
    const int b = task >> 9, rp = (task >> 2) & 127, hp = task & 3;
    const int h = 2 * hp + hsel, r = 2 * rp + rsel;
    const int rs_r = min(max(r - 4, 0), 248);
    const int R_lo = min(max(2 * rp - 4, 0), 248), R_hi = min(max(2 * rp + 1 - 4, 0), 248) + 7, nsteps = 4 + (R_hi - R_lo + 1);
    const int tn = task + F.G, bn = tn >> 9, rpn = (tn >> 2) & 127;
    const bool cont = tn < AT_NTASK && (tn & 3) == hp;
    const int R_lo_n = min(max(2 * rpn - 4, 0), 248);
    const bf16_t* ksrc = QKV + (size_t)krow_ * NIN0 + 512 + (2 * hp) * 64 + 8 * kchunk_;
    const bf16_t* vsrc = QKV + (size_t)krow_ * NIN0 + 1024 + (2 * hp) * 64 + 8 * ((lane & 7) ^ (((krow_ >> 1) & 1) << 2));
    if (!primed) {
        if (bias_hp != hp) {
            for (int i = F.tid; i < 2 * 15 * 128; i += 512) { const int hh = i / 1920, dr = (i >> 7) % 15, dc = (i & 127) - 48;
                BIAS[i] = (dc >= 0 && dc <= 30) ? F.in[I_RPB][(size_t)(2 * hp + hh) * 465 + dr * 31 + dc] * LOG2E : 0.f; }
            bias_hp = hp;
        }
        AT_LOADQ(b, r, h);
        asm volatile("s_waitcnt vmcnt(0)" ::: "memory");
        AT_DMA(b, R_lo, 0, gs0); AT_DMA(b, R_lo, 1, gs0 == 2 ? 0 : gs0 + 1);
    } else {
        asm volatile("s_waitcnt vmcnt(0)" ::: "memory");
#pragma unroll
        for (int d0 = 0; d0 < 4; ++d0) qr[d0] = *(LAS const bf16x8*)(lds + AT_QST + w * 4096 + d0 * 1024 + lane * 16);
    }
    float mref = 0.f, lrun = 0.f; f32x16 o[2], c0, c1;
#pragma unroll
    for (int i = 0; i < 16; ++i) { o[0][i] = 0.f; o[1][i] = 0.f; c0[i] = 0.f; c1[i] = 0.f; }
    const int cbase2 = ML + b * NCTX + 128, wbase2 = b * SEQ + (R_lo - 2) * 64, nbase = ML + bn * NCTX;
    int slc = gs0, sl2 = gs0 == 0 ? 2 : gs0 - 1;
    auto step = [&](const int s, auto win_t, auto qh_t) __attribute__((always_inline)) {
        constexpr bool WIN = decltype(win_t)::value; constexpr int QHC = decltype(qh_t)::value;
        if (WIN ? !(s + 1 < nsteps || cont) : (s == 0 && primed)) asm volatile("s_waitcnt vmcnt(0)" ::: "memory"); else asm volatile("s_waitcnt vmcnt(4)" ::: "memory");
        asm volatile("s_waitcnt lgkmcnt(0)" ::: "memory"); __builtin_amdgcn_s_barrier(); asm volatile("" ::: "memory");
        if constexpr (!WIN) { AT_DMAROW((s < 2 ? cbase2 : wbase2) + 64 * s, sl2); }
        else { const bool own = s + 2 < nsteps;
               if (own || cont) AT_DMAROW(own ? wbase2 + 64 * s : nbase + 64 * (s + 2 - nsteps), sl2);
               if (s == nsteps - 1 && cont) AT_DMAQ(bn, 2 * rpn + rsel, h); }
        const int kr = R_lo + s - 4;
        const bool active = !WIN || (kr >= rs_r && kr <= rs_r + 7);
        if (active) {
            LAS const unsigned char* Kslot = lds + slc * AT_SLOT + hsel * 8192;
            const unsigned vbs = (unsigned)(uintptr_t)(lds + slc * AT_SLOT + 16384 + hsel * 8192);
            f32x16 p0, p1;
            constexpr bool win = WIN; const bool l0a = !WIN || qh == 0, l1b = !WIN || qh == 1;
            bf16x8 kb0[4], kb1[4];
#pragma unroll
            for (int d0 = 0; d0 < 4; ++d0) { kb0[d0] = *(LAS const bf16x8*)(Kslot + koff[d0]); kb1[d0] = *(LAS const bf16x8*)(Kslot + koff[d0] + 4096); }
            if (win) {
                f32x16 cc0, cc1;
                const int dr = kr - r + 7;
                LAS const float* T = BIAS + (hsel * 15 + dr) * 128 + (63 - qc);
                float tb0[16], tb1[16];
#pragma unroll
                for (int i = 0; i < 16; ++i) { tb0[i] = T[crow(i, hi)]; tb1[i] = T[crow(i, hi) + 32]; }
#pragma unroll
                for (int i = 0; i < 16; ++i) { cc0[i] = c0[i] + tb0[i]; cc1[i] = c1[i] + tb1[i]; }
                qkt(p0, p1, kb0, kb1, qr, cc0, cc1);
            } else qkt(p0, p1, kb0, kb1, qr, c0, c1);
            float ra = max3f(p0[12], p0[13], p1[0]), rb = max3f(p0[14], p0[15], p1[1]); ra = max3f(ra, p1[2], p1[3]);
            if (l0a) {
#pragma unroll
                for (int i = 0; i < 12; i += 4) { ra = max3f(ra, p0[i], p0[i + 1]); rb = max3f(rb, p0[i + 2], p0[i + 3]); }
            }
            if (l1b) {
#pragma unroll
                for (int i = 4; i < 16; i += 4) { ra = max3f(ra, p1[i], p1[i + 1]); rb = max3f(rb, p1[i + 2], p1[i + 3]); }
            }
            float rm = half_swap_max(max2f(ra, rb));
            if ((!WIN && s == 0) || __any(rm > AT_THR)) {
                const float dl = (!WIN && s == 0) ? rm : max2f(rm, 0.f);
                mref += dl;
#pragma unroll
                for (int i = 0; i < 16; ++i) { p0[i] -= dl; p1[i] -= dl; c0[i] -= dl; c1[i] -= dl; }
                const float f = (!WIN && s == 0) ? 1.f : fast_exp2(-dl);
                lrun *= f;
#pragma unroll
                for (int i = 0; i < 16; ++i) { o[0][i] *= f; o[1][i] *= f; }
            }
            float ls = 0.f;
            u32x4 pw0, pw1, pw2, pw3;
            if (l0a) {
#pragma unroll
                for (int i = 0; i < 12; ++i) { p0[i] = fast_exp2(p0[i]); ls += p0[i]; }
                pw0.x = pg8::cvt_pk_bf16(p0[0], p0[1]); pw0.y = pg8::cvt_pk_bf16(p0[2], p0[3]); pw0.z = pg8::cvt_pk_bf16(p0[4], p0[5]); pw0.w = pg8::cvt_pk_bf16(p0[6], p0[7]);
                pw1.x = pg8::cvt_pk_bf16(p0[8], p0[9]); pw1.y = pg8::cvt_pk_bf16(p0[10], p0[11]);
            } else { pw0 = (u32x4){0u, 0u, 0u, 0u}; pw1.x = 0u; pw1.y = 0u; }
#pragma unroll
            for (int i = 12; i < 16; ++i) { p0[i] = fast_exp2(p0[i]); ls += p0[i]; }
#pragma unroll
            for (int i = 0; i < 4; ++i) { p1[i] = fast_exp2(p1[i]); ls += p1[i]; }
            pw1.z = pg8::cvt_pk_bf16(p0[12], p0[13]); pw1.w = pg8::cvt_pk_bf16(p0[14], p0[15]);
            pw2.x = pg8::cvt_pk_bf16(p1[0], p1[1]); pw2.y = pg8::cvt_pk_bf16(p1[2], p1[3]);
            if (l1b) {
#pragma unroll
                for (int i = 4; i < 16; ++i) { p1[i] = fast_exp2(p1[i]); ls += p1[i]; }
                pw2.z = pg8::cvt_pk_bf16(p1[4], p1[5]); pw2.w = pg8::cvt_pk_bf16(p1[6], p1[7]);
                pw3.x = pg8::cvt_pk_bf16(p1[8], p1[9]); pw3.y = pg8::cvt_pk_bf16(p1[10], p1[11]); pw3.z = pg8::cvt_pk_bf16(p1[12], p1[13]); pw3.w = pg8::cvt_pk_bf16(p1[14], p1[15]);
            } else { pw2.z = 0u; pw2.w = 0u; pw3 = (u32x4){0u, 0u, 0u, 0u}; }
            lrun += ls;
            LDS_WAIT();
            pv(o, vbs + vboff0, vbs + vboff1, __builtin_bit_cast(bf16x8, pw0), __builtin_bit_cast(bf16x8, pw1), __builtin_bit_cast(bf16x8, pw2), __builtin_bit_cast(bf16x8, pw3), l0a, l1b);
        }
            slc = slc == 2 ? 0 : slc + 1; sl2 = sl2 == 2 ? 0 : sl2 + 1;
    };
    int s_ = 0;
#pragma unroll 1
    for (; s_ < 4; ++s_) step(s_, std::false_type{}, std::integral_constant<int, -1>{});
    {
#pragma unroll
        for (int i = 0; i < 16; ++i) { const int k0_ = crow(i, hi); c0[i] = ((unsigned)(k0_ - cs) < 16u) ? c0[i] : -INFINITY; c1[i] = ((unsigned)(k0_ + 32 - cs) < 16u) ? c1[i] : -INFINITY; }
    }
#pragma unroll 1
    for (; s_ < nsteps; ++s_) step(s_, std::true_type{}, std::integral_constant<int, -1>{});
    const float ri = fast_rcp(half_swap_sum(lrun));
    unsigned char* orow = (unsigned char*)(MIX + (size_t)(b * SEQ + r * 64 + 32 * qh + r32) * D + h * 64) + (hi ? 16 : 0);
#pragma unroll
    for (int db = 0; db < 2; ++db) {
        unsigned gx[4], gy[4];
#pragma unroll
        for (int g = 0; g < 4; ++g) { gx[g] = pk2(o[db][4 * g] * ri, o[db][4 * g + 1] * ri); gy[g] = pk2(o[db][4 * g + 2] * ri, o[db][4 * g + 3] * ri); }
#pragma unroll
        for (int k = 0; k < 4; k += 2) {
            const auto rx = __builtin_amdgcn_permlane32_swap(gx[k], gx[k + 1], false, false);
            const auto ry = __builtin_amdgcn_permlane32_swap(gy[k], gy[k + 1], false, false);
            *(u32x4*)(orow + db * 64 + 16 * k) = (u32x4){rx[0], ry[0], rx[1], ry[1]};
        }
    }
    asm volatile("s_waitcnt lgkmcnt(0)" ::: "memory");
    if (!cont) { asm volatile("s_waitcnt vmcnt(0)" ::: "memory"); __builtin_amdgcn_s_barrier(); asm volatile("" ::: "memory"); }
    gs0 = (gs0 + nsteps) % 3; primed = cont;
    }
    __builtin_amdgcn_s_setprio(0);
#undef AT_DMA
#undef AT_LOADQ
#undef AT_DMAQ
#undef AT_DMAROW
}

struct LruW { bf16x8 wr[4], wi[4]; f32x16 cr, ci; float cn; };
constexpr int LRU_LW = 0, LRU_LC = 32768, LRU_HF = 36864, LRU_AF = LRU_HF + 65536;
static_assert(LRU_AF + 8 * 4096 <= LDSCTL_OFF, "LRU LDS map");
__device__ __forceinline__ void lru_stage_w(Frame& F, int g) {
    const u32x4* src = WSP(u32x4, WS_LRUW);
    LAS u32x4* dst = (LAS u32x4*)(F.lds + LRU_LW);
#pragma unroll
    for (int i = 0; i < 4; ++i) { const int idx = F.tid + 512 * i;
        const int d = idx >> 10, rest = idx & 1023;
        dst[idx] = src[(size_t)((d * 8 + g) * 1024) + rest]; }
    if (F.tid < 128) { const int d = F.tid >> 6, ch = d * 512 + g * 64 + (F.tid & 63);
        LAS float* lc = (LAS float*)(F.lds + LRU_LC) + F.tid * 4;
        lc[0] = -LOG2E * F.in[I_LBR][ch]; lc[1] = -LOG2E * F.in[I_LBI][ch]; lc[2] = -8.f * LOG2E * log1pf(__expf(-F.in[I_LAM][ch])); }
    __syncthreads();
}
__device__ __forceinline__ void lru_load_w(Frame& F, LruW& W, int d, int half, int lane) {
    LAS const bf16x8* wf = (LAS const bf16x8*)(F.lds + LRU_LW) + d * 1024 + lane;
#pragma unroll
    for (int s = 0; s < 4; ++s) { W.wr[s] = wf[((0 * 2 + half) * 4 + s) * 64]; W.wi[s] = wf[((1 * 2 + half) * 4 + s) * 64]; }
    LAS const float* lc = (LAS const float*)(F.lds + LRU_LC) + (d * 64 + 32 * half + (lane & 31)) * 4;
    { const float br = lc[0], bi = lc[1];
#pragma unroll
      for (int i = 0; i < 16; ++i) { W.cr[i] = br; W.ci[i] = bi; } }
    W.cn = lc[2];
}
__device__ __forceinline__ void lru_dma_af(const bf16_t* XC, size_t t0, int g, int lane, LAS unsigned char* afb) {
    const int rr = lane >> 3, sl = lane & 7;
#pragma unroll
    for (int i = 0; i < 4; ++i) { const int row = 8 * i + rr;
        __builtin_amdgcn_global_load_lds((const unsigned*)(XC + (t0 + row) * 512 + 64 * g + 8 * (sl ^ ((row >> 1) & 7))), (LAS unsigned*)(afb + i * 1024), 16, 0, 0); }
}
__device__ __forceinline__ void lru_read_af(LAS const unsigned char* afb, int r32, int hi, bf16x8 (&af)[4]) {
#pragma unroll
    for (int s = 0; s < 4; ++s) af[s] = *(LAS const bf16x8*)(afb + r32 * 128 + (((2 * s + hi) ^ ((r32 >> 1) & 7)) << 4));
}
__device__ __forceinline__ void lru_gates(const bf16x8 (&af)[4], const LruW& W, int half, bf16x8 I0, bf16x8 I1, float (&a)[16], float (&b)[16]) {
    f32x16 R, I, X;
#pragma unroll
    for (int i = 0; i < 16; ++i) X[i] = 0.f;
    R = __builtin_amdgcn_mfma_f32_32x32x16_bf16(af[0], W.wr[0], W.cr, 0, 0, 0); I = __builtin_amdgcn_mfma_f32_32x32x16_bf16(af[0], W.wi[0], W.ci, 0, 0, 0);
#pragma unroll
    for (int s = 1; s < 4; ++s) { R = __builtin_amdgcn_mfma_f32_32x32x16_bf16(af[s], W.wr[s], R, 0, 0, 0); I = __builtin_amdgcn_mfma_f32_32x32x16_bf16(af[s], W.wi[s], I, 0, 0, 0); }
    const bf16x8 ax0 = half ? af[2] : af[0], ax1 = half ? af[3] : af[1];
    X = __builtin_amdgcn_mfma_f32_32x32x16_bf16(ax0, I0, X, 0, 0, 0);
    X = __builtin_amdgcn_mfma_f32_32x32x16_bf16(ax1, I1, X, 0, 0, 0);
    const float cn = W.cn;
#pragma unroll
    for (int i = 0; i < 16; ++i) {
        const float rr = fast_rcp(1.f + fast_exp2(R[i])), ii = fast_rcp(1.f + fast_exp2(I[i]));
        const float av = fast_exp2(rr * cn);
        a[i] = av; b[i] = __builtin_amdgcn_sqrtf(1.f - av * av) * ii * X[i]; }
}
__device__ __forceinline__ float partner32(float x, int hi) { auto rr = __builtin_amdgcn_permlane32_swap(__float_as_uint(x), __float_as_uint(x), false, false); return __uint_as_float(hi ? rr[0] : rr[1]); }
template <bool REV, bool WANT_H> __device__ __forceinline__ void lru_scan_tile(const float (&a)[16], const float (&b)[16], int hi, float& H, float (&h)[16], float& ap) {
    float SA[4], SB[4], EAv[4], OAv[4], EBv[4], OBv[4];
#pragma unroll
    for (int q = 0; q < 4; ++q) { const float a0 = a[4 * q], a1 = a[4 * q + 1], a2 = a[4 * q + 2], a3 = a[4 * q + 3], b0 = b[4 * q], b1 = b[4 * q + 1], b2 = b[4 * q + 2], b3 = b[4 * q + 3];
        SA[q] = (a0 * a1) * (a2 * a3);
        SB[q] = REV ? ((b3 * a2 + b2) * a1 + b1) * a0 + b0 : ((b0 * a1 + b1) * a2 + b2) * a3 + b3; }
#pragma unroll
    for (int q = 0; q < 4; ++q) { auto ra_ = __builtin_amdgcn_permlane32_swap(__float_as_uint(SA[q]), __float_as_uint(SA[q]), false, false); EAv[q] = __uint_as_float(ra_[0]); OAv[q] = __uint_as_float(ra_[1]);
        auto rb_ = __builtin_amdgcn_permlane32_swap(__float_as_uint(SB[q]), __float_as_uint(SB[q]), false, false); EBv[q] = __uint_as_float(rb_[0]); OBv[q] = __uint_as_float(rb_[1]); }
    float cin[4];
    if (!REV) {
#pragma unroll
        for (int q = 0; q < 4; ++q) { const float EA = EAv[q], EB = EBv[q], OA = OAv[q], OB = OBv[q];
            const float he = H; H = EA * H + EB; const float ho = H; H = OA * H + OB; cin[q] = hi ? ho : he; if (!WANT_H) ap *= EA * OA; }
    } else {
#pragma unroll
        for (int q = 3; q >= 0; --q) { const float EA = EAv[q], EB = EBv[q], OA = OAv[q], OB = OBv[q];
            const float ho = H; H = OA * H + OB; const float he = H; H = EA * H + EB; cin[q] = hi ? ho : he; if (!WANT_H) ap *= EA * OA; }
    }
    if (WANT_H) {
#pragma unroll
        for (int q = 0; q < 4; ++q) { float hh = cin[q];
            if (!REV) {
#pragma unroll
                for (int e = 0; e < 4; ++e) { hh = a[4 * q + e] * hh + b[4 * q + e]; h[4 * q + e] = hh; }
            } else {
#pragma unroll
                for (int e = 3; e >= 0; --e) { hh = a[4 * q + e] * hh + b[4 * q + e]; h[4 * q + e] = hh; }
            } }
    }
}
__device__ __forceinline__ void lru_ident(int r32, int hi, bf16x8& I0, bf16x8& I1) {
#pragma unroll
    for (int j = 0; j < 8; ++j) { I0[j] = (8 * hi + j == r32) ? (short)0x3F80 : (short)0; I1[j] = (16 + 8 * hi + j == r32) ? (short)0x3F80 : (short)0; }
}
template <bool REV, int MODE> __device__ __forceinline__ void lru_subpass(Frame& F, size_t row0, int ntile, int g, int half, float& H, float& ap, LAS unsigned* HFL, bf16x8 (&af)[4], bool have) {
    const bf16_t* XC = WSP(bf16_t, WS_XCONV);
    const int lane = F.lane, r32 = lane & 31, hi = lane >> 5;
    LAS unsigned char* afb = F.lds + LRU_AF + F.wave * 4096;
    bf16x8 I0, I1; lru_ident(r32, hi, I0, I1);
    LruW W; lru_load_w(F, W, REV ? 1 : 0, half, lane);
    if (!have) {
        lru_dma_af(XC, row0 + (REV ? 32 * (ntile - 1) : 0), g, lane, afb);
        asm volatile("s_waitcnt vmcnt(0)" ::: "memory");
        lru_read_af(afb, r32, hi, af);
        asm volatile("s_waitcnt lgkmcnt(0)" ::: "memory");
    }
#pragma unroll 1
    for (int tt = 0; tt < ntile; ++tt) {
        const int ti = REV ? ntile - 1 - tt : tt;
        const bool more = tt + 1 < ntile;
        if (more) lru_dma_af(XC, row0 + 32 * (REV ? ti - 1 : ti + 1), g, lane, afb);
        const size_t t0 = row0 + 32 * ti;
        bf16_t grw[16];
        if (MODE == 2) { const bf16_t* gp = WSP(bf16_t, WS_BIG) + t0 * NIN0 + 2048 + 64 * g + 32 * half;
            const unsigned lo_ = (unsigned)(4 * hi * NIN0 + r32);
#pragma unroll
            for (int i = 0; i < 16; ++i) grw[i] = gp[lo_ + (unsigned)(((i & 3) + 8 * (i >> 2)) * NIN0)]; }
        float a[16], bb[16], h[16];
        lru_gates(af, W, half, I0, I1, a, bb);
        lru_scan_tile<REV, MODE != 0>(a, bb, hi, H, h, ap);
        asm volatile("s_waitcnt vmcnt(0)" ::: "memory");
        if (more) lru_read_af(afb, r32, hi, af);
        if (MODE == 1) {
#pragma unroll
            for (int p = 0; p < 8; ++p) HFL[(ti * 8 + p) * 64 + lane] = pk2(h[2 * p], h[2 * p + 1]);
        }
        if (MODE == 2) {
            bf16_t* op = WSP(bf16_t, WS_A2) + t0 * D + 512 + 64 * g + 32 * half;
            const unsigned so_ = (unsigned)(4 * hi * D + r32);
#pragma unroll
            for (int p = 0; p < 8; ++p) { const unsigned hf = HFL[(ti * 8 + p) * 64 + lane];
                const unsigned pr_ = pk2((bflo(hf) + h[2 * p]) * gelu_tanh(bf1(grw[2 * p])), (bfhi(hf) + h[2 * p + 1]) * gelu_tanh(bf1(grw[2 * p + 1])));
                op[so_ + (unsigned)((((2 * p) & 3) + 8 * ((2 * p) >> 2)) * D)] = (bf16_t)(pr_ & 0xffffu);
                op[so_ + (unsigned)((((2 * p + 1) & 3) + 8 * ((2 * p + 1) >> 2)) * D)] = (bf16_t)(pr_ >> 16); }
        }
        asm volatile("s_waitcnt lgkmcnt(0)" ::: "memory");
    }
    asm volatile("" ::: "memory");
}
template <bool REV> __device__ __forceinline__ void lru_subpass0(Frame& F, size_t row0, int ntile, int g, int half, float& H, float& ap) {
    const bf16_t* XC = WSP(bf16_t, WS_XCONV);
    const int lane = F.lane, r32 = lane & 31, hi = lane >> 5;
    LAS unsigned char* buf0 = F.lds + LRU_AF + F.wave * 4096; LAS unsigned char* buf1 = F.lds + LRU_HF + 8192 + F.wave * 4096;
    bf16x8 I0, I1; lru_ident(r32, hi, I0, I1);
    LruW W; lru_load_w(F, W, REV ? 1 : 0, half, lane);
    bf16x8 af[4];
#define LRU0_ROW(tt) (row0 + 32 * (REV ? ntile - 1 - (tt) : (tt)))
    lru_dma_af(XC, LRU0_ROW(0), g, lane, buf0);
    if (ntile > 1) { lru_dma_af(XC, LRU0_ROW(1), g, lane, buf1); asm volatile("s_waitcnt vmcnt(4)" ::: "memory"); } else asm volatile("s_waitcnt vmcnt(0)" ::: "memory");
    lru_read_af(buf0, r32, hi, af);
    asm volatile("s_waitcnt lgkmcnt(0)" ::: "memory");
#pragma unroll 1
    for (int tt = 0; tt < ntile; ++tt) {
        LAS unsigned char* bcur = (tt & 1) ? buf1 : buf0; LAS unsigned char* bnxt = (tt & 1) ? buf0 : buf1;
        if (tt + 2 < ntile) lru_dma_af(XC, LRU0_ROW(tt + 2), g, lane, bcur);
        float a[16], bb[16], h[16];
        lru_gates(af, W, half, I0, I1, a, bb);
        lru_scan_tile<REV, false>(a, bb, hi, H, h, ap);
        if (tt + 1 < ntile) {
            if (tt + 2 < ntile) asm volatile("s_waitcnt vmcnt(4)" ::: "memory"); else asm volatile("s_waitcnt vmcnt(0)" ::: "memory");
            lru_read_af(bnxt, r32, hi, af);
            asm volatile("s_waitcnt lgkmcnt(0)" ::: "memory");
        }
    }
#undef LRU0_ROW
    asm volatile("" ::: "memory");
}
__device__ __forceinline__ void conv4_local(Frame& F, size_t r0, int ngrp, size_t sbeg, size_t send, int g) {
    const bf16_t* QKV = WSP(bf16_t, WS_BIG); bf16_t* XC = WSP(bf16_t, WS_XCONV);
    const int lane = F.lane, rgrp = lane >> 3, cl = lane & 7, ch = 64 * g + 8 * cl;
    if (rgrp < ngrp) {
        const size_t row0 = r0 + 16 * rgrp;
        u32x4 raw[19];
#pragma unroll
        for (int i = 0; i < 19; ++i) { const size_t r = row0 + i - 2; raw[i] = (r >= sbeg && r < send) ? *(const u32x4*)(QKV + r * NIN0 + 1536 + ch) : (u32x4){0u, 0u, 0u, 0u}; }
        float w[4][8], bs[8];
#pragma unroll
        for (int j = 0; j < 4; ++j) { const f32x4 a = *(const f32x4*)(F.in[I_ECW] + j * 512 + ch), b = *(const f32x4*)(F.in[I_ECW] + j * 512 + ch + 4);
            w[j][0] = a.x; w[j][1] = a.y; w[j][2] = a.z; w[j][3] = a.w; w[j][4] = b.x; w[j][5] = b.y; w[j][6] = b.z; w[j][7] = b.w; }
        { const f32x4 a = *(const f32x4*)(F.in[I_ECB] + ch), b = *(const f32x4*)(F.in[I_ECB] + ch + 4); bs[0] = a.x; bs[1] = a.y; bs[2] = a.z; bs[3] = a.w; bs[4] = b.x; bs[5] = b.y; bs[6] = b.z; bs[7] = b.w; }
#pragma unroll
        for (int t = 0; t < 16; ++t) {
            float o[8];
#pragma unroll
            for (int e = 0; e < 8; ++e) o[e] = bs[e];
#pragma unroll
            for (int j = 0; j < 4; ++j) { const u32x4 r = raw[t + j];
                o[0] += w[j][0] * bflo(r.x); o[1] += w[j][1] * bfhi(r.x); o[2] += w[j][2] * bflo(r.y); o[3] += w[j][3] * bfhi(r.y);
                o[4] += w[j][4] * bflo(r.z); o[5] += w[j][5] * bfhi(r.z); o[6] += w[j][6] * bflo(r.w); o[7] += w[j][7] * bfhi(r.w); }
            u32x4 pk; pk.x = pk2(o[0], o[1]); pk.y = pk2(o[2], o[3]); pk.z = pk2(o[4], o[5]); pk.w = pk2(o[6], o[7]);
            *(u32x4*)(XC + (row0 + t) * 512 + ch) = pk;
        }
    }
    asm volatile("s_waitcnt vmcnt(0)" ::: "memory");
}
template <bool REV> __device__ __forceinline__ void lru_subpass2(Frame& F, size_t row0, int ntile, int g, float (&H)[2], float (&ap)[2]) {
    const bf16_t* XC = WSP(bf16_t, WS_XCONV);
    const int lane = F.lane, r32 = lane & 31, hi = lane >> 5;
    LAS unsigned char* afb = F.lds + LRU_AF + F.wave * 4096;
    bf16x8 I0, I1; lru_ident(r32, hi, I0, I1);
    LruW W0, W1; lru_load_w(F, W0, REV ? 1 : 0, 0, lane); lru_load_w(F, W1, REV ? 1 : 0, 1, lane);
    bf16x8 af[4];
    lru_dma_af(XC, row0 + (REV ? 32 * (ntile - 1) : 0), g, lane, afb);
    asm volatile("s_waitcnt vmcnt(0)" ::: "memory");
    lru_read_af(afb, r32, hi, af);
    asm volatile("s_waitcnt lgkmcnt(0)" ::: "memory");
#pragma unroll 1
    for (int tt = 0; tt < ntile; ++tt) {
        const int ti = REV ? ntile - 1 - tt : tt;
        const bool more = tt + 1 < ntile;
        if (more) lru_dma_af(XC, row0 + 32 * (REV ? ti - 1 : ti + 1), g, lane, afb);
        float a0[16], b0[16], a1[16], b1[16], hd[16];
        lru_gates(af, W0, 0, I0, I1, a0, b0);
        lru_gates(af, W1, 1, I0, I1, a1, b1);
        lru_scan_tile<REV, false>(a0, b0, hi, H[0], hd, ap[0]);
        lru_scan_tile<REV, false>(a1, b1, hi, H[1], hd, ap[1]);
        asm volatile("s_waitcnt vmcnt(0)" ::: "memory");
        if (more) lru_read_af(afb, r32, hi, af);
        asm volatile("s_waitcnt lgkmcnt(0)" ::: "memory");
    }
    asm volatile("" ::: "memory");
}
__device__ __forceinline__ void lru_pass1_wg(Frame& F, int wg) {
    const int j = wg & 15, g = (wg >> 4) & 7, b = wg >> 7, w = F.wave, lane = F.lane, hi = lane >> 5;
    f32x2* TOT = WSP(f32x2, WS_TOT); f32x2* TOTG = WSP(f32x2, WS_TOTG); f32x2* TOTC = WSP(f32x2, WS_TOTC);
    LAS f32x2* CB = (LAS f32x2*)(F.lds + LRU_HF);
    lru_stage_w(F, g);
    const int c = 8 * j + w, sub = w - 2;
    const int njobs = (w == 2 || w == 4) ? 2 : 1;
    if (njobs == 2) __builtin_amdgcn_s_setprio(1);
#pragma unroll 1
    for (int job = 0; job < njobs; ++job) {
        const size_t r0 = job == 0 ? (size_t)b * SEQ + (size_t)c * CHUNK : (size_t)ML + (size_t)b * NCTX + 32 * (j & 7);
        const int nt = job == 0 ? 4 : 1;
        { const size_t sb_ = job == 0 ? (size_t)b * SEQ : (size_t)ML + (size_t)b * NCTX, se_ = job == 0 ? sb_ + SEQ : sb_ + NCTX;
          asm volatile("" ::: "memory"); __builtin_amdgcn_sched_barrier(0);
          conv4_local(F, r0, job == 0 ? 8 : 2, sb_, se_, g);
          asm volatile("" ::: "memory"); __builtin_amdgcn_sched_barrier(0); }
        f32x2 tot[2] = {(f32x2){1.f, 0.f}, (f32x2){1.f, 0.f}};
#pragma unroll 1
        for (int half = 0; half < 2; ++half) {
            if (job != 0 && half != (j >> 3)) continue;
            if (job == 0 || sub < 2) { float H = 0.f, ap = 1.f; lru_subpass0<false>(F, r0, nt, g, half, H, ap); if (hi == half) tot[0] = (f32x2){ap, H}; }
            if (job == 0 || sub >= 2) { float H = 0.f, ap = 1.f; lru_subpass0<true>(F, r0, nt, g, half, H, ap); if (hi == half) tot[1] = (f32x2){ap, H}; }
        }
        if (job == 0) {
#pragma unroll
            for (int d = 0; d < 2; ++d) { st8_wt(&TOT[(size_t)((b * 2 + d) * NCHUNK + c) * 512 + 64 * g + lane], tot[d]); CB[(d * 8 + w) * 64 + lane] = tot[d]; }
        } else {
            if (hi == (j >> 3)) st8_wt(&TOTC[(size_t)((b * 2 + (sub >> 1)) * 8 + (j & 7)) * 512 + 64 * g + lane], (sub >> 1) ? tot[1] : tot[0]);
        }
    }
    __builtin_amdgcn_s_setprio(0);
    __syncthreads();
    if (w < 2) { const int d = w; float A = 1.f, B = 0.f;
#pragma unroll
        for (int k = 0; k < 8; ++k) { const f32x2 t = CB[(d * 8 + (d == 0 ? k : 7 - k)) * 64 + lane]; B = t.x * B + t.y; A *= t.x; }
        st8_wt(&TOTG[(size_t)((b * 2 + d) * 16 + j) * 512 + 64 * g + lane], (f32x2){A, B}); }
    asm volatile("s_waitcnt vmcnt(0)" ::: "memory");
    __syncthreads();
    if (F.tid == 0) (void)__hip_atomic_fetch_add((unsigned*)(F.ws + WS_CTL) + CW_LRUG + 64 * (b * 8 + g), 1u, __ATOMIC_RELAXED, __HIP_MEMORY_SCOPE_AGENT);
}
__device__ __forceinline__ void lru_pass3_wg(Frame& F, int wg, bool staged) {
    const int j = wg & 15, g = (wg >> 4) & 7, b = wg >> 7, w = F.wave, lane = F.lane, r32 = lane & 31;
    const f32x2* TOT = WSP(f32x2, WS_TOT); const f32x2* TOTG = WSP(f32x2, WS_TOTG); const f32x2* TOTC = WSP(f32x2, WS_TOTC);
    LAS unsigned* HFL = (LAS unsigned*)(F.lds + LRU_HF + w * 8192);
    if (F.tid == 0) { const unsigned* gc = (const unsigned*)(F.ws + WS_CTL) + CW_LRUG + 64 * (b * 8 + g); unsigned sp = 0;
        while (__hip_atomic_load(gc, __ATOMIC_RELAXED, __HIP_MEMORY_SCOPE_AGENT) < 16u) { __builtin_amdgcn_s_sleep(2); if (++sp > (1u << 22)) break; } }
    __syncthreads();
    const int c = 8 * j + w;
    const size_t row0 = (size_t)b * SEQ + (size_t)c * CHUNK;
    float Cf = 0.f, Cb = 0.f;
    {
        const f32x2 id = (f32x2){1.f, 0.f};
        const size_t chn = 64 * g + lane;
        f32x2 t[15];
#pragma unroll
        for (int k = 0; k < 8; ++k) t[k] = ld8_sc1(&TOTC[(size_t)((b * 2 + 0) * 8 + k) * 512 + chn]);
#pragma unroll
        for (int k = 0; k < 7; ++k) t[8 + k] = (k < w) ? ld8_sc1(&TOT[(size_t)((b * 2 + 0) * NCHUNK + 8 * j + k) * 512 + chn]) : id;
        f32x2 u[15];
#pragma unroll
        for (int k = 0; k < 15; ++k) u[k] = (k < j) ? ld8_sc1(&TOTG[(size_t)((b * 2 + 0) * 16 + k) * 512 + chn]) : id;
        f32x2 tb[15], ub[15];
#pragma unroll
        for (int k = 0; k < 8; ++k) tb[k] = ld8_sc1(&TOTC[(size_t)((b * 2 + 1) * 8 + (7 - k)) * 512 + chn]);
#pragma unroll
        for (int k = 0; k < 7; ++k) tb[8 + k] = (7 - k > w) ? ld8_sc1(&TOT[(size_t)((b * 2 + 1) * NCHUNK + 8 * j + (7 - k)) * 512 + chn]) : id;
#pragma unroll
        for (int k = 0; k < 15; ++k) ub[k] = (15 - k > j) ? ld8_sc1(&TOTG[(size_t)((b * 2 + 1) * 16 + (15 - k)) * 512 + chn]) : id;
        if (!staged) lru_stage_w(F, g);
#pragma unroll
        for (int k = 0; k < 8; ++k) Cf = t[k].x * Cf + t[k].y;
#pragma unroll
        for (int k = 0; k < 15; ++k) Cf = u[k].x * Cf + u[k].y;
#pragma unroll
        for (int k = 0; k < 7; ++k) Cf = t[8 + k].x * Cf + t[8 + k].y;
#pragma unroll
        for (int k = 0; k < 8; ++k) Cb = tb[k].x * Cb + tb[k].y;
#pragma unroll
        for (int k = 0; k < 15; ++k) Cb = ub[k].x * Cb + ub[k].y;
#pragma unroll
        for (int k = 0; k < 7; ++k) Cb = tb[8 + k].x * Cb + tb[8 + k].y;
        asm volatile("" ::: "memory");
    }
    float dummy = 1.f, H;
    bf16x8 af[4];
#pragma unroll 1
    for (int half = 0; half < 2; ++half) {
        H = __shfl(Cf, 32 * half + r32); lru_subpass<false, 1>(F, row0, 4, g, half, H, dummy, HFL, af, half != 0);
        H = __shfl(Cb, 32 * half + r32); lru_subpass<true, 2>(F, row0, 4, g, half, H, dummy, HFL, af, true);
    }
    LDS_WAIT();
    __syncthreads();
}

__device__ __forceinline__ void conv3_task(Frame& F, int task) {
    bf16_t* BG = WSP(bf16_t, WS_A1); const bf16_t* P = WSP(bf16_t, WS_A3);
    const int lane = F.lane, half = task & 1, row0 = (task >> 1) * 16, ch = half * 512 + 8 * lane;
    const int sbeg = (row0 / SEQ) * SEQ, send = sbeg + SEQ;
    u32x4 raw[18];
#pragma unroll
    for (int i = 0; i < 18; ++i) { const int r = row0 + i - 1; raw[i] = (r >= sbeg && r < send) ? *(const u32x4*)(P + (size_t)r * D + ch) : (u32x4){0u, 0u, 0u, 0u}; }
    u32x4 bgr[16];
#pragma unroll
    for (int t = 0; t < 16; ++t) bgr[t] = *(const u32x4*)(BG + (size_t)(row0 + t) * D + ch);
    float w[3][8];
#pragma unroll
    for (int j = 0; j < 3; ++j) { const f32x4 a = *(const f32x4*)(F.in[I_OCW] + j * D + ch), b = *(const f32x4*)(F.in[I_OCW] + j * D + ch + 4);
        w[j][0] = a.x; w[j][1] = a.y; w[j][2] = a.z; w[j][3] = a.w; w[j][4] = b.x; w[j][5] = b.y; w[j][6] = b.z; w[j][7] = b.w; }
#pragma unroll
    for (int t = 0; t < 16; ++t) {
        float o[8];
#pragma unroll
        for (int e = 0; e < 8; ++e) o[e] = 0.f;
#pragma unroll
        for (int j = 0; j < 3; ++j) { const u32x4 r = raw[t + j];
            o[0] += w[j][0] * bflo(r.x); o[1] += w[j][1] * bfhi(r.x); o[2] += w[j][2] * bflo(r.y); o[3] += w[j][3] * bfhi(r.y);
            o[4] += w[j][4] * bflo(r.z); o[5] += w[j][5] * bfhi(r.z); o[6] += w[j][6] * bflo(r.w); o[7] += w[j][7] * bfhi(r.w); }
        bf16_t* bp = BG + (size_t)(row0 + t) * D + ch;
        const u32x4 bgv = bgr[t];
        u32x4 pk; pk.x = pk2(o[0] * bflo(bgv.x), o[1] * bfhi(bgv.x)); pk.y = pk2(o[2] * bflo(bgv.y), o[3] * bfhi(bgv.y)); pk.z = pk2(o[4] * bflo(bgv.z), o[5] * bfhi(bgv.z)); pk.w = pk2(o[6] * bflo(bgv.w), o[7] * bfhi(bgv.w));
        st16_wt(bp, pk);
    }
}

__device__ __forceinline__ void final_row(Frame& F, int m) {
    f32x4* xr = (f32x4*)(F.out + (size_t)m * D) + F.lane;
    const float rs = fast_rsq(WSP(float, WS_SSQ)[3 * ML + m] * (1.f / D) + EPS);
    const f32x4* gp = (const f32x4*)F.in[I_FG] + F.lane;
#pragma unroll
    for (int j = 0; j < 4; ++j) { const f32x4 v = xr[64 * j], g = gp[64 * j]; xr[64 * j] = v * rs * g; }
}

__device__ __forceinline__ void ctx_proj_wg(Frame& F) {
    const int lane = F.lane, w = F.wave, r32 = lane & 31, hi = lane >> 5;
    const bf16_t* XB = WSP(bf16_t, WS_A1) + (size_t)ML * D;
    const bf16_t* W2 = WSP(bf16_t, WS_WIN0) + (size_t)2 * NIN0 * D;
    const float* ss = WSP(float, WS_SS0) + ML; const float* bias = WSP(float, WS_B_IN0) + (size_t)2 * NIN0;
    bf16_t* O = WSP(bf16_t, WS_BIG) + (size_t)ML * NIN0;
    LAS float* red = (LAS float*)F.lds;
    constexpr int NSTRIP = (NB * NCTX / 32) * (1536 / 96);
    for (int st = blockIdx.x; st < NSTRIP; st += (int)F.G) {
        const int rb = st >> 4, c0 = 512 + 96 * (st & 15);
        const bf16_t* ap = XB + (size_t)(32 * rb + r32) * D + 128 * w + 8 * hi;
        const bf16_t* bp = W2 + (size_t)(c0 + r32) * D + 128 * w + 8 * hi;
        bf16x8 a[8], b[3][8];
#pragma unroll
        for (int j = 0; j < 8; ++j) { a[j] = *(const bf16x8*)(ap + 16 * j);
#pragma unroll
            for (int t = 0; t < 3; ++t) b[t][j] = *(const bf16x8*)(bp + (size_t)(32 * t) * D + 16 * j); }
        f32x16 acc[3];
#pragma unroll
        for (int t = 0; t < 3; ++t) {
#pragma unroll
            for (int i = 0; i < 16; ++i) acc[t][i] = 0.f;
#pragma unroll
            for (int j = 0; j < 8; ++j) acc[t] = __builtin_amdgcn_mfma_f32_32x32x16_bf16(a[j], b[t][j], acc[t], 0, 0, 0);
#pragma unroll
            for (int i = 0; i < 16; ++i) red[((w * 3 + t) * 16 + i) * 64 + lane] = acc[t][i];
        }
        __syncthreads();
#pragma unroll
        for (int q = 0; q < 6; ++q) { const int p = w * 6 + q, t = p >> 4, i = p & 15, row = 32 * rb + crow(i, hi), col = c0 + 32 * t + r32;
            float v = 0.f;
#pragma unroll
            for (int k = 0; k < 8; ++k) v += red[((k * 3 + t) * 16 + i) * 64 + lane];
            v = v * fast_rsq(ss[row] * (1.f / D) + EPS) + bias[col];
            O[(size_t)row * NIN0 + col] = (bf16_t)f2bf(v); }
        __syncthreads();
    }
}

constexpr int PI_O = (D / 64) * (D / 32), PI_GU = (NGU / 32) * 16, PI_DN = (FF / 64) * (D / 32), PI_IN1 = (NIN1 / 32) * 16;
constexpr int PE0 = PI_O, PE1 = PE0 + PI_GU, PE2 = PE1 + PI_DN, PE3 = PE2 + PI_IN1, PE4 = PE3 + PI_O, PE5 = PE4 + PI_GU, L1_ITEMS = PE5 + PI_DN;
constexpr int PREP_SLICES = 9, PREP_PER = 1255;
__device__ __forceinline__ int prep_slice_begin(int k) { return PREP_PER * k; }
static_assert(2 * PREP_PER >= PE0 && 3 * PREP_PER >= PE1 && 4 * PREP_PER >= PE2 && 5 * PREP_PER >= PE3 && 7 * PREP_PER >= PE4 && 8 * PREP_PER >= PE5 && 9 * PREP_PER >= L1_ITEMS && PREP_PER <= 7 * 256, "prep deadlines");
__device__ __forceinline__ void prep_l1_item(Frame& F, int item) {
    LAS float* scr = (LAS float*)(F.lds + F.wave * 16384);
    const bool fold0 = item >= PE0 && item < PE1, fold_in1 = item >= PE2 && item < PE3, fold1 = item >= PE4 && item < PE5;
    if (fold0 || fold_in1 || fold1) {
        const bool gu = !fold_in1; const int l = fold0 ? 0 : 1;
        const int r = item - (fold0 ? PE0 : (fold_in1 ? PE2 : PE4)), ks = r & 15, n0 = (r >> 4) * 32;
        const int N = gu ? NGU : NIN1;
        fold_item<2>(gu ? F.in[I_WGU] + (size_t)l * D * NGU : F.in[I_OWIN], N, n0, gu ? gu_dst(n0) : in1_dst(n0), N, 64 * ks, 1.f, (gu ? F.in[I_N2G] : F.in[I_N1G]) + l * D, WSP(float, WS_MODS) + l * 3 * 6144,
                     gu ? 4096 : 1024, gu ? 3072 : 0, gu ? (l ? WSP(bf16_t, WS_WGU1) : WSP(bf16_t, WS_WGU0)) : WSP(bf16_t, WS_WIN1), gu ? (l ? WSP(float, WS_B_GU1) : WSP(float, WS_B_GU0)) : WSP(float, WS_B_IN1), scr, F.lane);
    } else {
        const int which = item < PE0 ? 0 : (item < PE2 ? 1 : (item < PE4 ? 2 : 3));
        const float* W = which == 0 ? F.in[I_EWOUT] : (which == 1 ? F.in[I_WDN] : (which == 2 ? F.in[I_OWOUT] : F.in[I_WDN] + (size_t)FF * D));
        bf16_t* WT = which == 0 ? WSP(bf16_t, WS_WOUT0) : (which == 1 ? WSP(bf16_t, WS_WDN0) : (which == 2 ? WSP(bf16_t, WS_WOUT1) : WSP(bf16_t, WS_WDN1)));
        p0_transpose_item(W, (which & 1) ? FF : D, D, WT, scr, which == 0 ? item : (which == 1 ? item - PE1 : (which == 2 ? item - PE3 : item - PE5)), F.lane);
    }
}
__device__ __forceinline__ void xcd_barrier_prep(const XcdBarrier& b, Frame& F, int slice) {
    asm volatile("s_waitcnt vmcnt(0)" ::: "memory");
    __syncthreads();
    if (F.wave == 0) {
        if (threadIdx.x == 0) {
            unsigned* bar = b.bar;
            __builtin_amdgcn_s_waitcnt(0);
            unsigned nloc = b.st[0], nx = b.st[1];
            if (nloc == 0u) { xcd_barrier_complete(bar, b.x, nloc, nx); b.st[0] = nloc; b.st[1] = nx; }
            const unsigned old = xb_add(&bar[XB_XSUB(b.x)], 1u);
            __builtin_amdgcn_fence(__ATOMIC_ACQUIRE, "agent");
            const unsigned gen = old / nloc;
            if (old + 1u == (gen + 1u) * nloc) {
                __builtin_amdgcn_fence(__ATOMIC_RELEASE, "agent");
                asm volatile("s_waitcnt vmcnt(0)" ::: "memory");
                const unsigned og = xb_add(&bar[XB_TOP], 1u);
                const unsigned tg = og / nx;
                if (og + 1u == (tg + 1u) * nx) {
#pragma unroll
                    for (unsigned j = 0; j < 16; ++j) xb_add(&bar[XB_XGEN(j)], 1u);
                } else XB_SPIN(xb_ld(&bar[XB_XGEN(b.x)]) == gen, bar);
                asm volatile("s_waitcnt vmcnt(0)" ::: "memory");
            } else {
                XB_SPIN(xb_ld(&bar[XB_XGEN(b.x)]) == gen, bar);
                asm volatile("s_waitcnt vmcnt(0)" ::: "memory");
            }
        }
    } else {
        const int w = (7 - F.wave) * (int)F.G + (int)blockIdx.x, item = prep_slice_begin(slice) + w;
        if (item < prep_slice_begin(slice + 1) && item < L1_ITEMS) prep_l1_item(F, item);
    }
    __syncthreads();
}

struct Args { const float* in[N_IN]; float* out; unsigned char* ws; int ph_lo, ph_hi; };
__global__ void __launch_bounds__(512, 2) dit_fwd(Args args) {
    extern __shared__ __attribute__((aligned(16))) unsigned char lds_raw[];
    Frame F;
    F.lds = (LAS unsigned char*)lds_raw;
    F.tid = threadIdx.x; F.lane = F.tid & 63; F.wave = __builtin_amdgcn_readfirstlane(F.tid >> 6);
    F.G = gridDim.x; F.gw = blockIdx.x * 8 + F.wave; F.NGW = F.G * 8;
#pragma unroll
    for (int i = 0; i < N_IN; ++i) F.in[i] = args.in[i];
    F.out = args.out; F.ws = args.ws;
    for (int u = F.tid; u < (LDS_BYTES - LDSCTL_OFF) / 4; u += 512) ((LAS unsigned*)(F.lds + LDSCTL_OFF))[u] = 0u;
    __syncthreads();
    volatile LAS unsigned* MISC = (volatile LAS unsigned*)(F.lds + MISC_OFF);
    XcdBarrier bar; bar.bar = (unsigned*)(F.ws + WS_CTL) + CW_BAR; bar.x = 0; bar.st = nullptr;
    const int lo = args.ph_lo, hi = args.ph_hi;
    if (hi - lo > 1) bar = xcd_barrier_post((unsigned*)(F.ws + WS_CTL) + CW_BAR, MISC + 8);
#ifdef ONLY_PHASE
#define IN(k) ((k) == ONLY_PHASE)
#else
#define IN(k) (lo <= (k) && (k) < hi)
#endif
#define SEAM(k) do { if (IN(k) && IN((k) + 1)) xcd_barrier(bar); } while (0)
#define SEAMP(k, sl) do { if (IN(k) && IN((k) + 1)) xcd_barrier_prep(bar, F, sl); } while (0)
    float* SSQ = WSP(float, WS_SSQ);
    const float* mods = WSP(float, WS_MODS);

    if (IN(0)) {
        unsigned* mt = (unsigned*)(F.ws + WS_CTL) + CW_MODS;
        for (int t = blockIdx.x; t < 192; t += F.G) {
            p0_mods_task(F, t);
            asm volatile("s_waitcnt vmcnt(0)" ::: "memory");
            __syncthreads();
            if (F.tid == 0) (void)__hip_atomic_fetch_add(mt, 1u, __ATOMIC_RELAXED, __HIP_MEMORY_SCOPE_AGENT);
        }
        phase_p0(F, 0, F.gw, F.NGW);
        if (F.tid == 0) { unsigned sp = 0; while (__hip_atomic_load(mt, __ATOMIC_RELAXED, __HIP_MEMORY_SCOPE_AGENT) < 192u) { __builtin_amdgcn_s_sleep(2); if (++sp > (1u << 22)) break; }
            __builtin_amdgcn_fence(__ATOMIC_ACQUIRE, "agent"); asm volatile("s_waitcnt vmcnt(0)" ::: "memory"); }
        __syncthreads();
        phase_p1(F, 0, F.wave * F.G + blockIdx.x, F.NGW);
    } SEAMP(0, 0);
    if (IN(2)) { for (int rep_ = 0; rep_ <= ((PROBE_REP_MASK >> 2) & 1); ++rep_) { if (rep_) xcd_barrier(bar);
        pg8::Gemm g{WSP(bf16_t, WS_A1), WSP(bf16_t, WS_WIN0), (long)NIN0 * D, (long)2 * NIN0 * D, D};
        pg8::Order S; S.init(ML / 256, NIN0 / 256, F.G, blockIdx.x);
        pg8::EpiInProj E{WSP(bf16_t, WS_BIG), WSP(float, WS_SS0), WSP(float, WS_B_IN0)};
        pg8::gemm_phase<pg8::EpiInProj, pg8::Order, true, true>(F.lds, g, S, E);
        __syncthreads();
        ctx_proj_wg(F);
    } } SEAMP(2, 1);
    if (IN(3)) { for (int rep_ = 0; rep_ <= ((PROBE_REP_MASK >> 3) & 1); ++rep_) { if (rep_) xcd_barrier(bar);
        attn_phase(F);
        __syncthreads();
        for (int t = blockIdx.x; t < 256; t += F.G) lru_pass1_wg(F, t);
        for (int t = blockIdx.x; t < 256; t += F.G) lru_pass3_wg(F, t, F.G >= 256);
    } }
    SEAMP(5, 2);
    if (IN(6)) { for (int rep_ = 0; rep_ <= ((PROBE_REP_MASK >> 6) & 1); ++rep_) { if (rep_) xcd_barrier(bar);
        pg8::Gemm g{WSP(bf16_t, WS_A2), WSP(bf16_t, WS_WOUT0), 0l, 0l, D};
        pg8::Order S; S.init(ML / 256, D / 256, F.G, blockIdx.x);
        pg8::EpiRes<false, false> E{nullptr, WSP(bf16_t, WS_A1), WSP(bf16_t, WS_A3), nullptr, mods + 2048, SSQ, (unsigned)(uintptr_t)(F.lds + 132096)};
        pg8::gemm_phase<pg8::EpiRes<false, false>, pg8::Order, true, true>(F.lds, g, S, E);
    } } SEAMP(6, 3);
    if (IN(7)) { for (int rep_ = 0; rep_ <= ((PROBE_REP_MASK >> 7) & 1); ++rep_) { if (rep_) xcd_barrier(bar);
        pg8::Gemm g{WSP(bf16_t, WS_A3), WSP(bf16_t, WS_WGU0), (long)NGU * D, 0l, D};
        pg8::Order S; S.init(ML / 256, NGU / 256, F.G, blockIdx.x);
        pg8::EpiSwiGLU E{WSP(bf16_t, WS_BIG), SSQ, WSP(float, WS_B_GU0)};
        pg8::gemm_phase<pg8::EpiSwiGLU, pg8::Order, true, true>(F.lds, g, S, E);
    } } SEAMP(7, 4);
    if (IN(8)) { for (int rep_ = 0; rep_ <= ((PROBE_REP_MASK >> 8) & 1); ++rep_) { if (rep_) xcd_barrier(bar);
        pg8::Gemm g{WSP(bf16_t, WS_BIG), WSP(bf16_t, WS_WDN0), 0l, 0l, FF};
        pg8::Order S; S.init(ML / 256, D / 256, F.G, blockIdx.x);
        pg8::EpiRes<false, false> E{nullptr, WSP(bf16_t, WS_A3), WSP(bf16_t, WS_A2), nullptr, mods + 5120, SSQ + ML, (unsigned)(uintptr_t)(F.lds + 132096)};
        pg8::gemm_phase<pg8::EpiRes<false, false>, pg8::Order, true, true>(F.lds, g, S, E);
    } } SEAMP(8, 5);
    if (IN(9)) { for (int rep_ = 0; rep_ <= ((PROBE_REP_MASK >> 9) & 1); ++rep_) { if (rep_) xcd_barrier(bar);
        pg8::Gemm g{WSP(bf16_t, WS_A2), WSP(bf16_t, WS_WIN1), (long)NIN1 * D, 0l, D};
        pg8::Order S; S.init(ML / 256, 8, F.G, blockIdx.x); S.pn_off = 4;
        pg8::EpiScIn E{WSP(bf16_t, WS_A1), WSP(bf16_t, WS_A3), SSQ + ML, WSP(float, WS_B_IN1)};
        pg8::gemm_phase<pg8::EpiScIn, pg8::Order, true, true>(F.lds, g, S, E);
    } } SEAMP(9, 6);
    if (IN(10)) { for (int rep_ = 0; rep_ <= ((PROBE_REP_MASK >> 10) & 1); ++rep_) { if (rep_) xcd_barrier(bar);
        pg8::Gemm g{WSP(bf16_t, WS_A2), WSP(bf16_t, WS_WIN1), (long)NIN1 * D, 0l, D};
        pg8::Order S; S.init(ML / 256, 4, F.G, blockIdx.x);
        pg8::EpiScGate E{WSP(bf16_t, WS_A1), WSP(bf16_t, WS_A3), SSQ + ML, WSP(float, WS_B_IN1), F.in[I_OCW]};
        pg8::gemm_phase<pg8::EpiScGate, pg8::Order, true, true>(F.lds, g, S, E);
    } } SEAMP(10, 7);
    if (IN(11)) { for (int rep_ = 0; rep_ <= ((PROBE_REP_MASK >> 11) & 1); ++rep_) { if (rep_) xcd_barrier(bar);
        pg8::Gemm g{WSP(bf16_t, WS_A1), WSP(bf16_t, WS_WOUT1), 0l, 0l, D};
        pg8::Order S; S.init(ML / 256, D / 256, F.G, blockIdx.x);
        pg8::EpiRes<false, false> E{nullptr, WSP(bf16_t, WS_A2), WSP(bf16_t, WS_A3), nullptr, mods + 3 * 6144 + 2048, SSQ + 2 * ML, (unsigned)(uintptr_t)(F.lds + 132096)};
        pg8::gemm_phase<pg8::EpiRes<false, false>, pg8::Order, true, true>(F.lds, g, S, E);
    } } SEAMP(11, 8);
    if (IN(12)) { for (int rep_ = 0; rep_ <= ((PROBE_REP_MASK >> 12) & 1); ++rep_) { if (rep_) xcd_barrier(bar);
        pg8::Gemm g{WSP(bf16_t, WS_A3), WSP(bf16_t, WS_WGU1), (long)NGU * D, 0l, D};
        pg8::Order S; S.init(ML / 256, NGU / 256, F.G, blockIdx.x);
        pg8::EpiSwiGLU E{WSP(bf16_t, WS_BIG), SSQ + 2 * ML, WSP(float, WS_B_GU1)};
        pg8::gemm_phase<pg8::EpiSwiGLU, pg8::Order, true, true>(F.lds, g, S, E);
    } } SEAM(12);
    if (IN(13)) { for (int rep_ = 0; rep_ <= ((PROBE_REP_MASK >> 13) & 1); ++rep_) { if (rep_) xcd_barrier(bar);
        pg8::Gemm g{WSP(bf16_t, WS_BIG), WSP(bf16_t, WS_WDN1), 0l, 0l, FF};
        pg8::Order S; S.init(ML / 256, D / 256, F.G, blockIdx.x);
        pg8::EpiFinal E{WSP(bf16_t, WS_A3), F.out, mods + 3 * 6144 + 5120, SSQ + 3 * ML, (unsigned*)(F.ws + WS_CTL) + CW_PCNT, F.in[I_FG], (unsigned)(uintptr_t)(F.lds + 132096)};
        pg8::gemm_phase<pg8::EpiFinal, pg8::Order, true, true>(F.lds, g, S, E);
    } }
#undef IN
#undef SEAM
#undef SEAMP
}

extern "C" void kernel_launch(void* const* d_in, const int* in_sizes, int n_in, void* d_out, int out_size, void* d_ws, size_t ws_size, hipStream_t stream) {
    static int grid = 0;
    if (grid == 0) {
        if (n_in != N_IN || in_sizes[0] != ML * D || out_size != ML * D || ws_size < WS_END) { fprintf(stderr, "kernel_launch: unexpected shapes (n_in %d, in0 %d, out %d, ws %zu)\n", n_in, n_in > 0 ? in_sizes[0] : -1, out_size, ws_size); grid = -1; return; }
        int dev = 0, cus = 0;
        if (hipGetDevice(&dev) != hipSuccess || hipDeviceGetAttribute(&cus, hipDeviceAttributeMultiprocessorCount, dev) != hipSuccess) { grid = -1; return; }
        if (hipFuncSetAttribute((const void*)dit_fwd, hipFuncAttributeMaxDynamicSharedMemorySize, LDS_BYTES) != hipSuccess) { fprintf(stderr, "kernel_launch: hipFuncSetAttribute failed\n"); grid = -1; return; }
        int per_cu = 0;
        if (hipOccupancyMaxActiveBlocksPerMultiprocessor(&per_cu, (const void*)dit_fwd, 512, LDS_BYTES) != hipSuccess || per_cu < 1) fprintf(stderr, "kernel_launch: note: occupancy query reports %d\n", per_cu);
        (void)hipGetLastError();
        grid = cus;
    }
    if (grid < 0) return;
    if (hipMemsetAsync((char*)d_ws + WS_CTL, 0, CTL_ZERO_BYTES, stream) != hipSuccess) { fprintf(stderr, "kernel_launch: memset failed\n"); return; }
    Args a{};
    for (int i = 0; i < N_IN; ++i) a.in[i] = (const float*)d_in[i];
    a.out = (float*)d_out; a.ws = (unsigned char*)d_ws;
    constexpr int NPH = 14;
#if MK_PER_PHASE
    for (int p = 0; p < NPH; ++p) { a.ph_lo = p; a.ph_hi = p + 1; hipLaunchKernelGGL(dit_fwd, dim3(grid), dim3(512), LDS_BYTES, stream, a); }
#else
    a.ph_lo = 0; a.ph_hi = NPH;
    hipLaunchKernelGGL(dit_fwd, dim3(grid), dim3(512), LDS_BYTES, stream, a);
#endif
    const hipError_t le = hipPeekAtLastError();
    if (le != hipSuccess) fprintf(stderr, "kernel_launch: launch failed: %s\n", hipGetErrorName(le));
}
```
